# Optimizing an MI355X kernel written in HIP

```python
import jax, jax.numpy as jnp
from jax import lax
import numpy as np

D_MODEL = 1024
BATCH = 8
SEQ = 2048
DEPTH = 1

CHUNK = 64
D_MIX = D_MODEL
D_POOL = D_MIX // 2
POOL_WINDOWS = (2, 4, 8, 16)
N_POOL_GROUPS = len(POOL_WINDOWS)
POOL_GROUP = D_POOL // N_POOL_GROUPS
D_RWKV = D_MIX - D_POOL
RWKV_HEAD = 64
N_RWKV_HEADS = D_RWKV // RWKV_HEAD
DECAY_LORA = 64
AAA_LORA = 64
D_SHIFT = 3 * D_RWKV + DECAY_LORA + AAA_LORA
D_IN = 2 * D_POOL + D_SHIFT + D_RWKV
NORM_EPS = 1e-6
GN_EPS = 64e-5

kernel_name = "hybrid_pool_rwkv7_block"


def rmsnorm(x, gain):
    x32 = x.astype(jnp.float32)
    inv = lax.rsqrt(jnp.mean(x32 * x32, axis=-1, keepdims=True) + NORM_EPS)
    return (x32 * inv * gain.astype(jnp.float32)).astype(x.dtype)


def multi_scale_pool(u, pool_w, pool_scale):
    B, S, _ = u.shape
    u32 = u.astype(jnp.float32).reshape(B, S, N_POOL_GROUPS, POOL_GROUP)
    cs = jnp.cumsum(u32, axis=1)
    cs0 = jnp.concatenate([jnp.zeros_like(cs[:, :1]), cs], axis=1)
    pos = jnp.arange(S)
    outs = []
    for g, w in enumerate(POOL_WINDOWS):
        hi = cs[:, :, g]
        lo = jnp.concatenate([jnp.zeros((B, w - 1, POOL_GROUP), jnp.float32),
                              cs0[:, :S + 1 - w, g]], axis=1)
        cnt = jnp.minimum(pos + 1, w).astype(jnp.float32)[None, :, None]
        outs.append((hi - lo) / cnt - u32[:, :, g])
    pooled = jnp.stack(outs, axis=2)
    mixed = jnp.einsum('bsgc,gcd->bsgd', pooled, pool_w.astype(jnp.float32))
    return (mixed.reshape(B, S, D_POOL) * pool_scale.astype(jnp.float32)).astype(u.dtype)


def rwkv7_time_mix(feat, w0, w_up, a0, a_up, k_k, k_a, r_k, gn_gain, gn_bias):
    B, S, _ = feat.shape
    H, N = N_RWKV_HEADS, RWKV_HEAD
    f = feat.astype(jnp.float32)
    r = f[..., :D_RWKV]
    k = f[..., D_RWKV:2 * D_RWKV]
    v = f[..., 2 * D_RWKV:3 * D_RWKV]
    w_lr = f[..., 3 * D_RWKV:3 * D_RWKV + DECAY_LORA]
    a_lr = f[..., 3 * D_RWKV + DECAY_LORA:]
    ww = w0.astype(jnp.float32) + jnp.tanh(w_lr) @ w_up.astype(jnp.float32)
    decay = jnp.exp(-jnp.exp(-jax.nn.softplus(-ww) - 0.5))
    a = jax.nn.sigmoid(a0.astype(jnp.float32) + a_lr @ a_up.astype(jnp.float32))
    heads = lambda t: t.reshape(B, S, H, N)
    kk = heads(k * k_k.astype(jnp.float32))
    kk = kk / jnp.maximum(jnp.sqrt(jnp.sum(kk * kk, axis=-1, keepdims=True)), 1e-12)
    k = k * (1.0 + (a - 1.0) * k_a.astype(jnp.float32))
    r, k, v, decay, a = heads(r), heads(k), heads(v), heads(decay), heads(a)

    def step(state, inp):
        r_t, k_t, v_t, w_t, kk_t, a_t = inp
        sa = jnp.einsum('bhvk,bhk->bhv', state, -kk_t)
        state = (state * w_t[:, :, None, :]
                 + sa[..., None] * (kk_t * a_t)[:, :, None, :]
                 + v_t[..., None] * k_t[:, :, None, :])
        y_t = jnp.einsum('bhvk,bhk->bhv', state, r_t)
        return state, y_t

    tm = lambda t: jnp.moveaxis(t, 1, 0)
    state0 = jnp.zeros((B, H, N, N), jnp.float32)
    _, y = lax.scan(step, state0, (tm(r), tm(k), tm(v), tm(decay), tm(kk), tm(a)))
    y = jnp.moveaxis(y, 0, 1)
    mu = jnp.mean(y, axis=-1, keepdims=True)
    var = jnp.mean(jnp.square(y - mu), axis=-1, keepdims=True)
    y = (y - mu) * lax.rsqrt(var + GN_EPS)
    y = y * gn_gain.astype(jnp.float32).reshape(H, N) + gn_bias.astype(jnp.float32).reshape(H, N)
    bonus = jnp.sum(r * k * r_k.astype(jnp.float32), axis=-1, keepdims=True) * v
    return (y + bonus).reshape(B, S, D_RWKV)


def setup_inputs(seed: int = 0) -> dict:
    key = jax.random.key(seed)
    ks = jax.random.split(key, 20)
    f32 = jnp.float32
    nrm = lambda k, shape, s: jax.random.normal(k, shape, f32) * s
    x = jax.random.normal(ks[0], (BATCH, SEQ, D_MODEL), f32)
    norm_gain = 1.0 + nrm(ks[1], (DEPTH, D_MODEL), 0.05)
    w_in = nrm(ks[2], (DEPTH, D_MODEL, D_IN), D_MODEL ** -0.5)
    pool_w = nrm(ks[3], (DEPTH, N_POOL_GROUPS, POOL_GROUP, POOL_GROUP), POOL_GROUP ** -0.5)
    pool_scale = 1.0 + nrm(ks[4], (DEPTH, D_POOL), 0.05)
    shift_mu = jax.random.uniform(ks[5], (DEPTH, D_SHIFT), f32, 0.0, 1.0)
    w0 = jax.random.uniform(ks[6], (DEPTH, D_RWKV), f32, -4.0, 2.0)
    w_up = nrm(ks[7], (DEPTH, DECAY_LORA, D_RWKV), 0.1)
    a0 = nrm(ks[8], (DEPTH, D_RWKV), 0.1)
    a_up = nrm(ks[9], (DEPTH, AAA_LORA, D_RWKV), 0.5 * AAA_LORA ** -0.5)
    k_k = 0.85 + nrm(ks[10], (DEPTH, D_RWKV), 0.05)
    k_a = 1.0 + nrm(ks[11], (DEPTH, D_RWKV), 0.05)
    r_k = nrm(ks[12], (DEPTH, N_RWKV_HEADS, RWKV_HEAD), 0.1)
    gn_gain = 1.0 + nrm(ks[13], (DEPTH, D_RWKV), 0.05)
    gn_bias = nrm(ks[14], (DEPTH, D_RWKV), 0.02)
    w_out = nrm(ks[15], (DEPTH, D_MIX, D_MODEL), D_MIX ** -0.5)
    final_gain = 1.0 + nrm(ks[16], (D_MODEL,), 0.05)
    return {"x": x, "norm_gain": norm_gain, "w_in": w_in, "pool_w": pool_w,
            "pool_scale": pool_scale, "shift_mu": shift_mu, "w0": w0, "w_up": w_up,
            "a0": a0, "a_up": a_up, "k_k": k_k, "k_a": k_a, "r_k": r_k,
            "gn_gain": gn_gain, "gn_bias": gn_bias, "w_out": w_out, "final_gain": final_gain}


def reference(x, norm_gain, w_in, pool_w, pool_scale, shift_mu, w0, w_up, a0, a_up,
              k_k, k_a, r_k, gn_gain, gn_bias, w_out, final_gain):
    for l in range(DEPTH):
        h = rmsnorm(x, norm_gain[l])
        z = h @ w_in[l]
        u_a = z[..., :D_POOL]
        g_a = z[..., D_POOL:2 * D_POOL]
        sh = z[..., 2 * D_POOL:2 * D_POOL + D_SHIFT]
        g_b = z[..., 2 * D_POOL + D_SHIFT:]
        sh_prev = jnp.pad(sh, ((0, 0), (1, 0), (0, 0)))[:, :-1]
        sh = sh + shift_mu[l] * (sh_prev - sh)
        y_a = multi_scale_pool(u_a, pool_w[l], pool_scale[l])
        y_b = rwkv7_time_mix(sh, w0[l], w_up[l], a0[l], a_up[l], k_k[l], k_a[l],
                             r_k[l], gn_gain[l], gn_bias[l]).astype(x.dtype)
        y = jnp.concatenate([y_a * jax.nn.silu(g_a), y_b * jax.nn.silu(g_b)], axis=-1)
        x = x + y @ w_out[l]
    return rmsnorm(x, final_gain)
```

```cpp
#include <hip/hip_runtime.h>
#include <stdint.h>
#include <cstdio>

typedef unsigned short u16;
typedef short bf16x8 __attribute__((ext_vector_type(8)));
typedef float f32x4 __attribute__((ext_vector_type(4)));
typedef float f32x2 __attribute__((ext_vector_type(2)));
typedef unsigned u32x2 __attribute__((ext_vector_type(2)));
typedef unsigned u32x4 __attribute__((ext_vector_type(4)));

#ifndef PROBE_DUP
#define PROBE_DUP -1
#endif
#ifndef N_LAUNCHES
#define N_LAUNCHES 1
#endif

constexpr int NTOK = 16384, DM = 1024, SEQ = 2048, DIN = 3200, DINP = 3328;
constexpr int NPH = 5;
constexpr int LDS_BYTES = 18432 + 8 * 17408;

constexpr size_t WS_CTL = 0;
constexpr size_t WS_WINT = 16384;
constexpr size_t WS_WOUTT = WS_WINT + (size_t)DINP * 1024 * 2;
constexpr size_t WS_WUPT = WS_WOUTT + (size_t)1024 * 1024 * 2;
constexpr size_t WS_AUPT = WS_WUPT + 512 * 64 * 2;
constexpr size_t WS_POOLT = WS_AUPT + 512 * 64 * 2;
constexpr size_t WS_Z = WS_POOLT + 4 * 128 * 128 * 2;
constexpr size_t WS_REC = WS_Z + (size_t)NTOK * DIN * 2;
constexpr size_t WS_Y = WS_REC + (size_t)64 * 2048 * 896;
constexpr size_t WS_BONUS = WS_Y + (size_t)NTOK * 1024 * 2;
constexpr size_t WS_PART = WS_BONUS + (size_t)64 * 2048 * 4;
constexpr size_t WS_END = WS_PART + (size_t)64 * 4 * 256 * 4;
constexpr int CTL_CNT_WORD = 3584;
constexpr int NUNIT = 64 * 128;
constexpr size_t CH_AF = WS_REC;
constexpr size_t CH_RF = CH_AF + (size_t)NUNIT * 2048;
constexpr size_t CH_BKF = CH_RF + (size_t)NUNIT * 2048;
constexpr size_t CH_ARB = CH_BKF + (size_t)NUNIT * 4096;
constexpr size_t CH_G15 = CH_ARB + (size_t)NUNIT * 512;
constexpr size_t CH_END = CH_G15 + (size_t)NUNIT * 256;
constexpr size_t WS_VB = CH_END;
static_assert(WS_VB + (size_t)NTOK * 512 * 2 <= WS_Y, "chunk operands + v must fit in the record region");
constexpr size_t OUT_CHV = 0;
constexpr size_t OUT_GB = (size_t)NUNIT * 4 * 3 * 512;
static_assert(OUT_GB + (size_t)NTOK * 512 * 2 <= (size_t)NTOK * DM * 4, "d_out scratch");

struct Params {
    const float* x; const float* norm_gain; const float* w_in; const float* pool_w; const float* pool_scale;
    const float* shift_mu; const float* w0; const float* w_up; const float* a0; const float* a_up;
    const float* k_k; const float* k_a; const float* r_k; const float* gn_gain; const float* gn_bias;
    const float* w_out; const float* final_gain;
    float* out; unsigned char* ws;
    int ph_lo, ph_hi, dup_n, pad;
};

extern __shared__ __attribute__((aligned(16))) unsigned char dyn_smem[];

__device__ __forceinline__ float bf2f(u16 v) { return __uint_as_float(((unsigned)v) << 16); }
__device__ __forceinline__ float bflo(unsigned v) { return __uint_as_float(v << 16); }
__device__ __forceinline__ float bfhi(unsigned v) { return __uint_as_float(v & 0xffff0000u); }
typedef __bf16 bf16x2_t __attribute__((ext_vector_type(2)));
__device__ __forceinline__ unsigned pack2(float lo, float hi) { bf16x2_t v = {(__bf16)lo, (__bf16)hi}; return __builtin_bit_cast(unsigned, v); }
__device__ __forceinline__ u16 f2bf(float f) { return (u16)(pack2(f, 0.f) & 0xffffu); }
__device__ __forceinline__ float wave_sum(float v) {
#pragma unroll
    for (int m = 32; m >= 1; m >>= 1) v += __shfl_xor(v, m, 64);
    return v;
}
__device__ __forceinline__ float rcp_(float v) { return __builtin_amdgcn_rcpf(v); }
__device__ __forceinline__ float rsq_(float v) { return __builtin_amdgcn_rsqf(v); }
__device__ __forceinline__ float sigmoidf_(float v) { return rcp_(1.f + __expf(-v)); }
__device__ __forceinline__ float tanhf_(float v) { return 1.f - 2.f * rcp_(1.f + __expf(2.f * v)); }

#define XB_TMO      128
#define XB_XCNT(j)  (256  + 64 * (j))
#define XB_XSUB(j)  (1280 + 64 * (j))
#define XB_XGEN(j)  (2304 + 64 * (j))
#define XB_TOP      3328
#define XB_TOPGEN   3392
#define XCD_BAR_WORDS 3456
#define XB_SPIN_CAP (1u << 22)
#define LAS __attribute__((address_space(3)))

__device__ __forceinline__ unsigned xb_ld(unsigned* p)              { return __hip_atomic_load(p, __ATOMIC_RELAXED, __HIP_MEMORY_SCOPE_AGENT); }
__device__ __forceinline__ unsigned xb_add(unsigned* p, unsigned v) { return __hip_atomic_fetch_add(p, v, __ATOMIC_RELAXED, __HIP_MEMORY_SCOPE_AGENT); }
__device__ __forceinline__ unsigned xb_xcc_id() { return (unsigned)__builtin_amdgcn_s_getreg((3 << 11) | 20) & 0xFu; }
#define XB_SPIN(cond, bar) do { unsigned _sp = 0; while (cond) { __builtin_amdgcn_s_sleep(1); \
    if ((++_sp & 255u) == 0u) { if (xb_ld(&(bar)[XB_TMO])) break; if (_sp > XB_SPIN_CAP) { atomicAdd(&(bar)[XB_TMO], 1u); break; } } } } while (0)

struct XcdBarrier { unsigned* bar; unsigned x; volatile LAS unsigned* st; };

__device__ __forceinline__ XcdBarrier xcd_barrier_post(unsigned* bar, volatile LAS unsigned* st) {
    XcdBarrier b; b.bar = bar; b.x = xb_xcc_id(); b.st = st;
    if (threadIdx.x == 0) (void)xb_add(&bar[XB_XCNT(b.x)], 1u);
    return b;
}
__device__ __forceinline__ void xcd_barrier_complete(unsigned* bar, unsigned x, unsigned& nloc, unsigned& nx) {
    const unsigned G = gridDim.x * gridDim.y * gridDim.z;
    unsigned sum, cnt, mine, sp = 0u;
    for (;;) {
        sum = 0u; cnt = 0u; mine = 0u;
#pragma unroll
        for (unsigned j = 0; j < 16; ++j) { const unsigned c = xb_ld(&bar[XB_XCNT(j)]); sum += c; cnt += (c > 0u) ? 1u : 0u; mine = (j == x) ? c : mine; }
        if (sum == G) break;
        __builtin_amdgcn_s_sleep(1);
        if ((++sp & 255u) == 0u) { if (xb_ld(&bar[XB_TMO])) break; if (sp > XB_SPIN_CAP) { atomicAdd(&bar[XB_TMO], 1u); break; } }
    }
    nloc = mine > 0u ? mine : 1u; nx = cnt > 0u ? cnt : 1u;
}
__device__ __forceinline__ void xcd_barrier(const XcdBarrier& b) {
    asm volatile("s_waitcnt vmcnt(0)" ::: "memory");
    __syncthreads();
    if (threadIdx.x == 0) {
        unsigned* bar = b.bar;
        __builtin_amdgcn_s_waitcnt(0);
        unsigned nloc = b.st[0], nx = b.st[1];
        if (nloc == 0u) { xcd_barrier_complete(bar, b.x, nloc, nx); b.st[0] = nloc; b.st[1] = nx; }
        const unsigned old = xb_add(&bar[XB_XSUB(b.x)], 1u);
        const unsigned gen = old / nloc;
        if (old + 1u == (gen + 1u) * nloc) {
            __builtin_amdgcn_fence(__ATOMIC_RELEASE, "agent");
            asm volatile("s_waitcnt vmcnt(0)" ::: "memory");
            const unsigned og = xb_add(&bar[XB_TOP], 1u);
            const unsigned tg = og / nx;
            if (og + 1u == (tg + 1u) * nx) xb_add(&bar[XB_TOPGEN], 1u);
            else XB_SPIN(xb_ld(&bar[XB_TOPGEN]) == tg, bar);
            __builtin_amdgcn_fence(__ATOMIC_ACQUIRE, "agent");
            xb_add(&bar[XB_XGEN(b.x)], 1u);
            asm volatile("s_waitcnt vmcnt(0)" ::: "memory");
        } else {
            XB_SPIN(xb_ld(&bar[XB_XGEN(b.x)]) == gen, bar);
            __builtin_amdgcn_fence(__ATOMIC_ACQUIRE, "agent");
            asm volatile("s_waitcnt vmcnt(0)" ::: "memory");
        }
    }
    __syncthreads();
}

constexpr int BM = 256, BK = 64, HALF = 128, HTB = HALF * BK * 2, STAGE_BYTES = 8 * HTB, NXCD = 8, WGM = 8;
__device__ __forceinline__ int lds_byte(int r, int c) { const int st = (r >> 4) * 2 + (c >> 5), rr = r & 15, cc = c & 31, ob = rr * 64 + cc * 2; return st * 1024 + (ob ^ (((ob >> 9) & 1) << 5)); }
__device__ __forceinline__ void stage_rc(int b, int& R, int& C) { const int st = b / 1024, sb = b % 1024, swz = sb ^ (((sb >> 9) & 1) << 5); R = (st >> 1) * 16 + swz / 64; C = (st & 1) * 32 + (swz % 64) / 2; }
__device__ __forceinline__ int perm32(int rho) { const int n = rho >> 4, i = rho & 15; return 8 * (i >> 2) + 4 * n + (i & 3); }

struct Unit { int pm, pn; };
struct Gemm { const u16* A; const u16* Bt; int M, N, K, Nvalid; };
struct StaticOrder {
    int nM, nN, nwg, G, c;
    __device__ void init(int M, int N, int G_, int c_) { nM = M / BM; nN = N / BM; nwg = nM * nN; G = G_; c = c_; }
    __device__ bool next(int i, Unit& u) const {
        const long L = (long)i * G + c; if (L >= nwg) return false;
        int wgid = (int)L; { const int q = nwg / NXCD, r = nwg % NXCD, xcd = wgid % NXCD, off = wgid / NXCD; wgid = (xcd < r ? xcd * (q + 1) : r * (q + 1) + (xcd - r) * q) + off; }
        const int nig = WGM * nN, gid = wgid / nig, fm = gid * WGM, gsz = (nM - fm) < WGM ? (nM - fm) : WGM;
        u.pm = fm + ((wgid % nig) % gsz); u.pn = (wgid % nig) / gsz; return true;
    }
};
struct EpiZ {
    static constexpr bool PERM = true, AFTER_DRAIN = false;
    u16* Z;
    __device__ __forceinline__ void operator()(const f32x4 (&acc)[2][2][4][2], const Unit& u, int wr, int wc, int fr, int fq) const {
        const int row0 = u.pm * BM + wr * 64 + fr, col0 = u.pn * BM + wc * 32 + 8 * fq;
#pragma unroll
        for (int ai = 0; ai < 2; ++ai)
#pragma unroll
            for (int m = 0; m < 4; ++m) { u16* rowp = Z + (size_t)(row0 + ai * HALF + m * 16) * DIN;
#pragma unroll
                for (int bj = 0; bj < 2; ++bj) { const int col = col0 + bj * HALF; const f32x4 v0 = acc[ai][bj][m][0], v1 = acc[ai][bj][m][1];
                    if (col < DIN) *(u32x4*)(rowp + col) = (u32x4){pack2(v0[0], v0[1]), pack2(v0[2], v0[3]), pack2(v1[0], v1[1]), pack2(v1[2], v1[3])}; } }
    }
};
struct EpiRes {
    static constexpr bool PERM = false, AFTER_DRAIN = false;
    const float* x; float* out;
    __device__ __forceinline__ void operator()(const f32x4 (&acc)[2][2][4][2], const Unit& u, int wr, int wc, int fr, int fq) const {
        const int row0 = u.pm * BM + wr * 64 + fr, col0 = u.pn * BM + wc * 32 + 4 * fq;
#pragma unroll
        for (int ai = 0; ai < 2; ++ai)
#pragma unroll
            for (int m = 0; m < 4; ++m) { const size_t ro = (size_t)(row0 + ai * HALF + m * 16) * DM + col0;
#pragma unroll
                for (int bj = 0; bj < 2; ++bj)
#pragma unroll
                    for (int n = 0; n < 2; ++n) { const f32x4 xv = *(const f32x4*)(x + ro + bj * HALF + n * 16); *(f32x4*)(out + ro + bj * HALF + n * 16) = xv + acc[ai][bj][m][n]; } }
    }
};
struct EpiResNorm {
    static constexpr bool PERM = false, AFTER_DRAIN = true;
    const float* x; const float* gain; float* out; float* part; unsigned* cnt;
    __device__ __forceinline__ void fused(f32x4 (&acc)[2][2][4][2], const Unit& u, int wr, int wc, int fr, int fq, LAS unsigned char* lds) const {
        const int row0 = u.pm * BM + wr * 64 + fr, col0 = u.pn * BM + wc * 32 + 4 * fq;
        LAS float* red = (LAS float*)lds;
        LAS float* tot = red + 1024;
        float rs[2][4];
#pragma unroll
        for (int ai = 0; ai < 2; ++ai)
#pragma unroll
            for (int m = 0; m < 4; ++m) { const size_t ro = (size_t)(row0 + ai * HALF + m * 16) * DM + col0; float s = 0.f;
#pragma unroll
                for (int bj = 0; bj < 2; ++bj)
#pragma unroll
                    for (int n = 0; n < 2; ++n) { const f32x4 v = *(const f32x4*)(x + ro + bj * HALF + n * 16) + acc[ai][bj][m][n]; acc[ai][bj][m][n] = v; s += v[0] * v[0] + v[1] * v[1] + v[2] * v[2] + v[3] * v[3]; }
                s += __shfl_xor(s, 16, 64); s += __shfl_xor(s, 32, 64);
                rs[ai][m] = s; }
        if (fq == 0) {
#pragma unroll
            for (int ai = 0; ai < 2; ++ai)
#pragma unroll
                for (int m = 0; m < 4; ++m) red[((wr * 4 + wc) * 8 + ai * 4 + m) * 16 + fr] = rs[ai][m];
        }
        __syncthreads();
        if (threadIdx.x < 256) {
            const int rl = threadIdx.x, ai = rl >> 7, wr_ = (rl >> 6) & 1, m = (rl >> 4) & 3, fr_ = rl & 15;
            const int o = ((wr_ * 4) * 8 + ai * 4 + m) * 16 + fr_;
            const float s = red[o] + red[o + 128] + red[o + 256] + red[o + 384];
            __hip_atomic_store(part + ((size_t)u.pm * 4 + u.pn) * 256 + rl, s, __ATOMIC_RELAXED, __HIP_MEMORY_SCOPE_AGENT);
        }
        asm volatile("s_waitcnt vmcnt(0)" ::: "memory");
        __syncthreads();
        if (threadIdx.x == 0) {
            __builtin_amdgcn_fence(__ATOMIC_RELEASE, "agent");
            asm volatile("s_waitcnt vmcnt(0)" ::: "memory");
            __hip_atomic_fetch_add(cnt + u.pm, 1u, __ATOMIC_RELAXED, __HIP_MEMORY_SCOPE_AGENT);
            unsigned sp = 0;
            while (__hip_atomic_load(cnt + u.pm, __ATOMIC_RELAXED, __HIP_MEMORY_SCOPE_AGENT) < 4u) { __builtin_amdgcn_s_sleep(1); if (++sp > (1u << 24)) break; }
            __builtin_amdgcn_fence(__ATOMIC_ACQUIRE, "agent");
            asm volatile("s_waitcnt vmcnt(0)" ::: "memory");
        }
        __syncthreads();
        for (int e = threadIdx.x; e < 1024; e += 512) tot[e] = __hip_atomic_load(part + (size_t)u.pm * 1024 + e, __ATOMIC_RELAXED, __HIP_MEMORY_SCOPE_AGENT);
        __syncthreads();
#pragma unroll
        for (int ai = 0; ai < 2; ++ai)
#pragma unroll
            for (int m = 0; m < 4; ++m) { const int rl = ai * 128 + wr * 64 + m * 16 + fr;
                const float inv = rsq_((tot[rl] + tot[256 + rl] + tot[512 + rl] + tot[768 + rl]) * (1.f / 1024.f) + 1e-6f);
                const size_t ro = (size_t)(row0 + ai * HALF + m * 16) * DM + col0;
#pragma unroll
                for (int bj = 0; bj < 2; ++bj)
#pragma unroll
                    for (int n = 0; n < 2; ++n) { const f32x4 g = *(const f32x4*)(gain + col0 + bj * HALF + n * 16); *(f32x4*)(out + ro + bj * HALF + n * 16) = acc[ai][bj][m][n] * inv * g; } }
    }
};

template <class Epi, class Sched>
__device__ __forceinline__ void gemm_phase(LAS unsigned char* lds, const Gemm g, const Sched& S, const Epi& E) {
    const int tid = threadIdx.x, wid = __builtin_amdgcn_readfirstlane(tid >> 6), lane = tid & 63, wr = wid >> 2, wc = wid & 3, fr = lane & 15, fq = lane >> 4;
    const int K = g.K, nt = K / BK;
    unsigned voffA[2], voffB[2];
#pragma unroll
    for (int i = 0; i < 2; ++i) { int R, C; stage_rc(tid * 16 + i * 8192, R, C); const int Rb = Epi::PERM ? ((R & ~31) + perm32(R & 31)) : R;
        voffA[i] = (unsigned)(R * K + C) * 2u; voffB[i] = (unsigned)(Rb * K + C) * 2u; }
    const size_t kstep = (size_t)(BK * 2);
    const size_t hstep = (size_t)HALF * K * 2;
    const size_t tstep = 2 * hstep;
    const unsigned ldsw = (unsigned)wid * 1024u;
    const int aoff = lds_byte(wr * 64 + fr, fq * 8), boff = lds_byte(wc * 32 + fr, fq * 8);
#define PG8_SA(b, h) (((b) * 2 + (h)) * HTB)
#define PG8_SB(b, h) ((4 + (b) * 2 + (h)) * HTB)
#define PG8_STAGE(bufoff, gbase, voff) do { _Pragma("unroll") for (int _i = 0; _i < 2; ++_i) \
        __builtin_amdgcn_global_load_lds((const unsigned*)((const char*)(gbase) + (voff)[_i]), (LAS unsigned*)(lds + (bufoff) + ldsw + _i * 8192), 16, 0, 0); } while (0)
#define PG8_LDA(dst, b, h) do { _Pragma("unroll") for (int m = 0; m < 4; ++m) _Pragma("unroll") for (int k = 0; k < 2; ++k) dst[m][k] = *(const LAS bf16x8*)(lds + PG8_SA(b, h) + aoff + m * 2048 + k * 1024); } while (0)
#define PG8_LDB(dst, b, h) do { _Pragma("unroll") for (int n = 0; n < 2; ++n) _Pragma("unroll") for (int k = 0; k < 2; ++k) dst[n][k] = *(const LAS bf16x8*)(lds + PG8_SB(b, h) + boff + n * 2048 + k * 1024); } while (0)
#define PG8_MMA(ai, bj, At, Bt) do { __builtin_amdgcn_s_setprio(1); _Pragma("unroll") for (int m = 0; m < 4; ++m) _Pragma("unroll") for (int n = 0; n < 2; ++n) _Pragma("unroll") for (int k = 0; k < 2; ++k) \
        acc[ai][bj][m][n] = __builtin_amdgcn_mfma_f32_16x16x32_bf16(Bt[n][k], At[m][k], acc[ai][bj][m][n], 0, 0, 0); __builtin_amdgcn_s_setprio(0); } while (0)
#define PG8_WAIT_V(n) asm volatile("s_waitcnt vmcnt(" #n ")" ::: "memory")
#define PG8_WAIT_L(n) asm volatile("s_waitcnt lgkmcnt(" #n ")" ::: "memory")
#define PG8_BAR __builtin_amdgcn_s_barrier()
#define PG8_SCHED __builtin_amdgcn_sched_barrier(0)
    Unit cur, nxt; int ui = 0;
    if (!S.next(0, cur)) return;
    f32x4 acc[2][2][4][2];
#pragma unroll
    for (int a = 0; a < 2; ++a)
#pragma unroll
        for (int b = 0; b < 2; ++b)
#pragma unroll
            for (int m = 0; m < 4; ++m)
#pragma unroll
                for (int n = 0; n < 2; ++n) acc[a][b][m][n] = (f32x4){0.f, 0.f, 0.f, 0.f};
    bf16x8 At[4][2], B0[2][2], B1[2][2];
    const char* cA = (const char*)g.A + (size_t)cur.pm * tstep; const char* cB = (const char*)g.Bt + (size_t)cur.pn * tstep;
    PG8_STAGE(PG8_SB(0, 0), cB, voffB); PG8_STAGE(PG8_SA(0, 0), cA, voffA); PG8_STAGE(PG8_SB(0, 1), cB + hstep, voffB); PG8_STAGE(PG8_SA(0, 1), cA + hstep, voffA);
    if (wr == 1) PG8_BAR;
    PG8_WAIT_V(4); PG8_BAR;
    PG8_STAGE(PG8_SB(1, 0), cB + kstep, voffB); PG8_STAGE(PG8_SA(1, 0), cA + kstep, voffA); PG8_STAGE(PG8_SB(1, 1), cB + hstep + kstep, voffB);
    PG8_WAIT_V(6); PG8_BAR;
    for (;;) {
        const bool has_next = S.next(ui + 1, nxt);
        const char* nA = has_next ? (const char*)g.A + (size_t)nxt.pm * tstep : cA; const char* nB = has_next ? (const char*)g.Bt + (size_t)nxt.pn * tstep : cB;
        const bool rhalf = (cur.pn * BM + HALF) < g.Nvalid;
        for (int t = 0; t < nt; t += 2) {
            const bool last = (t == nt - 2);
            const char* a1 = cA + (size_t)(t + 1) * kstep;
            const char* a2 = last ? nA : cA + (size_t)(t + 2) * kstep; const char* b2 = last ? nB : cB + (size_t)(t + 2) * kstep;
            const char* a3 = a2 + kstep; const char* b3 = b2 + kstep;
            PG8_LDB(B0, 0, 0); PG8_SCHED; PG8_LDA(At, 0, 0); PG8_STAGE(PG8_SA(1, 1), a1 + hstep, voffA);
            PG8_WAIT_L(8); PG8_BAR; PG8_WAIT_L(0); PG8_MMA(0, 0, At, B0); PG8_BAR; PG8_SCHED;
            PG8_LDB(B1, 0, 1); PG8_STAGE(PG8_SB(0, 0), b2, voffB);
            PG8_BAR; PG8_WAIT_L(0); if (rhalf) PG8_MMA(0, 1, At, B1); PG8_BAR;
            PG8_LDA(At, 0, 1); PG8_STAGE(PG8_SA(0, 0), a2, voffA);
            PG8_BAR; PG8_WAIT_L(0); PG8_MMA(1, 0, At, B0); PG8_BAR; PG8_SCHED;
            PG8_STAGE(PG8_SB(0, 1), b2 + hstep, voffB);
            PG8_WAIT_V(6); PG8_BAR; if (rhalf) PG8_MMA(1, 1, At, B1); PG8_BAR;
            PG8_LDB(B0, 1, 0); PG8_SCHED; PG8_LDA(At, 1, 0); PG8_STAGE(PG8_SA(0, 1), a2 + hstep, voffA);
            PG8_WAIT_L(8); PG8_BAR; PG8_WAIT_L(0); PG8_MMA(0, 0, At, B0); PG8_BAR; PG8_SCHED;
            PG8_LDB(B1, 1, 1); PG8_STAGE(PG8_SB(1, 0), b3, voffB);
            PG8_BAR; PG8_WAIT_L(0); if (rhalf) PG8_MMA(0, 1, At, B1); PG8_BAR;
            PG8_LDA(At, 1, 1); PG8_STAGE(PG8_SA(1, 0), a3, voffA);
            PG8_BAR; PG8_WAIT_L(0); PG8_MMA(1, 0, At, B0); PG8_BAR; PG8_SCHED;
            PG8_STAGE(PG8_SB(1, 1), b3 + hstep, voffB);
            PG8_WAIT_V(6); PG8_BAR; if (rhalf) PG8_MMA(1, 1, At, B1); PG8_BAR;
        }
        if constexpr (!Epi::AFTER_DRAIN) E(acc, cur, wr, wc, fr, fq);
        if (!has_next) break;
#pragma unroll
        for (int a = 0; a < 2; ++a)
#pragma unroll
            for (int b = 0; b < 2; ++b)
#pragma unroll
                for (int m = 0; m < 4; ++m)
#pragma unroll
                    for (int n = 0; n < 2; ++n) acc[a][b][m][n] = (f32x4){0.f, 0.f, 0.f, 0.f};
        cur = nxt; cA = nA; cB = nB; ++ui;
    }
    PG8_WAIT_V(0);
    if (wr == 0) PG8_BAR;
    PG8_BAR;
    if constexpr (Epi::AFTER_DRAIN) E.fused(acc, cur, wr, wc, fr, fq, lds);
#undef PG8_SA
#undef PG8_SB
#undef PG8_STAGE
#undef PG8_LDA
#undef PG8_LDB
#undef PG8_MMA
#undef PG8_WAIT_V
#undef PG8_WAIT_L
#undef PG8_BAR
#undef PG8_SCHED
}

__device__ void phase0(const Params& p) {
    const int tid = threadIdx.x, lane = tid & 63, wave = tid >> 6, blk = blockIdx.x;
    u16* Hbf = (u16*)p.out;
#pragma unroll 1
    for (int r0 = 0; r0 < 8; r0 += 4) {
        f32x4 v[4][4]; float ss[4];
#pragma unroll
        for (int i = 0; i < 4; ++i) {
            const f32x4* xr = (const f32x4*)(p.x + (size_t)(blk * 64 + wave * 8 + r0 + i) * DM);
#pragma unroll
            for (int q = 0; q < 4; ++q) v[i][q] = __builtin_nontemporal_load(xr + lane + 64 * q);
        }
#pragma unroll
        for (int i = 0; i < 4; ++i) {
            float s = 0.f;
#pragma unroll
            for (int q = 0; q < 4; ++q) s += v[i][q][0] * v[i][q][0] + v[i][q][1] * v[i][q][1] + v[i][q][2] * v[i][q][2] + v[i][q][3] * v[i][q][3];
            ss[i] = wave_sum(s);
        }
#pragma unroll
        for (int i = 0; i < 4; ++i) {
            const int row = blk * 64 + wave * 8 + r0 + i;
            const float inv = rsq_(ss[i] * (1.f / 1024.f) + 1e-6f);
#pragma unroll
            for (int q = 0; q < 4; ++q) {
                const f32x4 g = ((const f32x4*)p.norm_gain)[lane + 64 * q];
                u32x2 o; o.x = pack2(v[i][q][0] * inv * g[0], v[i][q][1] * inv * g[1]); o.y = pack2(v[i][q][2] * inv * g[2], v[i][q][3] * inv * g[3]);
                *(u32x2*)(Hbf + (size_t)row * DM + (lane + 64 * q) * 4) = o;
            }
        }
    }
    float* tl = (float*)dyn_smem;
    u16* WinT = (u16*)(p.ws + WS_WINT); u16* WoutT = (u16*)(p.ws + WS_WOUTT);
#pragma unroll 1
    for (int t = blk; t < 832 + 256; t += 256) {
        const float* src; u16* dst; int kt, ntile, N;
        if (t < 832) { kt = t & 15; ntile = t >> 4; src = p.w_in; N = DIN; dst = WinT; }
        else { const int t2 = t - 832; kt = t2 & 15; ntile = t2 >> 4; src = p.w_out; N = 1024; dst = WoutT; }
        const int k0 = kt * 64, n0 = ntile * 64;
        __syncthreads();
        for (int kk = wave; kk < 64; kk += 8) { const int n = n0 + lane; tl[kk * 65 + lane] = (n < N) ? src[(size_t)(k0 + kk) * N + n] : 0.f; }
        __syncthreads();
        for (int nn = wave; nn < 64; nn += 8) dst[(size_t)(n0 + nn) * 1024 + k0 + lane] = f2bf(tl[lane * 65 + nn]);
    }
    u16* WupT = (u16*)(p.ws + WS_WUPT); u16* AupT = (u16*)(p.ws + WS_AUPT); u16* PoolT = (u16*)(p.ws + WS_POOLT);
    const int gt = blk * 512 + tid;
    if (gt < 32768) { const int c = gt >> 6, j = gt & 63; WupT[gt] = f2bf(p.w_up[j * 512 + c]); AupT[gt] = f2bf(p.a_up[j * 512 + c]); }
    if (gt < 65536) { const int g = gt >> 14, d = (gt >> 7) & 127, c = gt & 127; PoolT[gt] = f2bf(p.pool_w[(g * 128 + c) * 128 + d]); }
}

__device__ void phase1(const Params& p) {
    Gemm g; g.A = (const u16*)p.out; g.Bt = (const u16*)(p.ws + WS_WINT); g.M = NTOK; g.N = DINP; g.K = 1024; g.Nvalid = DIN;
    StaticOrder S; S.init(NTOK, DINP, 256, blockIdx.x);
    EpiZ E; E.Z = (u16*)(p.ws + WS_Z);
    gemm_phase((LAS unsigned char*)dyn_smem, g, S, E);
}
__device__ void phase4(const Params& p) {
    Gemm g; g.A = (const u16*)(p.ws + WS_Y); g.Bt = (const u16*)(p.ws + WS_WOUTT); g.M = NTOK; g.N = 1024; g.K = 1024; g.Nvalid = 1024;
    StaticOrder S; S.init(NTOK, 1024, 256, blockIdx.x);
    EpiResNorm E; E.x = p.x; E.gain = p.final_gain; E.out = p.out; E.part = (float*)(p.ws + WS_PART); E.cnt = (unsigned*)(p.ws + WS_CTL) + CTL_CNT_WORD;
    gemm_phase((LAS unsigned char*)dyn_smem, g, S, E);
}

template <int CTRL> __device__ __forceinline__ float dpp_add(float v) {
    const int t = __builtin_amdgcn_update_dpp(0, __float_as_int(v), CTRL, 0xf, 0xf, false);
    return v + __int_as_float(t);
}
__device__ __forceinline__ float row16_allsum(float v) {
    v = dpp_add<0x128>(v); v = dpp_add<0x124>(v); v = dpp_add<0x122>(v); v = dpp_add<0x121>(v);
    return v;
}
#define WSYNC() do { __builtin_amdgcn_wave_barrier(); asm volatile("s_waitcnt lgkmcnt(0)" ::: "memory"); __builtin_amdgcn_wave_barrier(); } while (0)
#define MFMA16(a, b, c) __builtin_amdgcn_mfma_f32_16x16x32_bf16((a), (b), (c), 0, 0, 0)
__device__ __forceinline__ bf16x8 as_bf8(u32x4 v) { return __builtin_bit_cast(bf16x8, v); }
constexpr int P2_WREG = 17408;
__device__ void phase2(const Params& p) {
    const int tid = threadIdx.x, lane = tid & 63, wave = tid >> 6, blk = blockIdx.x, fr = lane & 15, fq = lane >> 4;
    const int t0 = blk * 64, b = t0 >> 11, s0 = t0 & 2047;
    const u16* Z = (const u16*)(p.ws + WS_Z);
    u16* twb = (u16*)dyn_smem;
    u16* alb = twb + 64 * 72;
    u16* pooled = alb + 64 * 72;
    for (int e = tid; e < 64 * 128; e += 512) {
        const int tt = e >> 7, j = e & 127;
        const size_t zi = (size_t)(t0 + tt) * DIN + 2560 + j;
        const float cur = bf2f(Z[zi]);
        const float prev = (s0 + tt > 0) ? bf2f(Z[zi - DIN]) : 0.f;
        const float val = cur + p.shift_mu[1536 + j] * (prev - cur);
        if (j < 64) twb[tt * 72 + j] = f2bf(tanhf_(val)); else alb[tt * 72 + (j - 64)] = f2bf(val);
    }
    {
        const int c = tid, W = 2 << (c >> 7);
        float sum = 0.f;
        for (int i = 1; i < W; ++i) if (s0 - i >= 0) sum += bf2f(Z[(size_t)(t0 - i) * DIN + c]);
#pragma unroll 16
        for (int tt = 0; tt < 64; ++tt) {
            const int s = s0 + tt;
            const float u = bf2f(Z[(size_t)(t0 + tt) * DIN + c]);
            sum += u;
            const float cnt = (float)((s + 1 < W) ? (s + 1) : W);
            pooled[tt * 520 + c] = f2bf(sum * rcp_(cnt) - u);
            if (s + 1 >= W) sum -= bf2f(Z[(size_t)(t0 + tt - W + 1) * DIN + c]);
        }
    }
    __syncthreads();
    {
        const int g = wave >> 1, dbase = (wave & 1) * 64;
        const u16* PoolT = (const u16*)(p.ws + WS_POOLT); u16* Y = (u16*)(p.ws + WS_Y);
        f32x4 acc[4][4];
#pragma unroll
        for (int mt = 0; mt < 4; ++mt)
#pragma unroll
            for (int nt = 0; nt < 4; ++nt) acc[mt][nt] = (f32x4){0.f, 0.f, 0.f, 0.f};
#pragma unroll
        for (int ks = 0; ks < 4; ++ks) {
            bf16x8 Bf[4];
#pragma unroll
            for (int nt = 0; nt < 4; ++nt) Bf[nt] = *(const bf16x8*)(PoolT + (size_t)(g * 128 + dbase + nt * 16 + fr) * 128 + ks * 32 + fq * 8);
#pragma unroll
            for (int mt = 0; mt < 4; ++mt) {
                const bf16x8 Af = *(const bf16x8*)(pooled + (mt * 16 + fr) * 520 + g * 128 + ks * 32 + fq * 8);
#pragma unroll
                for (int nt = 0; nt < 4; ++nt) acc[mt][nt] = MFMA16(Bf[nt], Af, acc[mt][nt]);
            }
        }
#pragma unroll
        for (int mt = 0; mt < 4; ++mt) {
            const size_t T = (size_t)(t0 + mt * 16 + fr);
#pragma unroll
            for (int nt = 0; nt < 4; ++nt) {
                const int ch = g * 128 + dbase + nt * 16 + fq * 4;
                const u32x2 ga = *(const u32x2*)(Z + T * DIN + 512 + ch);
                const f32x4 ps = *(const f32x4*)(p.pool_scale + ch);
                const f32x4 gv = (f32x4){bflo(ga.x), bfhi(ga.x), bflo(ga.y), bfhi(ga.y)};
                f32x4 y;
#pragma unroll
                for (int jj = 0; jj < 4; ++jj) y[jj] = acc[mt][nt][jj] * ps[jj] * gv[jj] * sigmoidf_(gv[jj]);
                u32x2 o; o.x = pack2(y[0], y[1]); o.y = pack2(y[2], y[3]);
                *(u32x2*)(Y + T * 1024 + ch) = o;
            }
        }
    }
    {
        u16* GB = (u16*)((unsigned char*)p.out + OUT_GB);
        for (int e = tid; e < 64 * 64; e += 512) { const int tt = e >> 6, q = e & 63;
            *(u32x4*)(GB + (size_t)(t0 + tt) * 512 + q * 8) = *(const u32x4*)(Z + (size_t)(t0 + tt) * DIN + 2688 + q * 8); }
    }
    __syncthreads();
    const int h = wave, bh = b * 8 + h;
    unsigned char* WL = dyn_smem + 18432 + wave * P2_WREG;
    unsigned char* recl = WL;
    u16* AR = (u16*)WL;
    u16* BK = AR + 32 * 72;
    u16* AtT = BK + 32 * 72;
    u16* BhT = AtT + 64 * 16;
    u16* KhT = BhT + 64 * 16;
    u16* VT = KhT + 64 * 16;
    float* Pab = (float*)WL;
    u16* Tm = (u16*)(Pab + 16 * 17);
    u16* AakT = Tm + 16 * 24;
    u16* M1m = AakT + 16 * 24;
    u16* Ark = M1m + 16 * 24;
    u16* Arb = Ark + 16 * 24;
    const u16* WupT = (const u16*)(p.ws + WS_WUPT); const u16* AupT = (const u16*)(p.ws + WS_AUPT);
    float* BON = (float*)(p.ws + WS_BONUS); u16* VB = (u16*)(p.ws + WS_VB);
    unsigned char* AFg = p.ws + CH_AF; unsigned char* RFg = p.ws + CH_RF; unsigned char* BKFg = p.ws + CH_BKF; unsigned char* ARBg = p.ws + CH_ARB;
    float* G15g = (float*)(p.ws + CH_G15); unsigned char* CHVg = (unsigned char*)p.out + OUT_CHV;
    const bf16x8 zero8 = (bf16x8){0, 0, 0, 0, 0, 0, 0, 0};
    const f32x4 zero4 = (f32x4){0.f, 0.f, 0.f, 0.f};
#pragma unroll 1
    for (int mt = 0; mt < 4; ++mt) {
        const size_t u = (size_t)bh * 128 + (s0 >> 4) + mt;
        {
            f32x4 aw[4], aa[4];
#pragma unroll
            for (int nt = 0; nt < 4; ++nt) { aw[nt] = zero4; aa[nt] = zero4; }
#pragma unroll
            for (int ks = 0; ks < 2; ++ks) {
                const bf16x8 Aw = *(const bf16x8*)(twb + (mt * 16 + fr) * 72 + ks * 32 + fq * 8);
                const bf16x8 Aa = *(const bf16x8*)(alb + (mt * 16 + fr) * 72 + ks * 32 + fq * 8);
#pragma unroll
                for (int nt = 0; nt < 4; ++nt) {
                    const bf16x8 Bw = *(const bf16x8*)(WupT + (h * 64 + nt * 16 + fr) * 64 + ks * 32 + fq * 8);
                    const bf16x8 Ba = *(const bf16x8*)(AupT + (h * 64 + nt * 16 + fr) * 64 + ks * 32 + fq * 8);
                    aw[nt] = MFMA16(Bw, Aw, aw[nt]);
                    aa[nt] = MFMA16(Ba, Aa, aa[nt]);
                }
            }
            const int tt = mt * 16 + fr, s = s0 + tt; const size_t T = (size_t)(t0 + tt);
            const bool hasprev = s > 0;
            f32x4 Kr[4], Av[4];
            float n2 = 0.f, bon = 0.f;
            unsigned char* rec = recl + fr * 896;
#pragma unroll
            for (int nt = 0; nt < 4; ++nt) {
                const int cb = h * 64 + nt * 16 + fq * 4, ci = nt * 16 + fq * 4;
                const u32x2 zr = *(const u32x2*)(Z + T * DIN + 1024 + cb), zk = *(const u32x2*)(Z + T * DIN + 1536 + cb), zv = *(const u32x2*)(Z + T * DIN + 2048 + cb);
                u32x2 pr = (u32x2){0u, 0u}, pk = (u32x2){0u, 0u}, pv = (u32x2){0u, 0u};
                if (hasprev) { pr = *(const u32x2*)(Z + (T - 1) * DIN + 1024 + cb); pk = *(const u32x2*)(Z + (T - 1) * DIN + 1536 + cb); pv = *(const u32x2*)(Z + (T - 1) * DIN + 2048 + cb); }
                const f32x4 mur = *(const f32x4*)(p.shift_mu + cb), muk = *(const f32x4*)(p.shift_mu + 512 + cb), muv = *(const f32x4*)(p.shift_mu + 1024 + cb);
                const f32x4 w0v = *(const f32x4*)(p.w0 + cb), a0v = *(const f32x4*)(p.a0 + cb), kkv = *(const f32x4*)(p.k_k + cb), kav = *(const f32x4*)(p.k_a + cb), rkv = *(const f32x4*)(p.r_k + cb);
                const f32x4 cr = (f32x4){bflo(zr.x), bfhi(zr.x), bflo(zr.y), bfhi(zr.y)}, ck = (f32x4){bflo(zk.x), bfhi(zk.x), bflo(zk.y), bfhi(zk.y)}, cv = (f32x4){bflo(zv.x), bfhi(zv.x), bflo(zv.y), bfhi(zv.y)};
                const f32x4 qr = (f32x4){bflo(pr.x), bfhi(pr.x), bflo(pr.y), bfhi(pr.y)}, qk = (f32x4){bflo(pk.x), bfhi(pk.x), bflo(pk.y), bfhi(pk.y)}, qv = (f32x4){bflo(pv.x), bfhi(pv.x), bflo(pv.y), bfhi(pv.y)};
                f32x4 Rr, Kp, Vv, Dc;
#pragma unroll
                for (int jj = 0; jj < 4; ++jj) {
                    const float r = cr[jj] + mur[jj] * (qr[jj] - cr[jj]);
                    const float k = ck[jj] + muk[jj] * (qk[jj] - ck[jj]);
                    const float v = cv[jj] + muv[jj] * (qv[jj] - cv[jj]);
                    const float ww = aw[nt][jj] + w0v[jj];
                    const float a = sigmoidf_(aa[nt][jj] + a0v[jj]);
                    const float dec = __expf(-0.6065306597126334f * sigmoidf_(ww));
                    const float kr = k * kkv[jj];
                    n2 += kr * kr;
                    const float kp = k * (1.f + (a - 1.f) * kav[jj]);
                    bon += r * kp * rkv[jj];
                    Rr[jj] = r; Kp[jj] = kp; Vv[jj] = v; Kr[nt][jj] = kr; Av[nt][jj] = a; Dc[jj] = dec;
                }
                *(f32x4*)(rec + ci * 4) = Dc;
                *(u32x2*)(rec + 256 + ci * 2) = (u32x2){pack2(Rr[0], Rr[1]), pack2(Rr[2], Rr[3])};
                *(u32x2*)(rec + 384 + ci * 2) = (u32x2){pack2(Kp[0], Kp[1]), pack2(Kp[2], Kp[3])};
                const u32x2 vpk = (u32x2){pack2(Vv[0], Vv[1]), pack2(Vv[2], Vv[3])};
                *(u32x2*)(rec + 512 + ci * 2) = vpk;
                *(u32x2*)(VB + T * 512 + cb) = vpk;
            }
            n2 += __shfl_xor(n2, 16, 64); n2 += __shfl_xor(n2, 32, 64);
            bon += __shfl_xor(bon, 16, 64); bon += __shfl_xor(bon, 32, 64);
            const float inv = rsq_(fmaxf(n2, 1e-24f));
#pragma unroll
            for (int nt = 0; nt < 4; ++nt) {
                const int ci = nt * 16 + fq * 4;
                const f32x4 kk = Kr[nt] * inv;
                *(u32x2*)(rec + 640 + ci * 2) = (u32x2){pack2(kk[0], kk[1]), pack2(kk[2], kk[3])};
                const f32x4 nb = -(kk * Av[nt]);
                *(u32x2*)(rec + 768 + ci * 2) = (u32x2){pack2(nb[0], nb[1]), pack2(nb[2], nb[3])};
            }
            if (fq == 0) BON[(size_t)bh * 2048 + s] = bon;
        }
        WSYNC();
        {
            float w_[16], r_[16], kp_[16], v_[16], kk_[16], nb_[16];
#pragma unroll
            for (int t = 0; t < 16; ++t) {
                const unsigned char* rt = recl + t * 896;
                w_[t] = *(const float*)(rt + lane * 4);
                r_[t] = bf2f(*(const u16*)(rt + 256 + lane * 2)); kp_[t] = bf2f(*(const u16*)(rt + 384 + lane * 2)); v_[t] = bf2f(*(const u16*)(rt + 512 + lane * 2));
                kk_[t] = bf2f(*(const u16*)(rt + 640 + lane * 2)); nb_[t] = bf2f(*(const u16*)(rt + 768 + lane * 2));
            }
            WSYNC();
            float g = 1.f;
            float At[16], Bt[16], Kt[16];
#pragma unroll
            for (int t = 0; t < 16; ++t) {
                const float gp = g; g = g * w_[t]; const float ig = rcp_(g);
                const float a = kk_[t] * gp, rr = r_[t] * g, bb = nb_[t] * ig, kt = kp_[t] * ig;
                AR[t * 72 + lane] = f2bf(a); AR[(16 + t) * 72 + lane] = f2bf(rr); BK[t * 72 + lane] = f2bf(bb); BK[(16 + t) * 72 + lane] = f2bf(kt);
                At[t] = a; Bt[t] = bb; Kt[t] = kt;
            }
            u32x4 o0, o1;
            o0 = (u32x4){pack2(At[0], At[1]), pack2(At[2], At[3]), pack2(At[4], At[5]), pack2(At[6], At[7])};
            o1 = (u32x4){pack2(At[8], At[9]), pack2(At[10], At[11]), pack2(At[12], At[13]), pack2(At[14], At[15])};
            *(u32x4*)(AtT + lane * 16) = o0; *(u32x4*)(AtT + lane * 16 + 8) = o1;
            o0 = (u32x4){pack2(Bt[0] * g, Bt[1] * g), pack2(Bt[2] * g, Bt[3] * g), pack2(Bt[4] * g, Bt[5] * g), pack2(Bt[6] * g, Bt[7] * g)};
            o1 = (u32x4){pack2(Bt[8] * g, Bt[9] * g), pack2(Bt[10] * g, Bt[11] * g), pack2(Bt[12] * g, Bt[13] * g), pack2(Bt[14] * g, Bt[15] * g)};
            *(u32x4*)(BhT + lane * 16) = o0; *(u32x4*)(BhT + lane * 16 + 8) = o1;
            o0 = (u32x4){pack2(Kt[0] * g, Kt[1] * g), pack2(Kt[2] * g, Kt[3] * g), pack2(Kt[4] * g, Kt[5] * g), pack2(Kt[6] * g, Kt[7] * g)};
            o1 = (u32x4){pack2(Kt[8] * g, Kt[9] * g), pack2(Kt[10] * g, Kt[11] * g), pack2(Kt[12] * g, Kt[13] * g), pack2(Kt[14] * g, Kt[15] * g)};
            *(u32x4*)(KhT + lane * 16) = o0; *(u32x4*)(KhT + lane * 16 + 8) = o1;
            o0 = (u32x4){pack2(v_[0], v_[1]), pack2(v_[2], v_[3]), pack2(v_[4], v_[5]), pack2(v_[6], v_[7])};
            o1 = (u32x4){pack2(v_[8], v_[9]), pack2(v_[10], v_[11]), pack2(v_[12], v_[13]), pack2(v_[14], v_[15])};
            *(u32x4*)(VT + lane * 16) = o0; *(u32x4*)(VT + lane * 16 + 8) = o1;
            G15g[u * 64 + lane] = g;
        }
        WSYNC();
        {
            u32x2 rp[4];
#pragma unroll
            for (int ta = 0; ta < 4; ++ta) rp[ta] = *(const u32x2*)(AR + (16 + fr) * 72 + 16 * ta + 4 * fq);
            *(u32x4*)(RFg + (u * 64 + lane) * 32) = (u32x4){rp[0].x, rp[0].y, rp[1].x, rp[1].y};
            *(u32x4*)(RFg + (u * 64 + lane) * 32 + 16) = (u32x4){rp[2].x, rp[2].y, rp[3].x, rp[3].y};
#pragma unroll
            for (int ta = 0; ta < 4; ++ta) {
                const u32x2 b2 = *(const u32x2*)(BhT + (16 * ta + fr) * 16 + 4 * fq), k2 = *(const u32x2*)(KhT + (16 * ta + fr) * 16 + 4 * fq);
                *(u32x4*)(BKFg + ((u * 4 + ta) * 64 + lane) * 16) = (u32x4){b2.x, b2.y, k2.x, k2.y};
            }
#pragma unroll
            for (int sl = 0; sl < 4; ++sl) *(u32x2*)(CHVg + (((u * 4 + sl) * 3 + 2) * 64 + lane) * 8) = *(const u32x2*)(VT + (16 * sl + fr) * 16 + 4 * fq);
        }
        {
            f32x4 P00 = zero4, P01 = zero4, P10 = zero4, P11 = zero4;
#pragma unroll
            for (int s = 0; s < 2; ++s) {
                const bf16x8 a0 = *(const bf16x8*)(AR + fr * 72 + s * 32 + fq * 8), a1 = *(const bf16x8*)(AR + (16 + fr) * 72 + s * 32 + fq * 8);
                const bf16x8 b0 = *(const bf16x8*)(BK + fr * 72 + s * 32 + fq * 8), b1 = *(const bf16x8*)(BK + (16 + fr) * 72 + s * 32 + fq * 8);
                P00 = MFMA16(a0, b0, P00); P01 = MFMA16(a0, b1, P01); P10 = MFMA16(a1, b0, P10); P11 = MFMA16(a1, b1, P11);
            }
            WSYNC();
            float ak[4];
#pragma unroll
            for (int r = 0; r < 4; ++r) {
                const int i = 4 * fq + r, j = fr;
                Pab[i * 17 + j] = (j < i) ? P00[r] : 0.f;
                ak[r] = (j < i) ? P01[r] : 0.f;
                Arb[i * 24 + j] = f2bf((j <= i) ? P10[r] : 0.f);
                Ark[i * 24 + j] = f2bf((j <= i) ? P11[r] : 0.f);
            }
            *(u32x2*)(AakT + fr * 24 + 4 * fq) = (u32x2){pack2(ak[0], ak[1]), pack2(ak[2], ak[3])};
        }
        WSYNC();
        {
            float T[16];
#pragma unroll
            for (int i = 0; i < 16; ++i) {
                float acc = (i == fr) ? 1.f : 0.f;
#pragma unroll
                for (int j = 0; j < i; ++j) acc += Pab[i * 17 + j] * T[j];
                T[i] = acc;
            }
#pragma unroll
            for (int i = 0; i < 16; ++i) Tm[i * 24 + fr] = f2bf(T[i]);
            *(u32x2*)(ARBg + (u * 64 + lane) * 8) = *(const u32x2*)(Arb + fr * 24 + 4 * fq);
        }
        WSYNC();
        const bf16x8 Tld = *(const bf16x8*)(Tm + fr * 24 + (fq & 1) * 8);
        const bf16x8 Tf = (fq < 2) ? Tld : zero8;
        {
            f32x4 D[4];
#pragma unroll
            for (int ta = 0; ta < 4; ++ta) {
                const bf16x8 ald = *(const bf16x8*)(AtT + (16 * ta + fr) * 16 + (fq & 1) * 8);
                D[ta] = MFMA16((fq < 2) ? ald : zero8, Tf, zero4);
            }
            *(u32x4*)(AFg + (u * 64 + lane) * 32) = (u32x4){pack2(D[0][0], D[0][1]), pack2(D[0][2], D[0][3]), pack2(D[1][0], D[1][1]), pack2(D[1][2], D[1][3])};
            *(u32x4*)(AFg + (u * 64 + lane) * 32 + 16) = (u32x4){pack2(D[2][0], D[2][1]), pack2(D[2][2], D[2][3]), pack2(D[3][0], D[3][1]), pack2(D[3][2], D[3][3])};
            const bf16x8 akld = *(const bf16x8*)(AakT + fr * 24 + (fq & 1) * 8);
            const f32x4 M1 = MFMA16(Tf, (fq < 2) ? akld : zero8, zero4);
#pragma unroll
            for (int r = 0; r < 4; ++r) M1m[(4 * fq + r) * 24 + fr] = f2bf(M1[r]);
        }
        WSYNC();
        {
            const bf16x8 m1ld = *(const bf16x8*)(M1m + fr * 24 + (fq & 1) * 8), rkld = *(const bf16x8*)(Ark + fr * 24 + (fq & 1) * 8);
            const bf16x8 M1f = (fq < 2) ? m1ld : zero8, Arkf = (fq < 2) ? rkld : zero8;
#pragma unroll
            for (int sl = 0; sl < 4; ++sl) {
                const bf16x8 vld = *(const bf16x8*)(VT + (16 * sl + fr) * 16 + (fq & 1) * 8);
                const bf16x8 Vb = (fq < 2) ? vld : zero8;
                const f32x4 Uh = MFMA16(M1f, Vb, zero4), Y0 = MFMA16(Arkf, Vb, zero4);
                *(u32x2*)(CHVg + (((u * 4 + sl) * 3 + 0) * 64 + lane) * 8) = (u32x2){pack2(Uh[0], Uh[1]), pack2(Uh[2], Uh[3])};
                *(u32x2*)(CHVg + (((u * 4 + sl) * 3 + 1) * 64 + lane) * 8) = (u32x2){pack2(Y0[0], Y0[1]), pack2(Y0[2], Y0[3])};
            }
        }
        WSYNC();
    }
}

struct ChunkOps { u32x4 af0, af1, rf0, rf1, bk0, bk1, bk2, bk3; u32x2 arb, uh, y0, vf; f32x4 g0, g1, g2, g3; };
constexpr int RING_SLOT = 22528, RING_NS = 6, RING_D = 5;
__device__ __forceinline__ void lds_chunk_ops(ChunkOps& o, const LAS unsigned char* s, int sl, int lane, int fq) {
    o.af0 = *(const LAS u32x4*)(s + lane * 32); o.af1 = *(const LAS u32x4*)(s + lane * 32 + 16);
    o.rf0 = *(const LAS u32x4*)(s + 2048 + lane * 32); o.rf1 = *(const LAS u32x4*)(s + 2048 + lane * 32 + 16);
    o.bk0 = *(const LAS u32x4*)(s + 4096 + (0 * 64 + lane) * 16); o.bk1 = *(const LAS u32x4*)(s + 4096 + (1 * 64 + lane) * 16);
    o.bk2 = *(const LAS u32x4*)(s + 4096 + (2 * 64 + lane) * 16); o.bk3 = *(const LAS u32x4*)(s + 4096 + (3 * 64 + lane) * 16);
    o.uh = *(const LAS u32x2*)(s + 8192 + ((sl * 3 + 0) * 64 + lane) * 8);
    o.y0 = *(const LAS u32x2*)(s + 8192 + ((sl * 3 + 1) * 64 + lane) * 8);
    o.vf = *(const LAS u32x2*)(s + 8192 + ((sl * 3 + 2) * 64 + lane) * 8);
    o.arb = *(const LAS u32x2*)(s + 14336 + lane * 8);
    o.g0 = *(const LAS f32x4*)(s + 15360 + 16 * fq); o.g1 = *(const LAS f32x4*)(s + 15360 + 64 + 16 * fq);
    o.g2 = *(const LAS f32x4*)(s + 15360 + 128 + 16 * fq); o.g3 = *(const LAS f32x4*)(s + 15360 + 192 + 16 * fq);
}
template <int LW> __device__ __forceinline__ void ring_issue(const Params& p, LAS unsigned char* ring, int bh, int c, int lane) {
    const size_t u = (size_t)bh * 128 + c;
    LAS unsigned char* slot = ring + (c % RING_NS) * RING_SLOT;
    const unsigned char* ws = p.ws; const unsigned char* od = (const unsigned char*)p.out;
#pragma unroll
    for (int j = 0; j < 11; ++j) {
        constexpr int Q0 = LW * 11; const int q = Q0 + j;
        const unsigned char* g;
        if (q < 2) g = ws + CH_AF + u * 2048 + q * 1024 + lane * 16;
        else if (q < 4) g = ws + CH_RF + u * 2048 + (q - 2) * 1024 + lane * 16;
        else if (q < 8) g = ws + CH_BKF + u * 4096 + (q - 4) * 1024 + lane * 16;
        else if (q < 14) g = od + OUT_CHV + u * 6144 + (q - 8) * 1024 + lane * 16;
        else if (q == 14) g = ws + CH_ARB + u * 512 + lane * 16;
        else if (q == 15) g = ws + CH_G15 + u * 256 + lane * 16;
        else if (q < 18) { const int i = (q - 16) * 64 + lane; g = od + OUT_GB + (((size_t)(bh >> 3) * 2048 + c * 16 + (i >> 3)) * 512 + (bh & 7) * 64) * 2 + (i & 7) * 16; }
        else if (q < 20) { const int i = (q - 18) * 64 + lane; g = ws + WS_VB + (((size_t)(bh >> 3) * 2048 + c * 16 + (i >> 3)) * 512 + (bh & 7) * 64) * 2 + (i & 7) * 16; }
        else g = ws + WS_BONUS + ((size_t)bh * 2048 + c * 16) * 4 + lane * 16;
        __builtin_amdgcn_global_load_lds((const unsigned*)g, (LAS unsigned*)(slot + q * 1024), 16, 0, 0);
    }
}
template <int CTRL> __device__ __forceinline__ float dpp_add_q(float v) {
    const int t = __builtin_amdgcn_update_dpp(0, __float_as_int(v), CTRL, 0xf, 0xf, false);
    return v + __int_as_float(t);
}
__device__ __forceinline__ float oct_allsum(float v) {
    v = dpp_add_q<0xB1>(v); v = dpp_add_q<0x4E>(v); v = dpp_add_q<0x141>(v);
    return v;
}
struct EpiIn { u32x4 vv, gb; float bon; };
__device__ __forceinline__ void epi_load(EpiIn& e, const LAS unsigned char* s, int t, int v0) {
    e.gb = *(const LAS u32x4*)(s + 16384 + t * 128 + v0 * 2);
    e.vv = *(const LAS u32x4*)(s + 18432 + t * 128 + v0 * 2);
    e.bon = *(const LAS float*)(s + 20480 + t * 4);
}
template <int LW> __device__ __forceinline__ void p3_loader(const Params& p, LAS unsigned char* ring, int bh, int lane) {
#pragma unroll
    for (int c = 0; c < RING_D; ++c) ring_issue<LW>(p, ring, bh, c, lane);
    asm volatile("s_waitcnt vmcnt(33)" ::: "memory");
    __builtin_amdgcn_s_barrier();
#pragma unroll 1
    for (int c = 0; c < 128; ++c) {
        const int cn = (c + RING_D < 128) ? c + RING_D : 127;
        ring_issue<LW>(p, ring, bh, cn, lane);
        asm volatile("s_waitcnt vmcnt(33)" ::: "memory");
        __builtin_amdgcn_s_barrier();
    }
    asm volatile("s_waitcnt vmcnt(0)" ::: "memory");
}
__device__ void phase3(const Params& p) {
    const int tid = threadIdx.x, lane = tid & 63, wave = __builtin_amdgcn_readfirstlane(tid >> 6), fr = lane & 15, fq = lane >> 4;
    const int bh = blockIdx.x;
    if (bh >= 64) return;
    LAS unsigned char* ring = (LAS unsigned char*)dyn_smem;
    LAS float* ybuf = (LAS float*)(ring + RING_NS * RING_SLOT);
    if (wave >= 6) {
        const int e = (wave - 6) * 64 + lane, t = e >> 3, v0 = (e & 7) * 8, b = bh >> 3, h = bh & 7;
        f32x4 ga0 = *(const f32x4*)(p.gn_gain + h * 64 + v0), ga1 = *(const f32x4*)(p.gn_gain + h * 64 + v0 + 4);
        f32x4 bi0 = *(const f32x4*)(p.gn_bias + h * 64 + v0), bi1 = *(const f32x4*)(p.gn_bias + h * 64 + v0 + 4);
        u16* Y = (u16*)(p.ws + WS_Y);
        EpiIn cur, nxt;
        __builtin_amdgcn_s_barrier();
        epi_load(cur, ring, t, v0);
#pragma unroll 1
        for (int c = 0; c <= 128; ++c) {
            if (c >= 1) {
                const int cc = c - 1;
                { const int cn = (c < 128) ? c : 127; epi_load(nxt, ring + (cn % RING_NS) * RING_SLOT, t, v0); }
                const LAS float* yb = ybuf + (cc & 1) * (16 * 68) + t * 68 + v0;
                const f32x4 y0 = *(const LAS f32x4*)(yb), y1 = *(const LAS f32x4*)(yb + 4);
                float s1 = (y0[0] + y0[1]) + (y0[2] + y0[3]) + (y1[0] + y1[1]) + (y1[2] + y1[3]);
                float s2 = y0[0] * y0[0] + y0[1] * y0[1] + y0[2] * y0[2] + y0[3] * y0[3] + y1[0] * y1[0] + y1[1] * y1[1] + y1[2] * y1[2] + y1[3] * y1[3];
                s1 = oct_allsum(s1); s2 = oct_allsum(s2);
                const float mean = s1 * (1.f / 64.f);
                const float var = fmaxf(s2 * (1.f / 64.f) - mean * mean, 0.f);
                const float rstd = rsq_(var + 64e-5f);
                const float vvf[8] = {bflo(cur.vv.x), bfhi(cur.vv.x), bflo(cur.vv.y), bfhi(cur.vv.y), bflo(cur.vv.z), bfhi(cur.vv.z), bflo(cur.vv.w), bfhi(cur.vv.w)};
                const float gbf[8] = {bflo(cur.gb.x), bfhi(cur.gb.x), bflo(cur.gb.y), bfhi(cur.gb.y), bflo(cur.gb.z), bfhi(cur.gb.z), bflo(cur.gb.w), bfhi(cur.gb.w)};
                float o[8];
#pragma unroll
                for (int i = 0; i < 8; ++i) {
                    const float yv = (i < 4) ? y0[i & 3] : y1[i & 3];
                    const float gn = (i < 4) ? ga0[i & 3] : ga1[i & 3], bs = (i < 4) ? bi0[i & 3] : bi1[i & 3];
                    const float yn = (yv - mean) * rstd * gn + bs;
                    o[i] = (yn + cur.bon * vvf[i]) * gbf[i] * sigmoidf_(gbf[i]);
                }
                *(u32x4*)(Y + ((size_t)b * 2048 + cc * 16 + t) * 1024 + 512 + h * 64 + v0) = (u32x4){pack2(o[0], o[1]), pack2(o[2], o[3]), pack2(o[4], o[5]), pack2(o[6], o[7])};
                cur = nxt;
            }
            if (c < 128) __builtin_amdgcn_s_barrier();
        }
        return;
    }
    if (wave >= 4) { if (wave == 4) p3_loader<0>(p, ring, bh, lane); else p3_loader<1>(p, ring, bh, lane); return; }
    const int sl = wave;
    f32x4 acc0 = (f32x4){0.f, 0.f, 0.f, 0.f}, acc1 = acc0, acc2 = acc0, acc3 = acc0;
    ChunkOps cur, nxt;
    __builtin_amdgcn_s_barrier();
    lds_chunk_ops(cur, ring, sl, lane, fq);
#pragma unroll 2
    for (int c = 0; c < 128; ++c) {
        { const int cn = (c + 1 < 128) ? c + 1 : c; lds_chunk_ops(nxt, ring + (cn % RING_NS) * RING_SLOT, sl, lane, fq); }
        const bf16x8 sb0 = as_bf8((u32x4){pack2(acc0[0], acc0[1]), pack2(acc0[2], acc0[3]), pack2(acc1[0], acc1[1]), pack2(acc1[2], acc1[3])});
        const bf16x8 sb1 = as_bf8((u32x4){pack2(acc2[0], acc2[1]), pack2(acc2[2], acc2[3]), pack2(acc3[0], acc3[1]), pack2(acc3[2], acc3[3])});
        f32x4 U = (f32x4){bflo(cur.uh.x), bfhi(cur.uh.x), bflo(cur.uh.y), bfhi(cur.uh.y)};
        U = MFMA16(as_bf8(cur.af0), sb0, U); U = MFMA16(as_bf8(cur.af1), sb1, U);
        f32x4 Yv = (f32x4){bflo(cur.y0.x), bfhi(cur.y0.x), bflo(cur.y0.y), bfhi(cur.y0.y)};
        Yv = MFMA16(as_bf8(cur.rf0), sb0, Yv); Yv = MFMA16(as_bf8(cur.rf1), sb1, Yv);
        const unsigned u01 = pack2(U[0], U[1]), u23 = pack2(U[2], U[3]);
        Yv = MFMA16(as_bf8((u32x4){cur.arb.x, cur.arb.y, 0u, 0u}), as_bf8((u32x4){u01, u23, 0u, 0u}), Yv);
        const bf16x8 uvb = as_bf8((u32x4){u01, u23, cur.vf.x, cur.vf.y});
        acc0 = MFMA16(as_bf8(cur.bk0), uvb, acc0 * cur.g0); acc1 = MFMA16(as_bf8(cur.bk1), uvb, acc1 * cur.g1);
        acc2 = MFMA16(as_bf8(cur.bk2), uvb, acc2 * cur.g2); acc3 = MFMA16(as_bf8(cur.bk3), uvb, acc3 * cur.g3);
        LAS float* yb = ybuf + (c & 1) * (16 * 68) + (4 * fq) * 68 + sl * 16 + fr;
        yb[0] = Yv[0]; yb[68] = Yv[1]; yb[136] = Yv[2]; yb[204] = Yv[3];
        asm volatile("s_waitcnt lgkmcnt(0)" ::: "memory");
        __builtin_amdgcn_s_barrier();
        asm volatile("" ::: "memory");
        cur = nxt;
    }
}

__device__ void phase5(const Params& p) {
    const int tid = threadIdx.x, lane = tid & 63, wave = tid >> 6, blk = blockIdx.x;
#pragma unroll 1
    for (int r0 = 0; r0 < 8; r0 += 4) {
        f32x4 v[4][4]; float ss[4];
#pragma unroll
        for (int i = 0; i < 4; ++i) {
            const f32x4* xr = (const f32x4*)(p.out + (size_t)(blk * 64 + wave * 8 + r0 + i) * DM);
#pragma unroll
            for (int q = 0; q < 4; ++q) v[i][q] = xr[lane + 64 * q];
        }
#pragma unroll
        for (int i = 0; i < 4; ++i) {
            float s = 0.f;
#pragma unroll
            for (int q = 0; q < 4; ++q) s += v[i][q][0] * v[i][q][0] + v[i][q][1] * v[i][q][1] + v[i][q][2] * v[i][q][2] + v[i][q][3] * v[i][q][3];
            ss[i] = wave_sum(s);
        }
#pragma unroll
        for (int i = 0; i < 4; ++i) {
            f32x4* xr = (f32x4*)(p.out + (size_t)(blk * 64 + wave * 8 + r0 + i) * DM);
            const float inv = rsq_(ss[i] * (1.f / 1024.f) + 1e-6f);
#pragma unroll
            for (int q = 0; q < 4; ++q) { const f32x4 g = ((const f32x4*)p.final_gain)[lane + 64 * q]; xr[lane + 64 * q] = v[i][q] * inv * g; }
        }
    }
}

__global__ void __launch_bounds__(512, 2) hybrid_fwd(Params p) {
    __shared__ uint4 xb_words;
    if (threadIdx.x == 0) xb_words = make_uint4(0u, 0u, 0u, 0u);
    __syncthreads();
    XcdBarrier bar; bar.bar = (unsigned*)(p.ws + WS_CTL); bar.x = 0; bar.st = (volatile LAS unsigned*)&xb_words;
    const int lo = p.ph_lo, hi = p.ph_hi;
    if (hi - lo > 1) bar = xcd_barrier_post((unsigned*)(p.ws + WS_CTL), (volatile LAS unsigned*)&xb_words);
#define IN(k) (lo <= (k) && (k) < hi)
#define SEAM(k) do { if (IN(k) && IN((k) + 1)) xcd_barrier(bar); } while (0)
#define RUN(k, f) do { if (IN(k)) { if (PROBE_DUP == (k)) { for (int _r = 0; _r < p.dup_n; ++_r) { if (_r) __syncthreads(); f(p); } } else f(p); } } while (0)
    RUN(0, phase0);
    SEAM(0);
    RUN(1, phase1);
    SEAM(1);
    RUN(2, phase2);
    SEAM(2);
    RUN(3, phase3);
    SEAM(3);
    RUN(4, phase4);
}

extern "C" void kernel_launch(void* const* d_in, const int* in_sizes, int n_in, void* d_out, int out_size, void* d_ws, size_t ws_size, hipStream_t stream) {
    static int grid = 0;
    if (grid == 0) {
        if (n_in != 17 || out_size != NTOK * DM || ws_size < WS_END) { fprintf(stderr, "kernel_launch: unexpected problem (n_in %d out %d ws %zu need %zu)\n", n_in, out_size, ws_size, (size_t)WS_END); grid = -1; return; }
        if (hipFuncSetAttribute((const void*)hybrid_fwd, hipFuncAttributeMaxDynamicSharedMemorySize, LDS_BYTES) != hipSuccess) { fprintf(stderr, "kernel_launch: hipFuncSetAttribute failed\n"); grid = -1; return; }
        int per_cu = 0;
        if (hipOccupancyMaxActiveBlocksPerMultiprocessor(&per_cu, (const void*)hybrid_fwd, 512, LDS_BYTES) != hipSuccess || per_cu < 1) fprintf(stderr, "kernel_launch: occupancy query says %d blocks per CU\n", per_cu);
        (void)hipGetLastError();
        grid = 256;
    }
    if (grid < 0) return;
    (void)hipMemsetAsync((char*)d_ws + WS_CTL, 0, 16384, stream);
    Params p{};
    p.x = (const float*)d_in[0]; p.norm_gain = (const float*)d_in[1]; p.w_in = (const float*)d_in[2]; p.pool_w = (const float*)d_in[3];
    p.pool_scale = (const float*)d_in[4]; p.shift_mu = (const float*)d_in[5]; p.w0 = (const float*)d_in[6]; p.w_up = (const float*)d_in[7];
    p.a0 = (const float*)d_in[8]; p.a_up = (const float*)d_in[9]; p.k_k = (const float*)d_in[10]; p.k_a = (const float*)d_in[11];
    p.r_k = (const float*)d_in[12]; p.gn_gain = (const float*)d_in[13]; p.gn_bias = (const float*)d_in[14]; p.w_out = (const float*)d_in[15];
    p.final_gain = (const float*)d_in[16];
    p.out = (float*)d_out; p.ws = (unsigned char*)d_ws; p.dup_n = 2;
#if N_LAUNCHES == 1
    p.ph_lo = 0; p.ph_hi = NPH;
    hipLaunchKernelGGL(hybrid_fwd, dim3(grid), dim3(512), LDS_BYTES, stream, p);
#else
    for (int k = 0; k < NPH; ++k) { p.ph_lo = k; p.ph_hi = k + 1; hipLaunchKernelGGL(hybrid_fwd, dim3(grid), dim3(512), LDS_BYTES, stream, p); }
#endif
}
```

```cpp
#include <hip/hip_runtime.h>
#include <stdint.h>
#include <cstdio>

typedef unsigned short u16;
typedef short bf16x8 __attribute__((ext_vector_type(8)));
typedef float f32x4 __attribute__((ext_vector_type(4)));
typedef float f32x2 __attribute__((ext_vector_type(2)));
typedef unsigned u32x2 __attribute__((ext_vector_type(2)));
typedef unsigned u32x4 __attribute__((ext_vector_type(4)));

#ifndef PROBE_DUP
#define PROBE_DUP -1
#endif
#ifndef N_LAUNCHES
#define N_LAUNCHES 1
#endif

constexpr int NTOK = 16384, DM = 1024, SEQ = 2048, DIN = 3200, DINP = 3328;
constexpr int NPH = 5;
constexpr int LDS_BYTES = 18432 + 8 * 17408;

constexpr size_t WS_CTL = 0;
constexpr size_t WS_WINT = 16384;
constexpr size_t WS_WOUTT = WS_WINT + (size_t)DINP * 1024 * 2;
constexpr size_t WS_WUPT = WS_WOUTT + (size_t)1024 * 1024 * 2;
constexpr size_t WS_AUPT = WS_WUPT + 512 * 64 * 2;
constexpr size_t WS_POOLT = WS_AUPT + 512 * 64 * 2;
constexpr size_t WS_Z = WS_POOLT + 4 * 128 * 128 * 2;
constexpr size_t WS_REC = WS_Z + (size_t)NTOK * DIN * 2;
constexpr size_t WS_Y = WS_REC + (size_t)64 * 2048 * 896;
constexpr size_t WS_BONUS = WS_Y + (size_t)NTOK * 1024 * 2;
constexpr size_t WS_PART = WS_BONUS + (size_t)64 * 2048 * 4;
constexpr size_t WS_END = WS_PART + (size_t)64 * 4 * 256 * 4;
constexpr int CTL_CNT_WORD = 3584;
constexpr int NUNIT = 64 * 128;
constexpr size_t CH_AF = WS_REC;
constexpr size_t CH_RF = CH_AF + (size_t)NUNIT * 2048;
constexpr size_t CH_BKF = CH_RF + (size_t)NUNIT * 2048;
constexpr size_t CH_ARB = CH_BKF + (size_t)NUNIT * 4096;
constexpr size_t CH_G15 = CH_ARB + (size_t)NUNIT * 512;
constexpr size_t CH_END = CH_G15 + (size_t)NUNIT * 256;
constexpr size_t WS_VB = CH_END;
static_assert(WS_VB + (size_t)NTOK * 512 * 2 <= WS_Y, "chunk operands + v must fit in the record region");
constexpr size_t OUT_CHV = 0;
constexpr size_t OUT_GB = (size_t)NUNIT * 4 * 3 * 512;
static_assert(OUT_GB + (size_t)NTOK * 512 * 2 <= (size_t)NTOK * DM * 4, "d_out scratch");

struct Params {
    const float* x; const float* norm_gain; const float* w_in; const float* pool_w; const float* pool_scale;
    const float* shift_mu; const float* w0; const float* w_up; const float* a0; const float* a_up;
    const float* k_k; const float* k_a; const float* r_k; const float* gn_gain; const float* gn_bias;
    const float* w_out; const float* final_gain;
    float* out; unsigned char* ws;
    int ph_lo, ph_hi, dup_n, pad;
};

extern __shared__ __attribute__((aligned(16))) unsigned char dyn_smem[];

__device__ __forceinline__ float bf2f(u16 v) { return __uint_as_float(((unsigned)v) << 16); }
__device__ __forceinline__ float bflo(unsigned v) { return __uint_as_float(v << 16); }
__device__ __forceinline__ float bfhi(unsigned v) { return __uint_as_float(v & 0xffff0000u); }
typedef __bf16 bf16x2_t __attribute__((ext_vector_type(2)));
__device__ __forceinline__ unsigned pack2(float lo, float hi) { bf16x2_t v = {(__bf16)lo, (__bf16)hi}; return __builtin_bit_cast(unsigned, v); }
__device__ __forceinline__ u16 f2bf(float f) { return (u16)(pack2(f, 0.f) & 0xffffu); }
__device__ __forceinline__ float wave_sum(float v) {
#pragma unroll
    for (int m = 32; m >= 1; m >>= 1) v += __shfl_xor(v, m, 64);
    return v;
}
__device__ __forceinline__ float rcp_(float v) { return __builtin_amdgcn_rcpf(v); }
__device__ __forceinline__ float rsq_(float v) { return __builtin_amdgcn_rsqf(v); }
__device__ __forceinline__ float sigmoidf_(float v) { return rcp_(1.f + __expf(-v)); }
__device__ __forceinline__ float tanhf_(float v) { return 1.f - 2.f * rcp_(1.f + __expf(2.f * v)); }

#define XB_TMO      128
#define XB_XCNT(j)  (256  + 64 * (j))
#define XB_XSUB(j)  (1280 + 64 * (j))
#define XB_XGEN(j)  (2304 + 64 * (j))
#define XB_TOP      3328
#define XB_TOPGEN   3392
#define XCD_BAR_WORDS 3456
#define XB_SPIN_CAP (1u << 22)
#define LAS __attribute__((address_space(3)))

__device__ __forceinline__ unsigned xb_ld(unsigned* p)              { return __hip_atomic_load(p, __ATOMIC_RELAXED, __HIP_MEMORY_SCOPE_AGENT); }
__device__ __forceinline__ unsigned xb_add(unsigned* p, unsigned v) { return __hip_atomic_fetch_add(p, v, __ATOMIC_RELAXED, __HIP_MEMORY_SCOPE_AGENT); }
__device__ __forceinline__ unsigned xb_xcc_id() { return (unsigned)__builtin_amdgcn_s_getreg((3 << 11) | 20) & 0xFu; }
#define XB_SPIN(cond, bar) do { unsigned _sp = 0; while (cond) { __builtin_amdgcn_s_sleep(1); \
    if ((++_sp & 255u) == 0u) { if (xb_ld(&(bar)[XB_TMO])) break; if (_sp > XB_SPIN_CAP) { atomicAdd(&(bar)[XB_TMO], 1u); break; } } } } while (0)

struct XcdBarrier { unsigned* bar; unsigned x; volatile LAS unsigned* st; };

__device__ __forceinline__ XcdBarrier xcd_barrier_post(unsigned* bar, volatile LAS unsigned* st) {
    XcdBarrier b; b.bar = bar; b.x = xb_xcc_id(); b.st = st;
    if (threadIdx.x == 0) (void)xb_add(&bar[XB_XCNT(b.x)], 1u);
    return b;
}
__device__ __forceinline__ void xcd_barrier_complete(unsigned* bar, unsigned x, unsigned& nloc, unsigned& nx) {
    const unsigned G = gridDim.x * gridDim.y * gridDim.z;
    unsigned sum, cnt, mine, sp = 0u;
    for (;;) {
        sum = 0u; cnt = 0u; mine = 0u;
#pragma unroll
        for (unsigned j = 0; j < 16; ++j) { const unsigned c = xb_ld(&bar[XB_XCNT(j)]); sum += c; cnt += (c > 0u) ? 1u : 0u; mine = (j == x) ? c : mine; }
        if (sum == G) break;
        __builtin_amdgcn_s_sleep(1);
        if ((++sp & 255u) == 0u) { if (xb_ld(&bar[XB_TMO])) break; if (sp > XB_SPIN_CAP) { atomicAdd(&bar[XB_TMO], 1u); break; } }
    }
    nloc = mine > 0u ? mine : 1u; nx = cnt > 0u ? cnt : 1u;
}
__device__ __forceinline__ void xcd_barrier(const XcdBarrier& b) {
    asm volatile("s_waitcnt vmcnt(0)" ::: "memory");
    __syncthreads();
    if (threadIdx.x == 0) {
        unsigned* bar = b.bar;
        __builtin_amdgcn_s_waitcnt(0);
        unsigned nloc = b.st[0], nx = b.st[1];
        if (nloc == 0u) { xcd_barrier_complete(bar, b.x, nloc, nx); b.st[0] = nloc; b.st[1] = nx; }
        const unsigned old = xb_add(&bar[XB_XSUB(b.x)], 1u);
        const unsigned gen = old / nloc;
        if (old + 1u == (gen + 1u) * nloc) {
            __builtin_amdgcn_fence(__ATOMIC_RELEASE, "agent");
            asm volatile("s_waitcnt vmcnt(0)" ::: "memory");
            const unsigned og = xb_add(&bar[XB_TOP], 1u);
            const unsigned tg = og / nx;
            if (og + 1u == (tg + 1u) * nx) xb_add(&bar[XB_TOPGEN], 1u);
            else XB_SPIN(xb_ld(&bar[XB_TOPGEN]) == tg, bar);
            __builtin_amdgcn_fence(__ATOMIC_ACQUIRE, "agent");
            xb_add(&bar[XB_XGEN(b.x)], 1u);
            asm volatile("s_waitcnt vmcnt(0)" ::: "memory");
        } else {
            XB_SPIN(xb_ld(&bar[XB_XGEN(b.x)]) == gen, bar);
            __builtin_amdgcn_fence(__ATOMIC_ACQUIRE, "agent");
            asm volatile("s_waitcnt vmcnt(0)" ::: "memory");
        }
    }
    __syncthreads();
}

constexpr int BM = 256, BK = 64, HALF = 128, HTB = HALF * BK * 2, STAGE_BYTES = 8 * HTB, NXCD = 8, WGM = 8;
__device__ __forceinline__ int lds_byte(int r, int c) { const int st = (r >> 4) * 2 + (c >> 5), rr = r & 15, cc = c & 31, ob = rr * 64 + cc * 2; return st * 1024 + (ob ^ (((ob >> 9) & 1) << 5)); }
__device__ __forceinline__ void stage_rc(int b, int& R, int& C) { const int st = b / 1024, sb = b % 1024, swz = sb ^ (((sb >> 9) & 1) << 5); R = (st >> 1) * 16 + swz / 64; C = (st & 1) * 32 + (swz % 64) / 2; }
__device__ __forceinline__ int perm32(int rho) { const int n = rho >> 4, i = rho & 15; return 8 * (i >> 2) + 4 * n + (i & 3); }

struct Unit { int pm, pn; };
struct Gemm { const u16* A; const u16* Bt; int M, N, K, Nvalid; };
struct StaticOrder {
    int nM, nN, nwg, G, c;
    __device__ void init(int M, int N, int G_, int c_) { nM = M / BM; nN = N / BM; nwg = nM * nN; G = G_; c = c_; }
    __device__ bool next(int i, Unit& u) const {
        const long L = (long)i * G + c; if (L >= nwg) return false;
        int wgid = (int)L; { const int q = nwg / NXCD, r = nwg % NXCD, xcd = wgid % NXCD, off = wgid / NXCD; wgid = (xcd < r ? xcd * (q + 1) : r * (q + 1) + (xcd - r) * q) + off; }
        const int nig = WGM * nN, gid = wgid / nig, fm = gid * WGM, gsz = (nM - fm) < WGM ? (nM - fm) : WGM;
        u.pm = fm + ((wgid % nig) % gsz); u.pn = (wgid % nig) / gsz; return true;
    }
};
struct EpiZ {
    static constexpr bool PERM = true, AFTER_DRAIN = false;
    u16* Z;
    __device__ __forceinline__ void operator()(const f32x4 (&acc)[2][2][4][2], const Unit& u, int wr, int wc, int fr, int fq) const {
        const int row0 = u.pm * BM + wr * 64 + fr, col0 = u.pn * BM + wc * 32 + 8 * fq;
#pragma unroll
        for (int ai = 0; ai < 2; ++ai)
#pragma unroll
            for (int m = 0; m < 4; ++m) { u16* rowp = Z + (size_t)(row0 + ai * HALF + m * 16) * DIN;
#pragma unroll
                for (int bj = 0; bj < 2; ++bj) { const int col = col0 + bj * HALF; const f32x4 v0 = acc[ai][bj][m][0], v1 = acc[ai][bj][m][1];
                    if (col < DIN) *(u32x4*)(rowp + col) = (u32x4){pack2(v0[0], v0[1]), pack2(v0[2], v0[3]), pack2(v1[0], v1[1]), pack2(v1[2], v1[3])}; } }
    }
};
struct EpiRes {
    static constexpr bool PERM = false, AFTER_DRAIN = false;
    const float* x; float* out;
    __device__ __forceinline__ void operator()(const f32x4 (&acc)[2][2][4][2], const Unit& u, int wr, int wc, int fr, int fq) const {
        const int row0 = u.pm * BM + wr * 64 + fr, col0 = u.pn * BM + wc * 32 + 4 * fq;
#pragma unroll
        for (int ai = 0; ai < 2; ++ai)
#pragma unroll
            for (int m = 0; m < 4; ++m) { const size_t ro = (size_t)(row0 + ai * HALF + m * 16) * DM + col0;
#pragma unroll
                for (int bj = 0; bj < 2; ++bj)
#pragma unroll
                    for (int n = 0; n < 2; ++n) { const f32x4 xv = *(const f32x4*)(x + ro + bj * HALF + n * 16); *(f32x4*)(out + ro + bj * HALF + n * 16) = xv + acc[ai][bj][m][n]; } }
    }
};
struct EpiResNorm {
    static constexpr bool PERM = false, AFTER_DRAIN = true;
    const float* x; const float* gain; float* out; float* part; unsigned* cnt;
    __device__ __forceinline__ void fused(f32x4 (&acc)[2][2][4][2], const Unit& u, int wr, int wc, int fr, int fq, LAS unsigned char* lds) const {
        const int row0 = u.pm * BM + wr * 64 + fr, col0 = u.pn * BM + wc * 32 + 4 * fq;
        LAS float* red = (LAS float*)lds;
        LAS float* tot = red + 1024;
        float rs[2][4];
#pragma unroll
        for (int ai = 0; ai < 2; ++ai)
#pragma unroll
            for (int m = 0; m < 4; ++m) { const size_t ro = (size_t)(row0 + ai * HALF + m * 16) * DM + col0; float s = 0.f;
#pragma unroll
                for (int bj = 0; bj < 2; ++bj)
#pragma unroll
                    for (int n = 0; n < 2; ++n) { const f32x4 v = *(const f32x4*)(x + ro + bj * HALF + n * 16) + acc[ai][bj][m][n]; acc[ai][bj][m][n] = v; s += v[0] * v[0] + v[1] * v[1] + v[2] * v[2] + v[3] * v[3]; }
                s += __shfl_xor(s, 16, 64); s += __shfl_xor(s, 32, 64);
                rs[ai][m] = s; }
        if (fq == 0) {
#pragma unroll
            for (int ai = 0; ai < 2; ++ai)
#pragma unroll
                for (int m = 0; m < 4; ++m) red[((wr * 4 + wc) * 8 + ai * 4 + m) * 16 + fr] = rs[ai][m];
        }
        __syncthreads();
        if (threadIdx.x < 256) {
            const int rl = threadIdx.x, ai = rl >> 7, wr_ = (rl >> 6) & 1, m = (rl >> 4) & 3, fr_ = rl & 15;
            const int o = ((wr_ * 4) * 8 + ai * 4 + m) * 16 + fr_;
            const float s = red[o] + red[o + 128] + red[o + 256] + red[o + 384];
            __hip_atomic_store(part + ((size_t)u.pm * 4 + u.pn) * 256 + rl, s, __ATOMIC_RELAXED, __HIP_MEMORY_SCOPE_AGENT);
        }
        asm volatile("s_waitcnt vmcnt(0)" ::: "memory");
        __syncthreads();
        if (threadIdx.x == 0) {
            __builtin_amdgcn_fence(__ATOMIC_RELEASE, "agent");
            asm volatile("s_waitcnt vmcnt(0)" ::: "memory");
            __hip_atomic_fetch_add(cnt + u.pm, 1u, __ATOMIC_RELAXED, __HIP_MEMORY_SCOPE_AGENT);
            unsigned sp = 0;
            while (__hip_atomic_load(cnt + u.pm, __ATOMIC_RELAXED, __HIP_MEMORY_SCOPE_AGENT) < 4u) { __builtin_amdgcn_s_sleep(1); if (++sp > (1u << 24)) break; }
            __builtin_amdgcn_fence(__ATOMIC_ACQUIRE, "agent");
            asm volatile("s_waitcnt vmcnt(0)" ::: "memory");
        }
        __syncthreads();
        for (int e = threadIdx.x; e < 1024; e += 512) tot[e] = __hip_atomic_load(part + (size_t)u.pm * 1024 + e, __ATOMIC_RELAXED, __HIP_MEMORY_SCOPE_AGENT);
        __syncthreads();
#pragma unroll
        for (int ai = 0; ai < 2; ++ai)
#pragma unroll
            for (int m = 0; m < 4; ++m) { const int rl = ai * 128 + wr * 64 + m * 16 + fr;
                const float inv = rsq_((tot[rl] + tot[256 + rl] + tot[512 + rl] + tot[768 + rl]) * (1.f / 1024.f) + 1e-6f);
                const size_t ro = (size_t)(row0 + ai * HALF + m * 16) * DM + col0;
#pragma unroll
                for (int bj = 0; bj < 2; ++bj)
#pragma unroll
                    for (int n = 0; n < 2; ++n) { const f32x4 g = *(const f32x4*)(gain + col0 + bj * HALF + n * 16); *(f32x4*)(out + ro + bj * HALF + n * 16) = acc[ai][bj][m][n] * inv * g; } }
    }
};

template <class Epi, class Sched>
__device__ __forceinline__ void gemm_phase(LAS unsigned char* lds, const Gemm g, const Sched& S, const Epi& E) {
    const int tid = threadIdx.x, wid = __builtin_amdgcn_readfirstlane(tid >> 6), lane = tid & 63, wr = wid >> 2, wc = wid & 3, fr = lane & 15, fq = lane >> 4;
    const int K = g.K, nt = K / BK;
    unsigned voffA[2], voffB[2];
#pragma unroll
    for (int i = 0; i < 2; ++i) { int R, C; stage_rc(tid * 16 + i * 8192, R, C); const int Rb = Epi::PERM ? ((R & ~31) + perm32(R & 31)) : R;
        voffA[i] = (unsigned)(R * K + C) * 2u; voffB[i] = (unsigned)(Rb * K + C) * 2u; }
    const size_t kstep = (size_t)(BK * 2);
    const size_t hstep = (size_t)HALF * K * 2;
    const size_t tstep = 2 * hstep;
    const unsigned ldsw = (unsigned)wid * 1024u;
    const int aoff = lds_byte(wr * 64 + fr, fq * 8), boff = lds_byte(wc * 32 + fr, fq * 8);
#define PG8_SA(b, h) (((b) * 2 + (h)) * HTB)
#define PG8_SB(b, h) ((4 + (b) * 2 + (h)) * HTB)
#define PG8_STAGE(bufoff, gbase, voff) do { _Pragma("unroll") for (int _i = 0; _i < 2; ++_i) \
        __builtin_amdgcn_global_load_lds((const unsigned*)((const char*)(gbase) + (voff)[_i]), (LAS unsigned*)(lds + (bufoff) + ldsw + _i * 8192), 16, 0, 0); } while (0)
#define PG8_LDA(dst, b, h) do { _Pragma("unroll") for (int m = 0; m < 4; ++m) _Pragma("unroll") for (int k = 0; k < 2; ++k) dst[m][k] = *(const LAS bf16x8*)(lds + PG8_SA(b, h) + aoff + m * 2048 + k * 1024); } while (0)
#define PG8_LDB(dst, b, h) do { _Pragma("unroll") for (int n = 0; n < 2; ++n) _Pragma("unroll") for (int k = 0; k < 2; ++k) dst[n][k] = *(const LAS bf16x8*)(lds + PG8_SB(b, h) + boff + n * 2048 + k * 1024); } while (0)
#define PG8_MMA(ai, bj, At, Bt) do { __builtin_amdgcn_s_setprio(1); _Pragma("unroll") for (int m = 0; m < 4; ++m) _Pragma("unroll") for (int n = 0; n < 2; ++n) _Pragma("unroll") for (int k = 0; k < 2; ++k) \
        acc[ai][bj][m][n] = __builtin_amdgcn_mfma_f32_16x16x32_bf16(Bt[n][k], At[m][k], acc[ai][bj][m][n], 0, 0, 0); __builtin_amdgcn_s_setprio(0); } while (0)
#define PG8_WAIT_V(n) asm volatile("s_waitcnt vmcnt(" #n ")" ::: "memory")
#define PG8_WAIT_L(n) asm volatile("s_waitcnt lgkmcnt(" #n ")" ::: "memory")
#define PG8_BAR __builtin_amdgcn_s_barrier()
#define PG8_SCHED __builtin_amdgcn_sched_barrier(0)
    Unit cur, nxt; int ui = 0;
    if (!S.next(0, cur)) return;
    f32x4 acc[2][2][4][2];
#pragma unroll
    for (int a = 0; a < 2; ++a)
#pragma unroll
        for (int b = 0; b < 2; ++b)
#pragma unroll
            for (int m = 0; m < 4; ++m)
#pragma unroll
                for (int n = 0; n < 2; ++n) acc[a][b][m][n] = (f32x4){0.f, 0.f, 0.f, 0.f};
    bf16x8 At[4][2], B0[2][2], B1[2][2];
    const char* cA = (const char*)g.A + (size_t)cur.pm * tstep; const char* cB = (const char*)g.Bt + (size_t)cur.pn * tstep;
    PG8_STAGE(PG8_SB(0, 0), cB, voffB); PG8_STAGE(PG8_SA(0, 0), cA, voffA); PG8_STAGE(PG8_SB(0, 1), cB + hstep, voffB); PG8_STAGE(PG8_SA(0, 1), cA + hstep, voffA);
    if (wr == 1) PG8_BAR;
    PG8_WAIT_V(4); PG8_BAR;
    PG8_STAGE(PG8_SB(1, 0), cB + kstep, voffB); PG8_STAGE(PG8_SA(1, 0), cA + kstep, voffA); PG8_STAGE(PG8_SB(1, 1), cB + hstep + kstep, voffB);
    PG8_WAIT_V(6); PG8_BAR;
    for (;;) {
        const bool has_next = S.next(ui + 1, nxt);
        const char* nA = has_next ? (const char*)g.A + (size_t)nxt.pm * tstep : cA; const char* nB = has_next ? (const char*)g.Bt + (size_t)nxt.pn * tstep : cB;
        const bool rhalf = (cur.pn * BM + HALF) < g.Nvalid;
        for (int t = 0; t < nt; t += 2) {
            const bool last = (t == nt - 2);
            const char* a1 = cA + (size_t)(t + 1) * kstep;
            const char* a2 = last ? nA : cA + (size_t)(t + 2) * kstep; const char* b2 = last ? nB : cB + (size_t)(t + 2) * kstep;
            const char* a3 = a2 + kstep; const char* b3 = b2 + kstep;
            PG8_LDB(B0, 0, 0); PG8_SCHED; PG8_LDA(At, 0, 0); PG8_STAGE(PG8_SA(1, 1), a1 + hstep, voffA);
            PG8_WAIT_L(8); PG8_BAR; PG8_WAIT_L(0); PG8_MMA(0, 0, At, B0); PG8_BAR; PG8_SCHED;
            PG8_LDB(B1, 0, 1); PG8_STAGE(PG8_SB(0, 0), b2, voffB);
            PG8_BAR; PG8_WAIT_L(0); if (rhalf) PG8_MMA(0, 1, At, B1); PG8_BAR;
            PG8_LDA(At, 0, 1); PG8_STAGE(PG8_SA(0, 0), a2, voffA);
            PG8_BAR; PG8_WAIT_L(0); PG8_MMA(1, 0, At, B0); PG8_BAR; PG8_SCHED;
            PG8_STAGE(PG8_SB(0, 1), b2 + hstep, voffB);
            PG8_WAIT_V(6); PG8_BAR; if (rhalf) PG8_MMA(1, 1, At, B1); PG8_BAR;
            PG8_LDB(B0, 1, 0); PG8_SCHED; PG8_LDA(At, 1, 0); PG8_STAGE(PG8_SA(0, 1), a2 + hstep, voffA);
            PG8_WAIT_L(8); PG8_BAR; PG8_WAIT_L(0); PG8_MMA(0, 0, At, B0); PG8_BAR; PG8_SCHED;
            PG8_LDB(B1, 1, 1); PG8_STAGE(PG8_SB(1, 0), b3, voffB);
            PG8_BAR; PG8_WAIT_L(0); if (rhalf) PG8_MMA(0, 1, At, B1); PG8_BAR;
            PG8_LDA(At, 1, 1); PG8_STAGE(PG8_SA(1, 0), a3, voffA);
            PG8_BAR; PG8_WAIT_L(0); PG8_MMA(1, 0, At, B0); PG8_BAR; PG8_SCHED;
            PG8_STAGE(PG8_SB(1, 1), b3 + hstep, voffB);
            PG8_WAIT_V(6); PG8_BAR; if (rhalf) PG8_MMA(1, 1, At, B1); PG8_BAR;
        }
        if constexpr (!Epi::AFTER_DRAIN) E(acc, cur, wr, wc, fr, fq);
        if (!has_next) break;
#pragma unroll
        for (int a = 0; a < 2; ++a)
#pragma unroll
            for (int b = 0; b < 2; ++b)
#pragma unroll
                for (int m = 0; m < 4; ++m)
#pragma unroll
                    for (int n = 0; n < 2; ++n) acc[a][b][m][n] = (f32x4){0.f, 0.f, 0.f, 0.f};
        cur = nxt; cA = nA; cB = nB; ++ui;
    }
    PG8_WAIT_V(0);
    if (wr == 0) PG8_BAR;
    PG8_BAR;
    if constexpr (Epi::AFTER_DRAIN) E.fused(acc, cur, wr, wc, fr, fq, lds);
#undef PG8_SA
#undef PG8_SB
#undef PG8_STAGE
#undef PG8_LDA
#undef PG8_LDB
#undef PG8_MMA
#undef PG8_WAIT_V
#undef PG8_WAIT_L
#undef PG8_BAR
#undef PG8_SCHED
}

__device__ void phase0(const Params& p) {
    const int tid = threadIdx.x, lane = tid & 63, wave = tid >> 6, blk = blockIdx.x;
    u16* Hbf = (u16*)p.out;
#pragma unroll 1
    for (int r0 = 0; r0 < 8; r0 += 4) {
        f32x4 v[4][4]; float ss[4];
#pragma unroll
        for (int i = 0; i < 4; ++i) {
            const f32x4* xr = (const f32x4*)(p.x + (size_t)(blk * 64 + wave * 8 + r0 + i) * DM);
#pragma unroll
            for (int q = 0; q < 4; ++q) v[i][q] = __builtin_nontemporal_load(xr + lane + 64 * q);
        }
#pragma unroll
        for (int i = 0; i < 4; ++i) {
            float s = 0.f;
#pragma unroll
            for (int q = 0; q < 4; ++q) s += v[i][q][0] * v[i][q][0] + v[i][q][1] * v[i][q][1] + v[i][q][2] * v[i][q][2] + v[i][q][3] * v[i][q][3];
            ss[i] = wave_sum(s);
        }
#pragma unroll
        for (int i = 0; i < 4; ++i) {
            const int row = blk * 64 + wave * 8 + r0 + i;
            const float inv = rsq_(ss[i] * (1.f / 1024.f) + 1e-6f);
#pragma unroll
            for (int q = 0; q < 4; ++q) {
                const f32x4 g = ((const f32x4*)p.norm_gain)[lane + 64 * q];
                u32x2 o; o.x = pack2(v[i][q][0] * inv * g[0], v[i][q][1] * inv * g[1]); o.y = pack2(v[i][q][2] * inv * g[2], v[i][q][3] * inv * g[3]);
                *(u32x2*)(Hbf + (size_t)row * DM + (lane + 64 * q) * 4) = o;
            }
        }
    }
    float* tl = (float*)dyn_smem;
    u16* WinT = (u16*)(p.ws + WS_WINT); u16* WoutT = (u16*)(p.ws + WS_WOUTT);
#pragma unroll 1
    for (int t = blk; t < 832 + 256; t += 256) {
        const float* src; u16* dst; int kt, ntile, N;
        if (t < 832) { kt = t & 15; ntile = t >> 4; src = p.w_in; N = DIN; dst = WinT; }
        else { const int t2 = t - 832; kt = t2 & 15; ntile = t2 >> 4; src = p.w_out; N = 1024; dst = WoutT; }
        const int k0 = kt * 64, n0 = ntile * 64;
        __syncthreads();
        for (int kk = wave; kk < 64; kk += 8) { const int n = n0 + lane; tl[kk * 65 + lane] = (n < N) ? src[(size_t)(k0 + kk) * N + n] : 0.f; }
        __syncthreads();
        for (int nn = wave; nn < 64; nn += 8) dst[(size_t)(n0 + nn) * 1024 + k0 + lane] = f2bf(tl[lane * 65 + nn]);
    }
    u16* WupT = (u16*)(p.ws + WS_WUPT); u16* AupT = (u16*)(p.ws + WS_AUPT); u16* PoolT = (u16*)(p.ws + WS_POOLT);
    const int gt = blk * 512 + tid;
    if (gt < 32768) { const int c = gt >> 6, j = gt & 63; WupT[gt] = f2bf(p.w_up[j * 512 + c]); AupT[gt] = f2bf(p.a_up[j * 512 + c]); }
    if (gt < 65536) { const int g = gt >> 14, d = (gt >> 7) & 127, c = gt & 127; PoolT[gt] = f2bf(p.pool_w[(g * 128 + c) * 128 + d]); }
}

__device__ void phase1(const Params& p) {
    Gemm g; g.A = (const u16*)p.out; g.Bt = (const u16*)(p.ws + WS_WINT); g.M = NTOK; g.N = DINP; g.K = 1024; g.Nvalid = DIN;
    StaticOrder S; S.init(NTOK, DINP, 256, blockIdx.x);
    EpiZ E; E.Z = (u16*)(p.ws + WS_Z);
    gemm_phase((LAS unsigned char*)dyn_smem, g, S, E);
}
__device__ void phase4(const Params& p) {
    Gemm g; g.A = (const u16*)(p.ws + WS_Y); g.Bt = (const u16*)(p.ws + WS_WOUTT); g.M = NTOK; g.N = 1024; g.K = 1024; g.Nvalid = 1024;
    StaticOrder S; S.init(NTOK, 1024, 256, blockIdx.x);
    EpiResNorm E; E.x = p.x; E.gain = p.final_gain; E.out = p.out; E.part = (float*)(p.ws + WS_PART); E.cnt = (unsigned*)(p.ws + WS_CTL) + CTL_CNT_WORD;
    gemm_phase((LAS unsigned char*)dyn_smem, g, S, E);
}

template <int CTRL> __device__ __forceinline__ float dpp_add(float v) {
    const int t = __builtin_amdgcn_update_dpp(0, __float_as_int(v), CTRL, 0xf, 0xf, false);
    return v + __int_as_float(t);
}
__device__ __forceinline__ float row16_allsum(float v) {
    v = dpp_add<0x128>(v); v = dpp_add<0x124>(v); v = dpp_add<0x122>(v); v = dpp_add<0x121>(v);
    return v;
}
#define WSYNC() do { __builtin_amdgcn_wave_barrier(); asm volatile("s_waitcnt lgkmcnt(0)" ::: "memory"); __builtin_amdgcn_wave_barrier(); } while (0)
#define MFMA16(a, b, c) __builtin_amdgcn_mfma_f32_16x16x32_bf16((a), (b), (c), 0, 0, 0)
__device__ __forceinline__ bf16x8 as_bf8(u32x4 v) { return __builtin_bit_cast(bf16x8, v); }
template <int W> __device__ __forceinline__ void pooled_run(const u16* __restrict__ Z, u16* pooled, int t0, int s0, int cp, int hf) {
    const int c0 = 2 * cp, tb = hf * 32;
    unsigned raw[W - 1 + 32];
#pragma unroll
    for (int i = 0; i < W - 1 + 32; ++i) { const int tt = tb - (W - 1) + i; raw[i] = (s0 + tt >= 0) ? *(const unsigned*)(Z + (size_t)(t0 + tt) * DIN + c0) : 0u; }
    float sum0 = 0.f, sum1 = 0.f;
#pragma unroll
    for (int i = 0; i < W - 1; ++i) { sum0 += bflo(raw[i]); sum1 += bfhi(raw[i]); }
#pragma unroll
    for (int j = 0; j < 32; ++j) {
        const int tt = tb + j, s = s0 + tt;
        const float u0 = bflo(raw[W - 1 + j]), u1 = bfhi(raw[W - 1 + j]);
        sum0 += u0; sum1 += u1;
        const float rc = rcp_((float)((s + 1 < W) ? (s + 1) : W));
        *(unsigned*)(pooled + tt * 520 + c0) = pack2(sum0 * rc - u0, sum1 * rc - u1);
        sum0 -= bflo(raw[j]); sum1 -= bfhi(raw[j]);
    }
}
constexpr int P2_WREG = 17408;
__device__ void phase2(const Params& p) {
    const int tid = threadIdx.x, lane = tid & 63, wave = tid >> 6, blk = blockIdx.x, fr = lane & 15, fq = lane >> 4;
    const int t0 = blk * 64, b = t0 >> 11, s0 = t0 & 2047;
    const u16* Z = (const u16*)(p.ws + WS_Z);
    u16* twb = (u16*)dyn_smem;
    u16* alb = twb + 64 * 72;
    u16* pooled = alb + 64 * 72;
    for (int e = tid; e < 64 * 128; e += 512) {
        const int tt = e >> 7, j = e & 127;
        const size_t zi = (size_t)(t0 + tt) * DIN + 2560 + j;
        const float cur = bf2f(Z[zi]);
        const float prev = (s0 + tt > 0) ? bf2f(Z[zi - DIN]) : 0.f;
        const float val = cur + p.shift_mu[1536 + j] * (prev - cur);
        if (j < 64) twb[tt * 72 + j] = f2bf(tanhf_(val)); else alb[tt * 72 + (j - 64)] = f2bf(val);
    }
    {
        const int cp = tid & 255, hf = tid >> 8;
        switch (wave & 3) {
            case 0: pooled_run<2>(Z, pooled, t0, s0, cp, hf); break;
            case 1: pooled_run<4>(Z, pooled, t0, s0, cp, hf); break;
            case 2: pooled_run<8>(Z, pooled, t0, s0, cp, hf); break;
            default: pooled_run<16>(Z, pooled, t0, s0, cp, hf); break;
        }
    }
    __syncthreads();
    {
        const int g = wave >> 1, dbase = (wave & 1) * 64;
        const u16* PoolT = (const u16*)(p.ws + WS_POOLT); u16* Y = (u16*)(p.ws + WS_Y);
        f32x4 acc[4][4];
#pragma unroll
        for (int mt = 0; mt < 4; ++mt)
#pragma unroll
            for (int nt = 0; nt < 4; ++nt) acc[mt][nt] = (f32x4){0.f, 0.f, 0.f, 0.f};
#pragma unroll
        for (int ks = 0; ks < 4; ++ks) {
            bf16x8 Bf[4];
#pragma unroll
            for (int nt = 0; nt < 4; ++nt) Bf[nt] = *(const bf16x8*)(PoolT + (size_t)(g * 128 + dbase + nt * 16 + fr) * 128 + ks * 32 + fq * 8);
#pragma unroll
            for (int mt = 0; mt < 4; ++mt) {
                const bf16x8 Af = *(const bf16x8*)(pooled + (mt * 16 + fr) * 520 + g * 128 + ks * 32 + fq * 8);
#pragma unroll
                for (int nt = 0; nt < 4; ++nt) acc[mt][nt] = MFMA16(Bf[nt], Af, acc[mt][nt]);
            }
        }
#pragma unroll
        for (int mt = 0; mt < 4; ++mt) {
            const size_t T = (size_t)(t0 + mt * 16 + fr);
#pragma unroll
            for (int nt = 0; nt < 4; ++nt) {
                const int ch = g * 128 + dbase + nt * 16 + fq * 4;
                const u32x2 ga = *(const u32x2*)(Z + T * DIN + 512 + ch);
                const f32x4 ps = *(const f32x4*)(p.pool_scale + ch);
                const f32x4 gv = (f32x4){bflo(ga.x), bfhi(ga.x), bflo(ga.y), bfhi(ga.y)};
                f32x4 y;
#pragma unroll
                for (int jj = 0; jj < 4; ++jj) y[jj] = acc[mt][nt][jj] * ps[jj] * gv[jj] * sigmoidf_(gv[jj]);
                u32x2 o; o.x = pack2(y[0], y[1]); o.y = pack2(y[2], y[3]);
                *(u32x2*)(Y + T * 1024 + ch) = o;
            }
        }
    }
    {
        u16* GB = (u16*)((unsigned char*)p.out + OUT_GB);
        for (int e = tid; e < 64 * 64; e += 512) { const int tt = e >> 6, q = e & 63;
            *(u32x4*)(GB + (size_t)(t0 + tt) * 512 + q * 8) = *(const u32x4*)(Z + (size_t)(t0 + tt) * DIN + 2688 + q * 8); }
    }
    __syncthreads();
    const int h = wave, bh = b * 8 + h;
    unsigned char* WL = dyn_smem + 18432 + wave * P2_WREG;
    unsigned char* recl = WL;
    u16* AR = (u16*)WL;
    u16* BK = AR + 32 * 72;
    u16* AtT = BK + 32 * 72;
    u16* BhT = AtT + 64 * 16;
    u16* KhT = BhT + 64 * 16;
    u16* VT = KhT + 64 * 16;
    float* Pab = (float*)WL;
    u16* Tm = (u16*)(Pab + 16 * 17);
    u16* AakT = Tm + 16 * 24;
    u16* M1m = AakT + 16 * 24;
    u16* Ark = M1m + 16 * 24;
    u16* Arb = Ark + 16 * 24;
    const u16* WupT = (const u16*)(p.ws + WS_WUPT); const u16* AupT = (const u16*)(p.ws + WS_AUPT);
    float* BON = (float*)(p.ws + WS_BONUS); u16* VB = (u16*)(p.ws + WS_VB);
    unsigned char* AFg = p.ws + CH_AF; unsigned char* RFg = p.ws + CH_RF; unsigned char* BKFg = p.ws + CH_BKF; unsigned char* ARBg = p.ws + CH_ARB;
    float* G15g = (float*)(p.ws + CH_G15); unsigned char* CHVg = (unsigned char*)p.out + OUT_CHV;
    const bf16x8 zero8 = (bf16x8){0, 0, 0, 0, 0, 0, 0, 0};
    const f32x4 zero4 = (f32x4){0.f, 0.f, 0.f, 0.f};
#pragma unroll 1
    for (int mt = 0; mt < 4; ++mt) {
        const size_t u = (size_t)bh * 128 + (s0 >> 4) + mt;
        {
            f32x4 aw[4], aa[4];
#pragma unroll
            for (int nt = 0; nt < 4; ++nt) { aw[nt] = zero4; aa[nt] = zero4; }
#pragma unroll
            for (int ks = 0; ks < 2; ++ks) {
                const bf16x8 Aw = *(const bf16x8*)(twb + (mt * 16 + fr) * 72 + ks * 32 + fq * 8);
                const bf16x8 Aa = *(const bf16x8*)(alb + (mt * 16 + fr) * 72 + ks * 32 + fq * 8);
#pragma unroll
                for (int nt = 0; nt < 4; ++nt) {
                    const bf16x8 Bw = *(const bf16x8*)(WupT + (h * 64 + nt * 16 + fr) * 64 + ks * 32 + fq * 8);
                    const bf16x8 Ba = *(const bf16x8*)(AupT + (h * 64 + nt * 16 + fr) * 64 + ks * 32 + fq * 8);
                    aw[nt] = MFMA16(Bw, Aw, aw[nt]);
                    aa[nt] = MFMA16(Ba, Aa, aa[nt]);
                }
            }
            const int tt = mt * 16 + fr, s = s0 + tt; const size_t T = (size_t)(t0 + tt);
            const bool hasprev = s > 0;
            f32x4 Kr[4], Av[4];
            float n2 = 0.f, bon = 0.f;
            unsigned char* rec = recl + fr * 896;
#pragma unroll
            for (int nt = 0; nt < 4; ++nt) {
                const int cb = h * 64 + nt * 16 + fq * 4, ci = nt * 16 + fq * 4;
                const u32x2 zr = *(const u32x2*)(Z + T * DIN + 1024 + cb), zk = *(const u32x2*)(Z + T * DIN + 1536 + cb), zv = *(const u32x2*)(Z + T * DIN + 2048 + cb);
                u32x2 pr = (u32x2){0u, 0u}, pk = (u32x2){0u, 0u}, pv = (u32x2){0u, 0u};
                if (hasprev) { pr = *(const u32x2*)(Z + (T - 1) * DIN + 1024 + cb); pk = *(const u32x2*)(Z + (T - 1) * DIN + 1536 + cb); pv = *(const u32x2*)(Z + (T - 1) * DIN + 2048 + cb); }
                const f32x4 mur = *(const f32x4*)(p.shift_mu + cb), muk = *(const f32x4*)(p.shift_mu + 512 + cb), muv = *(const f32x4*)(p.shift_mu + 1024 + cb);
                const f32x4 w0v = *(const f32x4*)(p.w0 + cb), a0v = *(const f32x4*)(p.a0 + cb), kkv = *(const f32x4*)(p.k_k + cb), kav = *(const f32x4*)(p.k_a + cb), rkv = *(const f32x4*)(p.r_k + cb);
                const f32x4 cr = (f32x4){bflo(zr.x), bfhi(zr.x), bflo(zr.y), bfhi(zr.y)}, ck = (f32x4){bflo(zk.x), bfhi(zk.x), bflo(zk.y), bfhi(zk.y)}, cv = (f32x4){bflo(zv.x), bfhi(zv.x), bflo(zv.y), bfhi(zv.y)};
                const f32x4 qr = (f32x4){bflo(pr.x), bfhi(pr.x), bflo(pr.y), bfhi(pr.y)}, qk = (f32x4){bflo(pk.x), bfhi(pk.x), bflo(pk.y), bfhi(pk.y)}, qv = (f32x4){bflo(pv.x), bfhi(pv.x), bflo(pv.y), bfhi(pv.y)};
                f32x4 Rr, Kp, Vv, Dc;
#pragma unroll
                for (int jj = 0; jj < 4; ++jj) {
                    const float r = cr[jj] + mur[jj] * (qr[jj] - cr[jj]);
                    const float k = ck[jj] + muk[jj] * (qk[jj] - ck[jj]);
                    const float v = cv[jj] + muv[jj] * (qv[jj] - cv[jj]);
                    const float ww = aw[nt][jj] + w0v[jj];
                    const float a = sigmoidf_(aa[nt][jj] + a0v[jj]);
                    const float dec = __expf(-0.6065306597126334f * sigmoidf_(ww));
                    const float kr = k * kkv[jj];
                    n2 += kr * kr;
                    const float kp = k * (1.f + (a - 1.f) * kav[jj]);
                    bon += r * kp * rkv[jj];
                    Rr[jj] = r; Kp[jj] = kp; Vv[jj] = v; Kr[nt][jj] = kr; Av[nt][jj] = a; Dc[jj] = dec;
                }
                *(f32x4*)(rec + ci * 4) = Dc;
                *(u32x2*)(rec + 256 + ci * 2) = (u32x2){pack2(Rr[0], Rr[1]), pack2(Rr[2], Rr[3])};
                *(u32x2*)(rec + 384 + ci * 2) = (u32x2){pack2(Kp[0], Kp[1]), pack2(Kp[2], Kp[3])};
                const u32x2 vpk = (u32x2){pack2(Vv[0], Vv[1]), pack2(Vv[2], Vv[3])};
                *(u32x2*)(rec + 512 + ci * 2) = vpk;
                *(u32x2*)(VB + T * 512 + cb) = vpk;
            }
            n2 += __shfl_xor(n2, 16, 64); n2 += __shfl_xor(n2, 32, 64);
            bon += __shfl_xor(bon, 16, 64); bon += __shfl_xor(bon, 32, 64);
            const float inv = rsq_(fmaxf(n2, 1e-24f));
#pragma unroll
            for (int nt = 0; nt < 4; ++nt) {
                const int ci = nt * 16 + fq * 4;
                const f32x4 kk = Kr[nt] * inv;
                *(u32x2*)(rec + 640 + ci * 2) = (u32x2){pack2(kk[0], kk[1]), pack2(kk[2], kk[3])};
                const f32x4 nb = -(kk * Av[nt]);
                *(u32x2*)(rec + 768 + ci * 2) = (u32x2){pack2(nb[0], nb[1]), pack2(nb[2], nb[3])};
            }
            if (fq == 0) BON[(size_t)bh * 2048 + s] = bon;
        }
        WSYNC();
        {
            float w_[16], r_[16], kp_[16], v_[16], kk_[16], nb_[16];
#pragma unroll
            for (int t = 0; t < 16; ++t) {
                const unsigned char* rt = recl + t * 896;
                w_[t] = *(const float*)(rt + lane * 4);
                r_[t] = bf2f(*(const u16*)(rt + 256 + lane * 2)); kp_[t] = bf2f(*(const u16*)(rt + 384 + lane * 2)); v_[t] = bf2f(*(const u16*)(rt + 512 + lane * 2));
                kk_[t] = bf2f(*(const u16*)(rt + 640 + lane * 2)); nb_[t] = bf2f(*(const u16*)(rt + 768 + lane * 2));
            }
            WSYNC();
            float g = 1.f;
            float At[16], Bt[16], Kt[16];
#pragma unroll
            for (int t = 0; t < 16; ++t) {
                const float gp = g; g = g * w_[t]; const float ig = rcp_(g);
                const float a = kk_[t] * gp, rr = r_[t] * g, bb = nb_[t] * ig, kt = kp_[t] * ig;
                AR[t * 72 + lane] = f2bf(a); AR[(16 + t) * 72 + lane] = f2bf(rr); BK[t * 72 + lane] = f2bf(bb); BK[(16 + t) * 72 + lane] = f2bf(kt);
                At[t] = a; Bt[t] = bb; Kt[t] = kt;
            }
            u32x4 o0, o1;
            o0 = (u32x4){pack2(At[0], At[1]), pack2(At[2], At[3]), pack2(At[4], At[5]), pack2(At[6], At[7])};
            o1 = (u32x4){pack2(At[8], At[9]), pack2(At[10], At[11]), pack2(At[12], At[13]), pack2(At[14], At[15])};
            *(u32x4*)(AtT + lane * 16) = o0; *(u32x4*)(AtT + lane * 16 + 8) = o1;
            o0 = (u32x4){pack2(Bt[0] * g, Bt[1] * g), pack2(Bt[2] * g, Bt[3] * g), pack2(Bt[4] * g, Bt[5] * g), pack2(Bt[6] * g, Bt[7] * g)};
            o1 = (u32x4){pack2(Bt[8] * g, Bt[9] * g), pack2(Bt[10] * g, Bt[11] * g), pack2(Bt[12] * g, Bt[13] * g), pack2(Bt[14] * g, Bt[15] * g)};
            *(u32x4*)(BhT + lane * 16) = o0; *(u32x4*)(BhT + lane * 16 + 8) = o1;
            o0 = (u32x4){pack2(Kt[0] * g, Kt[1] * g), pack2(Kt[2] * g, Kt[3] * g), pack2(Kt[4] * g, Kt[5] * g), pack2(Kt[6] * g, Kt[7] * g)};
            o1 = (u32x4){pack2(Kt[8] * g, Kt[9] * g), pack2(Kt[10] * g, Kt[11] * g), pack2(Kt[12] * g, Kt[13] * g), pack2(Kt[14] * g, Kt[15] * g)};
            *(u32x4*)(KhT + lane * 16) = o0; *(u32x4*)(KhT + lane * 16 + 8) = o1;
            o0 = (u32x4){pack2(v_[0], v_[1]), pack2(v_[2], v_[3]), pack2(v_[4], v_[5]), pack2(v_[6], v_[7])};
            o1 = (u32x4){pack2(v_[8], v_[9]), pack2(v_[10], v_[11]), pack2(v_[12], v_[13]), pack2(v_[14], v_[15])};
            *(u32x4*)(VT + lane * 16) = o0; *(u32x4*)(VT + lane * 16 + 8) = o1;
            G15g[u * 64 + lane] = g;
        }
        WSYNC();
        {
            u32x2 rp[4];
#pragma unroll
            for (int ta = 0; ta < 4; ++ta) rp[ta] = *(const u32x2*)(AR + (16 + fr) * 72 + 16 * ta + 4 * fq);
            *(u32x4*)(RFg + (u * 64 + lane) * 32) = (u32x4){rp[0].x, rp[0].y, rp[1].x, rp[1].y};
            *(u32x4*)(RFg + (u * 64 + lane) * 32 + 16) = (u32x4){rp[2].x, rp[2].y, rp[3].x, rp[3].y};
#pragma unroll
            for (int ta = 0; ta < 4; ++ta) {
                const u32x2 b2 = *(const u32x2*)(BhT + (16 * ta + fr) * 16 + 4 * fq), k2 = *(const u32x2*)(KhT + (16 * ta + fr) * 16 + 4 * fq);
                *(u32x4*)(BKFg + ((u * 4 + ta) * 64 + lane) * 16) = (u32x4){b2.x, b2.y, k2.x, k2.y};
            }
#pragma unroll
            for (int sl = 0; sl < 4; ++sl) *(u32x2*)(CHVg + (((u * 4 + sl) * 3 + 2) * 64 + lane) * 8) = *(const u32x2*)(VT + (16 * sl + fr) * 16 + 4 * fq);
        }
        {
            f32x4 P00 = zero4, P01 = zero4, P10 = zero4, P11 = zero4;
#pragma unroll
            for (int s = 0; s < 2; ++s) {
                const bf16x8 a0 = *(const bf16x8*)(AR + fr * 72 + s * 32 + fq * 8), a1 = *(const bf16x8*)(AR + (16 + fr) * 72 + s * 32 + fq * 8);
                const bf16x8 b0 = *(const bf16x8*)(BK + fr * 72 + s * 32 + fq * 8), b1 = *(const bf16x8*)(BK + (16 + fr) * 72 + s * 32 + fq * 8);
                P00 = MFMA16(a0, b0, P00); P01 = MFMA16(a0, b1, P01); P10 = MFMA16(a1, b0, P10); P11 = MFMA16(a1, b1, P11);
            }
            WSYNC();
            float ak[4];
#pragma unroll
            for (int r = 0; r < 4; ++r) {
                const int i = 4 * fq + r, j = fr;
                Pab[i * 17 + j] = (j < i) ? P00[r] : 0.f;
                ak[r] = (j < i) ? P01[r] : 0.f;
                Arb[i * 24 + j] = f2bf((j <= i) ? P10[r] : 0.f);
                Ark[i * 24 + j] = f2bf((j <= i) ? P11[r] : 0.f);
            }
            *(u32x2*)(AakT + fr * 24 + 4 * fq) = (u32x2){pack2(ak[0], ak[1]), pack2(ak[2], ak[3])};
        }
        WSYNC();
        {
            float T[16];
#pragma unroll
            for (int i = 0; i < 16; ++i) {
                float acc = (i == fr) ? 1.f : 0.f;
#pragma unroll
                for (int j = 0; j < i; ++j) acc += Pab[i * 17 + j] * T[j];
                T[i] = acc;
            }
#pragma unroll
            for (int i = 0; i < 16; ++i) Tm[i * 24 + fr] = f2bf(T[i]);
            *(u32x2*)(ARBg + (u * 64 + lane) * 8) = *(const u32x2*)(Arb + fr * 24 + 4 * fq);
        }
        WSYNC();
        const bf16x8 Tld = *(const bf16x8*)(Tm + fr * 24 + (fq & 1) * 8);
        const bf16x8 Tf = (fq < 2) ? Tld : zero8;
        {
            f32x4 D[4];
#pragma unroll
            for (int ta = 0; ta < 4; ++ta) {
                const bf16x8 ald = *(const bf16x8*)(AtT + (16 * ta + fr) * 16 + (fq & 1) * 8);
                D[ta] = MFMA16((fq < 2) ? ald : zero8, Tf, zero4);
            }
            *(u32x4*)(AFg + (u * 64 + lane) * 32) = (u32x4){pack2(D[0][0], D[0][1]), pack2(D[0][2], D[0][3]), pack2(D[1][0], D[1][1]), pack2(D[1][2], D[1][3])};
            *(u32x4*)(AFg + (u * 64 + lane) * 32 + 16) = (u32x4){pack2(D[2][0], D[2][1]), pack2(D[2][2], D[2][3]), pack2(D[3][0], D[3][1]), pack2(D[3][2], D[3][3])};
            const bf16x8 akld = *(const bf16x8*)(AakT + fr * 24 + (fq & 1) * 8);
            const f32x4 M1 = MFMA16(Tf, (fq < 2) ? akld : zero8, zero4);
#pragma unroll
            for (int r = 0; r < 4; ++r) M1m[(4 * fq + r) * 24 + fr] = f2bf(M1[r]);
        }
        WSYNC();
        {
            const bf16x8 m1ld = *(const bf16x8*)(M1m + fr * 24 + (fq & 1) * 8), rkld = *(const bf16x8*)(Ark + fr * 24 + (fq & 1) * 8);
            const bf16x8 M1f = (fq < 2) ? m1ld : zero8, Arkf = (fq < 2) ? rkld : zero8;
#pragma unroll
            for (int sl = 0; sl < 4; ++sl) {
                const bf16x8 vld = *(const bf16x8*)(VT + (16 * sl + fr) * 16 + (fq & 1) * 8);
                const bf16x8 Vb = (fq < 2) ? vld : zero8;
                const f32x4 Uh = MFMA16(M1f, Vb, zero4), Y0 = MFMA16(Arkf, Vb, zero4);
                *(u32x2*)(CHVg + (((u * 4 + sl) * 3 + 0) * 64 + lane) * 8) = (u32x2){pack2(Uh[0], Uh[1]), pack2(Uh[2], Uh[3])};
                *(u32x2*)(CHVg + (((u * 4 + sl) * 3 + 1) * 64 + lane) * 8) = (u32x2){pack2(Y0[0], Y0[1]), pack2(Y0[2], Y0[3])};
            }
        }
        WSYNC();
    }
}

struct ChunkOps { u32x4 af0, af1, rf0, rf1, bk0, bk1, bk2, bk3; u32x2 arb, uh, y0, vf; f32x4 g0, g1, g2, g3; };
constexpr int RING_SLOT = 22528, RING_NS = 6, RING_D = 5;
__device__ __forceinline__ void lds_chunk_ops(ChunkOps& o, const LAS unsigned char* s, int sl, int lane, int fq) {
    o.af0 = *(const LAS u32x4*)(s + lane * 32); o.af1 = *(const LAS u32x4*)(s + lane * 32 + 16);
    o.rf0 = *(const LAS u32x4*)(s + 2048 + lane * 32); o.rf1 = *(const LAS u32x4*)(s + 2048 + lane * 32 + 16);
    o.bk0 = *(const LAS u32x4*)(s + 4096 + (0 * 64 + lane) * 16); o.bk1 = *(const LAS u32x4*)(s + 4096 + (1 * 64 + lane) * 16);
    o.bk2 = *(const LAS u32x4*)(s + 4096 + (2 * 64 + lane) * 16); o.bk3 = *(const LAS u32x4*)(s + 4096 + (3 * 64 + lane) * 16);
    o.uh = *(const LAS u32x2*)(s + 8192 + ((sl * 3 + 0) * 64 + lane) * 8);
    o.y0 = *(const LAS u32x2*)(s + 8192 + ((sl * 3 + 1) * 64 + lane) * 8);
    o.vf = *(const LAS u32x2*)(s + 8192 + ((sl * 3 + 2) * 64 + lane) * 8);
    o.arb = *(const LAS u32x2*)(s + 14336 + lane * 8);
    o.g0 = *(const LAS f32x4*)(s + 15360 + 16 * fq); o.g1 = *(const LAS f32x4*)(s + 15360 + 64 + 16 * fq);
    o.g2 = *(const LAS f32x4*)(s + 15360 + 128 + 16 * fq); o.g3 = *(const LAS f32x4*)(s + 15360 + 192 + 16 * fq);
}
template <int LW> __device__ __forceinline__ void ring_issue(const Params& p, LAS unsigned char* ring, int bh, int c, int lane) {
    const size_t u = (size_t)bh * 128 + c;
    LAS unsigned char* slot = ring + (c % RING_NS) * RING_SLOT;
    const unsigned char* ws = p.ws; const unsigned char* od = (const unsigned char*)p.out;
#pragma unroll
    for (int j = 0; j < 11; ++j) {
        constexpr int Q0 = LW * 11; const int q = Q0 + j;
        const unsigned char* g;
        if (q < 2) g = ws + CH_AF + u * 2048 + q * 1024 + lane * 16;
        else if (q < 4) g = ws + CH_RF + u * 2048 + (q - 2) * 1024 + lane * 16;
        else if (q < 8) g = ws + CH_BKF + u * 4096 + (q - 4) * 1024 + lane * 16;
        else if (q < 14) g = od + OUT_CHV + u * 6144 + (q - 8) * 1024 + lane * 16;
        else if (q == 14) g = ws + CH_ARB + u * 512 + lane * 16;
        else if (q == 15) g = ws + CH_G15 + u * 256 + lane * 16;
        else if (q < 18) { const int i = (q - 16) * 64 + lane; g = od + OUT_GB + (((size_t)(bh >> 3) * 2048 + c * 16 + (i >> 3)) * 512 + (bh & 7) * 64) * 2 + (i & 7) * 16; }
        else if (q < 20) { const int i = (q - 18) * 64 + lane; g = ws + WS_VB + (((size_t)(bh >> 3) * 2048 + c * 16 + (i >> 3)) * 512 + (bh & 7) * 64) * 2 + (i & 7) * 16; }
        else g = ws + WS_BONUS + ((size_t)bh * 2048 + c * 16) * 4 + lane * 16;
        __builtin_amdgcn_global_load_lds((const unsigned*)g, (LAS unsigned*)(slot + q * 1024), 16, 0, 0);
    }
}
template <int CTRL> __device__ __forceinline__ float dpp_add_q(float v) {
    const int t = __builtin_amdgcn_update_dpp(0, __float_as_int(v), CTRL, 0xf, 0xf, false);
    return v + __int_as_float(t);
}
__device__ __forceinline__ float oct_allsum(float v) {
    v = dpp_add_q<0xB1>(v); v = dpp_add_q<0x4E>(v); v = dpp_add_q<0x141>(v);
    return v;
}
struct EpiIn { u32x4 vv, gb; float bon; };
__device__ __forceinline__ void epi_load(EpiIn& e, const LAS unsigned char* s, int t, int v0) {
    e.gb = *(const LAS u32x4*)(s + 16384 + t * 128 + v0 * 2);
    e.vv = *(const LAS u32x4*)(s + 18432 + t * 128 + v0 * 2);
    e.bon = *(const LAS float*)(s + 20480 + t * 4);
}
template <int LW> __device__ __forceinline__ void p3_loader(const Params& p, LAS unsigned char* ring, int bh, int lane) {
#pragma unroll
    for (int c = 0; c < RING_D; ++c) ring_issue<LW>(p, ring, bh, c, lane);
    asm volatile("s_waitcnt vmcnt(33)" ::: "memory");
    __builtin_amdgcn_s_barrier();
#pragma unroll 1
    for (int c = 0; c < 128; ++c) {
        const int cn = (c + RING_D < 128) ? c + RING_D : 127;
        ring_issue<LW>(p, ring, bh, cn, lane);
        asm volatile("s_waitcnt vmcnt(33)" ::: "memory");
        __builtin_amdgcn_s_barrier();
    }
    asm volatile("s_waitcnt vmcnt(0)" ::: "memory");
}
__device__ void phase3(const Params& p) {
    const int tid = threadIdx.x, lane = tid & 63, wave = __builtin_amdgcn_readfirstlane(tid >> 6), fr = lane & 15, fq = lane >> 4;
    const int bh = blockIdx.x;
    if (bh >= 64) return;
    LAS unsigned char* ring = (LAS unsigned char*)dyn_smem;
    LAS float* ybuf = (LAS float*)(ring + RING_NS * RING_SLOT);
    if (wave >= 6) {
        const int e = (wave - 6) * 64 + lane, t = e >> 3, v0 = (e & 7) * 8, b = bh >> 3, h = bh & 7;
        f32x4 ga0 = *(const f32x4*)(p.gn_gain + h * 64 + v0), ga1 = *(const f32x4*)(p.gn_gain + h * 64 + v0 + 4);
        f32x4 bi0 = *(const f32x4*)(p.gn_bias + h * 64 + v0), bi1 = *(const f32x4*)(p.gn_bias + h * 64 + v0 + 4);
        u16* Y = (u16*)(p.ws + WS_Y);
        EpiIn cur, nxt;
        __builtin_amdgcn_s_barrier();
        epi_load(cur, ring, t, v0);
#pragma unroll 1
        for (int c = 0; c <= 128; ++c) {
            if (c >= 1) {
                const int cc = c - 1;
                { const int cn = (c < 128) ? c : 127; epi_load(nxt, ring + (cn % RING_NS) * RING_SLOT, t, v0); }
                const LAS float* yb = ybuf + (cc & 1) * (16 * 68) + t * 68 + v0;
                const f32x4 y0 = *(const LAS f32x4*)(yb), y1 = *(const LAS f32x4*)(yb + 4);
                float s1 = (y0[0] + y0[1]) + (y0[2] + y0[3]) + (y1[0] + y1[1]) + (y1[2] + y1[3]);
                float s2 = y0[0] * y0[0] + y0[1] * y0[1] + y0[2] * y0[2] + y0[3] * y0[3] + y1[0] * y1[0] + y1[1] * y1[1] + y1[2] * y1[2] + y1[3] * y1[3];
                s1 = oct_allsum(s1); s2 = oct_allsum(s2);
                const float mean = s1 * (1.f / 64.f);
                const float var = fmaxf(s2 * (1.f / 64.f) - mean * mean, 0.f);
                const float rstd = rsq_(var + 64e-5f);
                const float vvf[8] = {bflo(cur.vv.x), bfhi(cur.vv.x), bflo(cur.vv.y), bfhi(cur.vv.y), bflo(cur.vv.z), bfhi(cur.vv.z), bflo(cur.vv.w), bfhi(cur.vv.w)};
                const float gbf[8] = {bflo(cur.gb.x), bfhi(cur.gb.x), bflo(cur.gb.y), bfhi(cur.gb.y), bflo(cur.gb.z), bfhi(cur.gb.z), bflo(cur.gb.w), bfhi(cur.gb.w)};
                float o[8];
#pragma unroll
                for (int i = 0; i < 8; ++i) {
                    const float yv = (i < 4) ? y0[i & 3] : y1[i & 3];
                    const float gn = (i < 4) ? ga0[i & 3] : ga1[i & 3], bs = (i < 4) ? bi0[i & 3] : bi1[i & 3];
                    const float yn = (yv - mean) * rstd * gn + bs;
                    o[i] = (yn + cur.bon * vvf[i]) * gbf[i] * sigmoidf_(gbf[i]);
                }
                *(u32x4*)(Y + ((size_t)b * 2048 + cc * 16 + t) * 1024 + 512 + h * 64 + v0) = (u32x4){pack2(o[0], o[1]), pack2(o[2], o[3]), pack2(o[4], o[5]), pack2(o[6], o[7])};
                cur = nxt;
            }
            if (c < 128) __builtin_amdgcn_s_barrier();
        }
        return;
    }
    if (wave >= 4) { if (wave == 4) p3_loader<0>(p, ring, bh, lane); else p3_loader<1>(p, ring, bh, lane); return; }
    const int sl = wave;
    f32x4 acc0 = (f32x4){0.f, 0.f, 0.f, 0.f}, acc1 = acc0, acc2 = acc0, acc3 = acc0;
    ChunkOps cur, nxt;
    __builtin_amdgcn_s_barrier();
    lds_chunk_ops(cur, ring, sl, lane, fq);
#pragma unroll 2
    for (int c = 0; c < 128; ++c) {
        { const int cn = (c + 1 < 128) ? c + 1 : c; lds_chunk_ops(nxt, ring + (cn % RING_NS) * RING_SLOT, sl, lane, fq); }
        const bf16x8 sb0 = as_bf8((u32x4){pack2(acc0[0], acc0[1]), pack2(acc0[2], acc0[3]), pack2(acc1[0], acc1[1]), pack2(acc1[2], acc1[3])});
        const bf16x8 sb1 = as_bf8((u32x4){pack2(acc2[0], acc2[1]), pack2(acc2[2], acc2[3]), pack2(acc3[0], acc3[1]), pack2(acc3[2], acc3[3])});
        f32x4 U = (f32x4){bflo(cur.uh.x), bfhi(cur.uh.x), bflo(cur.uh.y), bfhi(cur.uh.y)};
        U = MFMA16(as_bf8(cur.af0), sb0, U); U = MFMA16(as_bf8(cur.af1), sb1, U);
        f32x4 Yv = (f32x4){bflo(cur.y0.x), bfhi(cur.y0.x), bflo(cur.y0.y), bfhi(cur.y0.y)};
        Yv = MFMA16(as_bf8(cur.rf0), sb0, Yv); Yv = MFMA16(as_bf8(cur.rf1), sb1, Yv);
        const unsigned u01 = pack2(U[0], U[1]), u23 = pack2(U[2], U[3]);
        Yv = MFMA16(as_bf8((u32x4){cur.arb.x, cur.arb.y, 0u, 0u}), as_bf8((u32x4){u01, u23, 0u, 0u}), Yv);
        const bf16x8 uvb = as_bf8((u32x4){u01, u23, cur.vf.x, cur.vf.y});
        acc0 = MFMA16(as_bf8(cur.bk0), uvb, acc0 * cur.g0); acc1 = MFMA16(as_bf8(cur.bk1), uvb, acc1 * cur.g1);
        acc2 = MFMA16(as_bf8(cur.bk2), uvb, acc2 * cur.g2); acc3 = MFMA16(as_bf8(cur.bk3), uvb, acc3 * cur.g3);
        LAS float* yb = ybuf + (c & 1) * (16 * 68) + (4 * fq) * 68 + sl * 16 + fr;
        yb[0] = Yv[0]; yb[68] = Yv[1]; yb[136] = Yv[2]; yb[204] = Yv[3];
        asm volatile("s_waitcnt lgkmcnt(0)" ::: "memory");
        __builtin_amdgcn_s_barrier();
        asm volatile("" ::: "memory");
        cur = nxt;
    }
}

__device__ void phase5(const Params& p) {
    const int tid = threadIdx.x, lane = tid & 63, wave = tid >> 6, blk = blockIdx.x;
#pragma unroll 1
    for (int r0 = 0; r0 < 8; r0 += 4) {
        f32x4 v[4][4]; float ss[4];
#pragma unroll
        for (int i = 0; i < 4; ++i) {
            const f32x4* xr = (const f32x4*)(p.out + (size_t)(blk * 64 + wave * 8 + r0 + i) * DM);
#pragma unroll
            for (int q = 0; q < 4; ++q) v[i][q] = xr[lane + 64 * q];
        }
#pragma unroll
        for (int i = 0; i < 4; ++i) {
            float s = 0.f;
#pragma unroll
            for (int q = 0; q < 4; ++q) s += v[i][q][0] * v[i][q][0] + v[i][q][1] * v[i][q][1] + v[i][q][2] * v[i][q][2] + v[i][q][3] * v[i][q][3];
            ss[i] = wave_sum(s);
        }
#pragma unroll
        for (int i = 0; i < 4; ++i) {
            f32x4* xr = (f32x4*)(p.out + (size_t)(blk * 64 + wave * 8 + r0 + i) * DM);
            const float inv = rsq_(ss[i] * (1.f / 1024.f) + 1e-6f);
#pragma unroll
            for (int q = 0; q < 4; ++q) { const f32x4 g = ((const f32x4*)p.final_gain)[lane + 64 * q]; xr[lane + 64 * q] = v[i][q] * inv * g; }
        }
    }
}

__global__ void __launch_bounds__(512, 2) hybrid_fwd(Params p) {
    __shared__ uint4 xb_words;
    if (threadIdx.x == 0) xb_words = make_uint4(0u, 0u, 0u, 0u);
    __syncthreads();
    XcdBarrier bar; bar.bar = (unsigned*)(p.ws + WS_CTL); bar.x = 0; bar.st = (volatile LAS unsigned*)&xb_words;
    const int lo = p.ph_lo, hi = p.ph_hi;
    if (hi - lo > 1) bar = xcd_barrier_post((unsigned*)(p.ws + WS_CTL), (volatile LAS unsigned*)&xb_words);
#define IN(k) (lo <= (k) && (k) < hi)
#define SEAM(k) do { if (IN(k) && IN((k) + 1)) xcd_barrier(bar); } while (0)
#define RUN(k, f) do { if (IN(k)) { if (PROBE_DUP == (k)) { for (int _r = 0; _r < p.dup_n; ++_r) { if (_r) __syncthreads(); f(p); } } else f(p); } } while (0)
    RUN(0, phase0);
    SEAM(0);
    RUN(1, phase1);
    SEAM(1);
    RUN(2, phase2);
    SEAM(2);
    RUN(3, phase3);
    SEAM(3);
    RUN(4, phase4);
}

extern "C" void kernel_launch(void* const* d_in, const int* in_sizes, int n_in, void* d_out, int out_size, void* d_ws, size_t ws_size, hipStream_t stream) {
    static int grid = 0;
    if (grid == 0) {
        if (n_in != 17 || out_size != NTOK * DM || ws_size < WS_END) { fprintf(stderr, "kernel_launch: unexpected problem (n_in %d out %d ws %zu need %zu)\n", n_in, out_size, ws_size, (size_t)WS_END); grid = -1; return; }
        if (hipFuncSetAttribute((const void*)hybrid_fwd, hipFuncAttributeMaxDynamicSharedMemorySize, LDS_BYTES) != hipSuccess) { fprintf(stderr, "kernel_launch: hipFuncSetAttribute failed\n"); grid = -1; return; }
        int per_cu = 0;
        if (hipOccupancyMaxActiveBlocksPerMultiprocessor(&per_cu, (const void*)hybrid_fwd, 512, LDS_BYTES) != hipSuccess || per_cu < 1) fprintf(stderr, "kernel_launch: occupancy query says %d blocks per CU\n", per_cu);
        (void)hipGetLastError();
        grid = 256;
    }
    if (grid < 0) return;
    (void)hipMemsetAsync((char*)d_ws + WS_CTL, 0, 16384, stream);
    Params p{};
    p.x = (const float*)d_in[0]; p.norm_gain = (const float*)d_in[1]; p.w_in = (const float*)d_in[2]; p.pool_w = (const float*)d_in[3];
    p.pool_scale = (const float*)d_in[4]; p.shift_mu = (const float*)d_in[5]; p.w0 = (const float*)d_in[6]; p.w_up = (const float*)d_in[7];
    p.a0 = (const float*)d_in[8]; p.a_up = (const float*)d_in[9]; p.k_k = (const float*)d_in[10]; p.k_a = (const float*)d_in[11];
    p.r_k = (const float*)d_in[12]; p.gn_gain = (const float*)d_in[13]; p.gn_bias = (const float*)d_in[14]; p.w_out = (const float*)d_in[15];
    p.final_gain = (const float*)d_in[16];
    p.out = (float*)d_out; p.ws = (unsigned char*)d_ws; p.dup_n = 2;
#if N_LAUNCHES == 1
    p.ph_lo = 0; p.ph_hi = NPH;
    hipLaunchKernelGGL(hybrid_fwd, dim3(grid), dim3(512), LDS_BYTES, stream, p);
#else
    for (int k = 0; k < NPH; ++k) { p.ph_lo = k; p.ph_hi = k + 1; hipLaunchKernelGGL(hybrid_fwd, dim3(grid), dim3(512), LDS_BYTES, stream, p); }
#endif
}
```

```cpp
#include <hip/hip_runtime.h>
#include <stdint.h>
#include <cstdio>

typedef unsigned short u16;
typedef short bf16x8 __attribute__((ext_vector_type(8)));
typedef float f32x4 __attribute__((ext_vector_type(4)));
typedef float f32x2 __attribute__((ext_vector_type(2)));
typedef unsigned u32x2 __attribute__((ext_vector_type(2)));
typedef unsigned u32x4 __attribute__((ext_vector_type(4)));

#ifndef PROBE_DUP
#define PROBE_DUP -1
#endif
#ifndef N_LAUNCHES
#define N_LAUNCHES 1
#endif

constexpr int NTOK = 16384, DM = 1024, SEQ = 2048, DIN = 3200, DINP = 3328;
constexpr int NPH = 5;
constexpr int LDS_BYTES = 18432 + 8 * 17408;

constexpr size_t WS_CTL = 0;
constexpr size_t WS_WINT = 16384;
constexpr size_t WS_WOUTT = WS_WINT + (size_t)DINP * 1024 * 2;
constexpr size_t WS_WUPT = WS_WOUTT + (size_t)1024 * 1024 * 2;
constexpr size_t WS_AUPT = WS_WUPT + 512 * 64 * 2;
constexpr size_t WS_POOLT = WS_AUPT + 512 * 64 * 2;
constexpr size_t WS_Z = WS_POOLT + 4 * 128 * 128 * 2;
constexpr size_t WS_REC = WS_Z + (size_t)NTOK * DIN * 2;
constexpr size_t WS_Y = WS_REC + (size_t)64 * 2048 * 896;
constexpr size_t WS_BONUS = WS_Y + (size_t)NTOK * 1024 * 2;
constexpr size_t WS_PART = WS_BONUS + (size_t)64 * 2048 * 4;
constexpr size_t WS_END = WS_PART + (size_t)64 * 4 * 256 * 4;
constexpr int CTL_CNT_WORD = 3584;
constexpr int NUNIT = 64 * 128;
constexpr size_t CH_AF = WS_REC;
constexpr size_t CH_RF = CH_AF + (size_t)NUNIT * 2048;
constexpr size_t CH_BKF = CH_RF + (size_t)NUNIT * 2048;
constexpr size_t CH_ARB = CH_BKF + (size_t)NUNIT * 4096;
constexpr size_t CH_G15 = CH_ARB + (size_t)NUNIT * 512;
constexpr size_t CH_END = CH_G15 + (size_t)NUNIT * 256;
constexpr size_t WS_VB = CH_END;
static_assert(WS_VB + (size_t)NTOK * 512 * 2 <= WS_Y, "chunk operands + v must fit in the record region");
constexpr size_t OUT_CHV = 0;
constexpr size_t OUT_GB = (size_t)NUNIT * 4 * 3 * 512;
static_assert(OUT_GB + (size_t)NTOK * 512 * 2 <= (size_t)NTOK * DM * 4, "d_out scratch");

struct Params {
    const float* x; const float* norm_gain; const float* w_in; const float* pool_w; const float* pool_scale;
    const float* shift_mu; const float* w0; const float* w_up; const float* a0; const float* a_up;
    const float* k_k; const float* k_a; const float* r_k; const float* gn_gain; const float* gn_bias;
    const float* w_out; const float* final_gain;
    float* out; unsigned char* ws;
    int ph_lo, ph_hi, dup_n, pad;
};

extern __shared__ __attribute__((aligned(16))) unsigned char dyn_smem[];

__device__ __forceinline__ float bf2f(u16 v) { return __uint_as_float(((unsigned)v) << 16); }
__device__ __forceinline__ float bflo(unsigned v) { return __uint_as_float(v << 16); }
__device__ __forceinline__ float bfhi(unsigned v) { return __uint_as_float(v & 0xffff0000u); }
typedef __bf16 bf16x2_t __attribute__((ext_vector_type(2)));
__device__ __forceinline__ unsigned pack2(float lo, float hi) { bf16x2_t v = {(__bf16)lo, (__bf16)hi}; return __builtin_bit_cast(unsigned, v); }
__device__ __forceinline__ u16 f2bf(float f) { return (u16)(pack2(f, 0.f) & 0xffffu); }
__device__ __forceinline__ float wave_sum(float v) {
#pragma unroll
    for (int m = 32; m >= 1; m >>= 1) v += __shfl_xor(v, m, 64);
    return v;
}
__device__ __forceinline__ float rcp_(float v) { return __builtin_amdgcn_rcpf(v); }
__device__ __forceinline__ float rsq_(float v) { return __builtin_amdgcn_rsqf(v); }
__device__ __forceinline__ float sigmoidf_(float v) { return rcp_(1.f + __expf(-v)); }
__device__ __forceinline__ float tanhf_(float v) { return 1.f - 2.f * rcp_(1.f + __expf(2.f * v)); }

#define XB_TMO      128
#define XB_XCNT(j)  (256  + 64 * (j))
#define XB_XSUB(j)  (1280 + 64 * (j))
#define XB_XGEN(j)  (2304 + 64 * (j))
#define XB_TOP      3328
#define XB_TOPGEN   3392
#define XCD_BAR_WORDS 3456
#define XB_SPIN_CAP (1u << 22)
#define LAS __attribute__((address_space(3)))

__device__ __forceinline__ unsigned xb_ld(unsigned* p)              { return __hip_atomic_load(p, __ATOMIC_RELAXED, __HIP_MEMORY_SCOPE_AGENT); }
__device__ __forceinline__ unsigned xb_add(unsigned* p, unsigned v) { return __hip_atomic_fetch_add(p, v, __ATOMIC_RELAXED, __HIP_MEMORY_SCOPE_AGENT); }
__device__ __forceinline__ unsigned xb_xcc_id() { return (unsigned)__builtin_amdgcn_s_getreg((3 << 11) | 20) & 0xFu; }
#define XB_SPIN(cond, bar) do { unsigned _sp = 0; while (cond) { __builtin_amdgcn_s_sleep(1); \
    if ((++_sp & 255u) == 0u) { if (xb_ld(&(bar)[XB_TMO])) break; if (_sp > XB_SPIN_CAP) { atomicAdd(&(bar)[XB_TMO], 1u); break; } } } } while (0)

struct XcdBarrier { unsigned* bar; unsigned x; volatile LAS unsigned* st; };

__device__ __forceinline__ XcdBarrier xcd_barrier_post(unsigned* bar, volatile LAS unsigned* st) {
    XcdBarrier b; b.bar = bar; b.x = xb_xcc_id(); b.st = st;
    if (threadIdx.x == 0) (void)xb_add(&bar[XB_XCNT(b.x)], 1u);
    return b;
}
__device__ __forceinline__ void xcd_barrier_complete(unsigned* bar, unsigned x, unsigned& nloc, unsigned& nx) {
    const unsigned G = gridDim.x * gridDim.y * gridDim.z;
    unsigned sum, cnt, mine, sp = 0u;
    for (;;) {
        sum = 0u; cnt = 0u; mine = 0u;
#pragma unroll
        for (unsigned j = 0; j < 16; ++j) { const unsigned c = xb_ld(&bar[XB_XCNT(j)]); sum += c; cnt += (c > 0u) ? 1u : 0u; mine = (j == x) ? c : mine; }
        if (sum == G) break;
        __builtin_amdgcn_s_sleep(1);
        if ((++sp & 255u) == 0u) { if (xb_ld(&bar[XB_TMO])) break; if (sp > XB_SPIN_CAP) { atomicAdd(&bar[XB_TMO], 1u); break; } }
    }
    nloc = mine > 0u ? mine : 1u; nx = cnt > 0u ? cnt : 1u;
}
__device__ __forceinline__ void xcd_barrier(const XcdBarrier& b) {
    asm volatile("s_waitcnt vmcnt(0)" ::: "memory");
    __syncthreads();
    if (threadIdx.x == 0) {
        unsigned* bar = b.bar;
        __builtin_amdgcn_s_waitcnt(0);
        unsigned nloc = b.st[0], nx = b.st[1];
        if (nloc == 0u) { xcd_barrier_complete(bar, b.x, nloc, nx); b.st[0] = nloc; b.st[1] = nx; }
        const unsigned old = xb_add(&bar[XB_XSUB(b.x)], 1u);
        const unsigned gen = old / nloc;
        if (old + 1u == (gen + 1u) * nloc) {
            __builtin_amdgcn_fence(__ATOMIC_RELEASE, "agent");
            asm volatile("s_waitcnt vmcnt(0)" ::: "memory");
            const unsigned og = xb_add(&bar[XB_TOP], 1u);
            const unsigned tg = og / nx;
            if (og + 1u == (tg + 1u) * nx) xb_add(&bar[XB_TOPGEN], 1u);
            else XB_SPIN(xb_ld(&bar[XB_TOPGEN]) == tg, bar);
            __builtin_amdgcn_fence(__ATOMIC_ACQUIRE, "agent");
            xb_add(&bar[XB_XGEN(b.x)], 1u);
            asm volatile("s_waitcnt vmcnt(0)" ::: "memory");
        } else {
            XB_SPIN(xb_ld(&bar[XB_XGEN(b.x)]) == gen, bar);
            __builtin_amdgcn_fence(__ATOMIC_ACQUIRE, "agent");
            asm volatile("s_waitcnt vmcnt(0)" ::: "memory");
        }
    }
    __syncthreads();
}

constexpr int BM = 256, BK = 64, HALF = 128, HTB = HALF * BK * 2, STAGE_BYTES = 8 * HTB, NXCD = 8, WGM = 8;
__device__ __forceinline__ int lds_byte(int r, int c) { const int st = (r >> 4) * 2 + (c >> 5), rr = r & 15, cc = c & 31, ob = rr * 64 + cc * 2; return st * 1024 + (ob ^ (((ob >> 9) & 1) << 5)); }
__device__ __forceinline__ void stage_rc(int b, int& R, int& C) { const int st = b / 1024, sb = b % 1024, swz = sb ^ (((sb >> 9) & 1) << 5); R = (st >> 1) * 16 + swz / 64; C = (st & 1) * 32 + (swz % 64) / 2; }
__device__ __forceinline__ int perm32(int rho) { const int n = rho >> 4, i = rho & 15; return 8 * (i >> 2) + 4 * n + (i & 3); }

struct Unit { int pm, pn; };
struct Gemm { const u16* A; const u16* Bt; int M, N, K, Nvalid; };
struct StaticOrder {
    int nM, nN, nwg, G, c;
    __device__ void init(int M, int N, int G_, int c_) { nM = M / BM; nN = N / BM; nwg = nM * nN; G = G_; c = c_; }
    __device__ bool next(int i, Unit& u) const {
        const long L = (long)i * G + c; if (L >= nwg) return false;
        int wgid = (int)L; { const int q = nwg / NXCD, r = nwg % NXCD, xcd = wgid % NXCD, off = wgid / NXCD; wgid = (xcd < r ? xcd * (q + 1) : r * (q + 1) + (xcd - r) * q) + off; }
        const int nig = WGM * nN, gid = wgid / nig, fm = gid * WGM, gsz = (nM - fm) < WGM ? (nM - fm) : WGM;
        u.pm = fm + ((wgid % nig) % gsz); u.pn = (wgid % nig) / gsz; return true;
    }
};
struct EpiZ {
    static constexpr bool PERM = true, AFTER_DRAIN = false;
    u16* Z;
    __device__ __forceinline__ void operator()(const f32x4 (&acc)[2][2][4][2], const Unit& u, int wr, int wc, int fr, int fq) const {
        const int row0 = u.pm * BM + wr * 64 + fr, col0 = u.pn * BM + wc * 32 + 8 * fq;
#pragma unroll
        for (int ai = 0; ai < 2; ++ai)
#pragma unroll
            for (int m = 0; m < 4; ++m) { u16* rowp = Z + (size_t)(row0 + ai * HALF + m * 16) * DIN;
#pragma unroll
                for (int bj = 0; bj < 2; ++bj) { const int col = col0 + bj * HALF; const f32x4 v0 = acc[ai][bj][m][0], v1 = acc[ai][bj][m][1];
                    if (col < DIN) *(u32x4*)(rowp + col) = (u32x4){pack2(v0[0], v0[1]), pack2(v0[2], v0[3]), pack2(v1[0], v1[1]), pack2(v1[2], v1[3])}; } }
    }
};
struct EpiRes {
    static constexpr bool PERM = false, AFTER_DRAIN = false;
    const float* x; float* out;
    __device__ __forceinline__ void operator()(const f32x4 (&acc)[2][2][4][2], const Unit& u, int wr, int wc, int fr, int fq) const {
        const int row0 = u.pm * BM + wr * 64 + fr, col0 = u.pn * BM + wc * 32 + 4 * fq;
#pragma unroll
        for (int ai = 0; ai < 2; ++ai)
#pragma unroll
            for (int m = 0; m < 4; ++m) { const size_t ro = (size_t)(row0 + ai * HALF + m * 16) * DM + col0;
#pragma unroll
                for (int bj = 0; bj < 2; ++bj)
#pragma unroll
                    for (int n = 0; n < 2; ++n) { const f32x4 xv = *(const f32x4*)(x + ro + bj * HALF + n * 16); *(f32x4*)(out + ro + bj * HALF + n * 16) = xv + acc[ai][bj][m][n]; } }
    }
};
struct EpiResNorm {
    static constexpr bool PERM = false, AFTER_DRAIN = true;
    const float* x; const float* gain; float* out; float* part; unsigned* cnt;
    __device__ __forceinline__ void fused(f32x4 (&acc)[2][2][4][2], const Unit& u, int wr, int wc, int fr, int fq, LAS unsigned char* lds) const {
        const int row0 = u.pm * BM + wr * 64 + fr, col0 = u.pn * BM + wc * 32 + 4 * fq;
        LAS float* red = (LAS float*)lds;
        LAS float* tot = red + 1024;
        float rs[2][4];
#pragma unroll
        for (int ai = 0; ai < 2; ++ai)
#pragma unroll
            for (int m = 0; m < 4; ++m) { const size_t ro = (size_t)(row0 + ai * HALF + m * 16) * DM + col0; float s = 0.f;
#pragma unroll
                for (int bj = 0; bj < 2; ++bj)
#pragma unroll
                    for (int n = 0; n < 2; ++n) { const f32x4 v = *(const f32x4*)(x + ro + bj * HALF + n * 16) + acc[ai][bj][m][n]; acc[ai][bj][m][n] = v; s += v[0] * v[0] + v[1] * v[1] + v[2] * v[2] + v[3] * v[3]; }
                s += __shfl_xor(s, 16, 64); s += __shfl_xor(s, 32, 64);
                rs[ai][m] = s; }
        if (fq == 0) {
#pragma unroll
            for (int ai = 0; ai < 2; ++ai)
#pragma unroll
                for (int m = 0; m < 4; ++m) red[((wr * 4 + wc) * 8 + ai * 4 + m) * 16 + fr] = rs[ai][m];
        }
        __syncthreads();
        if (threadIdx.x < 256) {
            const int rl = threadIdx.x, ai = rl >> 7, wr_ = (rl >> 6) & 1, m = (rl >> 4) & 3, fr_ = rl & 15;
            const int o = ((wr_ * 4) * 8 + ai * 4 + m) * 16 + fr_;
            const float s = red[o] + red[o + 128] + red[o + 256] + red[o + 384];
            __hip_atomic_store(part + ((size_t)u.pm * 4 + u.pn) * 256 + rl, s, __ATOMIC_RELAXED, __HIP_MEMORY_SCOPE_AGENT);
        }
        asm volatile("s_waitcnt vmcnt(0)" ::: "memory");
        __syncthreads();
        if (threadIdx.x == 0) {
            __builtin_amdgcn_fence(__ATOMIC_RELEASE, "agent");
            asm volatile("s_waitcnt vmcnt(0)" ::: "memory");
            __hip_atomic_fetch_add(cnt + u.pm, 1u, __ATOMIC_RELAXED, __HIP_MEMORY_SCOPE_AGENT);
            unsigned sp = 0;
            while (__hip_atomic_load(cnt + u.pm, __ATOMIC_RELAXED, __HIP_MEMORY_SCOPE_AGENT) < 4u) { __builtin_amdgcn_s_sleep(1); if (++sp > (1u << 24)) break; }
            __builtin_amdgcn_fence(__ATOMIC_ACQUIRE, "agent");
            asm volatile("s_waitcnt vmcnt(0)" ::: "memory");
        }
        __syncthreads();
        for (int e = threadIdx.x; e < 1024; e += 512) tot[e] = __hip_atomic_load(part + (size_t)u.pm * 1024 + e, __ATOMIC_RELAXED, __HIP_MEMORY_SCOPE_AGENT);
        __syncthreads();
#pragma unroll
        for (int ai = 0; ai < 2; ++ai)
#pragma unroll
            for (int m = 0; m < 4; ++m) { const int rl = ai * 128 + wr * 64 + m * 16 + fr;
                const float inv = rsq_((tot[rl] + tot[256 + rl] + tot[512 + rl] + tot[768 + rl]) * (1.f / 1024.f) + 1e-6f);
                const size_t ro = (size_t)(row0 + ai * HALF + m * 16) * DM + col0;
#pragma unroll
                for (int bj = 0; bj < 2; ++bj)
#pragma unroll
                    for (int n = 0; n < 2; ++n) { const f32x4 g = *(const f32x4*)(gain + col0 + bj * HALF + n * 16); *(f32x4*)(out + ro + bj * HALF + n * 16) = acc[ai][bj][m][n] * inv * g; } }
    }
};

template <class Epi, class Sched>
__device__ __forceinline__ void gemm_phase(LAS unsigned char* lds, const Gemm g, const Sched& S, const Epi& E) {
    const int tid = threadIdx.x, wid = __builtin_amdgcn_readfirstlane(tid >> 6), lane = tid & 63, wr = wid >> 2, wc = wid & 3, fr = lane & 15, fq = lane >> 4;
    const int K = g.K, nt = K / BK;
    unsigned voffA[2], voffB[2];
#pragma unroll
    for (int i = 0; i < 2; ++i) { int R, C; stage_rc(tid * 16 + i * 8192, R, C); const int Rb = Epi::PERM ? ((R & ~31) + perm32(R & 31)) : R;
        voffA[i] = (unsigned)(R * K + C) * 2u; voffB[i] = (unsigned)(Rb * K + C) * 2u; }
    const size_t kstep = (size_t)(BK * 2);
    const size_t hstep = (size_t)HALF * K * 2;
    const size_t tstep = 2 * hstep;
    const unsigned ldsw = (unsigned)wid * 1024u;
    const int aoff = lds_byte(wr * 64 + fr, fq * 8), boff = lds_byte(wc * 32 + fr, fq * 8);
#define PG8_SA(b, h) (((b) * 2 + (h)) * HTB)
#define PG8_SB(b, h) ((4 + (b) * 2 + (h)) * HTB)
#define PG8_STAGE(bufoff, gbase, voff) do { _Pragma("unroll") for (int _i = 0; _i < 2; ++_i) \
        __builtin_amdgcn_global_load_lds((const unsigned*)((const char*)(gbase) + (voff)[_i]), (LAS unsigned*)(lds + (bufoff) + ldsw + _i * 8192), 16, 0, 0); } while (0)
#define PG8_LDA(dst, b, h) do { _Pragma("unroll") for (int m = 0; m < 4; ++m) _Pragma("unroll") for (int k = 0; k < 2; ++k) dst[m][k] = *(const LAS bf16x8*)(lds + PG8_SA(b, h) + aoff + m * 2048 + k * 1024); } while (0)
#define PG8_LDB(dst, b, h) do { _Pragma("unroll") for (int n = 0; n < 2; ++n) _Pragma("unroll") for (int k = 0; k < 2; ++k) dst[n][k] = *(const LAS bf16x8*)(lds + PG8_SB(b, h) + boff + n * 2048 + k * 1024); } while (0)
#define PG8_MMA(ai, bj, At, Bt) do { __builtin_amdgcn_s_setprio(1); _Pragma("unroll") for (int m = 0; m < 4; ++m) _Pragma("unroll") for (int n = 0; n < 2; ++n) _Pragma("unroll") for (int k = 0; k < 2; ++k) \
        acc[ai][bj][m][n] = __builtin_amdgcn_mfma_f32_16x16x32_bf16(Bt[n][k], At[m][k], acc[ai][bj][m][n], 0, 0, 0); __builtin_amdgcn_s_setprio(0); } while (0)
#define PG8_WAIT_V(n) asm volatile("s_waitcnt vmcnt(" #n ")" ::: "memory")
#define PG8_WAIT_L(n) asm volatile("s_waitcnt lgkmcnt(" #n ")" ::: "memory")
#define PG8_BAR __builtin_amdgcn_s_barrier()
#define PG8_SCHED __builtin_amdgcn_sched_barrier(0)
    Unit cur, nxt; int ui = 0;
    if (!S.next(0, cur)) return;
    f32x4 acc[2][2][4][2];
#pragma unroll
    for (int a = 0; a < 2; ++a)
#pragma unroll
        for (int b = 0; b < 2; ++b)
#pragma unroll
            for (int m = 0; m < 4; ++m)
#pragma unroll
                for (int n = 0; n < 2; ++n) acc[a][b][m][n] = (f32x4){0.f, 0.f, 0.f, 0.f};
    bf16x8 At[4][2], B0[2][2], B1[2][2];
    const char* cA = (const char*)g.A + (size_t)cur.pm * tstep; const char* cB = (const char*)g.Bt + (size_t)cur.pn * tstep;
    PG8_STAGE(PG8_SB(0, 0), cB, voffB); PG8_STAGE(PG8_SA(0, 0), cA, voffA); PG8_STAGE(PG8_SB(0, 1), cB + hstep, voffB); PG8_STAGE(PG8_SA(0, 1), cA + hstep, voffA);
    if (wr == 1) PG8_BAR;
    PG8_WAIT_V(4); PG8_BAR;
    PG8_STAGE(PG8_SB(1, 0), cB + kstep, voffB); PG8_STAGE(PG8_SA(1, 0), cA + kstep, voffA); PG8_STAGE(PG8_SB(1, 1), cB + hstep + kstep, voffB);
    PG8_WAIT_V(6); PG8_BAR;
    for (;;) {
        const bool has_next = S.next(ui + 1, nxt);
        const char* nA = has_next ? (const char*)g.A + (size_t)nxt.pm * tstep : cA; const char* nB = has_next ? (const char*)g.Bt + (size_t)nxt.pn * tstep : cB;
        const bool rhalf = (cur.pn * BM + HALF) < g.Nvalid;
        for (int t = 0; t < nt; t += 2) {
            const bool last = (t == nt - 2);
            const char* a1 = cA + (size_t)(t + 1) * kstep;
            const char* a2 = last ? nA : cA + (size_t)(t + 2) * kstep; const char* b2 = last ? nB : cB + (size_t)(t + 2) * kstep;
            const char* a3 = a2 + kstep; const char* b3 = b2 + kstep;
            PG8_LDB(B0, 0, 0); PG8_SCHED; PG8_LDA(At, 0, 0); PG8_STAGE(PG8_SA(1, 1), a1 + hstep, voffA);
            PG8_WAIT_L(8); PG8_BAR; PG8_WAIT_L(0); PG8_MMA(0, 0, At, B0); PG8_BAR; PG8_SCHED;
            PG8_LDB(B1, 0, 1); PG8_STAGE(PG8_SB(0, 0), b2, voffB);
            PG8_BAR; PG8_WAIT_L(0); if (rhalf) PG8_MMA(0, 1, At, B1); PG8_BAR;
            PG8_LDA(At, 0, 1); PG8_STAGE(PG8_SA(0, 0), a2, voffA);
            PG8_BAR; PG8_WAIT_L(0); PG8_MMA(1, 0, At, B0); PG8_BAR; PG8_SCHED;
            PG8_STAGE(PG8_SB(0, 1), b2 + hstep, voffB);
            PG8_WAIT_V(6); PG8_BAR; if (rhalf) PG8_MMA(1, 1, At, B1); PG8_BAR;
            PG8_LDB(B0, 1, 0); PG8_SCHED; PG8_LDA(At, 1, 0); PG8_STAGE(PG8_SA(0, 1), a2 + hstep, voffA);
            PG8_WAIT_L(8); PG8_BAR; PG8_WAIT_L(0); PG8_MMA(0, 0, At, B0); PG8_BAR; PG8_SCHED;
            PG8_LDB(B1, 1, 1); PG8_STAGE(PG8_SB(1, 0), b3, voffB);
            PG8_BAR; PG8_WAIT_L(0); if (rhalf) PG8_MMA(0, 1, At, B1); PG8_BAR;
            PG8_LDA(At, 1, 1); PG8_STAGE(PG8_SA(1, 0), a3, voffA);
            PG8_BAR; PG8_WAIT_L(0); PG8_MMA(1, 0, At, B0); PG8_BAR; PG8_SCHED;
            PG8_STAGE(PG8_SB(1, 1), b3 + hstep, voffB);
            PG8_WAIT_V(6); PG8_BAR; if (rhalf) PG8_MMA(1, 1, At, B1); PG8_BAR;
        }
        if constexpr (!Epi::AFTER_DRAIN) E(acc, cur, wr, wc, fr, fq);
        if (!has_next) break;
#pragma unroll
        for (int a = 0; a < 2; ++a)
#pragma unroll
            for (int b = 0; b < 2; ++b)
#pragma unroll
                for (int m = 0; m < 4; ++m)
#pragma unroll
                    for (int n = 0; n < 2; ++n) acc[a][b][m][n] = (f32x4){0.f, 0.f, 0.f, 0.f};
        cur = nxt; cA = nA; cB = nB; ++ui;
    }
    PG8_WAIT_V(0);
    if (wr == 0) PG8_BAR;
    PG8_BAR;
    if constexpr (Epi::AFTER_DRAIN) E.fused(acc, cur, wr, wc, fr, fq, lds);
#undef PG8_SA
#undef PG8_SB
#undef PG8_STAGE
#undef PG8_LDA
#undef PG8_LDB
#undef PG8_MMA
#undef PG8_WAIT_V
#undef PG8_WAIT_L
#undef PG8_BAR
#undef PG8_SCHED
}

__device__ void phase0(const Params& p) {
    const int tid = threadIdx.x, lane = tid & 63, wave = tid >> 6, blk = blockIdx.x;
    u16* Hbf = (u16*)p.out;
#pragma unroll 1
    for (int r0 = 0; r0 < 8; r0 += 4) {
        f32x4 v[4][4]; float ss[4];
#pragma unroll
        for (int i = 0; i < 4; ++i) {
            const f32x4* xr = (const f32x4*)(p.x + (size_t)(blk * 64 + wave * 8 + r0 + i) * DM);
#pragma unroll
            for (int q = 0; q < 4; ++q) v[i][q] = __builtin_nontemporal_load(xr + lane + 64 * q);
        }
#pragma unroll
        for (int i = 0; i < 4; ++i) {
            float s = 0.f;
#pragma unroll
            for (int q = 0; q < 4; ++q) s += v[i][q][0] * v[i][q][0] + v[i][q][1] * v[i][q][1] + v[i][q][2] * v[i][q][2] + v[i][q][3] * v[i][q][3];
            ss[i] = wave_sum(s);
        }
#pragma unroll
        for (int i = 0; i < 4; ++i) {
            const int row = blk * 64 + wave * 8 + r0 + i;
            const float inv = rsq_(ss[i] * (1.f / 1024.f) + 1e-6f);
#pragma unroll
            for (int q = 0; q < 4; ++q) {
                const f32x4 g = ((const f32x4*)p.norm_gain)[lane + 64 * q];
                u32x2 o; o.x = pack2(v[i][q][0] * inv * g[0], v[i][q][1] * inv * g[1]); o.y = pack2(v[i][q][2] * inv * g[2], v[i][q][3] * inv * g[3]);
                *(u32x2*)(Hbf + (size_t)row * DM + (lane + 64 * q) * 4) = o;
            }
        }
    }
    float* tl = (float*)dyn_smem;
    u16* WinT = (u16*)(p.ws + WS_WINT); u16* WoutT = (u16*)(p.ws + WS_WOUTT);
#pragma unroll 1
    for (int t = blk; t < 832 + 256; t += 256) {
        const float* src; u16* dst; int kt, ntile, N;
        if (t < 832) { kt = t & 15; ntile = t >> 4; src = p.w_in; N = DIN; dst = WinT; }
        else { const int t2 = t - 832; kt = t2 & 15; ntile = t2 >> 4; src = p.w_out; N = 1024; dst = WoutT; }
        const int k0 = kt * 64, n0 = ntile * 64;
        __syncthreads();
        for (int kk = wave; kk < 64; kk += 8) { const int n = n0 + lane; tl[kk * 65 + lane] = (n < N) ? src[(size_t)(k0 + kk) * N + n] : 0.f; }
        __syncthreads();
        for (int nn = wave; nn < 64; nn += 8) dst[(size_t)(n0 + nn) * 1024 + k0 + lane] = f2bf(tl[lane * 65 + nn]);
    }
    u16* WupT = (u16*)(p.ws + WS_WUPT); u16* AupT = (u16*)(p.ws + WS_AUPT); u16* PoolT = (u16*)(p.ws + WS_POOLT);
    const int gt = blk * 512 + tid;
    if (gt < 32768) { const int c = gt >> 6, j = gt & 63; WupT[gt] = f2bf(p.w_up[j * 512 + c]); AupT[gt] = f2bf(p.a_up[j * 512 + c]); }
    if (gt < 65536) { const int g = gt >> 14, d = (gt >> 7) & 127, c = gt & 127; PoolT[gt] = f2bf(p.pool_w[(g * 128 + c) * 128 + d]); }
}

__device__ void phase1(const Params& p) {
    Gemm g; g.A = (const u16*)p.out; g.Bt = (const u16*)(p.ws + WS_WINT); g.M = NTOK; g.N = DINP; g.K = 1024; g.Nvalid = DIN;
    StaticOrder S; S.init(NTOK, DINP, 256, blockIdx.x);
    EpiZ E; E.Z = (u16*)(p.ws + WS_Z);
    gemm_phase((LAS unsigned char*)dyn_smem, g, S, E);
}
__device__ void phase4(const Params& p) {
    Gemm g; g.A = (const u16*)(p.ws + WS_Y); g.Bt = (const u16*)(p.ws + WS_WOUTT); g.M = NTOK; g.N = 1024; g.K = 1024; g.Nvalid = 1024;
    StaticOrder S; S.init(NTOK, 1024, 256, blockIdx.x);
    EpiResNorm E; E.x = p.x; E.gain = p.final_gain; E.out = p.out; E.part = (float*)(p.ws + WS_PART); E.cnt = (unsigned*)(p.ws + WS_CTL) + CTL_CNT_WORD;
    gemm_phase((LAS unsigned char*)dyn_smem, g, S, E);
}

template <int CTRL> __device__ __forceinline__ float dpp_add(float v) {
    const int t = __builtin_amdgcn_update_dpp(0, __float_as_int(v), CTRL, 0xf, 0xf, false);
    return v + __int_as_float(t);
}
__device__ __forceinline__ float row16_allsum(float v) {
    v = dpp_add<0x128>(v); v = dpp_add<0x124>(v); v = dpp_add<0x122>(v); v = dpp_add<0x121>(v);
    return v;
}
#define WSYNC() do { __builtin_amdgcn_wave_barrier(); asm volatile("s_waitcnt lgkmcnt(0)" ::: "memory"); __builtin_amdgcn_wave_barrier(); } while (0)
#define MFMA16(a, b, c) __builtin_amdgcn_mfma_f32_16x16x32_bf16((a), (b), (c), 0, 0, 0)
__device__ __forceinline__ bf16x8 as_bf8(u32x4 v) { return __builtin_bit_cast(bf16x8, v); }
template <int W> __device__ __forceinline__ void pooled_run(const u16* __restrict__ Z, u16* pooled, int t0, int s0, int cp, int hf) {
    const int c0 = 2 * cp, tb = hf * 32;
    unsigned raw[W - 1 + 32];
#pragma unroll
    for (int i = 0; i < W - 1 + 32; ++i) { const int tt = tb - (W - 1) + i; raw[i] = (s0 + tt >= 0) ? *(const unsigned*)(Z + (size_t)(t0 + tt) * DIN + c0) : 0u; }
    float sum0 = 0.f, sum1 = 0.f;
#pragma unroll
    for (int i = 0; i < W - 1; ++i) { sum0 += bflo(raw[i]); sum1 += bfhi(raw[i]); }
#pragma unroll
    for (int j = 0; j < 32; ++j) {
        const int tt = tb + j, s = s0 + tt;
        const float u0 = bflo(raw[W - 1 + j]), u1 = bfhi(raw[W - 1 + j]);
        sum0 += u0; sum1 += u1;
        const float rc = rcp_((float)((s + 1 < W) ? (s + 1) : W));
        *(unsigned*)(pooled + tt * 520 + c0) = pack2(sum0 * rc - u0, sum1 * rc - u1);
        sum0 -= bflo(raw[j]); sum1 -= bfhi(raw[j]);
    }
}
constexpr int RST = 912;
__device__ __forceinline__ void p2_zload(u32x4 (&zq)[7], const u16* __restrict__ Z, size_t T0, bool has_halo, int h, int lane) {
#pragma unroll
    for (int q = 0; q < 7; ++q) {
        const int pidx = lane + 64 * q, rr = pidx / 24, w = pidx - rr * 24, a = w >> 3, pc = w & 7;
        u32x4 v = (u32x4){0u, 0u, 0u, 0u};
        if (pidx < 17 * 24) {
            if (rr < 16) v = *(const u32x4*)(Z + (T0 + rr) * DIN + 1024 + a * 512 + h * 64 + pc * 8);
            else if (has_halo) v = *(const u32x4*)(Z + (T0 - 1) * DIN + 1024 + a * 512 + h * 64 + pc * 8);
        }
        zq[q] = v;
    }
}
constexpr int P2_WREG = 17408;
__device__ void phase2(const Params& p) {
    const int tid = threadIdx.x, lane = tid & 63, wave = tid >> 6, blk = blockIdx.x, fr = lane & 15, fq = lane >> 4;
    const int t0 = blk * 64, b = t0 >> 11, s0 = t0 & 2047;
    const u16* Z = (const u16*)(p.ws + WS_Z);
    u16* twb = (u16*)dyn_smem;
    u16* alb = twb + 64 * 72;
    u16* pooled = alb + 64 * 72;
    for (int e = tid; e < 64 * 128; e += 512) {
        const int tt = e >> 7, j = e & 127;
        const size_t zi = (size_t)(t0 + tt) * DIN + 2560 + j;
        const float cur = bf2f(Z[zi]);
        const float prev = (s0 + tt > 0) ? bf2f(Z[zi - DIN]) : 0.f;
        const float val = cur + p.shift_mu[1536 + j] * (prev - cur);
        if (j < 64) twb[tt * 72 + j] = f2bf(tanhf_(val)); else alb[tt * 72 + (j - 64)] = f2bf(val);
    }
    {
        const int cp = tid & 255, hf = tid >> 8;
        switch (wave & 3) {
            case 0: pooled_run<2>(Z, pooled, t0, s0, cp, hf); break;
            case 1: pooled_run<4>(Z, pooled, t0, s0, cp, hf); break;
            case 2: pooled_run<8>(Z, pooled, t0, s0, cp, hf); break;
            default: pooled_run<16>(Z, pooled, t0, s0, cp, hf); break;
        }
    }
    __syncthreads();
    {
        const int g = wave >> 1, dbase = (wave & 1) * 64;
        const u16* PoolT = (const u16*)(p.ws + WS_POOLT); u16* Y = (u16*)(p.ws + WS_Y);
        f32x4 acc[4][4];
#pragma unroll
        for (int mt = 0; mt < 4; ++mt)
#pragma unroll
            for (int nt = 0; nt < 4; ++nt) acc[mt][nt] = (f32x4){0.f, 0.f, 0.f, 0.f};
#pragma unroll
        for (int ks = 0; ks < 4; ++ks) {
            bf16x8 Bf[4];
#pragma unroll
            for (int nt = 0; nt < 4; ++nt) Bf[nt] = *(const bf16x8*)(PoolT + (size_t)(g * 128 + dbase + nt * 16 + fr) * 128 + ks * 32 + fq * 8);
#pragma unroll
            for (int mt = 0; mt < 4; ++mt) {
                const bf16x8 Af = *(const bf16x8*)(pooled + (mt * 16 + fr) * 520 + g * 128 + ks * 32 + fq * 8);
#pragma unroll
                for (int nt = 0; nt < 4; ++nt) acc[mt][nt] = MFMA16(Bf[nt], Af, acc[mt][nt]);
            }
        }
#pragma unroll
        for (int mt = 0; mt < 4; ++mt) {
            const size_t T = (size_t)(t0 + mt * 16 + fr);
#pragma unroll
            for (int nt = 0; nt < 4; ++nt) {
                const int ch = g * 128 + dbase + nt * 16 + fq * 4;
                const u32x2 ga = *(const u32x2*)(Z + T * DIN + 512 + ch);
                const f32x4 ps = *(const f32x4*)(p.pool_scale + ch);
                const f32x4 gv = (f32x4){bflo(ga.x), bfhi(ga.x), bflo(ga.y), bfhi(ga.y)};
                f32x4 y;
#pragma unroll
                for (int jj = 0; jj < 4; ++jj) y[jj] = acc[mt][nt][jj] * ps[jj] * gv[jj] * sigmoidf_(gv[jj]);
                u32x2 o; o.x = pack2(y[0], y[1]); o.y = pack2(y[2], y[3]);
                *(u32x2*)(Y + T * 1024 + ch) = o;
            }
        }
    }
    {
        u16* GB = (u16*)((unsigned char*)p.out + OUT_GB);
        for (int e = tid; e < 64 * 64; e += 512) { const int tt = e >> 6, q = e & 63;
            *(u32x4*)(GB + (size_t)(t0 + tt) * 512 + q * 8) = *(const u32x4*)(Z + (size_t)(t0 + tt) * DIN + 2688 + q * 8); }
    }
    __syncthreads();
    const int h = wave, bh = b * 8 + h;
    unsigned char* WL = dyn_smem + 18432 + wave * P2_WREG;
    unsigned char* recl = WL;
    u16* AR = (u16*)WL;
    u16* BK = AR + 32 * 72;
    u16* AtT = BK + 32 * 72;
    u16* BhT = AtT + 64 * 16;
    u16* KhT = BhT + 64 * 16;
    u16* VT = KhT + 64 * 16;
    float* Pab = (float*)WL;
    u16* Tm = (u16*)(Pab + 16 * 17);
    u16* AakT = Tm + 16 * 24;
    u16* M1m = AakT + 16 * 24;
    u16* Ark = M1m + 16 * 24;
    u16* Arb = Ark + 16 * 24;
    const u16* WupT = (const u16*)(p.ws + WS_WUPT); const u16* AupT = (const u16*)(p.ws + WS_AUPT);
    float* BON = (float*)(p.ws + WS_BONUS); u16* VB = (u16*)(p.ws + WS_VB);
    unsigned char* AFg = p.ws + CH_AF; unsigned char* RFg = p.ws + CH_RF; unsigned char* BKFg = p.ws + CH_BKF; unsigned char* ARBg = p.ws + CH_ARB;
    float* G15g = (float*)(p.ws + CH_G15); unsigned char* CHVg = (unsigned char*)p.out + OUT_CHV;
    const bf16x8 zero8 = (bf16x8){0, 0, 0, 0, 0, 0, 0, 0};
    const f32x4 zero4 = (f32x4){0.f, 0.f, 0.f, 0.f};
#pragma unroll 1
    for (int mt = 0; mt < 4; ++mt) {
        const size_t u = (size_t)bh * 128 + (s0 >> 4) + mt;
        {
            u32x4 zq[7];
            p2_zload(zq, Z, (size_t)(t0 + mt * 16), (s0 + mt * 16) > 0, h, lane);
            f32x4 aw[4], aa[4];
#pragma unroll
            for (int nt = 0; nt < 4; ++nt) { aw[nt] = zero4; aa[nt] = zero4; }
#pragma unroll
            for (int ks = 0; ks < 2; ++ks) {
                const bf16x8 Aw = *(const bf16x8*)(twb + (mt * 16 + fr) * 72 + ks * 32 + fq * 8);
                const bf16x8 Aa = *(const bf16x8*)(alb + (mt * 16 + fr) * 72 + ks * 32 + fq * 8);
#pragma unroll
                for (int nt = 0; nt < 4; ++nt) {
                    const bf16x8 Bw = *(const bf16x8*)(WupT + (h * 64 + nt * 16 + fr) * 64 + ks * 32 + fq * 8);
                    const bf16x8 Ba = *(const bf16x8*)(AupT + (h * 64 + nt * 16 + fr) * 64 + ks * 32 + fq * 8);
                    aw[nt] = MFMA16(Bw, Aw, aw[nt]);
                    aa[nt] = MFMA16(Ba, Aa, aa[nt]);
                }
            }
#pragma unroll
            for (int q = 0; q < 7; ++q) {
                const int pidx = lane + 64 * q, rr = pidx / 24, w = pidx - rr * 24, a = w >> 3, pc = w & 7;
                if (pidx < 17 * 24) *(u32x4*)(recl + ((rr < 16) ? rr * RST + 256 : 16 * RST) + a * 128 + pc * 16) = zq[q];
            }
            WSYNC();
            const int tt = mt * 16 + fr, s = s0 + tt; const size_t T = (size_t)(t0 + tt);
            f32x4 Kr[4], Av[4];
            float n2 = 0.f, bon = 0.f;
            unsigned char* rec = recl + fr * RST;
            const unsigned char* prec = (fr > 0) ? (recl + (fr - 1) * RST) : (recl + 16 * RST - 256);
#pragma unroll
            for (int nt = 0; nt < 4; ++nt) {
                const int cb = h * 64 + nt * 16 + fq * 4, ci = nt * 16 + fq * 4;
                const u32x2 zr = *(const u32x2*)(rec + 256 + ci * 2), zk = *(const u32x2*)(rec + 384 + ci * 2), zv = *(const u32x2*)(rec + 512 + ci * 2);
                const u32x2 pr = *(const u32x2*)(prec + 256 + ci * 2), pk = *(const u32x2*)(prec + 384 + ci * 2), pv = *(const u32x2*)(prec + 512 + ci * 2);
                const f32x4 mur = *(const f32x4*)(p.shift_mu + cb), muk = *(const f32x4*)(p.shift_mu + 512 + cb), muv = *(const f32x4*)(p.shift_mu + 1024 + cb);
                const f32x4 w0v = *(const f32x4*)(p.w0 + cb), a0v = *(const f32x4*)(p.a0 + cb), kkv = *(const f32x4*)(p.k_k + cb), kav = *(const f32x4*)(p.k_a + cb), rkv = *(const f32x4*)(p.r_k + cb);
                const f32x4 cr = (f32x4){bflo(zr.x), bfhi(zr.x), bflo(zr.y), bfhi(zr.y)}, ck = (f32x4){bflo(zk.x), bfhi(zk.x), bflo(zk.y), bfhi(zk.y)}, cv = (f32x4){bflo(zv.x), bfhi(zv.x), bflo(zv.y), bfhi(zv.y)};
                const f32x4 qr = (f32x4){bflo(pr.x), bfhi(pr.x), bflo(pr.y), bfhi(pr.y)}, qk = (f32x4){bflo(pk.x), bfhi(pk.x), bflo(pk.y), bfhi(pk.y)}, qv = (f32x4){bflo(pv.x), bfhi(pv.x), bflo(pv.y), bfhi(pv.y)};
                f32x4 Rr, Kp, Vv, Dc;
#pragma unroll
                for (int jj = 0; jj < 4; ++jj) {
                    const float r = cr[jj] + mur[jj] * (qr[jj] - cr[jj]);
                    const float k = ck[jj] + muk[jj] * (qk[jj] - ck[jj]);
                    const float v = cv[jj] + muv[jj] * (qv[jj] - cv[jj]);
                    const float ww = aw[nt][jj] + w0v[jj];
                    const float a = sigmoidf_(aa[nt][jj] + a0v[jj]);
                    const float dec = __expf(-0.6065306597126334f * sigmoidf_(ww));
                    const float kr = k * kkv[jj];
                    n2 += kr * kr;
                    const float kp = k * (1.f + (a - 1.f) * kav[jj]);
                    bon += r * kp * rkv[jj];
                    Rr[jj] = r; Kp[jj] = kp; Vv[jj] = v; Kr[nt][jj] = kr; Av[nt][jj] = a; Dc[jj] = dec;
                }
                *(f32x4*)(rec + ci * 4) = Dc;
                *(u32x2*)(rec + 256 + ci * 2) = (u32x2){pack2(Rr[0], Rr[1]), pack2(Rr[2], Rr[3])};
                *(u32x2*)(rec + 384 + ci * 2) = (u32x2){pack2(Kp[0], Kp[1]), pack2(Kp[2], Kp[3])};
                const u32x2 vpk = (u32x2){pack2(Vv[0], Vv[1]), pack2(Vv[2], Vv[3])};
                *(u32x2*)(rec + 512 + ci * 2) = vpk;
                *(u32x2*)(VB + T * 512 + cb) = vpk;
            }
            n2 += __shfl_xor(n2, 16, 64); n2 += __shfl_xor(n2, 32, 64);
            bon += __shfl_xor(bon, 16, 64); bon += __shfl_xor(bon, 32, 64);
            const float inv = rsq_(fmaxf(n2, 1e-24f));
#pragma unroll
            for (int nt = 0; nt < 4; ++nt) {
                const int ci = nt * 16 + fq * 4;
                const f32x4 kk = Kr[nt] * inv;
                *(u32x2*)(rec + 640 + ci * 2) = (u32x2){pack2(kk[0], kk[1]), pack2(kk[2], kk[3])};
                const f32x4 nb = -(kk * Av[nt]);
                *(u32x2*)(rec + 768 + ci * 2) = (u32x2){pack2(nb[0], nb[1]), pack2(nb[2], nb[3])};
            }
            if (fq == 0) BON[(size_t)bh * 2048 + s] = bon;
        }
        WSYNC();
        {
            float w_[16], r_[16], kp_[16], v_[16], kk_[16], nb_[16];
#pragma unroll
            for (int t = 0; t < 16; ++t) {
                const unsigned char* rt = recl + t * RST;
                w_[t] = *(const float*)(rt + lane * 4);
                r_[t] = bf2f(*(const u16*)(rt + 256 + lane * 2)); kp_[t] = bf2f(*(const u16*)(rt + 384 + lane * 2)); v_[t] = bf2f(*(const u16*)(rt + 512 + lane * 2));
                kk_[t] = bf2f(*(const u16*)(rt + 640 + lane * 2)); nb_[t] = bf2f(*(const u16*)(rt + 768 + lane * 2));
            }
            WSYNC();
            float g = 1.f;
            float At[16], Bt[16], Kt[16];
#pragma unroll
            for (int t = 0; t < 16; ++t) {
                const float gp = g; g = g * w_[t]; const float ig = rcp_(g);
                const float a = kk_[t] * gp, rr = r_[t] * g, bb = nb_[t] * ig, kt = kp_[t] * ig;
                AR[t * 72 + lane] = f2bf(a); AR[(16 + t) * 72 + lane] = f2bf(rr); BK[t * 72 + lane] = f2bf(bb); BK[(16 + t) * 72 + lane] = f2bf(kt);
                At[t] = a; Bt[t] = bb; Kt[t] = kt;
            }
            u32x4 o0, o1;
            o0 = (u32x4){pack2(At[0], At[1]), pack2(At[2], At[3]), pack2(At[4], At[5]), pack2(At[6], At[7])};
            o1 = (u32x4){pack2(At[8], At[9]), pack2(At[10], At[11]), pack2(At[12], At[13]), pack2(At[14], At[15])};
            *(u32x4*)(AtT + lane * 16) = o0; *(u32x4*)(AtT + lane * 16 + 8) = o1;
            o0 = (u32x4){pack2(Bt[0] * g, Bt[1] * g), pack2(Bt[2] * g, Bt[3] * g), pack2(Bt[4] * g, Bt[5] * g), pack2(Bt[6] * g, Bt[7] * g)};
            o1 = (u32x4){pack2(Bt[8] * g, Bt[9] * g), pack2(Bt[10] * g, Bt[11] * g), pack2(Bt[12] * g, Bt[13] * g), pack2(Bt[14] * g, Bt[15] * g)};
            *(u32x4*)(BhT + lane * 16) = o0; *(u32x4*)(BhT + lane * 16 + 8) = o1;
            o0 = (u32x4){pack2(Kt[0] * g, Kt[1] * g), pack2(Kt[2] * g, Kt[3] * g), pack2(Kt[4] * g, Kt[5] * g), pack2(Kt[6] * g, Kt[7] * g)};
            o1 = (u32x4){pack2(Kt[8] * g, Kt[9] * g), pack2(Kt[10] * g, Kt[11] * g), pack2(Kt[12] * g, Kt[13] * g), pack2(Kt[14] * g, Kt[15] * g)};
            *(u32x4*)(KhT + lane * 16) = o0; *(u32x4*)(KhT + lane * 16 + 8) = o1;
            o0 = (u32x4){pack2(v_[0], v_[1]), pack2(v_[2], v_[3]), pack2(v_[4], v_[5]), pack2(v_[6], v_[7])};
            o1 = (u32x4){pack2(v_[8], v_[9]), pack2(v_[10], v_[11]), pack2(v_[12], v_[13]), pack2(v_[14], v_[15])};
            *(u32x4*)(VT + lane * 16) = o0; *(u32x4*)(VT + lane * 16 + 8) = o1;
            G15g[u * 64 + lane] = g;
        }
        WSYNC();
        {
            u32x2 rp[4];
#pragma unroll
            for (int ta = 0; ta < 4; ++ta) rp[ta] = *(const u32x2*)(AR + (16 + fr) * 72 + 16 * ta + 4 * fq);
            *(u32x4*)(RFg + (u * 64 + lane) * 32) = (u32x4){rp[0].x, rp[0].y, rp[1].x, rp[1].y};
            *(u32x4*)(RFg + (u * 64 + lane) * 32 + 16) = (u32x4){rp[2].x, rp[2].y, rp[3].x, rp[3].y};
#pragma unroll
            for (int ta = 0; ta < 4; ++ta) {
                const u32x2 b2 = *(const u32x2*)(BhT + (16 * ta + fr) * 16 + 4 * fq), k2 = *(const u32x2*)(KhT + (16 * ta + fr) * 16 + 4 * fq);
                *(u32x4*)(BKFg + ((u * 4 + ta) * 64 + lane) * 16) = (u32x4){b2.x, b2.y, k2.x, k2.y};
            }
#pragma unroll
            for (int sl = 0; sl < 4; ++sl) *(u32x2*)(CHVg + (((u * 4 + sl) * 3 + 2) * 64 + lane) * 8) = *(const u32x2*)(VT + (16 * sl + fr) * 16 + 4 * fq);
        }
        {
            f32x4 P00 = zero4, P01 = zero4, P10 = zero4, P11 = zero4;
#pragma unroll
            for (int s = 0; s < 2; ++s) {
                const bf16x8 a0 = *(const bf16x8*)(AR + fr * 72 + s * 32 + fq * 8), a1 = *(const bf16x8*)(AR + (16 + fr) * 72 + s * 32 + fq * 8);
                const bf16x8 b0 = *(const bf16x8*)(BK + fr * 72 + s * 32 + fq * 8), b1 = *(const bf16x8*)(BK + (16 + fr) * 72 + s * 32 + fq * 8);
                P00 = MFMA16(a0, b0, P00); P01 = MFMA16(a0, b1, P01); P10 = MFMA16(a1, b0, P10); P11 = MFMA16(a1, b1, P11);
            }
            WSYNC();
            float ak[4];
#pragma unroll
            for (int r = 0; r < 4; ++r) {
                const int i = 4 * fq + r, j = fr;
                Pab[i * 17 + j] = (j < i) ? P00[r] : 0.f;
                ak[r] = (j < i) ? P01[r] : 0.f;
                Arb[i * 24 + j] = f2bf((j <= i) ? P10[r] : 0.f);
                Ark[i * 24 + j] = f2bf((j <= i) ? P11[r] : 0.f);
            }
            *(u32x2*)(AakT + fr * 24 + 4 * fq) = (u32x2){pack2(ak[0], ak[1]), pack2(ak[2], ak[3])};
        }
        WSYNC();
        {
            float T[16];
#pragma unroll
            for (int i = 0; i < 16; ++i) {
                float acc = (i == fr) ? 1.f : 0.f;
#pragma unroll
                for (int j = 0; j < i; ++j) acc += Pab[i * 17 + j] * T[j];
                T[i] = acc;
            }
#pragma unroll
            for (int i = 0; i < 16; ++i) Tm[i * 24 + fr] = f2bf(T[i]);
            *(u32x2*)(ARBg + (u * 64 + lane) * 8) = *(const u32x2*)(Arb + fr * 24 + 4 * fq);
        }
        WSYNC();
        const bf16x8 Tld = *(const bf16x8*)(Tm + fr * 24 + (fq & 1) * 8);
        const bf16x8 Tf = (fq < 2) ? Tld : zero8;
        {
            f32x4 D[4];
#pragma unroll
            for (int ta = 0; ta < 4; ++ta) {
                const bf16x8 ald = *(const bf16x8*)(AtT + (16 * ta + fr) * 16 + (fq & 1) * 8);
                D[ta] = MFMA16((fq < 2) ? ald : zero8, Tf, zero4);
            }
            *(u32x4*)(AFg + (u * 64 + lane) * 32) = (u32x4){pack2(D[0][0], D[0][1]), pack2(D[0][2], D[0][3]), pack2(D[1][0], D[1][1]), pack2(D[1][2], D[1][3])};
            *(u32x4*)(AFg + (u * 64 + lane) * 32 + 16) = (u32x4){pack2(D[2][0], D[2][1]), pack2(D[2][2], D[2][3]), pack2(D[3][0], D[3][1]), pack2(D[3][2], D[3][3])};
            const bf16x8 akld = *(const bf16x8*)(AakT + fr * 24 + (fq & 1) * 8);
            const f32x4 M1 = MFMA16(Tf, (fq < 2) ? akld : zero8, zero4);
#pragma unroll
            for (int r = 0; r < 4; ++r) M1m[(4 * fq + r) * 24 + fr] = f2bf(M1[r]);
        }
        WSYNC();
        {
            const bf16x8 m1ld = *(const bf16x8*)(M1m + fr * 24 + (fq & 1) * 8), rkld = *(const bf16x8*)(Ark + fr * 24 + (fq & 1) * 8);
            const bf16x8 M1f = (fq < 2) ? m1ld : zero8, Arkf = (fq < 2) ? rkld : zero8;
#pragma unroll
            for (int sl = 0; sl < 4; ++sl) {
                const bf16x8 vld = *(const bf16x8*)(VT + (16 * sl + fr) * 16 + (fq & 1) * 8);
                const bf16x8 Vb = (fq < 2) ? vld : zero8;
                const f32x4 Uh = MFMA16(M1f, Vb, zero4), Y0 = MFMA16(Arkf, Vb, zero4);
                *(u32x2*)(CHVg + (((u * 4 + sl) * 3 + 0) * 64 + lane) * 8) = (u32x2){pack2(Uh[0], Uh[1]), pack2(Uh[2], Uh[3])};
                *(u32x2*)(CHVg + (((u * 4 + sl) * 3 + 1) * 64 + lane) * 8) = (u32x2){pack2(Y0[0], Y0[1]), pack2(Y0[2], Y0[3])};
            }
        }
        WSYNC();
    }
}

struct ChunkOps { u32x4 af0, af1, rf0, rf1, bk0, bk1, bk2, bk3; u32x2 arb, uh, y0, vf; f32x4 g0, g1, g2, g3; };
constexpr int RING_SLOT = 22528, RING_NS = 6, RING_D = 5;
__device__ __forceinline__ void lds_chunk_ops(ChunkOps& o, const LAS unsigned char* s, int sl, int lane, int fq) {
    o.af0 = *(const LAS u32x4*)(s + lane * 32); o.af1 = *(const LAS u32x4*)(s + lane * 32 + 16);
    o.rf0 = *(const LAS u32x4*)(s + 2048 + lane * 32); o.rf1 = *(const LAS u32x4*)(s + 2048 + lane * 32 + 16);
    o.bk0 = *(const LAS u32x4*)(s + 4096 + (0 * 64 + lane) * 16); o.bk1 = *(const LAS u32x4*)(s + 4096 + (1 * 64 + lane) * 16);
    o.bk2 = *(const LAS u32x4*)(s + 4096 + (2 * 64 + lane) * 16); o.bk3 = *(const LAS u32x4*)(s + 4096 + (3 * 64 + lane) * 16);
    o.uh = *(const LAS u32x2*)(s + 8192 + ((sl * 3 + 0) * 64 + lane) * 8);
    o.y0 = *(const LAS u32x2*)(s + 8192 + ((sl * 3 + 1) * 64 + lane) * 8);
    o.vf = *(const LAS u32x2*)(s + 8192 + ((sl * 3 + 2) * 64 + lane) * 8);
    o.arb = *(const LAS u32x2*)(s + 14336 + lane * 8);
    o.g0 = *(const LAS f32x4*)(s + 15360 + 16 * fq); o.g1 = *(const LAS f32x4*)(s + 15360 + 64 + 16 * fq);
    o.g2 = *(const LAS f32x4*)(s + 15360 + 128 + 16 * fq); o.g3 = *(const LAS f32x4*)(s + 15360 + 192 + 16 * fq);
}
template <int LW> __device__ __forceinline__ void ring_issue(const Params& p, LAS unsigned char* ring, int bh, int c, int lane) {
    const size_t u = (size_t)bh * 128 + c;
    LAS unsigned char* slot = ring + (c % RING_NS) * RING_SLOT;
    const unsigned char* ws = p.ws; const unsigned char* od = (const unsigned char*)p.out;
#pragma unroll
    for (int j = 0; j < 11; ++j) {
        constexpr int Q0 = LW * 11; const int q = Q0 + j;
        const unsigned char* g;
        if (q < 2) g = ws + CH_AF + u * 2048 + q * 1024 + lane * 16;
        else if (q < 4) g = ws + CH_RF + u * 2048 + (q - 2) * 1024 + lane * 16;
        else if (q < 8) g = ws + CH_BKF + u * 4096 + (q - 4) * 1024 + lane * 16;
        else if (q < 14) g = od + OUT_CHV + u * 6144 + (q - 8) * 1024 + lane * 16;
        else if (q == 14) g = ws + CH_ARB + u * 512 + lane * 16;
        else if (q == 15) g = ws + CH_G15 + u * 256 + lane * 16;
        else if (q < 18) { const int i = (q - 16) * 64 + lane; g = od + OUT_GB + (((size_t)(bh >> 3) * 2048 + c * 16 + (i >> 3)) * 512 + (bh & 7) * 64) * 2 + (i & 7) * 16; }
        else if (q < 20) { const int i = (q - 18) * 64 + lane; g = ws + WS_VB + (((size_t)(bh >> 3) * 2048 + c * 16 + (i >> 3)) * 512 + (bh & 7) * 64) * 2 + (i & 7) * 16; }
        else g = ws + WS_BONUS + ((size_t)bh * 2048 + c * 16) * 4 + lane * 16;
        __builtin_amdgcn_global_load_lds((const unsigned*)g, (LAS unsigned*)(slot + q * 1024), 16, 0, 0);
    }
}
template <int CTRL> __device__ __forceinline__ float dpp_add_q(float v) {
    const int t = __builtin_amdgcn_update_dpp(0, __float_as_int(v), CTRL, 0xf, 0xf, false);
    return v + __int_as_float(t);
}
__device__ __forceinline__ float oct_allsum(float v) {
    v = dpp_add_q<0xB1>(v); v = dpp_add_q<0x4E>(v); v = dpp_add_q<0x141>(v);
    return v;
}
struct EpiIn { u32x4 vv, gb; float bon; };
__device__ __forceinline__ void epi_load(EpiIn& e, const LAS unsigned char* s, int t, int v0) {
    e.gb = *(const LAS u32x4*)(s + 16384 + t * 128 + v0 * 2);
    e.vv = *(const LAS u32x4*)(s + 18432 + t * 128 + v0 * 2);
    e.bon = *(const LAS float*)(s + 20480 + t * 4);
}
template <int LW> __device__ __forceinline__ void p3_loader(const Params& p, LAS unsigned char* ring, int bh, int lane) {
#pragma unroll
    for (int c = 0; c < RING_D; ++c) ring_issue<LW>(p, ring, bh, c, lane);
    asm volatile("s_waitcnt vmcnt(33)" ::: "memory");
    __builtin_amdgcn_s_barrier();
#pragma unroll 1
    for (int c = 0; c < 128; ++c) {
        const int cn = (c + RING_D < 128) ? c + RING_D : 127;
        ring_issue<LW>(p, ring, bh, cn, lane);
        asm volatile("s_waitcnt vmcnt(33)" ::: "memory");
        __builtin_amdgcn_s_barrier();
    }
    asm volatile("s_waitcnt vmcnt(0)" ::: "memory");
}
__device__ void phase3(const Params& p) {
    const int tid = threadIdx.x, lane = tid & 63, wave = __builtin_amdgcn_readfirstlane(tid >> 6), fr = lane & 15, fq = lane >> 4;
    const int bh = blockIdx.x;
    if (bh >= 64) return;
    LAS unsigned char* ring = (LAS unsigned char*)dyn_smem;
    LAS float* ybuf = (LAS float*)(ring + RING_NS * RING_SLOT);
    if (wave >= 6) {
        const int e = (wave - 6) * 64 + lane, t = e >> 3, v0 = (e & 7) * 8, b = bh >> 3, h = bh & 7;
        f32x4 ga0 = *(const f32x4*)(p.gn_gain + h * 64 + v0), ga1 = *(const f32x4*)(p.gn_gain + h * 64 + v0 + 4);
        f32x4 bi0 = *(const f32x4*)(p.gn_bias + h * 64 + v0), bi1 = *(const f32x4*)(p.gn_bias + h * 64 + v0 + 4);
        u16* Y = (u16*)(p.ws + WS_Y);
        EpiIn cur, nxt;
        __builtin_amdgcn_s_barrier();
        epi_load(cur, ring, t, v0);
#pragma unroll 1
        for (int c = 0; c <= 128; ++c) {
            if (c >= 1) {
                const int cc = c - 1;
                { const int cn = (c < 128) ? c : 127; epi_load(nxt, ring + (cn % RING_NS) * RING_SLOT, t, v0); }
                const LAS float* yb = ybuf + (cc & 1) * (16 * 68) + t * 68 + v0;
                const f32x4 y0 = *(const LAS f32x4*)(yb), y1 = *(const LAS f32x4*)(yb + 4);
                float s1 = (y0[0] + y0[1]) + (y0[2] + y0[3]) + (y1[0] + y1[1]) + (y1[2] + y1[3]);
                float s2 = y0[0] * y0[0] + y0[1] * y0[1] + y0[2] * y0[2] + y0[3] * y0[3] + y1[0] * y1[0] + y1[1] * y1[1] + y1[2] * y1[2] + y1[3] * y1[3];
                s1 = oct_allsum(s1); s2 = oct_allsum(s2);
                const float mean = s1 * (1.f / 64.f);
                const float var = fmaxf(s2 * (1.f / 64.f) - mean * mean, 0.f);
                const float rstd = rsq_(var + 64e-5f);
                const float vvf[8] = {bflo(cur.vv.x), bfhi(cur.vv.x), bflo(cur.vv.y), bfhi(cur.vv.y), bflo(cur.vv.z), bfhi(cur.vv.z), bflo(cur.vv.w), bfhi(cur.vv.w)};
                const float gbf[8] = {bflo(cur.gb.x), bfhi(cur.gb.x), bflo(cur.gb.y), bfhi(cur.gb.y), bflo(cur.gb.z), bfhi(cur.gb.z), bflo(cur.gb.w), bfhi(cur.gb.w)};
                float o[8];
#pragma unroll
                for (int i = 0; i < 8; ++i) {
                    const float yv = (i < 4) ? y0[i & 3] : y1[i & 3];
                    const float gn = (i < 4) ? ga0[i & 3] : ga1[i & 3], bs = (i < 4) ? bi0[i & 3] : bi1[i & 3];
                    const float yn = (yv - mean) * rstd * gn + bs;
                    o[i] = (yn + cur.bon * vvf[i]) * gbf[i] * sigmoidf_(gbf[i]);
                }
                *(u32x4*)(Y + ((size_t)b * 2048 + cc * 16 + t) * 1024 + 512 + h * 64 + v0) = (u32x4){pack2(o[0], o[1]), pack2(o[2], o[3]), pack2(o[4], o[5]), pack2(o[6], o[7])};
                cur = nxt;
            }
            if (c < 128) __builtin_amdgcn_s_barrier();
        }
        return;
    }
    if (wave >= 4) { if (wave == 4) p3_loader<0>(p, ring, bh, lane); else p3_loader<1>(p, ring, bh, lane); return; }
    const int sl = wave;
    f32x4 acc0 = (f32x4){0.f, 0.f, 0.f, 0.f}, acc1 = acc0, acc2 = acc0, acc3 = acc0;
    ChunkOps cur, nxt;
    __builtin_amdgcn_s_barrier();
    lds_chunk_ops(cur, ring, sl, lane, fq);
#pragma unroll 2
    for (int c = 0; c < 128; ++c) {
        { const int cn = (c + 1 < 128) ? c + 1 : c; lds_chunk_ops(nxt, ring + (cn % RING_NS) * RING_SLOT, sl, lane, fq); }
        const bf16x8 sb0 = as_bf8((u32x4){pack2(acc0[0], acc0[1]), pack2(acc0[2], acc0[3]), pack2(acc1[0], acc1[1]), pack2(acc1[2], acc1[3])});
        const bf16x8 sb1 = as_bf8((u32x4){pack2(acc2[0], acc2[1]), pack2(acc2[2], acc2[3]), pack2(acc3[0], acc3[1]), pack2(acc3[2], acc3[3])});
        f32x4 U = (f32x4){bflo(cur.uh.x), bfhi(cur.uh.x), bflo(cur.uh.y), bfhi(cur.uh.y)};
        U = MFMA16(as_bf8(cur.af0), sb0, U); U = MFMA16(as_bf8(cur.af1), sb1, U);
        f32x4 Yv = (f32x4){bflo(cur.y0.x), bfhi(cur.y0.x), bflo(cur.y0.y), bfhi(cur.y0.y)};
        Yv = MFMA16(as_bf8(cur.rf0), sb0, Yv); Yv = MFMA16(as_bf8(cur.rf1), sb1, Yv);
        const unsigned u01 = pack2(U[0], U[1]), u23 = pack2(U[2], U[3]);
        Yv = MFMA16(as_bf8((u32x4){cur.arb.x, cur.arb.y, 0u, 0u}), as_bf8((u32x4){u01, u23, 0u, 0u}), Yv);
        const bf16x8 uvb = as_bf8((u32x4){u01, u23, cur.vf.x, cur.vf.y});
        acc0 = MFMA16(as_bf8(cur.bk0), uvb, acc0 * cur.g0); acc1 = MFMA16(as_bf8(cur.bk1), uvb, acc1 * cur.g1);
        acc2 = MFMA16(as_bf8(cur.bk2), uvb, acc2 * cur.g2); acc3 = MFMA16(as_bf8(cur.bk3), uvb, acc3 * cur.g3);
        LAS float* yb = ybuf + (c & 1) * (16 * 68) + (4 * fq) * 68 + sl * 16 + fr;
        yb[0] = Yv[0]; yb[68] = Yv[1]; yb[136] = Yv[2]; yb[204] = Yv[3];
        asm volatile("s_waitcnt lgkmcnt(0)" ::: "memory");
        __builtin_amdgcn_s_barrier();
        asm volatile("" ::: "memory");
        cur = nxt;
    }
}

__device__ void phase5(const Params& p) {
    const int tid = threadIdx.x, lane = tid & 63, wave = tid >> 6, blk = blockIdx.x;
#pragma unroll 1
    for (int r0 = 0; r0 < 8; r0 += 4) {
        f32x4 v[4][4]; float ss[4];
#pragma unroll
        for (int i = 0; i < 4; ++i) {
            const f32x4* xr = (const f32x4*)(p.out + (size_t)(blk * 64 + wave * 8 + r0 + i) * DM);
#pragma unroll
            for (int q = 0; q < 4; ++q) v[i][q] = xr[lane + 64 * q];
        }
#pragma unroll
        for (int i = 0; i < 4; ++i) {
            float s = 0.f;
#pragma unroll
            for (int q = 0; q < 4; ++q) s += v[i][q][0] * v[i][q][0] + v[i][q][1] * v[i][q][1] + v[i][q][2] * v[i][q][2] + v[i][q][3] * v[i][q][3];
            ss[i] = wave_sum(s);
        }
#pragma unroll
        for (int i = 0; i < 4; ++i) {
            f32x4* xr = (f32x4*)(p.out + (size_t)(blk * 64 + wave * 8 + r0 + i) * DM);
            const float inv = rsq_(ss[i] * (1.f / 1024.f) + 1e-6f);
#pragma unroll
            for (int q = 0; q < 4; ++q) { const f32x4 g = ((const f32x4*)p.final_gain)[lane + 64 * q]; xr[lane + 64 * q] = v[i][q] * inv * g; }
        }
    }
}

__global__ void __launch_bounds__(512, 2) hybrid_fwd(Params p) {
    __shared__ uint4 xb_words;
    if (threadIdx.x == 0) xb_words = make_uint4(0u, 0u, 0u, 0u);
    __syncthreads();
    XcdBarrier bar; bar.bar = (unsigned*)(p.ws + WS_CTL); bar.x = 0; bar.st = (volatile LAS unsigned*)&xb_words;
    const int lo = p.ph_lo, hi = p.ph_hi;
    if (hi - lo > 1) bar = xcd_barrier_post((unsigned*)(p.ws + WS_CTL), (volatile LAS unsigned*)&xb_words);
#define IN(k) (lo <= (k) && (k) < hi)
#define SEAM(k) do { if (IN(k) && IN((k) + 1)) xcd_barrier(bar); } while (0)
#define RUN(k, f) do { if (IN(k)) { if (PROBE_DUP == (k)) { for (int _r = 0; _r < p.dup_n; ++_r) { if (_r) __syncthreads(); f(p); } } else f(p); } } while (0)
    RUN(0, phase0);
    SEAM(0);
    RUN(1, phase1);
    SEAM(1);
    RUN(2, phase2);
    SEAM(2);
    RUN(3, phase3);
    SEAM(3);
    RUN(4, phase4);
}

extern "C" void kernel_launch(void* const* d_in, const int* in_sizes, int n_in, void* d_out, int out_size, void* d_ws, size_t ws_size, hipStream_t stream) {
    static int grid = 0;
    if (grid == 0) {
        if (n_in != 17 || out_size != NTOK * DM || ws_size < WS_END) { fprintf(stderr, "kernel_launch: unexpected problem (n_in %d out %d ws %zu need %zu)\n", n_in, out_size, ws_size, (size_t)WS_END); grid = -1; return; }
        if (hipFuncSetAttribute((const void*)hybrid_fwd, hipFuncAttributeMaxDynamicSharedMemorySize, LDS_BYTES) != hipSuccess) { fprintf(stderr, "kernel_launch: hipFuncSetAttribute failed\n"); grid = -1; return; }
        int per_cu = 0;
        if (hipOccupancyMaxActiveBlocksPerMultiprocessor(&per_cu, (const void*)hybrid_fwd, 512, LDS_BYTES) != hipSuccess || per_cu < 1) fprintf(stderr, "kernel_launch: occupancy query says %d blocks per CU\n", per_cu);
        (void)hipGetLastError();
        grid = 256;
    }
    if (grid < 0) return;
    (void)hipMemsetAsync((char*)d_ws + WS_CTL, 0, 16384, stream);
    Params p{};
    p.x = (const float*)d_in[0]; p.norm_gain = (const float*)d_in[1]; p.w_in = (const float*)d_in[2]; p.pool_w = (const float*)d_in[3];
    p.pool_scale = (const float*)d_in[4]; p.shift_mu = (const float*)d_in[5]; p.w0 = (const float*)d_in[6]; p.w_up = (const float*)d_in[7];
    p.a0 = (const float*)d_in[8]; p.a_up = (const float*)d_in[9]; p.k_k = (const float*)d_in[10]; p.k_a = (const float*)d_in[11];
    p.r_k = (const float*)d_in[12]; p.gn_gain = (const float*)d_in[13]; p.gn_bias = (const float*)d_in[14]; p.w_out = (const float*)d_in[15];
    p.final_gain = (const float*)d_in[16];
    p.out = (float*)d_out; p.ws = (unsigned char*)d_ws; p.dup_n = 2;
#if N_LAUNCHES == 1
    p.ph_lo = 0; p.ph_hi = NPH;
    hipLaunchKernelGGL(hybrid_fwd, dim3(grid), dim3(512), LDS_BYTES, stream, p);
#else
    for (int k = 0; k < NPH; ++k) { p.ph_lo = k; p.ph_hi = k + 1; hipLaunchKernelGGL(hybrid_fwd, dim3(grid), dim3(512), LDS_BYTES, stream, p); }
#endif
}
```

```cpp
#include <hip/hip_runtime.h>
#include <stdint.h>
#include <cstdio>

typedef unsigned short u16;
typedef short bf16x8 __attribute__((ext_vector_type(8)));
typedef float f32x4 __attribute__((ext_vector_type(4)));
typedef float f32x2 __attribute__((ext_vector_type(2)));
typedef unsigned u32x2 __attribute__((ext_vector_type(2)));
typedef unsigned u32x4 __attribute__((ext_vector_type(4)));

#ifndef PROBE_DUP
#define PROBE_DUP -1
#endif
#ifndef N_LAUNCHES
#define N_LAUNCHES 1
#endif

constexpr int NTOK = 16384, DM = 1024, SEQ = 2048, DIN = 3200, DINP = 3328;
constexpr int NPH = 5;
constexpr int LDS_BYTES = 18432 + 8 * 17408;

constexpr size_t WS_CTL = 0;
constexpr size_t WS_WINT = 16384;
constexpr size_t WS_WOUTT = WS_WINT + (size_t)DINP * 1024 * 2;
constexpr size_t WS_WUPT = WS_WOUTT + (size_t)1024 * 1024 * 2;
constexpr size_t WS_AUPT = WS_WUPT + 512 * 64 * 2;
constexpr size_t WS_POOLT = WS_AUPT + 512 * 64 * 2;
constexpr size_t WS_Z = WS_POOLT + 4 * 128 * 128 * 2;
constexpr size_t WS_REC = WS_Z + (size_t)NTOK * DIN * 2;
constexpr size_t WS_Y = WS_REC + (size_t)64 * 2048 * 896;
constexpr size_t WS_BONUS = WS_Y + (size_t)NTOK * 1024 * 2;
constexpr size_t WS_PART = WS_BONUS + (size_t)64 * 2048 * 4;
constexpr size_t WS_END = WS_PART + (size_t)64 * 4 * 256 * 4;
constexpr int CTL_CNT_WORD = 3584;
constexpr int NUNIT = 64 * 128;
constexpr size_t CH_AF = WS_REC;
constexpr size_t CH_RF = CH_AF + (size_t)NUNIT * 2048;
constexpr size_t CH_BKF = CH_RF + (size_t)NUNIT * 2048;
constexpr size_t CH_ARB = CH_BKF + (size_t)NUNIT * 4096;
constexpr size_t CH_G15 = CH_ARB + (size_t)NUNIT * 512;
constexpr size_t CH_END = CH_G15 + (size_t)NUNIT * 256;
constexpr size_t WS_VB = CH_END;
static_assert(WS_VB + (size_t)NTOK * 512 * 2 <= WS_Y, "chunk operands + v must fit in the record region");
constexpr size_t OUT_CHV = 0;
constexpr size_t OUT_GB = (size_t)NUNIT * 4 * 3 * 512;
static_assert(OUT_GB + (size_t)NTOK * 512 * 2 <= (size_t)NTOK * DM * 4, "d_out scratch");

struct Params {
    const float* x; const float* norm_gain; const float* w_in; const float* pool_w; const float* pool_scale;
    const float* shift_mu; const float* w0; const float* w_up; const float* a0; const float* a_up;
    const float* k_k; const float* k_a; const float* r_k; const float* gn_gain; const float* gn_bias;
    const float* w_out; const float* final_gain;
    float* out; unsigned char* ws;
    int ph_lo, ph_hi, dup_n, pad;
};

extern __shared__ __attribute__((aligned(16))) unsigned char dyn_smem[];

__device__ __forceinline__ float bf2f(u16 v) { return __uint_as_float(((unsigned)v) << 16); }
__device__ __forceinline__ float bflo(unsigned v) { return __uint_as_float(v << 16); }
__device__ __forceinline__ float bfhi(unsigned v) { return __uint_as_float(v & 0xffff0000u); }
typedef __bf16 bf16x2_t __attribute__((ext_vector_type(2)));
__device__ __forceinline__ unsigned pack2(float lo, float hi) { bf16x2_t v = {(__bf16)lo, (__bf16)hi}; return __builtin_bit_cast(unsigned, v); }
__device__ __forceinline__ u16 f2bf(float f) { return (u16)(pack2(f, 0.f) & 0xffffu); }
__device__ __forceinline__ float wave_sum(float v) {
#pragma unroll
    for (int m = 32; m >= 1; m >>= 1) v += __shfl_xor(v, m, 64);
    return v;
}
__device__ __forceinline__ float rcp_(float v) { return __builtin_amdgcn_rcpf(v); }
__device__ __forceinline__ float rsq_(float v) { return __builtin_amdgcn_rsqf(v); }
__device__ __forceinline__ float sigmoidf_(float v) { return rcp_(1.f + __expf(-v)); }
__device__ __forceinline__ float tanhf_(float v) { return 1.f - 2.f * rcp_(1.f + __expf(2.f * v)); }

#define XB_TMO      128
#define XB_XCNT(j)  (256  + 64 * (j))
#define XB_XSUB(j)  (1280 + 64 * (j))
#define XB_XGEN(j)  (2304 + 64 * (j))
#define XB_TOP      3328
#define XB_TOPGEN   3392
#define XCD_BAR_WORDS 3456
#define XB_SPIN_CAP (1u << 22)
#define LAS __attribute__((address_space(3)))

__device__ __forceinline__ unsigned xb_ld(unsigned* p)              { return __hip_atomic_load(p, __ATOMIC_RELAXED, __HIP_MEMORY_SCOPE_AGENT); }
__device__ __forceinline__ unsigned xb_add(unsigned* p, unsigned v) { return __hip_atomic_fetch_add(p, v, __ATOMIC_RELAXED, __HIP_MEMORY_SCOPE_AGENT); }
__device__ __forceinline__ unsigned xb_xcc_id() { return (unsigned)__builtin_amdgcn_s_getreg((3 << 11) | 20) & 0xFu; }
#define XB_SPIN(cond, bar) do { unsigned _sp = 0; while (cond) { __builtin_amdgcn_s_sleep(1); \
    if ((++_sp & 255u) == 0u) { if (xb_ld(&(bar)[XB_TMO])) break; if (_sp > XB_SPIN_CAP) { atomicAdd(&(bar)[XB_TMO], 1u); break; } } } } while (0)

struct XcdBarrier { unsigned* bar; unsigned x; volatile LAS unsigned* st; };

__device__ __forceinline__ XcdBarrier xcd_barrier_post(unsigned* bar, volatile LAS unsigned* st) {
    XcdBarrier b; b.bar = bar; b.x = xb_xcc_id(); b.st = st;
    if (threadIdx.x == 0) (void)xb_add(&bar[XB_XCNT(b.x)], 1u);
    return b;
}
__device__ __forceinline__ void xcd_barrier_complete(unsigned* bar, unsigned x, unsigned& nloc, unsigned& nx) {
    const unsigned G = gridDim.x * gridDim.y * gridDim.z;
    unsigned sum, cnt, mine, sp = 0u;
    for (;;) {
        sum = 0u; cnt = 0u; mine = 0u;
#pragma unroll
        for (unsigned j = 0; j < 16; ++j) { const unsigned c = xb_ld(&bar[XB_XCNT(j)]); sum += c; cnt += (c > 0u) ? 1u : 0u; mine = (j == x) ? c : mine; }
        if (sum == G) break;
        __builtin_amdgcn_s_sleep(1);
        if ((++sp & 255u) == 0u) { if (xb_ld(&bar[XB_TMO])) break; if (sp > XB_SPIN_CAP) { atomicAdd(&bar[XB_TMO], 1u); break; } }
    }
    nloc = mine > 0u ? mine : 1u; nx = cnt > 0u ? cnt : 1u;
}
__device__ __forceinline__ void xcd_barrier(const XcdBarrier& b) {
    asm volatile("s_waitcnt vmcnt(0)" ::: "memory");
    __syncthreads();
    if (threadIdx.x == 0) {
        unsigned* bar = b.bar;
        __builtin_amdgcn_s_waitcnt(0);
        unsigned nloc = b.st[0], nx = b.st[1];
        if (nloc == 0u) { xcd_barrier_complete(bar, b.x, nloc, nx); b.st[0] = nloc; b.st[1] = nx; }
        const unsigned old = xb_add(&bar[XB_XSUB(b.x)], 1u);
        const unsigned gen = old / nloc;
        if (old + 1u == (gen + 1u) * nloc) {
            __builtin_amdgcn_fence(__ATOMIC_RELEASE, "agent");
            asm volatile("s_waitcnt vmcnt(0)" ::: "memory");
            const unsigned og = xb_add(&bar[XB_TOP], 1u);
            const unsigned tg = og / nx;
            if (og + 1u == (tg + 1u) * nx) xb_add(&bar[XB_TOPGEN], 1u);
            else XB_SPIN(xb_ld(&bar[XB_TOPGEN]) == tg, bar);
            __builtin_amdgcn_fence(__ATOMIC_ACQUIRE, "agent");
            xb_add(&bar[XB_XGEN(b.x)], 1u);
            asm volatile("s_waitcnt vmcnt(0)" ::: "memory");
        } else {
            XB_SPIN(xb_ld(&bar[XB_XGEN(b.x)]) == gen, bar);
            __builtin_amdgcn_fence(__ATOMIC_ACQUIRE, "agent");
            asm volatile("s_waitcnt vmcnt(0)" ::: "memory");
        }
    }
    __syncthreads();
}

constexpr int BM = 256, BK = 64, HALF = 128, HTB = HALF * BK * 2, STAGE_BYTES = 8 * HTB, NXCD = 8, WGM = 8;
__device__ __forceinline__ int lds_byte(int r, int c) { const int st = (r >> 4) * 2 + (c >> 5), rr = r & 15, cc = c & 31, ob = rr * 64 + cc * 2; return st * 1024 + (ob ^ (((ob >> 9) & 1) << 5)); }
__device__ __forceinline__ void stage_rc(int b, int& R, int& C) { const int st = b / 1024, sb = b % 1024, swz = sb ^ (((sb >> 9) & 1) << 5); R = (st >> 1) * 16 + swz / 64; C = (st & 1) * 32 + (swz % 64) / 2; }
__device__ __forceinline__ int perm32(int rho) { const int n = rho >> 4, i = rho & 15; return 8 * (i >> 2) + 4 * n + (i & 3); }

struct Unit { int pm, pn; };
struct Gemm { const u16* A; const u16* Bt; int M, N, K, Nvalid; };
struct StaticOrder {
    int nM, nN, nwg, G, c;
    __device__ void init(int M, int N, int G_, int c_) { nM = M / BM; nN = N / BM; nwg = nM * nN; G = G_; c = c_; }
    __device__ bool next(int i, Unit& u) const {
        const long L = (long)i * G + c; if (L >= nwg) return false;
        int wgid = (int)L; { const int q = nwg / NXCD, r = nwg % NXCD, xcd = wgid % NXCD, off = wgid / NXCD; wgid = (xcd < r ? xcd * (q + 1) : r * (q + 1) + (xcd - r) * q) + off; }
        const int nig = WGM * nN, gid = wgid / nig, fm = gid * WGM, gsz = (nM - fm) < WGM ? (nM - fm) : WGM;
        u.pm = fm + ((wgid % nig) % gsz); u.pn = (wgid % nig) / gsz; return true;
    }
};
struct EpiZ {
    static constexpr bool PERM = true, AFTER_DRAIN = false;
    u16* Z;
    __device__ __forceinline__ void operator()(const f32x4 (&acc)[2][2][4][2], const Unit& u, int wr, int wc, int fr, int fq) const {
        const int row0 = u.pm * BM + wr * 64 + fr, col0 = u.pn * BM + wc * 32 + 8 * fq;
#pragma unroll
        for (int ai = 0; ai < 2; ++ai)
#pragma unroll
            for (int m = 0; m < 4; ++m) { u16* rowp = Z + (size_t)(row0 + ai * HALF + m * 16) * DIN;
#pragma unroll
                for (int bj = 0; bj < 2; ++bj) { const int col = col0 + bj * HALF; const f32x4 v0 = acc[ai][bj][m][0], v1 = acc[ai][bj][m][1];
                    if (col < DIN) *(u32x4*)(rowp + col) = (u32x4){pack2(v0[0], v0[1]), pack2(v0[2], v0[3]), pack2(v1[0], v1[1]), pack2(v1[2], v1[3])}; } }
    }
};
struct EpiRes {
    static constexpr bool PERM = false, AFTER_DRAIN = false;
    const float* x; float* out;
    __device__ __forceinline__ void operator()(const f32x4 (&acc)[2][2][4][2], const Unit& u, int wr, int wc, int fr, int fq) const {
        const int row0 = u.pm * BM + wr * 64 + fr, col0 = u.pn * BM + wc * 32 + 4 * fq;
#pragma unroll
        for (int ai = 0; ai < 2; ++ai)
#pragma unroll
            for (int m = 0; m < 4; ++m) { const size_t ro = (size_t)(row0 + ai * HALF + m * 16) * DM + col0;
#pragma unroll
                for (int bj = 0; bj < 2; ++bj)
#pragma unroll
                    for (int n = 0; n < 2; ++n) { const f32x4 xv = *(const f32x4*)(x + ro + bj * HALF + n * 16); *(f32x4*)(out + ro + bj * HALF + n * 16) = xv + acc[ai][bj][m][n]; } }
    }
};
struct EpiResNorm {
    static constexpr bool PERM = false, AFTER_DRAIN = true;
    const float* x; const float* gain; float* out; float* part; unsigned* cnt;
    __device__ __forceinline__ void fused(f32x4 (&acc)[2][2][4][2], const Unit& u, int wr, int wc, int fr, int fq, LAS unsigned char* lds) const {
        const int row0 = u.pm * BM + wr * 64 + fr, col0 = u.pn * BM + wc * 32 + 4 * fq;
        LAS float* red = (LAS float*)lds;
        LAS float* tot = red + 1024;
        float rs[2][4];
#pragma unroll
        for (int ai = 0; ai < 2; ++ai)
#pragma unroll
            for (int m = 0; m < 4; ++m) { const size_t ro = (size_t)(row0 + ai * HALF + m * 16) * DM + col0; float s = 0.f;
#pragma unroll
                for (int bj = 0; bj < 2; ++bj)
#pragma unroll
                    for (int n = 0; n < 2; ++n) { const f32x4 v = *(const f32x4*)(x + ro + bj * HALF + n * 16) + acc[ai][bj][m][n]; acc[ai][bj][m][n] = v; s += v[0] * v[0] + v[1] * v[1] + v[2] * v[2] + v[3] * v[3]; }
                s += __shfl_xor(s, 16, 64); s += __shfl_xor(s, 32, 64);
                rs[ai][m] = s; }
        if (fq == 0) {
#pragma unroll
            for (int ai = 0; ai < 2; ++ai)
#pragma unroll
                for (int m = 0; m < 4; ++m) red[((wr * 4 + wc) * 8 + ai * 4 + m) * 16 + fr] = rs[ai][m];
        }
        __syncthreads();
        if (threadIdx.x < 256) {
            const int rl = threadIdx.x, ai = rl >> 7, wr_ = (rl >> 6) & 1, m = (rl >> 4) & 3, fr_ = rl & 15;
            const int o = ((wr_ * 4) * 8 + ai * 4 + m) * 16 + fr_;
            const float s = red[o] + red[o + 128] + red[o + 256] + red[o + 384];
            __hip_atomic_store(part + ((size_t)u.pm * 4 + u.pn) * 256 + rl, s, __ATOMIC_RELAXED, __HIP_MEMORY_SCOPE_AGENT);
        }
        asm volatile("s_waitcnt vmcnt(0)" ::: "memory");
        __syncthreads();
        if (threadIdx.x == 0) {
            __builtin_amdgcn_fence(__ATOMIC_RELEASE, "agent");
            asm volatile("s_waitcnt vmcnt(0)" ::: "memory");
            __hip_atomic_fetch_add(cnt + u.pm, 1u, __ATOMIC_RELAXED, __HIP_MEMORY_SCOPE_AGENT);
            unsigned sp = 0;
            while (__hip_atomic_load(cnt + u.pm, __ATOMIC_RELAXED, __HIP_MEMORY_SCOPE_AGENT) < 4u) { __builtin_amdgcn_s_sleep(1); if (++sp > (1u << 24)) break; }
            __builtin_amdgcn_fence(__ATOMIC_ACQUIRE, "agent");
            asm volatile("s_waitcnt vmcnt(0)" ::: "memory");
        }
        __syncthreads();
        for (int e = threadIdx.x; e < 1024; e += 512) tot[e] = __hip_atomic_load(part + (size_t)u.pm * 1024 + e, __ATOMIC_RELAXED, __HIP_MEMORY_SCOPE_AGENT);
        __syncthreads();
#pragma unroll
        for (int ai = 0; ai < 2; ++ai)
#pragma unroll
            for (int m = 0; m < 4; ++m) { const int rl = ai * 128 + wr * 64 + m * 16 + fr;
                const float inv = rsq_((tot[rl] + tot[256 + rl] + tot[512 + rl] + tot[768 + rl]) * (1.f / 1024.f) + 1e-6f);
                const size_t ro = (size_t)(row0 + ai * HALF + m * 16) * DM + col0;
#pragma unroll
                for (int bj = 0; bj < 2; ++bj)
#pragma unroll
                    for (int n = 0; n < 2; ++n) { const f32x4 g = *(const f32x4*)(gain + col0 + bj * HALF + n * 16); *(f32x4*)(out + ro + bj * HALF + n * 16) = acc[ai][bj][m][n] * inv * g; } }
    }
};

template <class Epi, class Sched>
__device__ __forceinline__ void gemm_phase(LAS unsigned char* lds, const Gemm g, const Sched& S, const Epi& E) {
    const int tid = threadIdx.x, wid = __builtin_amdgcn_readfirstlane(tid >> 6), lane = tid & 63, wr = wid >> 2, wc = wid & 3, fr = lane & 15, fq = lane >> 4;
    const int K = g.K, nt = K / BK;
    unsigned voffA[2], voffB[2];
#pragma unroll
    for (int i = 0; i < 2; ++i) { int R, C; stage_rc(tid * 16 + i * 8192, R, C); const int Rb = Epi::PERM ? ((R & ~31) + perm32(R & 31)) : R;
        voffA[i] = (unsigned)(R * K + C) * 2u; voffB[i] = (unsigned)(Rb * K + C) * 2u; }
    const size_t kstep = (size_t)(BK * 2);
    const size_t hstep = (size_t)HALF * K * 2;
    const size_t tstep = 2 * hstep;
    const unsigned ldsw = (unsigned)wid * 1024u;
    const int aoff = lds_byte(wr * 64 + fr, fq * 8), boff = lds_byte(wc * 32 + fr, fq * 8);
#define PG8_SA(b, h) (((b) * 2 + (h)) * HTB)
#define PG8_SB(b, h) ((4 + (b) * 2 + (h)) * HTB)
#define PG8_STAGE(bufoff, gbase, voff) do { _Pragma("unroll") for (int _i = 0; _i < 2; ++_i) \
        __builtin_amdgcn_global_load_lds((const unsigned*)((const char*)(gbase) + (voff)[_i]), (LAS unsigned*)(lds + (bufoff) + ldsw + _i * 8192), 16, 0, 0); } while (0)
#define PG8_LDA(dst, b, h) do { _Pragma("unroll") for (int m = 0; m < 4; ++m) _Pragma("unroll") for (int k = 0; k < 2; ++k) dst[m][k] = *(const LAS bf16x8*)(lds + PG8_SA(b, h) + aoff + m * 2048 + k * 1024); } while (0)
#define PG8_LDB(dst, b, h) do { _Pragma("unroll") for (int n = 0; n < 2; ++n) _Pragma("unroll") for (int k = 0; k < 2; ++k) dst[n][k] = *(const LAS bf16x8*)(lds + PG8_SB(b, h) + boff + n * 2048 + k * 1024); } while (0)
#define PG8_MMA(ai, bj, At, Bt) do { __builtin_amdgcn_s_setprio(1); _Pragma("unroll") for (int m = 0; m < 4; ++m) _Pragma("unroll") for (int n = 0; n < 2; ++n) _Pragma("unroll") for (int k = 0; k < 2; ++k) \
        acc[ai][bj][m][n] = __builtin_amdgcn_mfma_f32_16x16x32_bf16(Bt[n][k], At[m][k], acc[ai][bj][m][n], 0, 0, 0); __builtin_amdgcn_s_setprio(0); } while (0)
#define PG8_WAIT_V(n) asm volatile("s_waitcnt vmcnt(" #n ")" ::: "memory")
#define PG8_WAIT_L(n) asm volatile("s_waitcnt lgkmcnt(" #n ")" ::: "memory")
#define PG8_BAR __builtin_amdgcn_s_barrier()
#define PG8_SCHED __builtin_amdgcn_sched_barrier(0)
    Unit cur, nxt; int ui = 0;
    if (!S.next(0, cur)) return;
    f32x4 acc[2][2][4][2];
#pragma unroll
    for (int a = 0; a < 2; ++a)
#pragma unroll
        for (int b = 0; b < 2; ++b)
#pragma unroll
            for (int m = 0; m < 4; ++m)
#pragma unroll
                for (int n = 0; n < 2; ++n) acc[a][b][m][n] = (f32x4){0.f, 0.f, 0.f, 0.f};
    bf16x8 At[4][2], B0[2][2], B1[2][2];
    const char* cA = (const char*)g.A + (size_t)cur.pm * tstep; const char* cB = (const char*)g.Bt + (size_t)cur.pn * tstep;
    PG8_STAGE(PG8_SB(0, 0), cB, voffB); PG8_STAGE(PG8_SA(0, 0), cA, voffA); PG8_STAGE(PG8_SB(0, 1), cB + hstep, voffB); PG8_STAGE(PG8_SA(0, 1), cA + hstep, voffA);
    if (wr == 1) PG8_BAR;
    PG8_WAIT_V(4); PG8_BAR;
    PG8_STAGE(PG8_SB(1, 0), cB + kstep, voffB); PG8_STAGE(PG8_SA(1, 0), cA + kstep, voffA); PG8_STAGE(PG8_SB(1, 1), cB + hstep + kstep, voffB);
    PG8_WAIT_V(6); PG8_BAR;
    for (;;) {
        const bool has_next = S.next(ui + 1, nxt);
        const char* nA = has_next ? (const char*)g.A + (size_t)nxt.pm * tstep : cA; const char* nB = has_next ? (const char*)g.Bt + (size_t)nxt.pn * tstep : cB;
        const bool rhalf = (cur.pn * BM + HALF) < g.Nvalid;
        for (int t = 0; t < nt; t += 2) {
            const bool last = (t == nt - 2);
            const char* a1 = cA + (size_t)(t + 1) * kstep;
            const char* a2 = last ? nA : cA + (size_t)(t + 2) * kstep; const char* b2 = last ? nB : cB + (size_t)(t + 2) * kstep;
            const char* a3 = a2 + kstep; const char* b3 = b2 + kstep;
            PG8_LDB(B0, 0, 0); PG8_SCHED; PG8_LDA(At, 0, 0); PG8_STAGE(PG8_SA(1, 1), a1 + hstep, voffA);
            PG8_WAIT_L(8); PG8_BAR; PG8_WAIT_L(0); PG8_MMA(0, 0, At, B0); PG8_BAR; PG8_SCHED;
            PG8_LDB(B1, 0, 1); PG8_STAGE(PG8_SB(0, 0), b2, voffB);
            PG8_BAR; PG8_WAIT_L(0); if (rhalf) PG8_MMA(0, 1, At, B1); PG8_BAR;
            PG8_LDA(At, 0, 1); PG8_STAGE(PG8_SA(0, 0), a2, voffA);
            PG8_BAR; PG8_WAIT_L(0); PG8_MMA(1, 0, At, B0); PG8_BAR; PG8_SCHED;
            PG8_STAGE(PG8_SB(0, 1), b2 + hstep, voffB);
            PG8_WAIT_V(6); PG8_BAR; if (rhalf) PG8_MMA(1, 1, At, B1); PG8_BAR;
            PG8_LDB(B0, 1, 0); PG8_SCHED; PG8_LDA(At, 1, 0); PG8_STAGE(PG8_SA(0, 1), a2 + hstep, voffA);
            PG8_WAIT_L(8); PG8_BAR; PG8_WAIT_L(0); PG8_MMA(0, 0, At, B0); PG8_BAR; PG8_SCHED;
            PG8_LDB(B1, 1, 1); PG8_STAGE(PG8_SB(1, 0), b3, voffB);
            PG8_BAR; PG8_WAIT_L(0); if (rhalf) PG8_MMA(0, 1, At, B1); PG8_BAR;
            PG8_LDA(At, 1, 1); PG8_STAGE(PG8_SA(1, 0), a3, voffA);
            PG8_BAR; PG8_WAIT_L(0); PG8_MMA(1, 0, At, B0); PG8_BAR; PG8_SCHED;
            PG8_STAGE(PG8_SB(1, 1), b3 + hstep, voffB);
            PG8_WAIT_V(6); PG8_BAR; if (rhalf) PG8_MMA(1, 1, At, B1); PG8_BAR;
        }
        if constexpr (!Epi::AFTER_DRAIN) E(acc, cur, wr, wc, fr, fq);
        if (!has_next) break;
#pragma unroll
        for (int a = 0; a < 2; ++a)
#pragma unroll
            for (int b = 0; b < 2; ++b)
#pragma unroll
                for (int m = 0; m < 4; ++m)
#pragma unroll
                    for (int n = 0; n < 2; ++n) acc[a][b][m][n] = (f32x4){0.f, 0.f, 0.f, 0.f};
        cur = nxt; cA = nA; cB = nB; ++ui;
    }
    PG8_WAIT_V(0);
    if (wr == 0) PG8_BAR;
    PG8_BAR;
    if constexpr (Epi::AFTER_DRAIN) E.fused(acc, cur, wr, wc, fr, fq, lds);
#undef PG8_SA
#undef PG8_SB
#undef PG8_STAGE
#undef PG8_LDA
#undef PG8_LDB
#undef PG8_MMA
#undef PG8_WAIT_V
#undef PG8_WAIT_L
#undef PG8_BAR
#undef PG8_SCHED
}

#define WSYNC() do { __builtin_amdgcn_wave_barrier(); asm volatile("s_waitcnt lgkmcnt(0)" ::: "memory"); __builtin_amdgcn_wave_barrier(); } while (0)
__device__ void phase0(const Params& p) {
    const int tid = threadIdx.x, lane = tid & 63, wave = tid >> 6, blk = blockIdx.x;
    u16* Hbf = (u16*)p.out;
#pragma unroll 1
    for (int r0 = 0; r0 < 8; r0 += 4) {
        f32x4 v[4][4]; float ss[4];
#pragma unroll
        for (int i = 0; i < 4; ++i) {
            const f32x4* xr = (const f32x4*)(p.x + (size_t)(blk * 64 + wave * 8 + r0 + i) * DM);
#pragma unroll
            for (int q = 0; q < 4; ++q) v[i][q] = __builtin_nontemporal_load(xr + lane + 64 * q);
        }
#pragma unroll
        for (int i = 0; i < 4; ++i) {
            float s = 0.f;
#pragma unroll
            for (int q = 0; q < 4; ++q) s += v[i][q][0] * v[i][q][0] + v[i][q][1] * v[i][q][1] + v[i][q][2] * v[i][q][2] + v[i][q][3] * v[i][q][3];
            ss[i] = wave_sum(s);
        }
#pragma unroll
        for (int i = 0; i < 4; ++i) {
            const int row = blk * 64 + wave * 8 + r0 + i;
            const float inv = rsq_(ss[i] * (1.f / 1024.f) + 1e-6f);
#pragma unroll
            for (int q = 0; q < 4; ++q) {
                const f32x4 g = ((const f32x4*)p.norm_gain)[lane + 64 * q];
                u32x2 o; o.x = pack2(v[i][q][0] * inv * g[0], v[i][q][1] * inv * g[1]); o.y = pack2(v[i][q][2] * inv * g[2], v[i][q][3] * inv * g[3]);
                *(u32x2*)(Hbf + (size_t)row * DM + (lane + 64 * q) * 4) = o;
            }
        }
    }
    u16* WinT = (u16*)(p.ws + WS_WINT); u16* WoutT = (u16*)(p.ws + WS_WOUTT);
    {
        float* tl = (float*)dyn_smem + wave * (64 * 65);
        const int t = blk + 256 * wave;
        if (t < 832 + 256) {
            const float* src; u16* dst; int kt, ntile, N;
            if (t < 832) { kt = t & 15; ntile = t >> 4; src = p.w_in; N = DIN; dst = WinT; }
            else { const int t2 = t - 832; kt = t2 & 15; ntile = t2 >> 4; src = p.w_out; N = 1024; dst = WoutT; }
            const int k0 = kt * 64, n0 = ntile * 64, n4 = (lane & 15) * 4;
            f32x4 v[16];
#pragma unroll
            for (int i = 0; i < 16; ++i) { const int kk = (lane >> 4) + 4 * i; v[i] = (n0 + n4 < N) ? *(const f32x4*)(src + (size_t)(k0 + kk) * N + n0 + n4) : (f32x4){0.f, 0.f, 0.f, 0.f}; }
#pragma unroll
            for (int i = 0; i < 16; ++i) { const int kk = (lane >> 4) + 4 * i; float* d = tl + kk * 65 + n4; d[0] = v[i][0]; d[1] = v[i][1]; d[2] = v[i][2]; d[3] = v[i][3]; }
            WSYNC();
            const int kp = lane & 31, nh = lane >> 5;
#pragma unroll 8
            for (int i = 0; i < 32; ++i) { const int nn = 2 * i + nh;
                *(unsigned*)(dst + (size_t)(n0 + nn) * 1024 + k0 + 2 * kp) = pack2(tl[(2 * kp) * 65 + nn], tl[(2 * kp + 1) * 65 + nn]); }
        }
    }
    u16* WupT = (u16*)(p.ws + WS_WUPT); u16* AupT = (u16*)(p.ws + WS_AUPT); u16* PoolT = (u16*)(p.ws + WS_POOLT);
    const int gt = blk * 512 + tid;
    if (gt < 32768) { const int c = gt >> 6, j = gt & 63; WupT[gt] = f2bf(p.w_up[j * 512 + c]); AupT[gt] = f2bf(p.a_up[j * 512 + c]); }
    if (gt < 65536) { const int g = gt >> 14, d = (gt >> 7) & 127, c = gt & 127; PoolT[gt] = f2bf(p.pool_w[(g * 128 + c) * 128 + d]); }
}

__device__ void phase1(const Params& p) {
    Gemm g; g.A = (const u16*)p.out; g.Bt = (const u16*)(p.ws + WS_WINT); g.M = NTOK; g.N = DINP; g.K = 1024; g.Nvalid = DIN;
    StaticOrder S; S.init(NTOK, DINP, 256, blockIdx.x);
    EpiZ E; E.Z = (u16*)(p.ws + WS_Z);
    gemm_phase((LAS unsigned char*)dyn_smem, g, S, E);
}
__device__ void phase4(const Params& p) {
    Gemm g; g.A = (const u16*)(p.ws + WS_Y); g.Bt = (const u16*)(p.ws + WS_WOUTT); g.M = NTOK; g.N = 1024; g.K = 1024; g.Nvalid = 1024;
    StaticOrder S; S.init(NTOK, 1024, 256, blockIdx.x);
    EpiResNorm E; E.x = p.x; E.gain = p.final_gain; E.out = p.out; E.part = (float*)(p.ws + WS_PART); E.cnt = (unsigned*)(p.ws + WS_CTL) + CTL_CNT_WORD;
    gemm_phase((LAS unsigned char*)dyn_smem, g, S, E);
}

template <int CTRL> __device__ __forceinline__ float dpp_add(float v) {
    const int t = __builtin_amdgcn_update_dpp(0, __float_as_int(v), CTRL, 0xf, 0xf, false);
    return v + __int_as_float(t);
}
__device__ __forceinline__ float row16_allsum(float v) {
    v = dpp_add<0x128>(v); v = dpp_add<0x124>(v); v = dpp_add<0x122>(v); v = dpp_add<0x121>(v);
    return v;
}
#define MFMA16(a, b, c) __builtin_amdgcn_mfma_f32_16x16x32_bf16((a), (b), (c), 0, 0, 0)
__device__ __forceinline__ bf16x8 as_bf8(u32x4 v) { return __builtin_bit_cast(bf16x8, v); }
template <int W> __device__ __forceinline__ void pooled_run(const u16* __restrict__ Z, u16* pooled, int t0, int s0, int cp, int hf) {
    const int c0 = 2 * cp, tb = hf * 32;
    unsigned raw[W - 1 + 32];
#pragma unroll
    for (int i = 0; i < W - 1 + 32; ++i) { const int tt = tb - (W - 1) + i; raw[i] = (s0 + tt >= 0) ? *(const unsigned*)(Z + (size_t)(t0 + tt) * DIN + c0) : 0u; }
    float sum0 = 0.f, sum1 = 0.f;
#pragma unroll
    for (int i = 0; i < W - 1; ++i) { sum0 += bflo(raw[i]); sum1 += bfhi(raw[i]); }
#pragma unroll
    for (int j = 0; j < 32; ++j) {
        const int tt = tb + j, s = s0 + tt;
        const float u0 = bflo(raw[W - 1 + j]), u1 = bfhi(raw[W - 1 + j]);
        sum0 += u0; sum1 += u1;
        const float rc = rcp_((float)((s + 1 < W) ? (s + 1) : W));
        *(unsigned*)(pooled + tt * 520 + c0) = pack2(sum0 * rc - u0, sum1 * rc - u1);
        sum0 -= bflo(raw[j]); sum1 -= bfhi(raw[j]);
    }
}
constexpr int RST = 912;
__device__ __forceinline__ void p2_zload(u32x4 (&zq)[7], const u16* __restrict__ Z, size_t T0, bool has_halo, int h, int lane) {
#pragma unroll
    for (int q = 0; q < 7; ++q) {
        const int pidx = lane + 64 * q, rr = pidx / 24, w = pidx - rr * 24, a = w >> 3, pc = w & 7;
        u32x4 v = (u32x4){0u, 0u, 0u, 0u};
        if (pidx < 17 * 24) {
            if (rr < 16) v = *(const u32x4*)(Z + (T0 + rr) * DIN + 1024 + a * 512 + h * 64 + pc * 8);
            else if (has_halo) v = *(const u32x4*)(Z + (T0 - 1) * DIN + 1024 + a * 512 + h * 64 + pc * 8);
        }
        zq[q] = v;
    }
}
constexpr int P2_WREG = 17408;
__device__ void phase2(const Params& p) {
    const int tid = threadIdx.x, lane = tid & 63, wave = tid >> 6, blk = blockIdx.x, fr = lane & 15, fq = lane >> 4;
    const int t0 = blk * 64, b = t0 >> 11, s0 = t0 & 2047;
    const u16* Z = (const u16*)(p.ws + WS_Z);
    u16* twb = (u16*)dyn_smem;
    u16* alb = twb + 64 * 72;
    u16* pooled = alb + 64 * 72;
    for (int e = tid; e < 64 * 128; e += 512) {
        const int tt = e >> 7, j = e & 127;
        const size_t zi = (size_t)(t0 + tt) * DIN + 2560 + j;
        const float cur = bf2f(Z[zi]);
        const float prev = (s0 + tt > 0) ? bf2f(Z[zi - DIN]) : 0.f;
        const float val = cur + p.shift_mu[1536 + j] * (prev - cur);
        if (j < 64) twb[tt * 72 + j] = f2bf(tanhf_(val)); else alb[tt * 72 + (j - 64)] = f2bf(val);
    }
    {
        const int cp = tid & 255, hf = tid >> 8;
        switch (wave & 3) {
            case 0: pooled_run<2>(Z, pooled, t0, s0, cp, hf); break;
            case 1: pooled_run<4>(Z, pooled, t0, s0, cp, hf); break;
            case 2: pooled_run<8>(Z, pooled, t0, s0, cp, hf); break;
            default: pooled_run<16>(Z, pooled, t0, s0, cp, hf); break;
        }
    }
    __syncthreads();
    {
        const int g = wave >> 1, dbase = (wave & 1) * 64;
        const u16* PoolT = (const u16*)(p.ws + WS_POOLT); u16* Y = (u16*)(p.ws + WS_Y);
        f32x4 acc[4][4];
#pragma unroll
        for (int mt = 0; mt < 4; ++mt)
#pragma unroll
            for (int nt = 0; nt < 4; ++nt) acc[mt][nt] = (f32x4){0.f, 0.f, 0.f, 0.f};
#pragma unroll
        for (int ks = 0; ks < 4; ++ks) {
            bf16x8 Bf[4];
#pragma unroll
            for (int nt = 0; nt < 4; ++nt) Bf[nt] = *(const bf16x8*)(PoolT + (size_t)(g * 128 + dbase + nt * 16 + fr) * 128 + ks * 32 + fq * 8);
#pragma unroll
            for (int mt = 0; mt < 4; ++mt) {
                const bf16x8 Af = *(const bf16x8*)(pooled + (mt * 16 + fr) * 520 + g * 128 + ks * 32 + fq * 8);
#pragma unroll
                for (int nt = 0; nt < 4; ++nt) acc[mt][nt] = MFMA16(Bf[nt], Af, acc[mt][nt]);
            }
        }
#pragma unroll
        for (int mt = 0; mt < 4; ++mt) {
            const size_t T = (size_t)(t0 + mt * 16 + fr);
#pragma unroll
            for (int nt = 0; nt < 4; ++nt) {
                const int ch = g * 128 + dbase + nt * 16 + fq * 4;
                const u32x2 ga = *(const u32x2*)(Z + T * DIN + 512 + ch);
                const f32x4 ps = *(const f32x4*)(p.pool_scale + ch);
                const f32x4 gv = (f32x4){bflo(ga.x), bfhi(ga.x), bflo(ga.y), bfhi(ga.y)};
                f32x4 y;
#pragma unroll
                for (int jj = 0; jj < 4; ++jj) y[jj] = acc[mt][nt][jj] * ps[jj] * gv[jj] * sigmoidf_(gv[jj]);
                u32x2 o; o.x = pack2(y[0], y[1]); o.y = pack2(y[2], y[3]);
                *(u32x2*)(Y + T * 1024 + ch) = o;
            }
        }
    }
    {
        u16* GB = (u16*)((unsigned char*)p.out + OUT_GB);
        for (int e = tid; e < 64 * 64; e += 512) { const int tt = e >> 6, q = e & 63;
            *(u32x4*)(GB + (size_t)(t0 + tt) * 512 + q * 8) = *(const u32x4*)(Z + (size_t)(t0 + tt) * DIN + 2688 + q * 8); }
    }
    __syncthreads();
    const int h = wave, bh = b * 8 + h;
    unsigned char* WL = dyn_smem + 18432 + wave * P2_WREG;
    unsigned char* recl = WL;
    u16* AR = (u16*)WL;
    u16* BK = AR + 32 * 72;
    u16* AtT = BK + 32 * 72;
    u16* BhT = AtT + 64 * 16;
    u16* KhT = BhT + 64 * 16;
    u16* VT = KhT + 64 * 16;
    float* Pab = (float*)WL;
    u16* Tm = (u16*)(Pab + 16 * 17);
    u16* AakT = Tm + 16 * 24;
    u16* M1m = AakT + 16 * 24;
    u16* Ark = M1m + 16 * 24;
    u16* Arb = Ark + 16 * 24;
    const u16* WupT = (const u16*)(p.ws + WS_WUPT); const u16* AupT = (const u16*)(p.ws + WS_AUPT);
    float* BON = (float*)(p.ws + WS_BONUS); u16* VB = (u16*)(p.ws + WS_VB);
    unsigned char* AFg = p.ws + CH_AF; unsigned char* RFg = p.ws + CH_RF; unsigned char* BKFg = p.ws + CH_BKF; unsigned char* ARBg = p.ws + CH_ARB;
    float* G15g = (float*)(p.ws + CH_G15); unsigned char* CHVg = (unsigned char*)p.out + OUT_CHV;
    const bf16x8 zero8 = (bf16x8){0, 0, 0, 0, 0, 0, 0, 0};
    const f32x4 zero4 = (f32x4){0.f, 0.f, 0.f, 0.f};
#pragma unroll 1
    for (int mt = 0; mt < 4; ++mt) {
        const size_t u = (size_t)bh * 128 + (s0 >> 4) + mt;
        {
            u32x4 zq[7];
            p2_zload(zq, Z, (size_t)(t0 + mt * 16), (s0 + mt * 16) > 0, h, lane);
            f32x4 aw[4], aa[4];
#pragma unroll
            for (int nt = 0; nt < 4; ++nt) { aw[nt] = zero4; aa[nt] = zero4; }
#pragma unroll
            for (int ks = 0; ks < 2; ++ks) {
                const bf16x8 Aw = *(const bf16x8*)(twb + (mt * 16 + fr) * 72 + ks * 32 + fq * 8);
                const bf16x8 Aa = *(const bf16x8*)(alb + (mt * 16 + fr) * 72 + ks * 32 + fq * 8);
#pragma unroll
                for (int nt = 0; nt < 4; ++nt) {
                    const bf16x8 Bw = *(const bf16x8*)(WupT + (h * 64 + nt * 16 + fr) * 64 + ks * 32 + fq * 8);
                    const bf16x8 Ba = *(const bf16x8*)(AupT + (h * 64 + nt * 16 + fr) * 64 + ks * 32 + fq * 8);
                    aw[nt] = MFMA16(Bw, Aw, aw[nt]);
                    aa[nt] = MFMA16(Ba, Aa, aa[nt]);
                }
            }
#pragma unroll
            for (int q = 0; q < 7; ++q) {
                const int pidx = lane + 64 * q, rr = pidx / 24, w = pidx - rr * 24, a = w >> 3, pc = w & 7;
                if (pidx < 17 * 24) *(u32x4*)(recl + ((rr < 16) ? rr * RST + 256 : 16 * RST) + a * 128 + pc * 16) = zq[q];
            }
            WSYNC();
            const int tt = mt * 16 + fr, s = s0 + tt; const size_t T = (size_t)(t0 + tt);
            f32x4 Kr[4], Av[4];
            float n2 = 0.f, bon = 0.f;
            unsigned char* rec = recl + fr * RST;
            const unsigned char* prec = (fr > 0) ? (recl + (fr - 1) * RST) : (recl + 16 * RST - 256);
#pragma unroll
            for (int nt = 0; nt < 4; ++nt) {
                const int cb = h * 64 + nt * 16 + fq * 4, ci = nt * 16 + fq * 4;
                const u32x2 zr = *(const u32x2*)(rec + 256 + ci * 2), zk = *(const u32x2*)(rec + 384 + ci * 2), zv = *(const u32x2*)(rec + 512 + ci * 2);
                const u32x2 pr = *(const u32x2*)(prec + 256 + ci * 2), pk = *(const u32x2*)(prec + 384 + ci * 2), pv = *(const u32x2*)(prec + 512 + ci * 2);
                const f32x4 mur = *(const f32x4*)(p.shift_mu + cb), muk = *(const f32x4*)(p.shift_mu + 512 + cb), muv = *(const f32x4*)(p.shift_mu + 1024 + cb);
                const f32x4 w0v = *(const f32x4*)(p.w0 + cb), a0v = *(const f32x4*)(p.a0 + cb), kkv = *(const f32x4*)(p.k_k + cb), kav = *(const f32x4*)(p.k_a + cb), rkv = *(const f32x4*)(p.r_k + cb);
                const f32x4 cr = (f32x4){bflo(zr.x), bfhi(zr.x), bflo(zr.y), bfhi(zr.y)}, ck = (f32x4){bflo(zk.x), bfhi(zk.x), bflo(zk.y), bfhi(zk.y)}, cv = (f32x4){bflo(zv.x), bfhi(zv.x), bflo(zv.y), bfhi(zv.y)};
                const f32x4 qr = (f32x4){bflo(pr.x), bfhi(pr.x), bflo(pr.y), bfhi(pr.y)}, qk = (f32x4){bflo(pk.x), bfhi(pk.x), bflo(pk.y), bfhi(pk.y)}, qv = (f32x4){bflo(pv.x), bfhi(pv.x), bflo(pv.y), bfhi(pv.y)};
                f32x4 Rr, Kp, Vv, Dc;
#pragma unroll
                for (int jj = 0; jj < 4; ++jj) {
                    const float r = cr[jj] + mur[jj] * (qr[jj] - cr[jj]);
                    const float k = ck[jj] + muk[jj] * (qk[jj] - ck[jj]);
                    const float v = cv[jj] + muv[jj] * (qv[jj] - cv[jj]);
                    const float ww = aw[nt][jj] + w0v[jj];
                    const float a = sigmoidf_(aa[nt][jj] + a0v[jj]);
                    const float dec = __expf(-0.6065306597126334f * sigmoidf_(ww));
                    const float kr = k * kkv[jj];
                    n2 += kr * kr;
                    const float kp = k * (1.f + (a - 1.f) * kav[jj]);
                    bon += r * kp * rkv[jj];
                    Rr[jj] = r; Kp[jj] = kp; Vv[jj] = v; Kr[nt][jj] = kr; Av[nt][jj] = a; Dc[jj] = dec;
                }
                *(f32x4*)(rec + ci * 4) = Dc;
                *(u32x2*)(rec + 256 + ci * 2) = (u32x2){pack2(Rr[0], Rr[1]), pack2(Rr[2], Rr[3])};
                *(u32x2*)(rec + 384 + ci * 2) = (u32x2){pack2(Kp[0], Kp[1]), pack2(Kp[2], Kp[3])};
                const u32x2 vpk = (u32x2){pack2(Vv[0], Vv[1]), pack2(Vv[2], Vv[3])};
                *(u32x2*)(rec + 512 + ci * 2) = vpk;
                *(u32x2*)(VB + T * 512 + cb) = vpk;
            }
            n2 += __shfl_xor(n2, 16, 64); n2 += __shfl_xor(n2, 32, 64);
            bon += __shfl_xor(bon, 16, 64); bon += __shfl_xor(bon, 32, 64);
            const float inv = rsq_(fmaxf(n2, 1e-24f));
#pragma unroll
            for (int nt = 0; nt < 4; ++nt) {
                const int ci = nt * 16 + fq * 4;
                const f32x4 kk = Kr[nt] * inv;
                *(u32x2*)(rec + 640 + ci * 2) = (u32x2){pack2(kk[0], kk[1]), pack2(kk[2], kk[3])};
                const f32x4 nb = -(kk * Av[nt]);
                *(u32x2*)(rec + 768 + ci * 2) = (u32x2){pack2(nb[0], nb[1]), pack2(nb[2], nb[3])};
            }
            if (fq == 0) BON[(size_t)bh * 2048 + s] = bon;
        }
        WSYNC();
        {
            float w_[16], r_[16], kp_[16], v_[16], kk_[16], nb_[16];
#pragma unroll
            for (int t = 0; t < 16; ++t) {
                const unsigned char* rt = recl + t * RST;
                w_[t] = *(const float*)(rt + lane * 4);
                r_[t] = bf2f(*(const u16*)(rt + 256 + lane * 2)); kp_[t] = bf2f(*(const u16*)(rt + 384 + lane * 2)); v_[t] = bf2f(*(const u16*)(rt + 512 + lane * 2));
                kk_[t] = bf2f(*(const u16*)(rt + 640 + lane * 2)); nb_[t] = bf2f(*(const u16*)(rt + 768 + lane * 2));
            }
            WSYNC();
            float g = 1.f;
            float At[16], Bt[16], Kt[16];
#pragma unroll
            for (int t = 0; t < 16; ++t) {
                const float gp = g; g = g * w_[t]; const float ig = rcp_(g);
                const float a = kk_[t] * gp, rr = r_[t] * g, bb = nb_[t] * ig, kt = kp_[t] * ig;
                AR[t * 72 + lane] = f2bf(a); AR[(16 + t) * 72 + lane] = f2bf(rr); BK[t * 72 + lane] = f2bf(bb); BK[(16 + t) * 72 + lane] = f2bf(kt);
                At[t] = a; Bt[t] = bb; Kt[t] = kt;
            }
            u32x4 o0, o1;
            o0 = (u32x4){pack2(At[0], At[1]), pack2(At[2], At[3]), pack2(At[4], At[5]), pack2(At[6], At[7])};
            o1 = (u32x4){pack2(At[8], At[9]), pack2(At[10], At[11]), pack2(At[12], At[13]), pack2(At[14], At[15])};
            *(u32x4*)(AtT + lane * 16) = o0; *(u32x4*)(AtT + lane * 16 + 8) = o1;
            o0 = (u32x4){pack2(Bt[0] * g, Bt[1] * g), pack2(Bt[2] * g, Bt[3] * g), pack2(Bt[4] * g, Bt[5] * g), pack2(Bt[6] * g, Bt[7] * g)};
            o1 = (u32x4){pack2(Bt[8] * g, Bt[9] * g), pack2(Bt[10] * g, Bt[11] * g), pack2(Bt[12] * g, Bt[13] * g), pack2(Bt[14] * g, Bt[15] * g)};
            *(u32x4*)(BhT + lane * 16) = o0; *(u32x4*)(BhT + lane * 16 + 8) = o1;
            o0 = (u32x4){pack2(Kt[0] * g, Kt[1] * g), pack2(Kt[2] * g, Kt[3] * g), pack2(Kt[4] * g, Kt[5] * g), pack2(Kt[6] * g, Kt[7] * g)};
            o1 = (u32x4){pack2(Kt[8] * g, Kt[9] * g), pack2(Kt[10] * g, Kt[11] * g), pack2(Kt[12] * g, Kt[13] * g), pack2(Kt[14] * g, Kt[15] * g)};
            *(u32x4*)(KhT + lane * 16) = o0; *(u32x4*)(KhT + lane * 16 + 8) = o1;
            o0 = (u32x4){pack2(v_[0], v_[1]), pack2(v_[2], v_[3]), pack2(v_[4], v_[5]), pack2(v_[6], v_[7])};
            o1 = (u32x4){pack2(v_[8], v_[9]), pack2(v_[10], v_[11]), pack2(v_[12], v_[13]), pack2(v_[14], v_[15])};
            *(u32x4*)(VT + lane * 16) = o0; *(u32x4*)(VT + lane * 16 + 8) = o1;
            G15g[u * 64 + lane] = g;
        }
        WSYNC();
        {
            u32x2 rp[4];
#pragma unroll
            for (int ta = 0; ta < 4; ++ta) rp[ta] = *(const u32x2*)(AR + (16 + fr) * 72 + 16 * ta + 4 * fq);
            *(u32x4*)(RFg + (u * 64 + lane) * 32) = (u32x4){rp[0].x, rp[0].y, rp[1].x, rp[1].y};
            *(u32x4*)(RFg + (u * 64 + lane) * 32 + 16) = (u32x4){rp[2].x, rp[2].y, rp[3].x, rp[3].y};
#pragma unroll
            for (int ta = 0; ta < 4; ++ta) {
                const u32x2 b2 = *(const u32x2*)(BhT + (16 * ta + fr) * 16 + 4 * fq), k2 = *(const u32x2*)(KhT + (16 * ta + fr) * 16 + 4 * fq);
                *(u32x4*)(BKFg + ((u * 4 + ta) * 64 + lane) * 16) = (u32x4){b2.x, b2.y, k2.x, k2.y};
            }
#pragma unroll
            for (int sl = 0; sl < 4; ++sl) *(u32x2*)(CHVg + (((u * 4 + sl) * 3 + 2) * 64 + lane) * 8) = *(const u32x2*)(VT + (16 * sl + fr) * 16 + 4 * fq);
        }
        {
            f32x4 P00 = zero4, P01 = zero4, P10 = zero4, P11 = zero4;
#pragma unroll
            for (int s = 0; s < 2; ++s) {
                const bf16x8 a0 = *(const bf16x8*)(AR + fr * 72 + s * 32 + fq * 8), a1 = *(const bf16x8*)(AR + (16 + fr) * 72 + s * 32 + fq * 8);
                const bf16x8 b0 = *(const bf16x8*)(BK + fr * 72 + s * 32 + fq * 8), b1 = *(const bf16x8*)(BK + (16 + fr) * 72 + s * 32 + fq * 8);
                P00 = MFMA16(a0, b0, P00); P01 = MFMA16(a0, b1, P01); P10 = MFMA16(a1, b0, P10); P11 = MFMA16(a1, b1, P11);
            }
            WSYNC();
            float ak[4];
#pragma unroll
            for (int r = 0; r < 4; ++r) {
                const int i = 4 * fq + r, j = fr;
                Pab[i * 17 + j] = (j < i) ? P00[r] : 0.f;
                ak[r] = (j < i) ? P01[r] : 0.f;
                Arb[i * 24 + j] = f2bf((j <= i) ? P10[r] : 0.f);
                Ark[i * 24 + j] = f2bf((j <= i) ? P11[r] : 0.f);
            }
            *(u32x2*)(AakT + fr * 24 + 4 * fq) = (u32x2){pack2(ak[0], ak[1]), pack2(ak[2], ak[3])};
        }
        WSYNC();
        {
            float T[16];
#pragma unroll
            for (int i = 0; i < 16; ++i) {
                float acc = (i == fr) ? 1.f : 0.f;
#pragma unroll
                for (int j = 0; j < i; ++j) acc += Pab[i * 17 + j] * T[j];
                T[i] = acc;
            }
#pragma unroll
            for (int i = 0; i < 16; ++i) Tm[i * 24 + fr] = f2bf(T[i]);
            *(u32x2*)(ARBg + (u * 64 + lane) * 8) = *(const u32x2*)(Arb + fr * 24 + 4 * fq);
        }
        WSYNC();
        const bf16x8 Tld = *(const bf16x8*)(Tm + fr * 24 + (fq & 1) * 8);
        const bf16x8 Tf = (fq < 2) ? Tld : zero8;
        {
            f32x4 D[4];
#pragma unroll
            for (int ta = 0; ta < 4; ++ta) {
                const bf16x8 ald = *(const bf16x8*)(AtT + (16 * ta + fr) * 16 + (fq & 1) * 8);
                D[ta] = MFMA16((fq < 2) ? ald : zero8, Tf, zero4);
            }
            *(u32x4*)(AFg + (u * 64 + lane) * 32) = (u32x4){pack2(D[0][0], D[0][1]), pack2(D[0][2], D[0][3]), pack2(D[1][0], D[1][1]), pack2(D[1][2], D[1][3])};
            *(u32x4*)(AFg + (u * 64 + lane) * 32 + 16) = (u32x4){pack2(D[2][0], D[2][1]), pack2(D[2][2], D[2][3]), pack2(D[3][0], D[3][1]), pack2(D[3][2], D[3][3])};
            const bf16x8 akld = *(const bf16x8*)(AakT + fr * 24 + (fq & 1) * 8);
            const f32x4 M1 = MFMA16(Tf, (fq < 2) ? akld : zero8, zero4);
#pragma unroll
            for (int r = 0; r < 4; ++r) M1m[(4 * fq + r) * 24 + fr] = f2bf(M1[r]);
        }
        WSYNC();
        {
            const bf16x8 m1ld = *(const bf16x8*)(M1m + fr * 24 + (fq & 1) * 8), rkld = *(const bf16x8*)(Ark + fr * 24 + (fq & 1) * 8);
            const bf16x8 M1f = (fq < 2) ? m1ld : zero8, Arkf = (fq < 2) ? rkld : zero8;
#pragma unroll
            for (int sl = 0; sl < 4; ++sl) {
                const bf16x8 vld = *(const bf16x8*)(VT + (16 * sl + fr) * 16 + (fq & 1) * 8);
                const bf16x8 Vb = (fq < 2) ? vld : zero8;
                const f32x4 Uh = MFMA16(M1f, Vb, zero4), Y0 = MFMA16(Arkf, Vb, zero4);
                *(u32x2*)(CHVg + (((u * 4 + sl) * 3 + 0) * 64 + lane) * 8) = (u32x2){pack2(Uh[0], Uh[1]), pack2(Uh[2], Uh[3])};
                *(u32x2*)(CHVg + (((u * 4 + sl) * 3 + 1) * 64 + lane) * 8) = (u32x2){pack2(Y0[0], Y0[1]), pack2(Y0[2], Y0[3])};
            }
        }
        WSYNC();
    }
}

struct ChunkOps { u32x4 af0, af1, rf0, rf1, bk0, bk1, bk2, bk3; u32x2 arb, uh, y0, vf; f32x4 g0, g1, g2, g3; };
constexpr int RING_SLOT = 22528, RING_NS = 6, RING_D = 5;
__device__ __forceinline__ void lds_chunk_ops(ChunkOps& o, const LAS unsigned char* s, int sl, int lane, int fq) {
    o.af0 = *(const LAS u32x4*)(s + lane * 32); o.af1 = *(const LAS u32x4*)(s + lane * 32 + 16);
    o.rf0 = *(const LAS u32x4*)(s + 2048 + lane * 32); o.rf1 = *(const LAS u32x4*)(s + 2048 + lane * 32 + 16);
    o.bk0 = *(const LAS u32x4*)(s + 4096 + (0 * 64 + lane) * 16); o.bk1 = *(const LAS u32x4*)(s + 4096 + (1 * 64 + lane) * 16);
    o.bk2 = *(const LAS u32x4*)(s + 4096 + (2 * 64 + lane) * 16); o.bk3 = *(const LAS u32x4*)(s + 4096 + (3 * 64 + lane) * 16);
    o.uh = *(const LAS u32x2*)(s + 8192 + ((sl * 3 + 0) * 64 + lane) * 8);
    o.y0 = *(const LAS u32x2*)(s + 8192 + ((sl * 3 + 1) * 64 + lane) * 8);
    o.vf = *(const LAS u32x2*)(s + 8192 + ((sl * 3 + 2) * 64 + lane) * 8);
    o.arb = *(const LAS u32x2*)(s + 14336 + lane * 8);
    o.g0 = *(const LAS f32x4*)(s + 15360 + 16 * fq); o.g1 = *(const LAS f32x4*)(s + 15360 + 64 + 16 * fq);
    o.g2 = *(const LAS f32x4*)(s + 15360 + 128 + 16 * fq); o.g3 = *(const LAS f32x4*)(s + 15360 + 192 + 16 * fq);
}
template <int LW> __device__ __forceinline__ void ring_issue(const Params& p, LAS unsigned char* ring, int bh, int c, int lane) {
    const size_t u = (size_t)bh * 128 + c;
    LAS unsigned char* slot = ring + (c % RING_NS) * RING_SLOT;
    const unsigned char* ws = p.ws; const unsigned char* od = (const unsigned char*)p.out;
#pragma unroll
    for (int j = 0; j < 11; ++j) {
        constexpr int Q0 = LW * 11; const int q = Q0 + j;
        const unsigned char* g;
        if (q < 2) g = ws + CH_AF + u * 2048 + q * 1024 + lane * 16;
        else if (q < 4) g = ws + CH_RF + u * 2048 + (q - 2) * 1024 + lane * 16;
        else if (q < 8) g = ws + CH_BKF + u * 4096 + (q - 4) * 1024 + lane * 16;
        else if (q < 14) g = od + OUT_CHV + u * 6144 + (q - 8) * 1024 + lane * 16;
        else if (q == 14) g = ws + CH_ARB + u * 512 + lane * 16;
        else if (q == 15) g = ws + CH_G15 + u * 256 + lane * 16;
        else if (q < 18) { const int i = (q - 16) * 64 + lane; g = od + OUT_GB + (((size_t)(bh >> 3) * 2048 + c * 16 + (i >> 3)) * 512 + (bh & 7) * 64) * 2 + (i & 7) * 16; }
        else if (q < 20) { const int i = (q - 18) * 64 + lane; g = ws + WS_VB + (((size_t)(bh >> 3) * 2048 + c * 16 + (i >> 3)) * 512 + (bh & 7) * 64) * 2 + (i & 7) * 16; }
        else g = ws + WS_BONUS + ((size_t)bh * 2048 + c * 16) * 4 + lane * 16;
        __builtin_amdgcn_global_load_lds((const unsigned*)g, (LAS unsigned*)(slot + q * 1024), 16, 0, 0);
    }
}
template <int CTRL> __device__ __forceinline__ float dpp_add_q(float v) {
    const int t = __builtin_amdgcn_update_dpp(0, __float_as_int(v), CTRL, 0xf, 0xf, false);
    return v + __int_as_float(t);
}
__device__ __forceinline__ float oct_allsum(float v) {
    v = dpp_add_q<0xB1>(v); v = dpp_add_q<0x4E>(v); v = dpp_add_q<0x141>(v);
    return v;
}
struct EpiIn { u32x4 vv, gb; float bon; };
__device__ __forceinline__ void epi_load(EpiIn& e, const LAS unsigned char* s, int t, int v0) {
    e.gb = *(const LAS u32x4*)(s + 16384 + t * 128 + v0 * 2);
    e.vv = *(const LAS u32x4*)(s + 18432 + t * 128 + v0 * 2);
    e.bon = *(const LAS float*)(s + 20480 + t * 4);
}
template <int LW> __device__ __forceinline__ void p3_loader(const Params& p, LAS unsigned char* ring, int bh, int lane) {
#pragma unroll
    for (int c = 0; c < RING_D; ++c) ring_issue<LW>(p, ring, bh, c, lane);
    asm volatile("s_waitcnt vmcnt(33)" ::: "memory");
    __builtin_amdgcn_s_barrier();
#pragma unroll 1
    for (int c = 0; c < 128; ++c) {
        const int cn = (c + RING_D < 128) ? c + RING_D : 127;
        ring_issue<LW>(p, ring, bh, cn, lane);
        asm volatile("s_waitcnt vmcnt(33)" ::: "memory");
        __builtin_amdgcn_s_barrier();
    }
    asm volatile("s_waitcnt vmcnt(0)" ::: "memory");
}
__device__ void phase3(const Params& p) {
    const int tid = threadIdx.x, lane = tid & 63, wave = __builtin_amdgcn_readfirstlane(tid >> 6), fr = lane & 15, fq = lane >> 4;
    const int bh = blockIdx.x;
    if (bh >= 64) return;
    LAS unsigned char* ring = (LAS unsigned char*)dyn_smem;
    LAS float* ybuf = (LAS float*)(ring + RING_NS * RING_SLOT);
    if (wave >= 6) {
        const int e = (wave - 6) * 64 + lane, t = e >> 3, v0 = (e & 7) * 8, b = bh >> 3, h = bh & 7;
        f32x4 ga0 = *(const f32x4*)(p.gn_gain + h * 64 + v0), ga1 = *(const f32x4*)(p.gn_gain + h * 64 + v0 + 4);
        f32x4 bi0 = *(const f32x4*)(p.gn_bias + h * 64 + v0), bi1 = *(const f32x4*)(p.gn_bias + h * 64 + v0 + 4);
        u16* Y = (u16*)(p.ws + WS_Y);
        EpiIn cur, nxt;
        __builtin_amdgcn_s_barrier();
        epi_load(cur, ring, t, v0);
#pragma unroll 1
        for (int c = 0; c <= 128; ++c) {
            if (c >= 1) {
                const int cc = c - 1;
                { const int cn = (c < 128) ? c : 127; epi_load(nxt, ring + (cn % RING_NS) * RING_SLOT, t, v0); }
                const LAS float* yb = ybuf + (cc & 1) * (16 * 68) + t * 68 + v0;
                const f32x4 y0 = *(const LAS f32x4*)(yb), y1 = *(const LAS f32x4*)(yb + 4);
                float s1 = (y0[0] + y0[1]) + (y0[2] + y0[3]) + (y1[0] + y1[1]) + (y1[2] + y1[3]);
                float s2 = y0[0] * y0[0] + y0[1] * y0[1] + y0[2] * y0[2] + y0[3] * y0[3] + y1[0] * y1[0] + y1[1] * y1[1] + y1[2] * y1[2] + y1[3] * y1[3];
                s1 = oct_allsum(s1); s2 = oct_allsum(s2);
                const float mean = s1 * (1.f / 64.f);
                const float var = fmaxf(s2 * (1.f / 64.f) - mean * mean, 0.f);
                const float rstd = rsq_(var + 64e-5f);
                const float vvf[8] = {bflo(cur.vv.x), bfhi(cur.vv.x), bflo(cur.vv.y), bfhi(cur.vv.y), bflo(cur.vv.z), bfhi(cur.vv.z), bflo(cur.vv.w), bfhi(cur.vv.w)};
                const float gbf[8] = {bflo(cur.gb.x), bfhi(cur.gb.x), bflo(cur.gb.y), bfhi(cur.gb.y), bflo(cur.gb.z), bfhi(cur.gb.z), bflo(cur.gb.w), bfhi(cur.gb.w)};
                float o[8];
#pragma unroll
                for (int i = 0; i < 8; ++i) {
                    const float yv = (i < 4) ? y0[i & 3] : y1[i & 3];
                    const float gn = (i < 4) ? ga0[i & 3] : ga1[i & 3], bs = (i < 4) ? bi0[i & 3] : bi1[i & 3];
                    const float yn = (yv - mean) * rstd * gn + bs;
                    o[i] = (yn + cur.bon * vvf[i]) * gbf[i] * sigmoidf_(gbf[i]);
                }
                *(u32x4*)(Y + ((size_t)b * 2048 + cc * 16 + t) * 1024 + 512 + h * 64 + v0) = (u32x4){pack2(o[0], o[1]), pack2(o[2], o[3]), pack2(o[4], o[5]), pack2(o[6], o[7])};
                cur = nxt;
            }
            if (c < 128) __builtin_amdgcn_s_barrier();
        }
        return;
    }
    if (wave >= 4) { if (wave == 4) p3_loader<0>(p, ring, bh, lane); else p3_loader<1>(p, ring, bh, lane); return; }
    const int sl = wave;
    f32x4 acc0 = (f32x4){0.f, 0.f, 0.f, 0.f}, acc1 = acc0, acc2 = acc0, acc3 = acc0;
    ChunkOps cur, nxt;
    __builtin_amdgcn_s_barrier();
    lds_chunk_ops(cur, ring, sl, lane, fq);
#pragma unroll 2
    for (int c = 0; c < 128; ++c) {
        { const int cn = (c + 1 < 128) ? c + 1 : c; lds_chunk_ops(nxt, ring + (cn % RING_NS) * RING_SLOT, sl, lane, fq); }
        const bf16x8 sb0 = as_bf8((u32x4){pack2(acc0[0], acc0[1]), pack2(acc0[2], acc0[3]), pack2(acc1[0], acc1[1]), pack2(acc1[2], acc1[3])});
        const bf16x8 sb1 = as_bf8((u32x4){pack2(acc2[0], acc2[1]), pack2(acc2[2], acc2[3]), pack2(acc3[0], acc3[1]), pack2(acc3[2], acc3[3])});
        f32x4 U = (f32x4){bflo(cur.uh.x), bfhi(cur.uh.x), bflo(cur.uh.y), bfhi(cur.uh.y)};
        U = MFMA16(as_bf8(cur.af0), sb0, U); U = MFMA16(as_bf8(cur.af1), sb1, U);
        f32x4 Yv = (f32x4){bflo(cur.y0.x), bfhi(cur.y0.x), bflo(cur.y0.y), bfhi(cur.y0.y)};
        Yv = MFMA16(as_bf8(cur.rf0), sb0, Yv); Yv = MFMA16(as_bf8(cur.rf1), sb1, Yv);
        const unsigned u01 = pack2(U[0], U[1]), u23 = pack2(U[2], U[3]);
        Yv = MFMA16(as_bf8((u32x4){cur.arb.x, cur.arb.y, 0u, 0u}), as_bf8((u32x4){u01, u23, 0u, 0u}), Yv);
        const bf16x8 uvb = as_bf8((u32x4){u01, u23, cur.vf.x, cur.vf.y});
        acc0 = MFMA16(as_bf8(cur.bk0), uvb, acc0 * cur.g0); acc1 = MFMA16(as_bf8(cur.bk1), uvb, acc1 * cur.g1);
        acc2 = MFMA16(as_bf8(cur.bk2), uvb, acc2 * cur.g2); acc3 = MFMA16(as_bf8(cur.bk3), uvb, acc3 * cur.g3);
        LAS float* yb = ybuf + (c & 1) * (16 * 68) + (4 * fq) * 68 + sl * 16 + fr;
        yb[0] = Yv[0]; yb[68] = Yv[1]; yb[136] = Yv[2]; yb[204] = Yv[3];
        asm volatile("s_waitcnt lgkmcnt(0)" ::: "memory");
        __builtin_amdgcn_s_barrier();
        asm volatile("" ::: "memory");
        cur = nxt;
    }
}

__device__ void phase5(const Params& p) {
    const int tid = threadIdx.x, lane = tid & 63, wave = tid >> 6, blk = blockIdx.x;
#pragma unroll 1
    for (int r0 = 0; r0 < 8; r0 += 4) {
        f32x4 v[4][4]; float ss[4];
#pragma unroll
        for (int i = 0; i < 4; ++i) {
            const f32x4* xr = (const f32x4*)(p.out + (size_t)(blk * 64 + wave * 8 + r0 + i) * DM);
#pragma unroll
            for (int q = 0; q < 4; ++q) v[i][q] = xr[lane + 64 * q];
        }
#pragma unroll
        for (int i = 0; i < 4; ++i) {
            float s = 0.f;
#pragma unroll
            for (int q = 0; q < 4; ++q) s += v[i][q][0] * v[i][q][0] + v[i][q][1] * v[i][q][1] + v[i][q][2] * v[i][q][2] + v[i][q][3] * v[i][q][3];
            ss[i] = wave_sum(s);
        }
#pragma unroll
        for (int i = 0; i < 4; ++i) {
            f32x4* xr = (f32x4*)(p.out + (size_t)(blk * 64 + wave * 8 + r0 + i) * DM);
            const float inv = rsq_(ss[i] * (1.f / 1024.f) + 1e-6f);
#pragma unroll
            for (int q = 0; q < 4; ++q) { const f32x4 g = ((const f32x4*)p.final_gain)[lane + 64 * q]; xr[lane + 64 * q] = v[i][q] * inv * g; }
        }
    }
}

__global__ void __launch_bounds__(512, 2) hybrid_fwd(Params p) {
    __shared__ uint4 xb_words;
    if (threadIdx.x == 0) xb_words = make_uint4(0u, 0u, 0u, 0u);
    __syncthreads();
    XcdBarrier bar; bar.bar = (unsigned*)(p.ws + WS_CTL); bar.x = 0; bar.st = (volatile LAS unsigned*)&xb_words;
    const int lo = p.ph_lo, hi = p.ph_hi;
    if (hi - lo > 1) bar = xcd_barrier_post((unsigned*)(p.ws + WS_CTL), (volatile LAS unsigned*)&xb_words);
#define IN(k) (lo <= (k) && (k) < hi)
#define SEAM(k) do { if (IN(k) && IN((k) + 1)) xcd_barrier(bar); } while (0)
#define RUN(k, f) do { if (IN(k)) { if (PROBE_DUP == (k)) { for (int _r = 0; _r < p.dup_n; ++_r) { if (_r) __syncthreads(); f(p); } } else f(p); } } while (0)
    RUN(0, phase0);
    SEAM(0);
    RUN(1, phase1);
    SEAM(1);
    RUN(2, phase2);
    SEAM(2);
    RUN(3, phase3);
    SEAM(3);
    RUN(4, phase4);
}

extern "C" void kernel_launch(void* const* d_in, const int* in_sizes, int n_in, void* d_out, int out_size, void* d_ws, size_t ws_size, hipStream_t stream) {
    static int grid = 0;
    if (grid == 0) {
        if (n_in != 17 || out_size != NTOK * DM || ws_size < WS_END) { fprintf(stderr, "kernel_launch: unexpected problem (n_in %d out %d ws %zu need %zu)\n", n_in, out_size, ws_size, (size_t)WS_END); grid = -1; return; }
        if (hipFuncSetAttribute((const void*)hybrid_fwd, hipFuncAttributeMaxDynamicSharedMemorySize, LDS_BYTES) != hipSuccess) { fprintf(stderr, "kernel_launch: hipFuncSetAttribute failed\n"); grid = -1; return; }
        int per_cu = 0;
        if (hipOccupancyMaxActiveBlocksPerMultiprocessor(&per_cu, (const void*)hybrid_fwd, 512, LDS_BYTES) != hipSuccess || per_cu < 1) fprintf(stderr, "kernel_launch: occupancy query says %d blocks per CU\n", per_cu);
        (void)hipGetLastError();
        grid = 256;
    }
    if (grid < 0) return;
    (void)hipMemsetAsync((char*)d_ws + WS_CTL, 0, 16384, stream);
    Params p{};
    p.x = (const float*)d_in[0]; p.norm_gain = (const float*)d_in[1]; p.w_in = (const float*)d_in[2]; p.pool_w = (const float*)d_in[3];
    p.pool_scale = (const float*)d_in[4]; p.shift_mu = (const float*)d_in[5]; p.w0 = (const float*)d_in[6]; p.w_up = (const float*)d_in[7];
    p.a0 = (const float*)d_in[8]; p.a_up = (const float*)d_in[9]; p.k_k = (const float*)d_in[10]; p.k_a = (const float*)d_in[11];
    p.r_k = (const float*)d_in[12]; p.gn_gain = (const float*)d_in[13]; p.gn_bias = (const float*)d_in[14]; p.w_out = (const float*)d_in[15];
    p.final_gain = (const float*)d_in[16];
    p.out = (float*)d_out; p.ws = (unsigned char*)d_ws; p.dup_n = 2;
#if N_LAUNCHES == 1
    p.ph_lo = 0; p.ph_hi = NPH;
    hipLaunchKernelGGL(hybrid_fwd, dim3(grid), dim3(512), LDS_BYTES, stream, p);
#else
    for (int k = 0; k < NPH; ++k) { p.ph_lo = k; p.ph_hi = k + 1; hipLaunchKernelGGL(hybrid_fwd, dim3(grid), dim3(512), LDS_BYTES, stream, p); }
#endif
}
```

```cpp
#include <hip/hip_runtime.h>
#include <stdint.h>
#include <cstdio>

typedef unsigned short u16;
typedef short bf16x8 __attribute__((ext_vector_type(8)));
typedef float f32x4 __attribute__((ext_vector_type(4)));
typedef float f32x2 __attribute__((ext_vector_type(2)));
typedef unsigned u32x2 __attribute__((ext_vector_type(2)));
typedef unsigned u32x4 __attribute__((ext_vector_type(4)));

#ifndef PROBE_DUP
#define PROBE_DUP -1
#endif
#ifndef N_LAUNCHES
#define N_LAUNCHES 1
#endif

constexpr int NTOK = 16384, DM = 1024, SEQ = 2048, DIN = 3200, DINP = 3328;
constexpr int NPH = 5;
constexpr int LDS_BYTES = 18432 + 8 * 17408;

constexpr size_t WS_CTL = 0;
constexpr size_t WS_WINT = 16384;
constexpr size_t WS_WOUTT = WS_WINT + (size_t)DINP * 1024 * 2;
constexpr size_t WS_WUPT = WS_WOUTT + (size_t)1024 * 1024 * 2;
constexpr size_t WS_AUPT = WS_WUPT + 512 * 64 * 2;
constexpr size_t WS_POOLT = WS_AUPT + 512 * 64 * 2;
constexpr size_t WS_Z = WS_POOLT + 4 * 128 * 128 * 2;
constexpr size_t WS_REC = WS_Z + (size_t)NTOK * DIN * 2;
constexpr size_t WS_Y = WS_REC + (size_t)64 * 2048 * 896;
constexpr size_t WS_BONUS = WS_Y + (size_t)NTOK * 1024 * 2;
constexpr size_t WS_PART = WS_BONUS + (size_t)64 * 2048 * 4;
constexpr size_t WS_END = WS_PART + (size_t)64 * 4 * 256 * 4;
constexpr int CTL_CNT_WORD = 3584;
constexpr int NUNIT = 64 * 128;
constexpr size_t CH_AF = WS_REC;
constexpr size_t CH_RF = CH_AF + (size_t)NUNIT * 2048;
constexpr size_t CH_BKF = CH_RF + (size_t)NUNIT * 2048;
constexpr size_t CH_ARB = CH_BKF + (size_t)NUNIT * 4096;
constexpr size_t CH_G15 = CH_ARB + (size_t)NUNIT * 512;
constexpr size_t CH_END = CH_G15 + (size_t)NUNIT * 256;
constexpr size_t WS_VB = CH_END;
static_assert(WS_VB + (size_t)NTOK * 512 * 2 <= WS_Y, "chunk operands + v must fit in the record region");
constexpr size_t OUT_CHV = 0;
constexpr size_t OUT_GB = (size_t)NUNIT * 4 * 3 * 512;
static_assert(OUT_GB + (size_t)NTOK * 512 * 2 <= (size_t)NTOK * DM * 4, "d_out scratch");

struct Params {
    const float* x; const float* norm_gain; const float* w_in; const float* pool_w; const float* pool_scale;
    const float* shift_mu; const float* w0; const float* w_up; const float* a0; const float* a_up;
    const float* k_k; const float* k_a; const float* r_k; const float* gn_gain; const float* gn_bias;
    const float* w_out; const float* final_gain;
    float* out; unsigned char* ws;
    int ph_lo, ph_hi, dup_n, pad;
};

extern __shared__ __attribute__((aligned(16))) unsigned char dyn_smem[];

__device__ __forceinline__ float bf2f(u16 v) { return __uint_as_float(((unsigned)v) << 16); }
__device__ __forceinline__ float bflo(unsigned v) { return __uint_as_float(v << 16); }
__device__ __forceinline__ float bfhi(unsigned v) { return __uint_as_float(v & 0xffff0000u); }
typedef __bf16 bf16x2_t __attribute__((ext_vector_type(2)));
__device__ __forceinline__ unsigned pack2(float lo, float hi) { bf16x2_t v = {(__bf16)lo, (__bf16)hi}; return __builtin_bit_cast(unsigned, v); }
__device__ __forceinline__ u16 f2bf(float f) { return (u16)(pack2(f, 0.f) & 0xffffu); }
__device__ __forceinline__ float wave_sum(float v) {
#pragma unroll
    for (int m = 32; m >= 1; m >>= 1) v += __shfl_xor(v, m, 64);
    return v;
}
__device__ __forceinline__ float rcp_(float v) { return __builtin_amdgcn_rcpf(v); }
__device__ __forceinline__ float rsq_(float v) { return __builtin_amdgcn_rsqf(v); }
__device__ __forceinline__ float sigmoidf_(float v) { return rcp_(1.f + __expf(-v)); }
__device__ __forceinline__ float tanhf_(float v) { return 1.f - 2.f * rcp_(1.f + __expf(2.f * v)); }

#define XB_TMO      128
#define XB_XCNT(j)  (256  + 64 * (j))
#define XB_XSUB(j)  (1280 + 64 * (j))
#define XB_XGEN(j)  (2304 + 64 * (j))
#define XB_TOP      3328
#define XB_TOPGEN   3392
#define XCD_BAR_WORDS 3456
#define XB_SPIN_CAP (1u << 22)
#define LAS __attribute__((address_space(3)))

__device__ __forceinline__ unsigned xb_ld(unsigned* p)              { return __hip_atomic_load(p, __ATOMIC_RELAXED, __HIP_MEMORY_SCOPE_AGENT); }
__device__ __forceinline__ unsigned xb_add(unsigned* p, unsigned v) { return __hip_atomic_fetch_add(p, v, __ATOMIC_RELAXED, __HIP_MEMORY_SCOPE_AGENT); }
__device__ __forceinline__ unsigned xb_xcc_id() { return (unsigned)__builtin_amdgcn_s_getreg((3 << 11) | 20) & 0xFu; }
#define XB_SPIN(cond, bar) do { unsigned _sp = 0; while (cond) { __builtin_amdgcn_s_sleep(1); \
    if ((++_sp & 255u) == 0u) { if (xb_ld(&(bar)[XB_TMO])) break; if (_sp > XB_SPIN_CAP) { atomicAdd(&(bar)[XB_TMO], 1u); break; } } } } while (0)

struct XcdBarrier { unsigned* bar; unsigned x; volatile LAS unsigned* st; };

__device__ __forceinline__ XcdBarrier xcd_barrier_post(unsigned* bar, volatile LAS unsigned* st) {
    XcdBarrier b; b.bar = bar; b.x = xb_xcc_id(); b.st = st;
    if (threadIdx.x == 0) (void)xb_add(&bar[XB_XCNT(b.x)], 1u);
    return b;
}
__device__ __forceinline__ void xcd_barrier_complete(unsigned* bar, unsigned x, unsigned& nloc, unsigned& nx) {
    const unsigned G = gridDim.x * gridDim.y * gridDim.z;
    unsigned sum, cnt, mine, sp = 0u;
    for (;;) {
        sum = 0u; cnt = 0u; mine = 0u;
#pragma unroll
        for (unsigned j = 0; j < 16; ++j) { const unsigned c = xb_ld(&bar[XB_XCNT(j)]); sum += c; cnt += (c > 0u) ? 1u : 0u; mine = (j == x) ? c : mine; }
        if (sum == G) break;
        __builtin_amdgcn_s_sleep(1);
        if ((++sp & 255u) == 0u) { if (xb_ld(&bar[XB_TMO])) break; if (sp > XB_SPIN_CAP) { atomicAdd(&bar[XB_TMO], 1u); break; } }
    }
    nloc = mine > 0u ? mine : 1u; nx = cnt > 0u ? cnt : 1u;
}
__device__ __forceinline__ void xcd_barrier(const XcdBarrier& b) {
    asm volatile("s_waitcnt vmcnt(0)" ::: "memory");
    __syncthreads();
    if (threadIdx.x == 0) {
        unsigned* bar = b.bar;
        __builtin_amdgcn_s_waitcnt(0);
        unsigned nloc = b.st[0], nx = b.st[1];
        if (nloc == 0u) { xcd_barrier_complete(bar, b.x, nloc, nx); b.st[0] = nloc; b.st[1] = nx; }
        const unsigned old = xb_add(&bar[XB_XSUB(b.x)], 1u);
        const unsigned gen = old / nloc;
        if (old + 1u == (gen + 1u) * nloc) {
            __builtin_amdgcn_fence(__ATOMIC_RELEASE, "agent");
            asm volatile("s_waitcnt vmcnt(0)" ::: "memory");
            const unsigned og = xb_add(&bar[XB_TOP], 1u);
            const unsigned tg = og / nx;
            if (og + 1u == (tg + 1u) * nx) xb_add(&bar[XB_TOPGEN], 1u);
            else XB_SPIN(xb_ld(&bar[XB_TOPGEN]) == tg, bar);
            __builtin_amdgcn_fence(__ATOMIC_ACQUIRE, "agent");
            xb_add(&bar[XB_XGEN(b.x)], 1u);
            asm volatile("s_waitcnt vmcnt(0)" ::: "memory");
        } else {
            XB_SPIN(xb_ld(&bar[XB_XGEN(b.x)]) == gen, bar);
            __builtin_amdgcn_fence(__ATOMIC_ACQUIRE, "agent");
            asm volatile("s_waitcnt vmcnt(0)" ::: "memory");
        }
    }
    __syncthreads();
}

constexpr int BM = 256, BK = 64, HALF = 128, HTB = HALF * BK * 2, STAGE_BYTES = 8 * HTB, NXCD = 8, WGM = 8;
__device__ __forceinline__ int lds_byte(int r, int c) { const int st = (r >> 4) * 2 + (c >> 5), rr = r & 15, cc = c & 31, ob = rr * 64 + cc * 2; return st * 1024 + (ob ^ (((ob >> 9) & 1) << 5)); }
__device__ __forceinline__ void stage_rc(int b, int& R, int& C) { const int st = b / 1024, sb = b % 1024, swz = sb ^ (((sb >> 9) & 1) << 5); R = (st >> 1) * 16 + swz / 64; C = (st & 1) * 32 + (swz % 64) / 2; }
__device__ __forceinline__ int perm32(int rho) { const int n = rho >> 4, i = rho & 15; return 8 * (i >> 2) + 4 * n + (i & 3); }

struct Unit { int pm, pn; };
struct Gemm { const u16* A; const u16* Bt; int M, N, K, Nvalid; };
struct StaticOrder {
    int nM, nN, nwg, G, c;
    __device__ void init(int M, int N, int G_, int c_) { nM = M / BM; nN = N / BM; nwg = nM * nN; G = G_; c = c_; }
    __device__ bool next(int i, Unit& u) const {
        const long L = (long)i * G + c; if (L >= nwg) return false;
        int wgid = (int)L; { const int q = nwg / NXCD, r = nwg % NXCD, xcd = wgid % NXCD, off = wgid / NXCD; wgid = (xcd < r ? xcd * (q + 1) : r * (q + 1) + (xcd - r) * q) + off; }
        const int nig = WGM * nN, gid = wgid / nig, fm = gid * WGM, gsz = (nM - fm) < WGM ? (nM - fm) : WGM;
        u.pm = fm + ((wgid % nig) % gsz); u.pn = (wgid % nig) / gsz; return true;
    }
};
struct EpiZ {
    static constexpr bool PERM = true, AFTER_DRAIN = false;
    u16* Z;
    __device__ __forceinline__ void operator()(const f32x4 (&acc)[2][2][4][2], const Unit& u, int wr, int wc, int fr, int fq) const {
        const int row0 = u.pm * BM + wr * 64 + fr, col0 = u.pn * BM + wc * 32 + 8 * fq;
#pragma unroll
        for (int ai = 0; ai < 2; ++ai)
#pragma unroll
            for (int m = 0; m < 4; ++m) { u16* rowp = Z + (size_t)(row0 + ai * HALF + m * 16) * DIN;
#pragma unroll
                for (int bj = 0; bj < 2; ++bj) { const int col = col0 + bj * HALF; const f32x4 v0 = acc[ai][bj][m][0], v1 = acc[ai][bj][m][1];
                    if (col < DIN) *(u32x4*)(rowp + col) = (u32x4){pack2(v0[0], v0[1]), pack2(v0[2], v0[3]), pack2(v1[0], v1[1]), pack2(v1[2], v1[3])}; } }
    }
};
struct EpiRes {
    static constexpr bool PERM = false, AFTER_DRAIN = false;
    const float* x; float* out;
    __device__ __forceinline__ void operator()(const f32x4 (&acc)[2][2][4][2], const Unit& u, int wr, int wc, int fr, int fq) const {
        const int row0 = u.pm * BM + wr * 64 + fr, col0 = u.pn * BM + wc * 32 + 4 * fq;
#pragma unroll
        for (int ai = 0; ai < 2; ++ai)
#pragma unroll
            for (int m = 0; m < 4; ++m) { const size_t ro = (size_t)(row0 + ai * HALF + m * 16) * DM + col0;
#pragma unroll
                for (int bj = 0; bj < 2; ++bj)
#pragma unroll
                    for (int n = 0; n < 2; ++n) { const f32x4 xv = *(const f32x4*)(x + ro + bj * HALF + n * 16); *(f32x4*)(out + ro + bj * HALF + n * 16) = xv + acc[ai][bj][m][n]; } }
    }
};
struct EpiResNorm {
    static constexpr bool PERM = false, AFTER_DRAIN = true;
    const float* x; const float* gain; float* out; float* part; unsigned* cnt;
    __device__ __forceinline__ void fused(f32x4 (&acc)[2][2][4][2], const Unit& u, int wr, int wc, int fr, int fq, LAS unsigned char* lds) const {
        const int row0 = u.pm * BM + wr * 64 + fr, col0 = u.pn * BM + wc * 32 + 4 * fq;
        LAS float* red = (LAS float*)lds;
        LAS float* tot = red + 1024;
        float rs[2][4];
#pragma unroll
        for (int ai = 0; ai < 2; ++ai)
#pragma unroll
            for (int m = 0; m < 4; ++m) { const size_t ro = (size_t)(row0 + ai * HALF + m * 16) * DM + col0; float s = 0.f;
#pragma unroll
                for (int bj = 0; bj < 2; ++bj)
#pragma unroll
                    for (int n = 0; n < 2; ++n) { const f32x4 v = *(const f32x4*)(x + ro + bj * HALF + n * 16) + acc[ai][bj][m][n]; acc[ai][bj][m][n] = v; s += v[0] * v[0] + v[1] * v[1] + v[2] * v[2] + v[3] * v[3]; }
                s += __shfl_xor(s, 16, 64); s += __shfl_xor(s, 32, 64);
                rs[ai][m] = s; }
        if (fq == 0) {
#pragma unroll
            for (int ai = 0; ai < 2; ++ai)
#pragma unroll
                for (int m = 0; m < 4; ++m) red[((wr * 4 + wc) * 8 + ai * 4 + m) * 16 + fr] = rs[ai][m];
        }
        __syncthreads();
        if (threadIdx.x < 256) {
            const int rl = threadIdx.x, ai = rl >> 7, wr_ = (rl >> 6) & 1, m = (rl >> 4) & 3, fr_ = rl & 15;
            const int o = ((wr_ * 4) * 8 + ai * 4 + m) * 16 + fr_;
            const float s = red[o] + red[o + 128] + red[o + 256] + red[o + 384];
            __hip_atomic_store(part + ((size_t)u.pm * 4 + u.pn) * 256 + rl, s, __ATOMIC_RELAXED, __HIP_MEMORY_SCOPE_AGENT);
        }
        asm volatile("s_waitcnt vmcnt(0)" ::: "memory");
        __syncthreads();
        if (threadIdx.x == 0) {
            __builtin_amdgcn_fence(__ATOMIC_RELEASE, "agent");
            asm volatile("s_waitcnt vmcnt(0)" ::: "memory");
            __hip_atomic_fetch_add(cnt + u.pm, 1u, __ATOMIC_RELAXED, __HIP_MEMORY_SCOPE_AGENT);
            unsigned sp = 0;
            while (__hip_atomic_load(cnt + u.pm, __ATOMIC_RELAXED, __HIP_MEMORY_SCOPE_AGENT) < 4u) { __builtin_amdgcn_s_sleep(1); if (++sp > (1u << 24)) break; }
            __builtin_amdgcn_fence(__ATOMIC_ACQUIRE, "agent");
            asm volatile("s_waitcnt vmcnt(0)" ::: "memory");
        }
        __syncthreads();
        for (int e = threadIdx.x; e < 1024; e += 512) tot[e] = __hip_atomic_load(part + (size_t)u.pm * 1024 + e, __ATOMIC_RELAXED, __HIP_MEMORY_SCOPE_AGENT);
        __syncthreads();
#pragma unroll
        for (int ai = 0; ai < 2; ++ai)
#pragma unroll
            for (int m = 0; m < 4; ++m) { const int rl = ai * 128 + wr * 64 + m * 16 + fr;
                const float inv = rsq_((tot[rl] + tot[256 + rl] + tot[512 + rl] + tot[768 + rl]) * (1.f / 1024.f) + 1e-6f);
                const size_t ro = (size_t)(row0 + ai * HALF + m * 16) * DM + col0;
#pragma unroll
                for (int bj = 0; bj < 2; ++bj)
#pragma unroll
                    for (int n = 0; n < 2; ++n) { const f32x4 g = *(const f32x4*)(gain + col0 + bj * HALF + n * 16); *(f32x4*)(out + ro + bj * HALF + n * 16) = acc[ai][bj][m][n] * inv * g; } }
    }
};

template <class Epi, class Sched>
__device__ __forceinline__ void gemm_phase(LAS unsigned char* lds, const Gemm g, const Sched& S, const Epi& E) {
    const int tid = threadIdx.x, wid = __builtin_amdgcn_readfirstlane(tid >> 6), lane = tid & 63, wr = wid >> 2, wc = wid & 3, fr = lane & 15, fq = lane >> 4;
    const int K = g.K, nt = K / BK;
    unsigned voffA[2], voffB[2];
#pragma unroll
    for (int i = 0; i < 2; ++i) { int R, C; stage_rc(tid * 16 + i * 8192, R, C); const int Rb = Epi::PERM ? ((R & ~31) + perm32(R & 31)) : R;
        voffA[i] = (unsigned)(R * K + C) * 2u; voffB[i] = (unsigned)(Rb * K + C) * 2u; }
    const size_t kstep = (size_t)(BK * 2);
    const size_t hstep = (size_t)HALF * K * 2;
    const size_t tstep = 2 * hstep;
    const unsigned ldsw = (unsigned)wid * 1024u;
    const int aoff = lds_byte(wr * 64 + fr, fq * 8), boff = lds_byte(wc * 32 + fr, fq * 8);
#define PG8_SA(b, h) (((b) * 2 + (h)) * HTB)
#define PG8_SB(b, h) ((4 + (b) * 2 + (h)) * HTB)
#define PG8_STAGE(bufoff, gbase, voff) do { _Pragma("unroll") for (int _i = 0; _i < 2; ++_i) \
        __builtin_amdgcn_global_load_lds((const unsigned*)((const char*)(gbase) + (voff)[_i]), (LAS unsigned*)(lds + (bufoff) + ldsw + _i * 8192), 16, 0, 0); } while (0)
#define PG8_LDA(dst, b, h) do { _Pragma("unroll") for (int m = 0; m < 4; ++m) _Pragma("unroll") for (int k = 0; k < 2; ++k) dst[m][k] = *(const LAS bf16x8*)(lds + PG8_SA(b, h) + aoff + m * 2048 + k * 1024); } while (0)
#define PG8_LDB(dst, b, h) do { _Pragma("unroll") for (int n = 0; n < 2; ++n) _Pragma("unroll") for (int k = 0; k < 2; ++k) dst[n][k] = *(const LAS bf16x8*)(lds + PG8_SB(b, h) + boff + n * 2048 + k * 1024); } while (0)
#define PG8_MMA(ai, bj, At, Bt) do { __builtin_amdgcn_s_setprio(1); _Pragma("unroll") for (int m = 0; m < 4; ++m) _Pragma("unroll") for (int n = 0; n < 2; ++n) _Pragma("unroll") for (int k = 0; k < 2; ++k) \
        acc[ai][bj][m][n] = __builtin_amdgcn_mfma_f32_16x16x32_bf16(Bt[n][k], At[m][k], acc[ai][bj][m][n], 0, 0, 0); __builtin_amdgcn_s_setprio(0); } while (0)
#define PG8_WAIT_V(n) asm volatile("s_waitcnt vmcnt(" #n ")" ::: "memory")
#define PG8_WAIT_L(n) asm volatile("s_waitcnt lgkmcnt(" #n ")" ::: "memory")
#define PG8_BAR __builtin_amdgcn_s_barrier()
#define PG8_SCHED __builtin_amdgcn_sched_barrier(0)
    Unit cur, nxt; int ui = 0;
    if (!S.next(0, cur)) return;
    f32x4 acc[2][2][4][2];
#pragma unroll
    for (int a = 0; a < 2; ++a)
#pragma unroll
        for (int b = 0; b < 2; ++b)
#pragma unroll
            for (int m = 0; m < 4; ++m)
#pragma unroll
                for (int n = 0; n < 2; ++n) acc[a][b][m][n] = (f32x4){0.f, 0.f, 0.f, 0.f};
    bf16x8 At[4][2], B0[2][2], B1[2][2];
    const char* cA = (const char*)g.A + (size_t)cur.pm * tstep; const char* cB = (const char*)g.Bt + (size_t)cur.pn * tstep;
    PG8_STAGE(PG8_SB(0, 0), cB, voffB); PG8_STAGE(PG8_SA(0, 0), cA, voffA); PG8_STAGE(PG8_SB(0, 1), cB + hstep, voffB); PG8_STAGE(PG8_SA(0, 1), cA + hstep, voffA);
    if (wr == 1) PG8_BAR;
    PG8_WAIT_V(4); PG8_BAR;
    PG8_STAGE(PG8_SB(1, 0), cB + kstep, voffB); PG8_STAGE(PG8_SA(1, 0), cA + kstep, voffA); PG8_STAGE(PG8_SB(1, 1), cB + hstep + kstep, voffB);
    PG8_WAIT_V(6); PG8_BAR;
    for (;;) {
        const bool has_next = S.next(ui + 1, nxt);
        const char* nA = has_next ? (const char*)g.A + (size_t)nxt.pm * tstep : cA; const char* nB = has_next ? (const char*)g.Bt + (size_t)nxt.pn * tstep : cB;
        const bool rhalf = (cur.pn * BM + HALF) < g.Nvalid;
        for (int t = 0; t < nt; t += 2) {
            const bool last = (t == nt - 2);
            const char* a1 = cA + (size_t)(t + 1) * kstep;
            const char* a2 = last ? nA : cA + (size_t)(t + 2) * kstep; const char* b2 = last ? nB : cB + (size_t)(t + 2) * kstep;
            const char* a3 = a2 + kstep; const char* b3 = b2 + kstep;
            PG8_LDB(B0, 0, 0); PG8_SCHED; PG8_LDA(At, 0, 0); PG8_STAGE(PG8_SA(1, 1), a1 + hstep, voffA);
            PG8_WAIT_L(8); PG8_BAR; PG8_WAIT_L(0); PG8_MMA(0, 0, At, B0); PG8_BAR; PG8_SCHED;
            PG8_LDB(B1, 0, 1); PG8_STAGE(PG8_SB(0, 0), b2, voffB);
            PG8_BAR; PG8_WAIT_L(0); if (rhalf) PG8_MMA(0, 1, At, B1); PG8_BAR;
            PG8_LDA(At, 0, 1); PG8_STAGE(PG8_SA(0, 0), a2, voffA);
            PG8_BAR; PG8_WAIT_L(0); PG8_MMA(1, 0, At, B0); PG8_BAR; PG8_SCHED;
            PG8_STAGE(PG8_SB(0, 1), b2 + hstep, voffB);
            PG8_WAIT_V(6); PG8_BAR; if (rhalf) PG8_MMA(1, 1, At, B1); PG8_BAR;
            PG8_LDB(B0, 1, 0); PG8_SCHED; PG8_LDA(At, 1, 0); PG8_STAGE(PG8_SA(0, 1), a2 + hstep, voffA);
            PG8_WAIT_L(8); PG8_BAR; PG8_WAIT_L(0); PG8_MMA(0, 0, At, B0); PG8_BAR; PG8_SCHED;
            PG8_LDB(B1, 1, 1); PG8_STAGE(PG8_SB(1, 0), b3, voffB);
            PG8_BAR; PG8_WAIT_L(0); if (rhalf) PG8_MMA(0, 1, At, B1); PG8_BAR;
            PG8_LDA(At, 1, 1); PG8_STAGE(PG8_SA(1, 0), a3, voffA);
            PG8_BAR; PG8_WAIT_L(0); PG8_MMA(1, 0, At, B0); PG8_BAR; PG8_SCHED;
            PG8_STAGE(PG8_SB(1, 1), b3 + hstep, voffB);
            PG8_WAIT_V(6); PG8_BAR; if (rhalf) PG8_MMA(1, 1, At, B1); PG8_BAR;
        }
        if constexpr (!Epi::AFTER_DRAIN) E(acc, cur, wr, wc, fr, fq);
        if (!has_next) break;
#pragma unroll
        for (int a = 0; a < 2; ++a)
#pragma unroll
            for (int b = 0; b < 2; ++b)
#pragma unroll
                for (int m = 0; m < 4; ++m)
#pragma unroll
                    for (int n = 0; n < 2; ++n) acc[a][b][m][n] = (f32x4){0.f, 0.f, 0.f, 0.f};
        cur = nxt; cA = nA; cB = nB; ++ui;
    }
    PG8_WAIT_V(0);
    if (wr == 0) PG8_BAR;
    PG8_BAR;
    if constexpr (Epi::AFTER_DRAIN) E.fused(acc, cur, wr, wc, fr, fq, lds);
#undef PG8_SA
#undef PG8_SB
#undef PG8_STAGE
#undef PG8_LDA
#undef PG8_LDB
#undef PG8_MMA
#undef PG8_WAIT_V
#undef PG8_WAIT_L
#undef PG8_BAR
#undef PG8_SCHED
}

#define WSYNC() do { __builtin_amdgcn_wave_barrier(); asm volatile("s_waitcnt lgkmcnt(0)" ::: "memory"); __builtin_amdgcn_wave_barrier(); } while (0)
__device__ void phase0(const Params& p) {
    const int tid = threadIdx.x, lane = tid & 63, wave = tid >> 6, blk = blockIdx.x;
    u16* Hbf = (u16*)p.out;
#pragma unroll 1
    for (int r0 = 0; r0 < 8; r0 += 4) {
        f32x4 v[4][4]; float ss[4];
#pragma unroll
        for (int i = 0; i < 4; ++i) {
            const f32x4* xr = (const f32x4*)(p.x + (size_t)(blk * 64 + wave * 8 + r0 + i) * DM);
#pragma unroll
            for (int q = 0; q < 4; ++q) v[i][q] = __builtin_nontemporal_load(xr + lane + 64 * q);
        }
#pragma unroll
        for (int i = 0; i < 4; ++i) {
            float s = 0.f;
#pragma unroll
            for (int q = 0; q < 4; ++q) s += v[i][q][0] * v[i][q][0] + v[i][q][1] * v[i][q][1] + v[i][q][2] * v[i][q][2] + v[i][q][3] * v[i][q][3];
            ss[i] = wave_sum(s);
        }
#pragma unroll
        for (int i = 0; i < 4; ++i) {
            const int row = blk * 64 + wave * 8 + r0 + i;
            const float inv = rsq_(ss[i] * (1.f / 1024.f) + 1e-6f);
#pragma unroll
            for (int q = 0; q < 4; ++q) {
                const f32x4 g = ((const f32x4*)p.norm_gain)[lane + 64 * q];
                u32x2 o; o.x = pack2(v[i][q][0] * inv * g[0], v[i][q][1] * inv * g[1]); o.y = pack2(v[i][q][2] * inv * g[2], v[i][q][3] * inv * g[3]);
                *(u32x2*)(Hbf + (size_t)row * DM + (lane + 64 * q) * 4) = o;
            }
        }
    }
    u16* WinT = (u16*)(p.ws + WS_WINT); u16* WoutT = (u16*)(p.ws + WS_WOUTT);
    {
        float* tl = (float*)dyn_smem + wave * (64 * 65);
        const int t = blk + 256 * wave;
        if (t < 832 + 256) {
            const float* src; u16* dst; int kt, ntile, N;
            if (t < 832) { kt = t & 15; ntile = t >> 4; src = p.w_in; N = DIN; dst = WinT; }
            else { const int t2 = t - 832; kt = t2 & 15; ntile = t2 >> 4; src = p.w_out; N = 1024; dst = WoutT; }
            const int k0 = kt * 64, n0 = ntile * 64, n4 = (lane & 15) * 4;
            f32x4 v[16];
#pragma unroll
            for (int i = 0; i < 16; ++i) { const int kk = (lane >> 4) + 4 * i; v[i] = (n0 + n4 < N) ? *(const f32x4*)(src + (size_t)(k0 + kk) * N + n0 + n4) : (f32x4){0.f, 0.f, 0.f, 0.f}; }
#pragma unroll
            for (int i = 0; i < 16; ++i) { const int kk = (lane >> 4) + 4 * i; float* d = tl + kk * 65 + n4; d[0] = v[i][0]; d[1] = v[i][1]; d[2] = v[i][2]; d[3] = v[i][3]; }
            WSYNC();
            const int kp = lane & 31, nh = lane >> 5;
#pragma unroll 8
            for (int i = 0; i < 32; ++i) { const int nn = 2 * i + nh;
                *(unsigned*)(dst + (size_t)(n0 + nn) * 1024 + k0 + 2 * kp) = pack2(tl[(2 * kp) * 65 + nn], tl[(2 * kp + 1) * 65 + nn]); }
        }
    }
    u16* WupT = (u16*)(p.ws + WS_WUPT); u16* AupT = (u16*)(p.ws + WS_AUPT); u16* PoolT = (u16*)(p.ws + WS_POOLT);
    const int gt = blk * 512 + tid;
    if (gt < 32768) { const int c = gt >> 6, j = gt & 63; WupT[gt] = f2bf(p.w_up[j * 512 + c]); AupT[gt] = f2bf(p.a_up[j * 512 + c]); }
    if (gt < 65536) { const int g = gt >> 14, d = (gt >> 7) & 127, c = gt & 127; PoolT[gt] = f2bf(p.pool_w[(g * 128 + c) * 128 + d]); }
}

__device__ void phase1(const Params& p) {
    Gemm g; g.A = (const u16*)p.out; g.Bt = (const u16*)(p.ws + WS_WINT); g.M = NTOK; g.N = DINP; g.K = 1024; g.Nvalid = DIN;
    StaticOrder S; S.init(NTOK, DINP, 256, blockIdx.x);
    EpiZ E; E.Z = (u16*)(p.ws + WS_Z);
    gemm_phase((LAS unsigned char*)dyn_smem, g, S, E);
}
__device__ void phase4(const Params& p) {
    Gemm g; g.A = (const u16*)(p.ws + WS_Y); g.Bt = (const u16*)(p.ws + WS_WOUTT); g.M = NTOK; g.N = 1024; g.K = 1024; g.Nvalid = 1024;
    StaticOrder S; S.init(NTOK, 1024, 256, blockIdx.x);
    EpiResNorm E; E.x = p.x; E.gain = p.final_gain; E.out = p.out; E.part = (float*)(p.ws + WS_PART); E.cnt = (unsigned*)(p.ws + WS_CTL) + CTL_CNT_WORD;
    gemm_phase((LAS unsigned char*)dyn_smem, g, S, E);
}

template <int CTRL> __device__ __forceinline__ float dpp_add(float v) {
    const int t = __builtin_amdgcn_update_dpp(0, __float_as_int(v), CTRL, 0xf, 0xf, false);
    return v + __int_as_float(t);
}
__device__ __forceinline__ float row16_allsum(float v) {
    v = dpp_add<0x128>(v); v = dpp_add<0x124>(v); v = dpp_add<0x122>(v); v = dpp_add<0x121>(v);
    return v;
}
#define MFMA16(a, b, c) __builtin_amdgcn_mfma_f32_16x16x32_bf16((a), (b), (c), 0, 0, 0)
__device__ __forceinline__ bf16x8 as_bf8(u32x4 v) { return __builtin_bit_cast(bf16x8, v); }
template <int W> __device__ __forceinline__ void pooled_run(const u16* __restrict__ Z, u16* pooled, int t0, int s0, int cp, int hf) {
    const int c0 = 2 * cp, tb = hf * 32;
    unsigned raw[W - 1 + 32];
#pragma unroll
    for (int i = 0; i < W - 1 + 32; ++i) { const int tt = tb - (W - 1) + i; raw[i] = (s0 + tt >= 0) ? *(const unsigned*)(Z + (size_t)(t0 + tt) * DIN + c0) : 0u; }
    float sum0 = 0.f, sum1 = 0.f;
#pragma unroll
    for (int i = 0; i < W - 1; ++i) { sum0 += bflo(raw[i]); sum1 += bfhi(raw[i]); }
#pragma unroll
    for (int j = 0; j < 32; ++j) {
        const int tt = tb + j, s = s0 + tt;
        const float u0 = bflo(raw[W - 1 + j]), u1 = bfhi(raw[W - 1 + j]);
        sum0 += u0; sum1 += u1;
        const float rc = rcp_((float)((s + 1 < W) ? (s + 1) : W));
        *(unsigned*)(pooled + tt * 520 + c0) = pack2(sum0 * rc - u0, sum1 * rc - u1);
        sum0 -= bflo(raw[j]); sum1 -= bfhi(raw[j]);
    }
}
constexpr int RST = 912;
__device__ __forceinline__ void p2_zload(u32x4 (&zq)[7], const u16* __restrict__ Z, size_t T0, bool has_halo, int h, int lane) {
#pragma unroll
    for (int q = 0; q < 7; ++q) {
        const int pidx = lane + 64 * q, rr = pidx / 24, w = pidx - rr * 24, a = w >> 3, pc = w & 7;
        u32x4 v = (u32x4){0u, 0u, 0u, 0u};
        if (pidx < 17 * 24) {
            if (rr < 16) v = *(const u32x4*)(Z + (T0 + rr) * DIN + 1024 + a * 512 + h * 64 + pc * 8);
            else if (has_halo) v = *(const u32x4*)(Z + (T0 - 1) * DIN + 1024 + a * 512 + h * 64 + pc * 8);
        }
        zq[q] = v;
    }
}
constexpr int P2_WREG = 17408;
__device__ void phase2(const Params& p) {
    const int tid = threadIdx.x, lane = tid & 63, wave = tid >> 6, blk = blockIdx.x, fr = lane & 15, fq = lane >> 4;
    const int t0 = blk * 64, b = t0 >> 11, s0 = t0 & 2047;
    const u16* Z = (const u16*)(p.ws + WS_Z);
    u16* twb = (u16*)dyn_smem;
    u16* alb = twb + 64 * 72;
    u16* pooled = alb + 64 * 72;
    for (int e = tid; e < 64 * 128; e += 512) {
        const int tt = e >> 7, j = e & 127;
        const size_t zi = (size_t)(t0 + tt) * DIN + 2560 + j;
        const float cur = bf2f(Z[zi]);
        const float prev = (s0 + tt > 0) ? bf2f(Z[zi - DIN]) : 0.f;
        const float val = cur + p.shift_mu[1536 + j] * (prev - cur);
        if (j < 64) twb[tt * 72 + j] = f2bf(tanhf_(val)); else alb[tt * 72 + (j - 64)] = f2bf(val);
    }
    {
        const int cp = tid & 255, hf = tid >> 8;
        switch (wave & 3) {
            case 0: pooled_run<2>(Z, pooled, t0, s0, cp, hf); break;
            case 1: pooled_run<4>(Z, pooled, t0, s0, cp, hf); break;
            case 2: pooled_run<8>(Z, pooled, t0, s0, cp, hf); break;
            default: pooled_run<16>(Z, pooled, t0, s0, cp, hf); break;
        }
    }
    __syncthreads();
    {
        const int g = wave >> 1, dbase = (wave & 1) * 64;
        const u16* PoolT = (const u16*)(p.ws + WS_POOLT); u16* Y = (u16*)(p.ws + WS_Y);
        f32x4 acc[4][4];
#pragma unroll
        for (int mt = 0; mt < 4; ++mt)
#pragma unroll
            for (int nt = 0; nt < 4; ++nt) acc[mt][nt] = (f32x4){0.f, 0.f, 0.f, 0.f};
#pragma unroll
        for (int ks = 0; ks < 4; ++ks) {
            bf16x8 Bf[4];
#pragma unroll
            for (int nt = 0; nt < 4; ++nt) Bf[nt] = *(const bf16x8*)(PoolT + (size_t)(g * 128 + dbase + nt * 16 + fr) * 128 + ks * 32 + fq * 8);
#pragma unroll
            for (int mt = 0; mt < 4; ++mt) {
                const bf16x8 Af = *(const bf16x8*)(pooled + (mt * 16 + fr) * 520 + g * 128 + ks * 32 + fq * 8);
#pragma unroll
                for (int nt = 0; nt < 4; ++nt) acc[mt][nt] = MFMA16(Bf[nt], Af, acc[mt][nt]);
            }
        }
#pragma unroll
        for (int mt = 0; mt < 4; ++mt) {
            const size_t T = (size_t)(t0 + mt * 16 + fr);
#pragma unroll
            for (int nt = 0; nt < 4; ++nt) {
                const int ch = g * 128 + dbase + nt * 16 + fq * 4;
                const u32x2 ga = *(const u32x2*)(Z + T * DIN + 512 + ch);
                const f32x4 ps = *(const f32x4*)(p.pool_scale + ch);
                const f32x4 gv = (f32x4){bflo(ga.x), bfhi(ga.x), bflo(ga.y), bfhi(ga.y)};
                f32x4 y;
#pragma unroll
                for (int jj = 0; jj < 4; ++jj) y[jj] = acc[mt][nt][jj] * ps[jj] * gv[jj] * sigmoidf_(gv[jj]);
                u32x2 o; o.x = pack2(y[0], y[1]); o.y = pack2(y[2], y[3]);
                *(u32x2*)(Y + T * 1024 + ch) = o;
            }
        }
    }
    {
        u16* GB = (u16*)((unsigned char*)p.out + OUT_GB);
        for (int e = tid; e < 64 * 64; e += 512) { const int tt = e >> 6, q = e & 63;
            *(u32x4*)(GB + (size_t)(t0 + tt) * 512 + q * 8) = *(const u32x4*)(Z + (size_t)(t0 + tt) * DIN + 2688 + q * 8); }
    }
    __syncthreads();
    const int h = wave, bh = b * 8 + h;
    unsigned char* WL = dyn_smem + 18432 + wave * P2_WREG;
    unsigned char* recl = WL;
    u16* AR = (u16*)WL;
    u16* BK = AR + 32 * 72;
    u16* AtT = BK + 32 * 72;
    u16* BhT = AtT + 64 * 16;
    u16* KhT = BhT + 64 * 16;
    u16* VT = KhT + 64 * 16;
    float* Pab = (float*)WL;
    u16* Tm = (u16*)(Pab + 16 * 17);
    u16* AakT = Tm + 16 * 24;
    u16* M1m = AakT + 16 * 24;
    u16* Ark = M1m + 16 * 24;
    u16* Arb = Ark + 16 * 24;
    const u16* WupT = (const u16*)(p.ws + WS_WUPT); const u16* AupT = (const u16*)(p.ws + WS_AUPT);
    float* BON = (float*)(p.ws + WS_BONUS); u16* VB = (u16*)(p.ws + WS_VB);
    unsigned char* AFg = p.ws + CH_AF; unsigned char* RFg = p.ws + CH_RF; unsigned char* BKFg = p.ws + CH_BKF; unsigned char* ARBg = p.ws + CH_ARB;
    float* G15g = (float*)(p.ws + CH_G15); unsigned char* CHVg = (unsigned char*)p.out + OUT_CHV;
    const bf16x8 zero8 = (bf16x8){0, 0, 0, 0, 0, 0, 0, 0};
    const f32x4 zero4 = (f32x4){0.f, 0.f, 0.f, 0.f};
#pragma unroll 1
    for (int mt = 0; mt < 4; ++mt) {
        const size_t u = (size_t)bh * 128 + (s0 >> 4) + mt;
        {
            u32x4 zq[7];
            p2_zload(zq, Z, (size_t)(t0 + mt * 16), (s0 + mt * 16) > 0, h, lane);
            f32x4 aw[4], aa[4];
#pragma unroll
            for (int nt = 0; nt < 4; ++nt) { aw[nt] = zero4; aa[nt] = zero4; }
#pragma unroll
            for (int ks = 0; ks < 2; ++ks) {
                const bf16x8 Aw = *(const bf16x8*)(twb + (mt * 16 + fr) * 72 + ks * 32 + fq * 8);
                const bf16x8 Aa = *(const bf16x8*)(alb + (mt * 16 + fr) * 72 + ks * 32 + fq * 8);
#pragma unroll
                for (int nt = 0; nt < 4; ++nt) {
                    const bf16x8 Bw = *(const bf16x8*)(WupT + (h * 64 + nt * 16 + fr) * 64 + ks * 32 + fq * 8);
                    const bf16x8 Ba = *(const bf16x8*)(AupT + (h * 64 + nt * 16 + fr) * 64 + ks * 32 + fq * 8);
                    aw[nt] = MFMA16(Bw, Aw, aw[nt]);
                    aa[nt] = MFMA16(Ba, Aa, aa[nt]);
                }
            }
#pragma unroll
            for (int q = 0; q < 7; ++q) {
                const int pidx = lane + 64 * q, rr = pidx / 24, w = pidx - rr * 24, a = w >> 3, pc = w & 7;
                if (pidx < 17 * 24) *(u32x4*)(recl + ((rr < 16) ? rr * RST + 256 : 16 * RST) + a * 128 + pc * 16) = zq[q];
            }
            WSYNC();
            const int tt = mt * 16 + fr, s = s0 + tt; const size_t T = (size_t)(t0 + tt);
            f32x4 Kr[4], Av[4];
            float n2 = 0.f, bon = 0.f;
            unsigned char* rec = recl + fr * RST;
            const unsigned char* prec = (fr > 0) ? (recl + (fr - 1) * RST) : (recl + 16 * RST - 256);
#pragma unroll
            for (int nt = 0; nt < 4; ++nt) {
                const int cb = h * 64 + nt * 16 + fq * 4, ci = nt * 16 + fq * 4;
                const u32x2 zr = *(const u32x2*)(rec + 256 + ci * 2), zk = *(const u32x2*)(rec + 384 + ci * 2), zv = *(const u32x2*)(rec + 512 + ci * 2);
                const u32x2 pr = *(const u32x2*)(prec + 256 + ci * 2), pk = *(const u32x2*)(prec + 384 + ci * 2), pv = *(const u32x2*)(prec + 512 + ci * 2);
                const f32x4 mur = *(const f32x4*)(p.shift_mu + cb), muk = *(const f32x4*)(p.shift_mu + 512 + cb), muv = *(const f32x4*)(p.shift_mu + 1024 + cb);
                const f32x4 w0v = *(const f32x4*)(p.w0 + cb), a0v = *(const f32x4*)(p.a0 + cb), kkv = *(const f32x4*)(p.k_k + cb), kav = *(const f32x4*)(p.k_a + cb), rkv = *(const f32x4*)(p.r_k + cb);
                const f32x4 cr = (f32x4){bflo(zr.x), bfhi(zr.x), bflo(zr.y), bfhi(zr.y)}, ck = (f32x4){bflo(zk.x), bfhi(zk.x), bflo(zk.y), bfhi(zk.y)}, cv = (f32x4){bflo(zv.x), bfhi(zv.x), bflo(zv.y), bfhi(zv.y)};
                const f32x4 qr = (f32x4){bflo(pr.x), bfhi(pr.x), bflo(pr.y), bfhi(pr.y)}, qk = (f32x4){bflo(pk.x), bfhi(pk.x), bflo(pk.y), bfhi(pk.y)}, qv = (f32x4){bflo(pv.x), bfhi(pv.x), bflo(pv.y), bfhi(pv.y)};
                f32x4 Rr, Kp, Vv, Dc;
#pragma unroll
                for (int jj = 0; jj < 4; ++jj) {
                    const float r = cr[jj] + mur[jj] * (qr[jj] - cr[jj]);
                    const float k = ck[jj] + muk[jj] * (qk[jj] - ck[jj]);
                    const float v = cv[jj] + muv[jj] * (qv[jj] - cv[jj]);
                    const float ww = aw[nt][jj] + w0v[jj];
                    const float a = sigmoidf_(aa[nt][jj] + a0v[jj]);
                    const float dec = __expf(-0.6065306597126334f * sigmoidf_(ww));
                    const float kr = k * kkv[jj];
                    n2 += kr * kr;
                    const float kp = k * (1.f + (a - 1.f) * kav[jj]);
                    bon += r * kp * rkv[jj];
                    Rr[jj] = r; Kp[jj] = kp; Vv[jj] = v; Kr[nt][jj] = kr; Av[nt][jj] = a; Dc[jj] = dec;
                }
                *(f32x4*)(rec + ci * 4) = Dc;
                *(u32x2*)(rec + 256 + ci * 2) = (u32x2){pack2(Rr[0], Rr[1]), pack2(Rr[2], Rr[3])};
                *(u32x2*)(rec + 384 + ci * 2) = (u32x2){pack2(Kp[0], Kp[1]), pack2(Kp[2], Kp[3])};
                const u32x2 vpk = (u32x2){pack2(Vv[0], Vv[1]), pack2(Vv[2], Vv[3])};
                *(u32x2*)(rec + 512 + ci * 2) = vpk;
                *(u32x2*)(VB + T * 512 + cb) = vpk;
            }
            n2 += __shfl_xor(n2, 16, 64); n2 += __shfl_xor(n2, 32, 64);
            bon += __shfl_xor(bon, 16, 64); bon += __shfl_xor(bon, 32, 64);
            const float inv = rsq_(fmaxf(n2, 1e-24f));
#pragma unroll
            for (int nt = 0; nt < 4; ++nt) {
                const int ci = nt * 16 + fq * 4;
                const f32x4 kk = Kr[nt] * inv;
                *(u32x2*)(rec + 640 + ci * 2) = (u32x2){pack2(kk[0], kk[1]), pack2(kk[2], kk[3])};
                const f32x4 nb = -(kk * Av[nt]);
                *(u32x2*)(rec + 768 + ci * 2) = (u32x2){pack2(nb[0], nb[1]), pack2(nb[2], nb[3])};
            }
            if (fq == 0) BON[(size_t)bh * 2048 + s] = bon;
        }
        WSYNC();
        {
            float w_[16], r_[16], kp_[16], v_[16], kk_[16], nb_[16];
#pragma unroll
            for (int t = 0; t < 16; ++t) {
                const unsigned char* rt = recl + t * RST;
                w_[t] = *(const float*)(rt + lane * 4);
                r_[t] = bf2f(*(const u16*)(rt + 256 + lane * 2)); kp_[t] = bf2f(*(const u16*)(rt + 384 + lane * 2)); v_[t] = bf2f(*(const u16*)(rt + 512 + lane * 2));
                kk_[t] = bf2f(*(const u16*)(rt + 640 + lane * 2)); nb_[t] = bf2f(*(const u16*)(rt + 768 + lane * 2));
            }
            WSYNC();
            float g = 1.f;
            float At[16], Bt[16], Kt[16];
#pragma unroll
            for (int t = 0; t < 16; ++t) {
                const float gp = g; g = g * w_[t]; const float ig = rcp_(g);
                const float a = kk_[t] * gp, rr = r_[t] * g, bb = nb_[t] * ig, kt = kp_[t] * ig;
                AR[t * 72 + lane] = f2bf(a); AR[(16 + t) * 72 + lane] = f2bf(rr); BK[t * 72 + lane] = f2bf(bb); BK[(16 + t) * 72 + lane] = f2bf(kt);
                At[t] = a; Bt[t] = bb; Kt[t] = kt;
            }
            u32x4 o0, o1;
            o0 = (u32x4){pack2(At[0], At[1]), pack2(At[2], At[3]), pack2(At[4], At[5]), pack2(At[6], At[7])};
            o1 = (u32x4){pack2(At[8], At[9]), pack2(At[10], At[11]), pack2(At[12], At[13]), pack2(At[14], At[15])};
            *(u32x4*)(AtT + lane * 16) = o0; *(u32x4*)(AtT + lane * 16 + 8) = o1;
            o0 = (u32x4){pack2(Bt[0] * g, Bt[1] * g), pack2(Bt[2] * g, Bt[3] * g), pack2(Bt[4] * g, Bt[5] * g), pack2(Bt[6] * g, Bt[7] * g)};
            o1 = (u32x4){pack2(Bt[8] * g, Bt[9] * g), pack2(Bt[10] * g, Bt[11] * g), pack2(Bt[12] * g, Bt[13] * g), pack2(Bt[14] * g, Bt[15] * g)};
            *(u32x4*)(BhT + lane * 16) = o0; *(u32x4*)(BhT + lane * 16 + 8) = o1;
            o0 = (u32x4){pack2(Kt[0] * g, Kt[1] * g), pack2(Kt[2] * g, Kt[3] * g), pack2(Kt[4] * g, Kt[5] * g), pack2(Kt[6] * g, Kt[7] * g)};
            o1 = (u32x4){pack2(Kt[8] * g, Kt[9] * g), pack2(Kt[10] * g, Kt[11] * g), pack2(Kt[12] * g, Kt[13] * g), pack2(Kt[14] * g, Kt[15] * g)};
            *(u32x4*)(KhT + lane * 16) = o0; *(u32x4*)(KhT + lane * 16 + 8) = o1;
            o0 = (u32x4){pack2(v_[0], v_[1]), pack2(v_[2], v_[3]), pack2(v_[4], v_[5]), pack2(v_[6], v_[7])};
            o1 = (u32x4){pack2(v_[8], v_[9]), pack2(v_[10], v_[11]), pack2(v_[12], v_[13]), pack2(v_[14], v_[15])};
            *(u32x4*)(VT + lane * 16) = o0; *(u32x4*)(VT + lane * 16 + 8) = o1;
            G15g[u * 64 + lane] = g;
        }
        WSYNC();
        {
            u32x2 rp[4];
#pragma unroll
            for (int ta = 0; ta < 4; ++ta) rp[ta] = *(const u32x2*)(AR + (16 + fr) * 72 + 16 * ta + 4 * fq);
            *(u32x4*)(RFg + (u * 64 + lane) * 32) = (u32x4){rp[0].x, rp[0].y, rp[1].x, rp[1].y};
            *(u32x4*)(RFg + (u * 64 + lane) * 32 + 16) = (u32x4){rp[2].x, rp[2].y, rp[3].x, rp[3].y};
#pragma unroll
            for (int ta = 0; ta < 4; ++ta) {
                const u32x2 b2 = *(const u32x2*)(BhT + (16 * ta + fr) * 16 + 4 * fq), k2 = *(const u32x2*)(KhT + (16 * ta + fr) * 16 + 4 * fq);
                *(u32x4*)(BKFg + ((u * 4 + ta) * 64 + lane) * 16) = (u32x4){b2.x, b2.y, k2.x, k2.y};
            }
#pragma unroll
            for (int sl = 0; sl < 4; ++sl) *(u32x2*)(CHVg + (((u * 4 + sl) * 3 + 2) * 64 + lane) * 8) = *(const u32x2*)(VT + (16 * sl + fr) * 16 + 4 * fq);
        }
        {
            f32x4 P00 = zero4, P01 = zero4, P10 = zero4, P11 = zero4;
#pragma unroll
            for (int s = 0; s < 2; ++s) {
                const bf16x8 a0 = *(const bf16x8*)(AR + fr * 72 + s * 32 + fq * 8), a1 = *(const bf16x8*)(AR + (16 + fr) * 72 + s * 32 + fq * 8);
                const bf16x8 b0 = *(const bf16x8*)(BK + fr * 72 + s * 32 + fq * 8), b1 = *(const bf16x8*)(BK + (16 + fr) * 72 + s * 32 + fq * 8);
                P00 = MFMA16(a0, b0, P00); P01 = MFMA16(a0, b1, P01); P10 = MFMA16(a1, b0, P10); P11 = MFMA16(a1, b1, P11);
            }
            WSYNC();
            float ak[4];
#pragma unroll
            for (int r = 0; r < 4; ++r) {
                const int i = 4 * fq + r, j = fr;
                Pab[i * 17 + j] = (j < i) ? P00[r] : 0.f;
                ak[r] = (j < i) ? P01[r] : 0.f;
                Arb[i * 24 + j] = f2bf((j <= i) ? P10[r] : 0.f);
                Ark[i * 24 + j] = f2bf((j <= i) ? P11[r] : 0.f);
            }
            *(u32x2*)(AakT + fr * 24 + 4 * fq) = (u32x2){pack2(ak[0], ak[1]), pack2(ak[2], ak[3])};
        }
        WSYNC();
        {
            float T[16];
#pragma unroll
            for (int i = 0; i < 16; ++i) {
                float acc = (i == fr) ? 1.f : 0.f;
#pragma unroll
                for (int j = 0; j < i; ++j) acc += Pab[i * 17 + j] * T[j];
                T[i] = acc;
            }
#pragma unroll
            for (int i = 0; i < 16; ++i) Tm[i * 24 + fr] = f2bf(T[i]);
            *(u32x2*)(ARBg + (u * 64 + lane) * 8) = *(const u32x2*)(Arb + fr * 24 + 4 * fq);
        }
        WSYNC();
        const bf16x8 Tld = *(const bf16x8*)(Tm + fr * 24 + (fq & 1) * 8);
        const bf16x8 Tf = (fq < 2) ? Tld : zero8;
        {
            f32x4 D[4];
#pragma unroll
            for (int ta = 0; ta < 4; ++ta) {
                const bf16x8 ald = *(const bf16x8*)(AtT + (16 * ta + fr) * 16 + (fq & 1) * 8);
                D[ta] = MFMA16((fq < 2) ? ald : zero8, Tf, zero4);
            }
            *(u32x4*)(AFg + (u * 64 + lane) * 32) = (u32x4){pack2(D[0][0], D[0][1]), pack2(D[0][2], D[0][3]), pack2(D[1][0], D[1][1]), pack2(D[1][2], D[1][3])};
            *(u32x4*)(AFg + (u * 64 + lane) * 32 + 16) = (u32x4){pack2(D[2][0], D[2][1]), pack2(D[2][2], D[2][3]), pack2(D[3][0], D[3][1]), pack2(D[3][2], D[3][3])};
            const bf16x8 akld = *(const bf16x8*)(AakT + fr * 24 + (fq & 1) * 8);
            const f32x4 M1 = MFMA16(Tf, (fq < 2) ? akld : zero8, zero4);
#pragma unroll
            for (int r = 0; r < 4; ++r) M1m[(4 * fq + r) * 24 + fr] = f2bf(M1[r]);
        }
        WSYNC();
        {
            const bf16x8 m1ld = *(const bf16x8*)(M1m + fr * 24 + (fq & 1) * 8), rkld = *(const bf16x8*)(Ark + fr * 24 + (fq & 1) * 8);
            const bf16x8 M1f = (fq < 2) ? m1ld : zero8, Arkf = (fq < 2) ? rkld : zero8;
#pragma unroll
            for (int sl = 0; sl < 4; ++sl) {
                const bf16x8 vld = *(const bf16x8*)(VT + (16 * sl + fr) * 16 + (fq & 1) * 8);
                const bf16x8 Vb = (fq < 2) ? vld : zero8;
                const f32x4 Uh = MFMA16(M1f, Vb, zero4), Y0 = MFMA16(Arkf, Vb, zero4);
                *(u32x2*)(CHVg + (((u * 4 + sl) * 3 + 0) * 64 + lane) * 8) = (u32x2){pack2(Uh[0], Uh[1]), pack2(Uh[2], Uh[3])};
                *(u32x2*)(CHVg + (((u * 4 + sl) * 3 + 1) * 64 + lane) * 8) = (u32x2){pack2(Y0[0], Y0[1]), pack2(Y0[2], Y0[3])};
            }
        }
        WSYNC();
    }
}

struct ChunkOps { u32x4 af0, af1, rf0, rf1, bk0, bk1, bk2, bk3; u32x2 arb, uh, y0, vf; f32x4 g0, g1, g2, g3; };
constexpr int RING_SLOT = 17408, RING_NS = 7, RING_D = 6;
__device__ __forceinline__ void lds_chunk_ops(ChunkOps& o, const LAS unsigned char* s, int sl, int lane, int fq) {
    o.af0 = *(const LAS u32x4*)(s + lane * 32); o.af1 = *(const LAS u32x4*)(s + lane * 32 + 16);
    o.rf0 = *(const LAS u32x4*)(s + 2048 + lane * 32); o.rf1 = *(const LAS u32x4*)(s + 2048 + lane * 32 + 16);
    o.bk0 = *(const LAS u32x4*)(s + 4096 + (0 * 64 + lane) * 16); o.bk1 = *(const LAS u32x4*)(s + 4096 + (1 * 64 + lane) * 16);
    o.bk2 = *(const LAS u32x4*)(s + 4096 + (2 * 64 + lane) * 16); o.bk3 = *(const LAS u32x4*)(s + 4096 + (3 * 64 + lane) * 16);
    o.uh = *(const LAS u32x2*)(s + 8192 + ((sl * 3 + 0) * 64 + lane) * 8);
    o.y0 = *(const LAS u32x2*)(s + 8192 + ((sl * 3 + 1) * 64 + lane) * 8);
    o.vf = *(const LAS u32x2*)(s + 8192 + ((sl * 3 + 2) * 64 + lane) * 8);
    o.arb = *(const LAS u32x2*)(s + 16384 + lane * 8);
    o.g0 = *(const LAS f32x4*)(s + 16896 + 16 * fq); o.g1 = *(const LAS f32x4*)(s + 16896 + 64 + 16 * fq);
    o.g2 = *(const LAS f32x4*)(s + 16896 + 128 + 16 * fq); o.g3 = *(const LAS f32x4*)(s + 16896 + 192 + 16 * fq);
}
template <int LW> __device__ __forceinline__ void ring_issue(const Params& p, LAS unsigned char* ring, int bh, int c, int lane) {
    const size_t u = (size_t)bh * 128 + c;
    LAS unsigned char* slot = ring + (c % RING_NS) * RING_SLOT;
    const unsigned char* ws = p.ws; const unsigned char* od = (const unsigned char*)p.out;
#pragma unroll
    for (int j = 0; j < 8; ++j) {
        constexpr int Q0 = LW * 8; const int q = Q0 + j;
        const unsigned char* g;
        if (q < 2) g = ws + CH_AF + u * 2048 + q * 1024 + lane * 16;
        else if (q < 4) g = ws + CH_RF + u * 2048 + (q - 2) * 1024 + lane * 16;
        else if (q < 8) g = ws + CH_BKF + u * 4096 + (q - 4) * 1024 + lane * 16;
        else if (q < 14) g = od + OUT_CHV + u * 6144 + (q - 8) * 1024 + lane * 16;
        else { const int i = (q - 14) * 64 + lane; g = od + OUT_GB + (((size_t)(bh >> 3) * 2048 + c * 16 + (i >> 3)) * 512 + (bh & 7) * 64) * 2 + (i & 7) * 16; }
        __builtin_amdgcn_global_load_lds((const unsigned*)g, (LAS unsigned*)(slot + q * 1024), 16, 0, 0);
    }
    if (LW == 0) {
        __builtin_amdgcn_global_load_lds((const unsigned*)(ws + CH_ARB + u * 512 + lane * 4), (LAS unsigned*)(slot + 16384), 4, 0, 0);
        __builtin_amdgcn_global_load_lds((const unsigned*)(ws + CH_ARB + u * 512 + 256 + lane * 4), (LAS unsigned*)(slot + 16384 + 256), 4, 0, 0);
    } else {
        __builtin_amdgcn_global_load_lds((const unsigned*)(ws + CH_G15 + u * 256 + lane * 4), (LAS unsigned*)(slot + 16896), 4, 0, 0);
        __builtin_amdgcn_global_load_lds((const unsigned*)(ws + WS_BONUS + ((size_t)bh * 2048 + c * 16) * 4 + (lane & 15) * 4), (LAS unsigned*)(slot + 17152), 4, 0, 0);
    }
}
template <int CTRL> __device__ __forceinline__ float dpp_add_q(float v) {
    const int t = __builtin_amdgcn_update_dpp(0, __float_as_int(v), CTRL, 0xf, 0xf, false);
    return v + __int_as_float(t);
}
__device__ __forceinline__ float oct_allsum(float v) {
    v = dpp_add_q<0xB1>(v); v = dpp_add_q<0x4E>(v); v = dpp_add_q<0x141>(v);
    return v;
}
struct EpiIn { u32x4 gb; float bon; u16 v[8]; };
__device__ __forceinline__ void epi_load(EpiIn& e, const LAS unsigned char* s, int t, int v0) {
    e.gb = *(const LAS u32x4*)(s + 14336 + t * 128 + v0 * 2);
    e.bon = *(const LAS float*)(s + 17152 + t * 4);
    const LAS unsigned char* vp = s + 8192 + (((v0 >> 4) * 3 + 2) * 64 + (t >> 2) * 16 + (v0 & 15)) * 8 + (t & 3) * 2;
#pragma unroll
    for (int i = 0; i < 8; ++i) e.v[i] = *(const LAS u16*)(vp + 8 * i);
}
template <int LW> __device__ __forceinline__ void p3_loader(const Params& p, LAS unsigned char* ring, int bh, int lane) {
#pragma unroll
    for (int c = 0; c < RING_D; ++c) ring_issue<LW>(p, ring, bh, c, lane);
    asm volatile("s_waitcnt vmcnt(40)" ::: "memory");
    __builtin_amdgcn_s_barrier();
#pragma unroll 1
    for (int c = 0; c < 128; ++c) {
        const int cn = (c + RING_D < 128) ? c + RING_D : 127;
        ring_issue<LW>(p, ring, bh, cn, lane);
        asm volatile("s_waitcnt vmcnt(40)" ::: "memory");
        __builtin_amdgcn_s_barrier();
    }
    asm volatile("s_waitcnt vmcnt(0)" ::: "memory");
}
__device__ void phase3(const Params& p) {
    const int tid = threadIdx.x, lane = tid & 63, wave = __builtin_amdgcn_readfirstlane(tid >> 6), fr = lane & 15, fq = lane >> 4;
    const int bh = blockIdx.x;
    if (bh >= 64) return;
    LAS unsigned char* ring = (LAS unsigned char*)dyn_smem;
    LAS float* ybuf = (LAS float*)(ring + RING_NS * RING_SLOT);
    if (wave >= 6) {
        const int e = (wave - 6) * 64 + lane, t = e >> 3, v0 = (e & 7) * 8, b = bh >> 3, h = bh & 7;
        f32x4 ga0 = *(const f32x4*)(p.gn_gain + h * 64 + v0), ga1 = *(const f32x4*)(p.gn_gain + h * 64 + v0 + 4);
        f32x4 bi0 = *(const f32x4*)(p.gn_bias + h * 64 + v0), bi1 = *(const f32x4*)(p.gn_bias + h * 64 + v0 + 4);
        u16* Y = (u16*)(p.ws + WS_Y);
        EpiIn cur, nxt;
        __builtin_amdgcn_s_barrier();
        epi_load(cur, ring, t, v0);
#pragma unroll 1
        for (int c = 0; c <= 128; ++c) {
            if (c >= 1) {
                const int cc = c - 1;
                { const int cn = (c < 128) ? c : 127; epi_load(nxt, ring + (cn % RING_NS) * RING_SLOT, t, v0); }
                const LAS float* yb = ybuf + (cc & 1) * (16 * 68) + t * 68 + v0;
                const f32x4 y0 = *(const LAS f32x4*)(yb), y1 = *(const LAS f32x4*)(yb + 4);
                float s1 = (y0[0] + y0[1]) + (y0[2] + y0[3]) + (y1[0] + y1[1]) + (y1[2] + y1[3]);
                float s2 = y0[0] * y0[0] + y0[1] * y0[1] + y0[2] * y0[2] + y0[3] * y0[3] + y1[0] * y1[0] + y1[1] * y1[1] + y1[2] * y1[2] + y1[3] * y1[3];
                s1 = oct_allsum(s1); s2 = oct_allsum(s2);
                const float mean = s1 * (1.f / 64.f);
                const float var = fmaxf(s2 * (1.f / 64.f) - mean * mean, 0.f);
                const float rstd = rsq_(var + 64e-5f);
                const float vvf[8] = {bf2f(cur.v[0]), bf2f(cur.v[1]), bf2f(cur.v[2]), bf2f(cur.v[3]), bf2f(cur.v[4]), bf2f(cur.v[5]), bf2f(cur.v[6]), bf2f(cur.v[7])};
                const float gbf[8] = {bflo(cur.gb.x), bfhi(cur.gb.x), bflo(cur.gb.y), bfhi(cur.gb.y), bflo(cur.gb.z), bfhi(cur.gb.z), bflo(cur.gb.w), bfhi(cur.gb.w)};
                float o[8];
#pragma unroll
                for (int i = 0; i < 8; ++i) {
                    const float yv = (i < 4) ? y0[i & 3] : y1[i & 3];
                    const float gn = (i < 4) ? ga0[i & 3] : ga1[i & 3], bs = (i < 4) ? bi0[i & 3] : bi1[i & 3];
                    const float yn = (yv - mean) * rstd * gn + bs;
                    o[i] = (yn + cur.bon * vvf[i]) * gbf[i] * sigmoidf_(gbf[i]);
                }
                *(u32x4*)(Y + ((size_t)b * 2048 + cc * 16 + t) * 1024 + 512 + h * 64 + v0) = (u32x4){pack2(o[0], o[1]), pack2(o[2], o[3]), pack2(o[4], o[5]), pack2(o[6], o[7])};
                cur = nxt;
            }
            if (c < 128) __builtin_amdgcn_s_barrier();
        }
        return;
    }
    if (wave >= 4) { if (wave == 4) p3_loader<0>(p, ring, bh, lane); else p3_loader<1>(p, ring, bh, lane); return; }
    const int sl = wave;
    f32x4 acc0 = (f32x4){0.f, 0.f, 0.f, 0.f}, acc1 = acc0, acc2 = acc0, acc3 = acc0;
    ChunkOps cur, nxt;
    __builtin_amdgcn_s_barrier();
    lds_chunk_ops(cur, ring, sl, lane, fq);
#pragma unroll 2
    for (int c = 0; c < 128; ++c) {
        { const int cn = (c + 1 < 128) ? c + 1 : c; lds_chunk_ops(nxt, ring + (cn % RING_NS) * RING_SLOT, sl, lane, fq); }
        const bf16x8 sb0 = as_bf8((u32x4){pack2(acc0[0], acc0[1]), pack2(acc0[2], acc0[3]), pack2(acc1[0], acc1[1]), pack2(acc1[2], acc1[3])});
        const bf16x8 sb1 = as_bf8((u32x4){pack2(acc2[0], acc2[1]), pack2(acc2[2], acc2[3]), pack2(acc3[0], acc3[1]), pack2(acc3[2], acc3[3])});
        f32x4 U = (f32x4){bflo(cur.uh.x), bfhi(cur.uh.x), bflo(cur.uh.y), bfhi(cur.uh.y)};
        U = MFMA16(as_bf8(cur.af0), sb0, U); U = MFMA16(as_bf8(cur.af1), sb1, U);
        f32x4 Yv = (f32x4){bflo(cur.y0.x), bfhi(cur.y0.x), bflo(cur.y0.y), bfhi(cur.y0.y)};
        Yv = MFMA16(as_bf8(cur.rf0), sb0, Yv); Yv = MFMA16(as_bf8(cur.rf1), sb1, Yv);
        const unsigned u01 = pack2(U[0], U[1]), u23 = pack2(U[2], U[3]);
        Yv = MFMA16(as_bf8((u32x4){cur.arb.x, cur.arb.y, 0u, 0u}), as_bf8((u32x4){u01, u23, 0u, 0u}), Yv);
        const bf16x8 uvb = as_bf8((u32x4){u01, u23, cur.vf.x, cur.vf.y});
        acc0 = MFMA16(as_bf8(cur.bk0), uvb, acc0 * cur.g0); acc1 = MFMA16(as_bf8(cur.bk1), uvb, acc1 * cur.g1);
        acc2 = MFMA16(as_bf8(cur.bk2), uvb, acc2 * cur.g2); acc3 = MFMA16(as_bf8(cur.bk3), uvb, acc3 * cur.g3);
        LAS float* yb = ybuf + (c & 1) * (16 * 68) + (4 * fq) * 68 + sl * 16 + fr;
        yb[0] = Yv[0]; yb[68] = Yv[1]; yb[136] = Yv[2]; yb[204] = Yv[3];
        asm volatile("s_waitcnt lgkmcnt(0)" ::: "memory");
        __builtin_amdgcn_s_barrier();
        asm volatile("" ::: "memory");
        cur = nxt;
    }
}

__device__ void phase5(const Params& p) {
    const int tid = threadIdx.x, lane = tid & 63, wave = tid >> 6, blk = blockIdx.x;
#pragma unroll 1
    for (int r0 = 0; r0 < 8; r0 += 4) {
        f32x4 v[4][4]; float ss[4];
#pragma unroll
        for (int i = 0; i < 4; ++i) {
            const f32x4* xr = (const f32x4*)(p.out + (size_t)(blk * 64 + wave * 8 + r0 + i) * DM);
#pragma unroll
            for (int q = 0; q < 4; ++q) v[i][q] = xr[lane + 64 * q];
        }
#pragma unroll
        for (int i = 0; i < 4; ++i) {
            float s = 0.f;
#pragma unroll
            for (int q = 0; q < 4; ++q) s += v[i][q][0] * v[i][q][0] + v[i][q][1] * v[i][q][1] + v[i][q][2] * v[i][q][2] + v[i][q][3] * v[i][q][3];
            ss[i] = wave_sum(s);
        }
#pragma unroll
        for (int i = 0; i < 4; ++i) {
            f32x4* xr = (f32x4*)(p.out + (size_t)(blk * 64 + wave * 8 + r0 + i) * DM);
            const float inv = rsq_(ss[i] * (1.f / 1024.f) + 1e-6f);
#pragma unroll
            for (int q = 0; q < 4; ++q) { const f32x4 g = ((const f32x4*)p.final_gain)[lane + 64 * q]; xr[lane + 64 * q] = v[i][q] * inv * g; }
        }
    }
}

__global__ void __launch_bounds__(512, 2) hybrid_fwd(Params p) {
    __shared__ uint4 xb_words;
    if (threadIdx.x == 0) xb_words = make_uint4(0u, 0u, 0u, 0u);
    __syncthreads();
    XcdBarrier bar; bar.bar = (unsigned*)(p.ws + WS_CTL); bar.x = 0; bar.st = (volatile LAS unsigned*)&xb_words;
    const int lo = p.ph_lo, hi = p.ph_hi;
    if (hi - lo > 1) bar = xcd_barrier_post((unsigned*)(p.ws + WS_CTL), (volatile LAS unsigned*)&xb_words);
#define IN(k) (lo <= (k) && (k) < hi)
#define SEAM(k) do { if (IN(k) && IN((k) + 1)) xcd_barrier(bar); } while (0)
#define RUN(k, f) do { if (IN(k)) { if (PROBE_DUP == (k)) { for (int _r = 0; _r < p.dup_n; ++_r) { if (_r) __syncthreads(); f(p); } } else f(p); } } while (0)
    RUN(0, phase0);
    SEAM(0);
    RUN(1, phase1);
    SEAM(1);
    RUN(2, phase2);
    SEAM(2);
    RUN(3, phase3);
    SEAM(3);
    RUN(4, phase4);
}

extern "C" void kernel_launch(void* const* d_in, const int* in_sizes, int n_in, void* d_out, int out_size, void* d_ws, size_t ws_size, hipStream_t stream) {
    static int grid = 0;
    if (grid == 0) {
        if (n_in != 17 || out_size != NTOK * DM || ws_size < WS_END) { fprintf(stderr, "kernel_launch: unexpected problem (n_in %d out %d ws %zu need %zu)\n", n_in, out_size, ws_size, (size_t)WS_END); grid = -1; return; }
        if (hipFuncSetAttribute((const void*)hybrid_fwd, hipFuncAttributeMaxDynamicSharedMemorySize, LDS_BYTES) != hipSuccess) { fprintf(stderr, "kernel_launch: hipFuncSetAttribute failed\n"); grid = -1; return; }
        int per_cu = 0;
        if (hipOccupancyMaxActiveBlocksPerMultiprocessor(&per_cu, (const void*)hybrid_fwd, 512, LDS_BYTES) != hipSuccess || per_cu < 1) fprintf(stderr, "kernel_launch: occupancy query says %d blocks per CU\n", per_cu);
        (void)hipGetLastError();
        grid = 256;
    }
    if (grid < 0) return;
    (void)hipMemsetAsync((char*)d_ws + WS_CTL, 0, 16384, stream);
    Params p{};
    p.x = (const float*)d_in[0]; p.norm_gain = (const float*)d_in[1]; p.w_in = (const float*)d_in[2]; p.pool_w = (const float*)d_in[3];
    p.pool_scale = (const float*)d_in[4]; p.shift_mu = (const float*)d_in[5]; p.w0 = (const float*)d_in[6]; p.w_up = (const float*)d_in[7];
    p.a0 = (const float*)d_in[8]; p.a_up = (const float*)d_in[9]; p.k_k = (const float*)d_in[10]; p.k_a = (const float*)d_in[11];
    p.r_k = (const float*)d_in[12]; p.gn_gain = (const float*)d_in[13]; p.gn_bias = (const float*)d_in[14]; p.w_out = (const float*)d_in[15];
    p.final_gain = (const float*)d_in[16];
    p.out = (float*)d_out; p.ws = (unsigned char*)d_ws; p.dup_n = 2;
#if N_LAUNCHES == 1
    p.ph_lo = 0; p.ph_hi = NPH;
    hipLaunchKernelGGL(hybrid_fwd, dim3(grid), dim3(512), LDS_BYTES, stream, p);
#else
    for (int k = 0; k < NPH; ++k) { p.ph_lo = k; p.ph_hi = k + 1; hipLaunchKernelGGL(hybrid_fwd, dim3(grid), dim3(512), LDS_BYTES, stream, p); }
#endif
}
```

```cpp
#include <hip/hip_runtime.h>
#include <stdint.h>
#include <cstdio>

typedef unsigned short u16;
typedef short bf16x8 __attribute__((ext_vector_type(8)));
typedef float f32x4 __attribute__((ext_vector_type(4)));
typedef float f32x2 __attribute__((ext_vector_type(2)));
typedef unsigned u32x2 __attribute__((ext_vector_type(2)));
typedef unsigned u32x4 __attribute__((ext_vector_type(4)));

#ifndef PROBE_DUP
#define PROBE_DUP -1
#endif
#ifndef N_LAUNCHES
#define N_LAUNCHES 1
#endif

constexpr int NTOK = 16384, DM = 1024, SEQ = 2048, DIN = 3200, DINP = 3328;
constexpr int NPH = 5;
constexpr int LDS_BYTES = 18432 + 8 * 17408;

constexpr size_t WS_CTL = 0;
constexpr size_t WS_WINT = 16384;
constexpr size_t WS_WOUTT = WS_WINT + (size_t)DINP * 1024 * 2;
constexpr size_t WS_WUPT = WS_WOUTT + (size_t)1024 * 1024 * 2;
constexpr size_t WS_AUPT = WS_WUPT + 512 * 64 * 2;
constexpr size_t WS_POOLT = WS_AUPT + 512 * 64 * 2;
constexpr size_t WS_Z = WS_POOLT + 4 * 128 * 128 * 2;
constexpr size_t WS_REC = WS_Z + (size_t)NTOK * DIN * 2;
constexpr size_t WS_Y = WS_REC + (size_t)64 * 2048 * 896;
constexpr size_t WS_BONUS = WS_Y + (size_t)NTOK * 1024 * 2;
constexpr size_t WS_PART = WS_BONUS + (size_t)64 * 2048 * 4;
constexpr size_t WS_END = WS_PART + (size_t)64 * 4 * 256 * 4;
constexpr int CTL_CNT_WORD = 3584;
constexpr int NUNIT = 64 * 128;
constexpr size_t CH_AF = WS_REC;
constexpr size_t CH_RF = CH_AF + (size_t)NUNIT * 2048;
constexpr size_t CH_BKF = CH_RF + (size_t)NUNIT * 2048;
constexpr size_t CH_ARB = CH_BKF + (size_t)NUNIT * 4096;
constexpr size_t CH_G15 = CH_ARB + (size_t)NUNIT * 512;
constexpr size_t CH_END = CH_G15 + (size_t)NUNIT * 256;
constexpr size_t WS_VB = CH_END;
static_assert(WS_VB + (size_t)NTOK * 512 * 2 <= WS_Y, "chunk operands + v must fit in the record region");
constexpr size_t OUT_CHV = 0;
constexpr size_t OUT_GB = (size_t)NUNIT * 4 * 3 * 512;
static_assert(OUT_GB + (size_t)NTOK * 512 * 2 <= (size_t)NTOK * DM * 4, "d_out scratch");

struct Params {
    const float* x; const float* norm_gain; const float* w_in; const float* pool_w; const float* pool_scale;
    const float* shift_mu; const float* w0; const float* w_up; const float* a0; const float* a_up;
    const float* k_k; const float* k_a; const float* r_k; const float* gn_gain; const float* gn_bias;
    const float* w_out; const float* final_gain;
    float* out; unsigned char* ws;
    int ph_lo, ph_hi, dup_n, pad;
};

extern __shared__ __attribute__((aligned(16))) unsigned char dyn_smem[];

__device__ __forceinline__ float bf2f(u16 v) { return __uint_as_float(((unsigned)v) << 16); }
__device__ __forceinline__ float bflo(unsigned v) { return __uint_as_float(v << 16); }
__device__ __forceinline__ float bfhi(unsigned v) { return __uint_as_float(v & 0xffff0000u); }
typedef __bf16 bf16x2_t __attribute__((ext_vector_type(2)));
__device__ __forceinline__ unsigned pack2(float lo, float hi) { bf16x2_t v = {(__bf16)lo, (__bf16)hi}; return __builtin_bit_cast(unsigned, v); }
__device__ __forceinline__ u16 f2bf(float f) { return (u16)(pack2(f, 0.f) & 0xffffu); }
__device__ __forceinline__ float wave_sum(float v) {
#pragma unroll
    for (int m = 32; m >= 1; m >>= 1) v += __shfl_xor(v, m, 64);
    return v;
}
__device__ __forceinline__ float rcp_(float v) { return __builtin_amdgcn_rcpf(v); }
__device__ __forceinline__ float rsq_(float v) { return __builtin_amdgcn_rsqf(v); }
__device__ __forceinline__ float sigmoidf_(float v) { return rcp_(1.f + __expf(-v)); }
__device__ __forceinline__ float tanhf_(float v) { return 1.f - 2.f * rcp_(1.f + __expf(2.f * v)); }

#define XB_TMO      128
#define XB_XCNT(j)  (256  + 64 * (j))
#define XB_XSUB(j)  (1280 + 64 * (j))
#define XB_XGEN(j)  (2304 + 64 * (j))
#define XB_TOP      3328
#define XB_TOPGEN   3392
#define XCD_BAR_WORDS 3456
#define XB_SPIN_CAP (1u << 22)
#define LAS __attribute__((address_space(3)))

__device__ __forceinline__ unsigned xb_ld(unsigned* p)              { return __hip_atomic_load(p, __ATOMIC_RELAXED, __HIP_MEMORY_SCOPE_AGENT); }
__device__ __forceinline__ unsigned xb_add(unsigned* p, unsigned v) { return __hip_atomic_fetch_add(p, v, __ATOMIC_RELAXED, __HIP_MEMORY_SCOPE_AGENT); }
__device__ __forceinline__ unsigned xb_xcc_id() { return (unsigned)__builtin_amdgcn_s_getreg((3 << 11) | 20) & 0xFu; }
#define XB_SPIN(cond, bar) do { unsigned _sp = 0; while (cond) { __builtin_amdgcn_s_sleep(1); \
    if ((++_sp & 255u) == 0u) { if (xb_ld(&(bar)[XB_TMO])) break; if (_sp > XB_SPIN_CAP) { atomicAdd(&(bar)[XB_TMO], 1u); break; } } } } while (0)

struct XcdBarrier { unsigned* bar; unsigned x; volatile LAS unsigned* st; };

__device__ __forceinline__ XcdBarrier xcd_barrier_post(unsigned* bar, volatile LAS unsigned* st) {
    XcdBarrier b; b.bar = bar; b.x = xb_xcc_id(); b.st = st;
    if (threadIdx.x == 0) (void)xb_add(&bar[XB_XCNT(b.x)], 1u);
    return b;
}
__device__ __forceinline__ void xcd_barrier_complete(unsigned* bar, unsigned x, unsigned& nloc, unsigned& nx) {
    const unsigned G = gridDim.x * gridDim.y * gridDim.z;
    unsigned sum, cnt, mine, sp = 0u;
    for (;;) {
        sum = 0u; cnt = 0u; mine = 0u;
#pragma unroll
        for (unsigned j = 0; j < 16; ++j) { const unsigned c = xb_ld(&bar[XB_XCNT(j)]); sum += c; cnt += (c > 0u) ? 1u : 0u; mine = (j == x) ? c : mine; }
        if (sum == G) break;
        __builtin_amdgcn_s_sleep(1);
        if ((++sp & 255u) == 0u) { if (xb_ld(&bar[XB_TMO])) break; if (sp > XB_SPIN_CAP) { atomicAdd(&bar[XB_TMO], 1u); break; } }
    }
    nloc = mine > 0u ? mine : 1u; nx = cnt > 0u ? cnt : 1u;
}
__device__ __forceinline__ void xcd_barrier(const XcdBarrier& b) {
    asm volatile("s_waitcnt vmcnt(0)" ::: "memory");
    __syncthreads();
    if (threadIdx.x == 0) {
        unsigned* bar = b.bar;
        __builtin_amdgcn_s_waitcnt(0);
        unsigned nloc = b.st[0], nx = b.st[1];
        if (nloc == 0u) { xcd_barrier_complete(bar, b.x, nloc, nx); b.st[0] = nloc; b.st[1] = nx; }
        const unsigned old = xb_add(&bar[XB_XSUB(b.x)], 1u);
        const unsigned gen = old / nloc;
        if (old + 1u == (gen + 1u) * nloc) {
            __builtin_amdgcn_fence(__ATOMIC_RELEASE, "agent");
            asm volatile("s_waitcnt vmcnt(0)" ::: "memory");
            const unsigned og = xb_add(&bar[XB_TOP], 1u);
            const unsigned tg = og / nx;
            if (og + 1u == (tg + 1u) * nx) xb_add(&bar[XB_TOPGEN], 1u);
            else XB_SPIN(xb_ld(&bar[XB_TOPGEN]) == tg, bar);
            __builtin_amdgcn_fence(__ATOMIC_ACQUIRE, "agent");
            xb_add(&bar[XB_XGEN(b.x)], 1u);
            asm volatile("s_waitcnt vmcnt(0)" ::: "memory");
        } else {
            XB_SPIN(xb_ld(&bar[XB_XGEN(b.x)]) == gen, bar);
            __builtin_amdgcn_fence(__ATOMIC_ACQUIRE, "agent");
            asm volatile("s_waitcnt vmcnt(0)" ::: "memory");
        }
    }
    __syncthreads();
}

constexpr int BM = 256, BK = 64, HALF = 128, HTB = HALF * BK * 2, STAGE_BYTES = 8 * HTB, NXCD = 8, WGM = 8;
__device__ __forceinline__ int lds_byte(int r, int c) { const int st = (r >> 4) * 2 + (c >> 5), rr = r & 15, cc = c & 31, ob = rr * 64 + cc * 2; return st * 1024 + (ob ^ (((ob >> 9) & 1) << 5)); }
__device__ __forceinline__ void stage_rc(int b, int& R, int& C) { const int st = b / 1024, sb = b % 1024, swz = sb ^ (((sb >> 9) & 1) << 5); R = (st >> 1) * 16 + swz / 64; C = (st & 1) * 32 + (swz % 64) / 2; }
__device__ __forceinline__ int perm32(int rho) { const int n = rho >> 4, i = rho & 15; return 8 * (i >> 2) + 4 * n + (i & 3); }

struct Unit { int pm, pn; };
struct Gemm { const u16* A; const u16* Bt; int M, N, K, Nvalid; };
struct StaticOrder {
    int nM, nN, nwg, G, c;
    __device__ void init(int M, int N, int G_, int c_) { nM = M / BM; nN = N / BM; nwg = nM * nN; G = G_; c = c_; }
    __device__ bool next(int i, Unit& u) const {
        const long L = (long)i * G + c; if (L >= nwg) return false;
        int wgid = (int)L; { const int q = nwg / NXCD, r = nwg % NXCD, xcd = wgid % NXCD, off = wgid / NXCD; wgid = (xcd < r ? xcd * (q + 1) : r * (q + 1) + (xcd - r) * q) + off; }
        const int nig = WGM * nN, gid = wgid / nig, fm = gid * WGM, gsz = (nM - fm) < WGM ? (nM - fm) : WGM;
        u.pm = fm + ((wgid % nig) % gsz); u.pn = (wgid % nig) / gsz; return true;
    }
};
struct EpiZ {
    static constexpr bool PERM = true, AFTER_DRAIN = false;
    u16* Z;
    __device__ __forceinline__ void operator()(const f32x4 (&acc)[2][2][4][2], const Unit& u, int wr, int wc, int fr, int fq) const {
        const int row0 = u.pm * BM + wr * 64 + fr, col0 = u.pn * BM + wc * 32 + 8 * fq;
#pragma unroll
        for (int ai = 0; ai < 2; ++ai)
#pragma unroll
            for (int m = 0; m < 4; ++m) { u16* rowp = Z + (size_t)(row0 + ai * HALF + m * 16) * DIN;
#pragma unroll
                for (int bj = 0; bj < 2; ++bj) { const int col = col0 + bj * HALF; const f32x4 v0 = acc[ai][bj][m][0], v1 = acc[ai][bj][m][1];
                    if (col < DIN) *(u32x4*)(rowp + col) = (u32x4){pack2(v0[0], v0[1]), pack2(v0[2], v0[3]), pack2(v1[0], v1[1]), pack2(v1[2], v1[3])}; } }
    }
};
struct EpiRes {
    static constexpr bool PERM = false, AFTER_DRAIN = false;
    const float* x; float* out;
    __device__ __forceinline__ void operator()(const f32x4 (&acc)[2][2][4][2], const Unit& u, int wr, int wc, int fr, int fq) const {
        const int row0 = u.pm * BM + wr * 64 + fr, col0 = u.pn * BM + wc * 32 + 4 * fq;
#pragma unroll
        for (int ai = 0; ai < 2; ++ai)
#pragma unroll
            for (int m = 0; m < 4; ++m) { const size_t ro = (size_t)(row0 + ai * HALF + m * 16) * DM + col0;
#pragma unroll
                for (int bj = 0; bj < 2; ++bj)
#pragma unroll
                    for (int n = 0; n < 2; ++n) { const f32x4 xv = *(const f32x4*)(x + ro + bj * HALF + n * 16); *(f32x4*)(out + ro + bj * HALF + n * 16) = xv + acc[ai][bj][m][n]; } }
    }
};
struct EpiResNorm {
    static constexpr bool PERM = false, AFTER_DRAIN = true;
    const float* x; const float* gain; float* out; float* part; unsigned* cnt;
    __device__ __forceinline__ void fused(f32x4 (&acc)[2][2][4][2], const Unit& u, int wr, int wc, int fr, int fq, LAS unsigned char* lds) const {
        const int row0 = u.pm * BM + wr * 64 + fr, col0 = u.pn * BM + wc * 32 + 4 * fq;
        LAS float* red = (LAS float*)lds;
        LAS float* tot = red + 1024;
        float rs[2][4];
#pragma unroll
        for (int ai = 0; ai < 2; ++ai)
#pragma unroll
            for (int m = 0; m < 4; ++m) { const size_t ro = (size_t)(row0 + ai * HALF + m * 16) * DM + col0; float s = 0.f;
#pragma unroll
                for (int bj = 0; bj < 2; ++bj)
#pragma unroll
                    for (int n = 0; n < 2; ++n) { const f32x4 v = __builtin_nontemporal_load((const f32x4*)(x + ro + bj * HALF + n * 16)) + acc[ai][bj][m][n]; acc[ai][bj][m][n] = v; s += v[0] * v[0] + v[1] * v[1] + v[2] * v[2] + v[3] * v[3]; }
                s += __shfl_xor(s, 16, 64); s += __shfl_xor(s, 32, 64);
                rs[ai][m] = s; }
        if (fq == 0) {
#pragma unroll
            for (int ai = 0; ai < 2; ++ai)
#pragma unroll
                for (int m = 0; m < 4; ++m) red[((wr * 4 + wc) * 8 + ai * 4 + m) * 16 + fr] = rs[ai][m];
        }
        __syncthreads();
        if (threadIdx.x < 256) {
            const int rl = threadIdx.x, ai = rl >> 7, wr_ = (rl >> 6) & 1, m = (rl >> 4) & 3, fr_ = rl & 15;
            const int o = ((wr_ * 4) * 8 + ai * 4 + m) * 16 + fr_;
            const float s = red[o] + red[o + 128] + red[o + 256] + red[o + 384];
            __hip_atomic_store(part + ((size_t)u.pm * 4 + u.pn) * 256 + rl, s, __ATOMIC_RELAXED, __HIP_MEMORY_SCOPE_AGENT);
        }
        asm volatile("s_waitcnt vmcnt(0)" ::: "memory");
        __syncthreads();
        if (threadIdx.x == 0) {
            __builtin_amdgcn_fence(__ATOMIC_RELEASE, "agent");
            asm volatile("s_waitcnt vmcnt(0)" ::: "memory");
            __hip_atomic_fetch_add(cnt + u.pm, 1u, __ATOMIC_RELAXED, __HIP_MEMORY_SCOPE_AGENT);
            unsigned sp = 0;
            while (__hip_atomic_load(cnt + u.pm, __ATOMIC_RELAXED, __HIP_MEMORY_SCOPE_AGENT) < 4u) { __builtin_amdgcn_s_sleep(1); if (++sp > (1u << 24)) break; }
            __builtin_amdgcn_fence(__ATOMIC_ACQUIRE, "agent");
            asm volatile("s_waitcnt vmcnt(0)" ::: "memory");
        }
        __syncthreads();
        for (int e = threadIdx.x; e < 1024; e += 512) tot[e] = __hip_atomic_load(part + (size_t)u.pm * 1024 + e, __ATOMIC_RELAXED, __HIP_MEMORY_SCOPE_AGENT);
        __syncthreads();
#pragma unroll
        for (int ai = 0; ai < 2; ++ai)
#pragma unroll
            for (int m = 0; m < 4; ++m) { const int rl = ai * 128 + wr * 64 + m * 16 + fr;
                const float inv = rsq_((tot[rl] + tot[256 + rl] + tot[512 + rl] + tot[768 + rl]) * (1.f / 1024.f) + 1e-6f);
                const size_t ro = (size_t)(row0 + ai * HALF + m * 16) * DM + col0;
#pragma unroll
                for (int bj = 0; bj < 2; ++bj)
#pragma unroll
                    for (int n = 0; n < 2; ++n) { const f32x4 g = *(const f32x4*)(gain + col0 + bj * HALF + n * 16); __builtin_nontemporal_store(acc[ai][bj][m][n] * inv * g, (f32x4*)(out + ro + bj * HALF + n * 16)); } }
    }
};

template <class Epi, class Sched>
__device__ __forceinline__ void gemm_phase(LAS unsigned char* lds, const Gemm g, const Sched& S, const Epi& E) {
    const int tid = threadIdx.x, wid = __builtin_amdgcn_readfirstlane(tid >> 6), lane = tid & 63, wr = wid >> 2, wc = wid & 3, fr = lane & 15, fq = lane >> 4;
    const int K = g.K, nt = K / BK;
    unsigned voffA[2], voffB[2];
#pragma unroll
    for (int i = 0; i < 2; ++i) { int R, C; stage_rc(tid * 16 + i * 8192, R, C); const int Rb = Epi::PERM ? ((R & ~31) + perm32(R & 31)) : R;
        voffA[i] = (unsigned)(R * K + C) * 2u; voffB[i] = (unsigned)(Rb * K + C) * 2u; }
    const size_t kstep = (size_t)(BK * 2);
    const size_t hstep = (size_t)HALF * K * 2;
    const size_t tstep = 2 * hstep;
    const unsigned ldsw = (unsigned)wid * 1024u;
    const int aoff = lds_byte(wr * 64 + fr, fq * 8), boff = lds_byte(wc * 32 + fr, fq * 8);
#define PG8_SA(b, h) (((b) * 2 + (h)) * HTB)
#define PG8_SB(b, h) ((4 + (b) * 2 + (h)) * HTB)
#define PG8_STAGE(bufoff, gbase, voff) do { _Pragma("unroll") for (int _i = 0; _i < 2; ++_i) \
        __builtin_amdgcn_global_load_lds((const unsigned*)((const char*)(gbase) + (voff)[_i]), (LAS unsigned*)(lds + (bufoff) + ldsw + _i * 8192), 16, 0, 0); } while (0)
#define PG8_LDA(dst, b, h) do { _Pragma("unroll") for (int m = 0; m < 4; ++m) _Pragma("unroll") for (int k = 0; k < 2; ++k) dst[m][k] = *(const LAS bf16x8*)(lds + PG8_SA(b, h) + aoff + m * 2048 + k * 1024); } while (0)
#define PG8_LDB(dst, b, h) do { _Pragma("unroll") for (int n = 0; n < 2; ++n) _Pragma("unroll") for (int k = 0; k < 2; ++k) dst[n][k] = *(const LAS bf16x8*)(lds + PG8_SB(b, h) + boff + n * 2048 + k * 1024); } while (0)
#define PG8_MMA(ai, bj, At, Bt) do { __builtin_amdgcn_s_setprio(1); _Pragma("unroll") for (int m = 0; m < 4; ++m) _Pragma("unroll") for (int n = 0; n < 2; ++n) _Pragma("unroll") for (int k = 0; k < 2; ++k) \
        acc[ai][bj][m][n] = __builtin_amdgcn_mfma_f32_16x16x32_bf16(Bt[n][k], At[m][k], acc[ai][bj][m][n], 0, 0, 0); __builtin_amdgcn_s_setprio(0); } while (0)
#define PG8_WAIT_V(n) asm volatile("s_waitcnt vmcnt(" #n ")" ::: "memory")
#define PG8_WAIT_L(n) asm volatile("s_waitcnt lgkmcnt(" #n ")" ::: "memory")
#define PG8_BAR __builtin_amdgcn_s_barrier()
#define PG8_SCHED __builtin_amdgcn_sched_barrier(0)
    Unit cur, nxt; int ui = 0;
    if (!S.next(0, cur)) return;
    f32x4 acc[2][2][4][2];
#pragma unroll
    for (int a = 0; a < 2; ++a)
#pragma unroll
        for (int b = 0; b < 2; ++b)
#pragma unroll
            for (int m = 0; m < 4; ++m)
#pragma unroll
                for (int n = 0; n < 2; ++n) acc[a][b][m][n] = (f32x4){0.f, 0.f, 0.f, 0.f};
    bf16x8 At[4][2], B0[2][2], B1[2][2];
    const char* cA = (const char*)g.A + (size_t)cur.pm * tstep; const char* cB = (const char*)g.Bt + (size_t)cur.pn * tstep;
    PG8_STAGE(PG8_SB(0, 0), cB, voffB); PG8_STAGE(PG8_SA(0, 0), cA, voffA); PG8_STAGE(PG8_SB(0, 1), cB + hstep, voffB); PG8_STAGE(PG8_SA(0, 1), cA + hstep, voffA);
    if (wr == 1) PG8_BAR;
    PG8_WAIT_V(4); PG8_BAR;
    PG8_STAGE(PG8_SB(1, 0), cB + kstep, voffB); PG8_STAGE(PG8_SA(1, 0), cA + kstep, voffA); PG8_STAGE(PG8_SB(1, 1), cB + hstep + kstep, voffB);
    PG8_WAIT_V(6); PG8_BAR;
    for (;;) {
        const bool has_next = S.next(ui + 1, nxt);
        const char* nA = has_next ? (const char*)g.A + (size_t)nxt.pm * tstep : cA; const char* nB = has_next ? (const char*)g.Bt + (size_t)nxt.pn * tstep : cB;
        const bool rhalf = (cur.pn * BM + HALF) < g.Nvalid;
        for (int t = 0; t < nt; t += 2) {
            const bool last = (t == nt - 2);
            const char* a1 = cA + (size_t)(t + 1) * kstep;
            const char* a2 = last ? nA : cA + (size_t)(t + 2) * kstep; const char* b2 = last ? nB : cB + (size_t)(t + 2) * kstep;
            const char* a3 = a2 + kstep; const char* b3 = b2 + kstep;
            PG8_LDB(B0, 0, 0); PG8_SCHED; PG8_LDA(At, 0, 0); PG8_STAGE(PG8_SA(1, 1), a1 + hstep, voffA);
            PG8_WAIT_L(8); PG8_BAR; PG8_WAIT_L(0); PG8_MMA(0, 0, At, B0); PG8_BAR; PG8_SCHED;
            PG8_LDB(B1, 0, 1); PG8_STAGE(PG8_SB(0, 0), b2, voffB);
            PG8_BAR; PG8_WAIT_L(0); if (rhalf) PG8_MMA(0, 1, At, B1); PG8_BAR;
            PG8_LDA(At, 0, 1); PG8_STAGE(PG8_SA(0, 0), a2, voffA);
            PG8_BAR; PG8_WAIT_L(0); PG8_MMA(1, 0, At, B0); PG8_BAR; PG8_SCHED;
            PG8_STAGE(PG8_SB(0, 1), b2 + hstep, voffB);
            PG8_WAIT_V(6); PG8_BAR; if (rhalf) PG8_MMA(1, 1, At, B1); PG8_BAR;
            PG8_LDB(B0, 1, 0); PG8_SCHED; PG8_LDA(At, 1, 0); PG8_STAGE(PG8_SA(0, 1), a2 + hstep, voffA);
            PG8_WAIT_L(8); PG8_BAR; PG8_WAIT_L(0); PG8_MMA(0, 0, At, B0); PG8_BAR; PG8_SCHED;
            PG8_LDB(B1, 1, 1); PG8_STAGE(PG8_SB(1, 0), b3, voffB);
            PG8_BAR; PG8_WAIT_L(0); if (rhalf) PG8_MMA(0, 1, At, B1); PG8_BAR;
            PG8_LDA(At, 1, 1); PG8_STAGE(PG8_SA(1, 0), a3, voffA);
            PG8_BAR; PG8_WAIT_L(0); PG8_MMA(1, 0, At, B0); PG8_BAR; PG8_SCHED;
            PG8_STAGE(PG8_SB(1, 1), b3 + hstep, voffB);
            PG8_WAIT_V(6); PG8_BAR; if (rhalf) PG8_MMA(1, 1, At, B1); PG8_BAR;
        }
        if constexpr (!Epi::AFTER_DRAIN) E(acc, cur, wr, wc, fr, fq);
        if (!has_next) break;
#pragma unroll
        for (int a = 0; a < 2; ++a)
#pragma unroll
            for (int b = 0; b < 2; ++b)
#pragma unroll
                for (int m = 0; m < 4; ++m)
#pragma unroll
                    for (int n = 0; n < 2; ++n) acc[a][b][m][n] = (f32x4){0.f, 0.f, 0.f, 0.f};
        cur = nxt; cA = nA; cB = nB; ++ui;
    }
    PG8_WAIT_V(0);
    if (wr == 0) PG8_BAR;
    PG8_BAR;
    if constexpr (Epi::AFTER_DRAIN) E.fused(acc, cur, wr, wc, fr, fq, lds);
#undef PG8_SA
#undef PG8_SB
#undef PG8_STAGE
#undef PG8_LDA
#undef PG8_LDB
#undef PG8_MMA
#undef PG8_WAIT_V
#undef PG8_WAIT_L
#undef PG8_BAR
#undef PG8_SCHED
}

#define WSYNC() do { __builtin_amdgcn_wave_barrier(); asm volatile("s_waitcnt lgkmcnt(0)" ::: "memory"); __builtin_amdgcn_wave_barrier(); } while (0)
__device__ void phase0(const Params& p) {
    const int tid = threadIdx.x, lane = tid & 63, wave = tid >> 6, blk = blockIdx.x;
    u16* Hbf = (u16*)p.out;
#pragma unroll 1
    for (int r0 = 0; r0 < 8; r0 += 4) {
        f32x4 v[4][4]; float ss[4];
#pragma unroll
        for (int i = 0; i < 4; ++i) {
            const f32x4* xr = (const f32x4*)(p.x + (size_t)(blk * 64 + wave * 8 + r0 + i) * DM);
#pragma unroll
            for (int q = 0; q < 4; ++q) v[i][q] = __builtin_nontemporal_load(xr + lane + 64 * q);
        }
#pragma unroll
        for (int i = 0; i < 4; ++i) {
            float s = 0.f;
#pragma unroll
            for (int q = 0; q < 4; ++q) s += v[i][q][0] * v[i][q][0] + v[i][q][1] * v[i][q][1] + v[i][q][2] * v[i][q][2] + v[i][q][3] * v[i][q][3];
            ss[i] = wave_sum(s);
        }
#pragma unroll
        for (int i = 0; i < 4; ++i) {
            const int row = blk * 64 + wave * 8 + r0 + i;
            const float inv = rsq_(ss[i] * (1.f / 1024.f) + 1e-6f);
#pragma unroll
            for (int q = 0; q < 4; ++q) {
                const f32x4 g = ((const f32x4*)p.norm_gain)[lane + 64 * q];
                u32x2 o; o.x = pack2(v[i][q][0] * inv * g[0], v[i][q][1] * inv * g[1]); o.y = pack2(v[i][q][2] * inv * g[2], v[i][q][3] * inv * g[3]);
                *(u32x2*)(Hbf + (size_t)row * DM + (lane + 64 * q) * 4) = o;
            }
        }
    }
    u16* WinT = (u16*)(p.ws + WS_WINT); u16* WoutT = (u16*)(p.ws + WS_WOUTT);
    {
        float* tl = (float*)dyn_smem + wave * (64 * 65);
        const int t = blk + 256 * wave;
        if (t < 832 + 256) {
            const float* src; u16* dst; int kt, ntile, N;
            if (t < 832) { kt = t & 15; ntile = t >> 4; src = p.w_in; N = DIN; dst = WinT; }
            else { const int t2 = t - 832; kt = t2 & 15; ntile = t2 >> 4; src = p.w_out; N = 1024; dst = WoutT; }
            const int k0 = kt * 64, n0 = ntile * 64, n4 = (lane & 15) * 4;
            f32x4 v[16];
#pragma unroll
            for (int i = 0; i < 16; ++i) { const int kk = (lane >> 4) + 4 * i; v[i] = (n0 + n4 < N) ? *(const f32x4*)(src + (size_t)(k0 + kk) * N + n0 + n4) : (f32x4){0.f, 0.f, 0.f, 0.f}; }
#pragma unroll
            for (int i = 0; i < 16; ++i) { const int kk = (lane >> 4) + 4 * i; float* d = tl + kk * 65 + n4; d[0] = v[i][0]; d[1] = v[i][1]; d[2] = v[i][2]; d[3] = v[i][3]; }
            WSYNC();
            const int kp = lane & 31, nh = lane >> 5;
#pragma unroll 8
            for (int i = 0; i < 32; ++i) { const int nn = 2 * i + nh;
                *(unsigned*)(dst + (size_t)(n0 + nn) * 1024 + k0 + 2 * kp) = pack2(tl[(2 * kp) * 65 + nn], tl[(2 * kp + 1) * 65 + nn]); }
        }
    }
    u16* WupT = (u16*)(p.ws + WS_WUPT); u16* AupT = (u16*)(p.ws + WS_AUPT); u16* PoolT = (u16*)(p.ws + WS_POOLT);
    const int gt = blk * 512 + tid;
    if (gt < 32768) { const int c = gt >> 6, j = gt & 63; WupT[gt] = f2bf(p.w_up[j * 512 + c]); AupT[gt] = f2bf(p.a_up[j * 512 + c]); }
    if (gt < 65536) { const int g = gt >> 14, d = (gt >> 7) & 127, c = gt & 127; PoolT[gt] = f2bf(p.pool_w[(g * 128 + c) * 128 + d]); }
}

__device__ void phase1(const Params& p) {
    Gemm g; g.A = (const u16*)p.out; g.Bt = (const u16*)(p.ws + WS_WINT); g.M = NTOK; g.N = DINP; g.K = 1024; g.Nvalid = DIN;
    StaticOrder S; S.init(NTOK, DINP, 256, blockIdx.x);
    EpiZ E; E.Z = (u16*)(p.ws + WS_Z);
    gemm_phase((LAS unsigned char*)dyn_smem, g, S, E);
}
__device__ void phase4(const Params& p) {
    Gemm g; g.A = (const u16*)(p.ws + WS_Y); g.Bt = (const u16*)(p.ws + WS_WOUTT); g.M = NTOK; g.N = 1024; g.K = 1024; g.Nvalid = 1024;
    StaticOrder S; S.init(NTOK, 1024, 256, blockIdx.x);
    EpiResNorm E; E.x = p.x; E.gain = p.final_gain; E.out = p.out; E.part = (float*)(p.ws + WS_PART); E.cnt = (unsigned*)(p.ws + WS_CTL) + CTL_CNT_WORD;
    gemm_phase((LAS unsigned char*)dyn_smem, g, S, E);
}

template <int CTRL> __device__ __forceinline__ float dpp_add(float v) {
    const int t = __builtin_amdgcn_update_dpp(0, __float_as_int(v), CTRL, 0xf, 0xf, false);
    return v + __int_as_float(t);
}
__device__ __forceinline__ float row16_allsum(float v) {
    v = dpp_add<0x128>(v); v = dpp_add<0x124>(v); v = dpp_add<0x122>(v); v = dpp_add<0x121>(v);
    return v;
}
#define MFMA16(a, b, c) __builtin_amdgcn_mfma_f32_16x16x32_bf16((a), (b), (c), 0, 0, 0)
__device__ __forceinline__ bf16x8 as_bf8(u32x4 v) { return __builtin_bit_cast(bf16x8, v); }
template <int W> __device__ __forceinline__ void pooled_run(const u16* __restrict__ Z, u16* pooled, int t0, int s0, int cp, int hf) {
    const int c0 = 2 * cp, tb = hf * 32;
    unsigned raw[W - 1 + 32];
#pragma unroll
    for (int i = 0; i < W - 1 + 32; ++i) { const int tt = tb - (W - 1) + i; raw[i] = (s0 + tt >= 0) ? *(const unsigned*)(Z + (size_t)(t0 + tt) * DIN + c0) : 0u; }
    float sum0 = 0.f, sum1 = 0.f;
#pragma unroll
    for (int i = 0; i < W - 1; ++i) { sum0 += bflo(raw[i]); sum1 += bfhi(raw[i]); }
#pragma unroll
    for (int j = 0; j < 32; ++j) {
        const int tt = tb + j, s = s0 + tt;
        const float u0 = bflo(raw[W - 1 + j]), u1 = bfhi(raw[W - 1 + j]);
        sum0 += u0; sum1 += u1;
        const float rc = rcp_((float)((s + 1 < W) ? (s + 1) : W));
        *(unsigned*)(pooled + tt * 520 + c0) = pack2(sum0 * rc - u0, sum1 * rc - u1);
        sum0 -= bflo(raw[j]); sum1 -= bfhi(raw[j]);
    }
}
constexpr int RST = 912;
__device__ __forceinline__ void p2_zload(u32x4 (&zq)[7], const u16* __restrict__ Z, size_t T0, bool has_halo, int h, int lane) {
#pragma unroll
    for (int q = 0; q < 7; ++q) {
        const int pidx = lane + 64 * q, rr = pidx / 24, w = pidx - rr * 24, a = w >> 3, pc = w & 7;
        u32x4 v = (u32x4){0u, 0u, 0u, 0u};
        if (pidx < 17 * 24) {
            if (rr < 16) v = *(const u32x4*)(Z + (T0 + rr) * DIN + 1024 + a * 512 + h * 64 + pc * 8);
            else if (has_halo) v = *(const u32x4*)(Z + (T0 - 1) * DIN + 1024 + a * 512 + h * 64 + pc * 8);
        }
        zq[q] = v;
    }
}
constexpr int P2_WREG = 17408;
__device__ void phase2(const Params& p) {
    const int tid = threadIdx.x, lane = tid & 63, wave = tid >> 6, blk = blockIdx.x, fr = lane & 15, fq = lane >> 4;
    const int t0 = blk * 64, b = t0 >> 11, s0 = t0 & 2047;
    const u16* Z = (const u16*)(p.ws + WS_Z);
    u16* twb = (u16*)dyn_smem;
    u16* alb = twb + 64 * 72;
    u16* pooled = alb + 64 * 72;
    for (int e = tid; e < 64 * 128; e += 512) {
        const int tt = e >> 7, j = e & 127;
        const size_t zi = (size_t)(t0 + tt) * DIN + 2560 + j;
        const float cur = bf2f(Z[zi]);
        const float prev = (s0 + tt > 0) ? bf2f(Z[zi - DIN]) : 0.f;
        const float val = cur + p.shift_mu[1536 + j] * (prev - cur);
        if (j < 64) twb[tt * 72 + j] = f2bf(tanhf_(val)); else alb[tt * 72 + (j - 64)] = f2bf(val);
    }
    {
        const int cp = tid & 255, hf = tid >> 8;
        switch (wave & 3) {
            case 0: pooled_run<2>(Z, pooled, t0, s0, cp, hf); break;
            case 1: pooled_run<4>(Z, pooled, t0, s0, cp, hf); break;
            case 2: pooled_run<8>(Z, pooled, t0, s0, cp, hf); break;
            default: pooled_run<16>(Z, pooled, t0, s0, cp, hf); break;
        }
    }
    __syncthreads();
    {
        const int g = wave >> 1, dbase = (wave & 1) * 64;
        const u16* PoolT = (const u16*)(p.ws + WS_POOLT); u16* Y = (u16*)(p.ws + WS_Y);
        f32x4 acc[4][4];
#pragma unroll
        for (int mt = 0; mt < 4; ++mt)
#pragma unroll
            for (int nt = 0; nt < 4; ++nt) acc[mt][nt] = (f32x4){0.f, 0.f, 0.f, 0.f};
#pragma unroll
        for (int ks = 0; ks < 4; ++ks) {
            bf16x8 Bf[4];
#pragma unroll
            for (int nt = 0; nt < 4; ++nt) Bf[nt] = *(const bf16x8*)(PoolT + (size_t)(g * 128 + dbase + nt * 16 + fr) * 128 + ks * 32 + fq * 8);
#pragma unroll
            for (int mt = 0; mt < 4; ++mt) {
                const bf16x8 Af = *(const bf16x8*)(pooled + (mt * 16 + fr) * 520 + g * 128 + ks * 32 + fq * 8);
#pragma unroll
                for (int nt = 0; nt < 4; ++nt) acc[mt][nt] = MFMA16(Bf[nt], Af, acc[mt][nt]);
            }
        }
#pragma unroll
        for (int mt = 0; mt < 4; ++mt) {
            const size_t T = (size_t)(t0 + mt * 16 + fr);
#pragma unroll
            for (int nt = 0; nt < 4; ++nt) {
                const int ch = g * 128 + dbase + nt * 16 + fq * 4;
                const u32x2 ga = *(const u32x2*)(Z + T * DIN + 512 + ch);
                const f32x4 ps = *(const f32x4*)(p.pool_scale + ch);
                const f32x4 gv = (f32x4){bflo(ga.x), bfhi(ga.x), bflo(ga.y), bfhi(ga.y)};
                f32x4 y;
#pragma unroll
                for (int jj = 0; jj < 4; ++jj) y[jj] = acc[mt][nt][jj] * ps[jj] * gv[jj] * sigmoidf_(gv[jj]);
                u32x2 o; o.x = pack2(y[0], y[1]); o.y = pack2(y[2], y[3]);
                *(u32x2*)(Y + T * 1024 + ch) = o;
            }
        }
    }
    {
        u16* GB = (u16*)((unsigned char*)p.out + OUT_GB);
        for (int e = tid; e < 64 * 64; e += 512) { const int tt = e >> 6, q = e & 63;
            *(u32x4*)(GB + (size_t)(t0 + tt) * 512 + q * 8) = *(const u32x4*)(Z + (size_t)(t0 + tt) * DIN + 2688 + q * 8); }
    }
    __syncthreads();
    const int h = wave, bh = b * 8 + h;
    unsigned char* WL = dyn_smem + 18432 + wave * P2_WREG;
    unsigned char* recl = WL;
    u16* AR = (u16*)WL;
    u16* BK = AR + 32 * 72;
    u16* AtT = BK + 32 * 72;
    u16* BhT = AtT + 64 * 16;
    u16* KhT = BhT + 64 * 16;
    u16* VT = KhT + 64 * 16;
    float* Pab = (float*)WL;
    u16* Tm = (u16*)(Pab + 16 * 17);
    u16* AakT = Tm + 16 * 24;
    u16* M1m = AakT + 16 * 24;
    u16* Ark = M1m + 16 * 24;
    u16* Arb = Ark + 16 * 24;
    const u16* WupT = (const u16*)(p.ws + WS_WUPT); const u16* AupT = (const u16*)(p.ws + WS_AUPT);
    float* BON = (float*)(p.ws + WS_BONUS); u16* VB = (u16*)(p.ws + WS_VB);
    unsigned char* AFg = p.ws + CH_AF; unsigned char* RFg = p.ws + CH_RF; unsigned char* BKFg = p.ws + CH_BKF; unsigned char* ARBg = p.ws + CH_ARB;
    float* G15g = (float*)(p.ws + CH_G15); unsigned char* CHVg = (unsigned char*)p.out + OUT_CHV;
    const bf16x8 zero8 = (bf16x8){0, 0, 0, 0, 0, 0, 0, 0};
    const f32x4 zero4 = (f32x4){0.f, 0.f, 0.f, 0.f};
#pragma unroll 1
    for (int mt = 0; mt < 4; ++mt) {
        const size_t u = (size_t)bh * 128 + (s0 >> 4) + mt;
        {
            u32x4 zq[7];
            p2_zload(zq, Z, (size_t)(t0 + mt * 16), (s0 + mt * 16) > 0, h, lane);
            f32x4 aw[4], aa[4];
#pragma unroll
            for (int nt = 0; nt < 4; ++nt) { aw[nt] = zero4; aa[nt] = zero4; }
#pragma unroll
            for (int ks = 0; ks < 2; ++ks) {
                const bf16x8 Aw = *(const bf16x8*)(twb + (mt * 16 + fr) * 72 + ks * 32 + fq * 8);
                const bf16x8 Aa = *(const bf16x8*)(alb + (mt * 16 + fr) * 72 + ks * 32 + fq * 8);
#pragma unroll
                for (int nt = 0; nt < 4; ++nt) {
                    const bf16x8 Bw = *(const bf16x8*)(WupT + (h * 64 + nt * 16 + fr) * 64 + ks * 32 + fq * 8);
                    const bf16x8 Ba = *(const bf16x8*)(AupT + (h * 64 + nt * 16 + fr) * 64 + ks * 32 + fq * 8);
                    aw[nt] = MFMA16(Bw, Aw, aw[nt]);
                    aa[nt] = MFMA16(Ba, Aa, aa[nt]);
                }
            }
#pragma unroll
            for (int q = 0; q < 7; ++q) {
                const int pidx = lane + 64 * q, rr = pidx / 24, w = pidx - rr * 24, a = w >> 3, pc = w & 7;
                if (pidx < 17 * 24) *(u32x4*)(recl + ((rr < 16) ? rr * RST + 256 : 16 * RST) + a * 128 + pc * 16) = zq[q];
            }
            WSYNC();
            const int tt = mt * 16 + fr, s = s0 + tt; const size_t T = (size_t)(t0 + tt);
            f32x4 Kr[4], Av[4];
            float n2 = 0.f, bon = 0.f;
            unsigned char* rec = recl + fr * RST;
            const unsigned char* prec = (fr > 0) ? (recl + (fr - 1) * RST) : (recl + 16 * RST - 256);
#pragma unroll
            for (int nt = 0; nt < 4; ++nt) {
                const int cb = h * 64 + nt * 16 + fq * 4, ci = nt * 16 + fq * 4;
                const u32x2 zr = *(const u32x2*)(rec + 256 + ci * 2), zk = *(const u32x2*)(rec + 384 + ci * 2), zv = *(const u32x2*)(rec + 512 + ci * 2);
                const u32x2 pr = *(const u32x2*)(prec + 256 + ci * 2), pk = *(const u32x2*)(prec + 384 + ci * 2), pv = *(const u32x2*)(prec + 512 + ci * 2);
                const f32x4 mur = *(const f32x4*)(p.shift_mu + cb), muk = *(const f32x4*)(p.shift_mu + 512 + cb), muv = *(const f32x4*)(p.shift_mu + 1024 + cb);
                const f32x4 w0v = *(const f32x4*)(p.w0 + cb), a0v = *(const f32x4*)(p.a0 + cb), kkv = *(const f32x4*)(p.k_k + cb), kav = *(const f32x4*)(p.k_a + cb), rkv = *(const f32x4*)(p.r_k + cb);
                const f32x4 cr = (f32x4){bflo(zr.x), bfhi(zr.x), bflo(zr.y), bfhi(zr.y)}, ck = (f32x4){bflo(zk.x), bfhi(zk.x), bflo(zk.y), bfhi(zk.y)}, cv = (f32x4){bflo(zv.x), bfhi(zv.x), bflo(zv.y), bfhi(zv.y)};
                const f32x4 qr = (f32x4){bflo(pr.x), bfhi(pr.x), bflo(pr.y), bfhi(pr.y)}, qk = (f32x4){bflo(pk.x), bfhi(pk.x), bflo(pk.y), bfhi(pk.y)}, qv = (f32x4){bflo(pv.x), bfhi(pv.x), bflo(pv.y), bfhi(pv.y)};
                f32x4 Rr, Kp, Vv, Dc;
#pragma unroll
                for (int jj = 0; jj < 4; ++jj) {
                    const float r = cr[jj] + mur[jj] * (qr[jj] - cr[jj]);
                    const float k = ck[jj] + muk[jj] * (qk[jj] - ck[jj]);
                    const float v = cv[jj] + muv[jj] * (qv[jj] - cv[jj]);
                    const float ww = aw[nt][jj] + w0v[jj];
                    const float a = sigmoidf_(aa[nt][jj] + a0v[jj]);
                    const float dec = __expf(-0.6065306597126334f * sigmoidf_(ww));
                    const float kr = k * kkv[jj];
                    n2 += kr * kr;
                    const float kp = k * (1.f + (a - 1.f) * kav[jj]);
                    bon += r * kp * rkv[jj];
                    Rr[jj] = r; Kp[jj] = kp; Vv[jj] = v; Kr[nt][jj] = kr; Av[nt][jj] = a; Dc[jj] = dec;
                }
                *(f32x4*)(rec + ci * 4) = Dc;
                *(u32x2*)(rec + 256 + ci * 2) = (u32x2){pack2(Rr[0], Rr[1]), pack2(Rr[2], Rr[3])};
                *(u32x2*)(rec + 384 + ci * 2) = (u32x2){pack2(Kp[0], Kp[1]), pack2(Kp[2], Kp[3])};
                const u32x2 vpk = (u32x2){pack2(Vv[0], Vv[1]), pack2(Vv[2], Vv[3])};
                *(u32x2*)(rec + 512 + ci * 2) = vpk;
                *(u32x2*)(VB + T * 512 + cb) = vpk;
            }
            n2 += __shfl_xor(n2, 16, 64); n2 += __shfl_xor(n2, 32, 64);
            bon += __shfl_xor(bon, 16, 64); bon += __shfl_xor(bon, 32, 64);
            const float inv = rsq_(fmaxf(n2, 1e-24f));
#pragma unroll
            for (int nt = 0; nt < 4; ++nt) {
                const int ci = nt * 16 + fq * 4;
                const f32x4 kk = Kr[nt] * inv;
                *(u32x2*)(rec + 640 + ci * 2) = (u32x2){pack2(kk[0], kk[1]), pack2(kk[2], kk[3])};
                const f32x4 nb = -(kk * Av[nt]);
                *(u32x2*)(rec + 768 + ci * 2) = (u32x2){pack2(nb[0], nb[1]), pack2(nb[2], nb[3])};
            }
            if (fq == 0) BON[(size_t)bh * 2048 + s] = bon;
        }
        WSYNC();
        {
            float w_[16], r_[16], kp_[16], v_[16], kk_[16], nb_[16];
#pragma unroll
            for (int t = 0; t < 16; ++t) {
                const unsigned char* rt = recl + t * RST;
                w_[t] = *(const float*)(rt + lane * 4);
                r_[t] = bf2f(*(const u16*)(rt + 256 + lane * 2)); kp_[t] = bf2f(*(const u16*)(rt + 384 + lane * 2)); v_[t] = bf2f(*(const u16*)(rt + 512 + lane * 2));
                kk_[t] = bf2f(*(const u16*)(rt + 640 + lane * 2)); nb_[t] = bf2f(*(const u16*)(rt + 768 + lane * 2));
            }
            WSYNC();
            float g = 1.f;
            float At[16], Bt[16], Kt[16];
#pragma unroll
            for (int t = 0; t < 16; ++t) {
                const float gp = g; g = g * w_[t]; const float ig = rcp_(g);
                const float a = kk_[t] * gp, rr = r_[t] * g, bb = nb_[t] * ig, kt = kp_[t] * ig;
                AR[t * 72 + lane] = f2bf(a); AR[(16 + t) * 72 + lane] = f2bf(rr); BK[t * 72 + lane] = f2bf(bb); BK[(16 + t) * 72 + lane] = f2bf(kt);
                At[t] = a; Bt[t] = bb; Kt[t] = kt;
            }
            u32x4 o0, o1;
            o0 = (u32x4){pack2(At[0], At[1]), pack2(At[2], At[3]), pack2(At[4], At[5]), pack2(At[6], At[7])};
            o1 = (u32x4){pack2(At[8], At[9]), pack2(At[10], At[11]), pack2(At[12], At[13]), pack2(At[14], At[15])};
            *(u32x4*)(AtT + lane * 16) = o0; *(u32x4*)(AtT + lane * 16 + 8) = o1;
            o0 = (u32x4){pack2(Bt[0] * g, Bt[1] * g), pack2(Bt[2] * g, Bt[3] * g), pack2(Bt[4] * g, Bt[5] * g), pack2(Bt[6] * g, Bt[7] * g)};
            o1 = (u32x4){pack2(Bt[8] * g, Bt[9] * g), pack2(Bt[10] * g, Bt[11] * g), pack2(Bt[12] * g, Bt[13] * g), pack2(Bt[14] * g, Bt[15] * g)};
            *(u32x4*)(BhT + lane * 16) = o0; *(u32x4*)(BhT + lane * 16 + 8) = o1;
            o0 = (u32x4){pack2(Kt[0] * g, Kt[1] * g), pack2(Kt[2] * g, Kt[3] * g), pack2(Kt[4] * g, Kt[5] * g), pack2(Kt[6] * g, Kt[7] * g)};
            o1 = (u32x4){pack2(Kt[8] * g, Kt[9] * g), pack2(Kt[10] * g, Kt[11] * g), pack2(Kt[12] * g, Kt[13] * g), pack2(Kt[14] * g, Kt[15] * g)};
            *(u32x4*)(KhT + lane * 16) = o0; *(u32x4*)(KhT + lane * 16 + 8) = o1;
            o0 = (u32x4){pack2(v_[0], v_[1]), pack2(v_[2], v_[3]), pack2(v_[4], v_[5]), pack2(v_[6], v_[7])};
            o1 = (u32x4){pack2(v_[8], v_[9]), pack2(v_[10], v_[11]), pack2(v_[12], v_[13]), pack2(v_[14], v_[15])};
            *(u32x4*)(VT + lane * 16) = o0; *(u32x4*)(VT + lane * 16 + 8) = o1;
            G15g[u * 64 + lane] = g;
        }
        WSYNC();
        {
            u32x2 rp[4];
#pragma unroll
            for (int ta = 0; ta < 4; ++ta) rp[ta] = *(const u32x2*)(AR + (16 + fr) * 72 + 16 * ta + 4 * fq);
            *(u32x4*)(RFg + (u * 64 + lane) * 32) = (u32x4){rp[0].x, rp[0].y, rp[1].x, rp[1].y};
            *(u32x4*)(RFg + (u * 64 + lane) * 32 + 16) = (u32x4){rp[2].x, rp[2].y, rp[3].x, rp[3].y};
#pragma unroll
            for (int ta = 0; ta < 4; ++ta) {
                const u32x2 b2 = *(const u32x2*)(BhT + (16 * ta + fr) * 16 + 4 * fq), k2 = *(const u32x2*)(KhT + (16 * ta + fr) * 16 + 4 * fq);
                *(u32x4*)(BKFg + ((u * 4 + ta) * 64 + lane) * 16) = (u32x4){b2.x, b2.y, k2.x, k2.y};
            }
#pragma unroll
            for (int sl = 0; sl < 4; ++sl) *(u32x2*)(CHVg + (((u * 4 + sl) * 3 + 2) * 64 + lane) * 8) = *(const u32x2*)(VT + (16 * sl + fr) * 16 + 4 * fq);
        }
        {
            f32x4 P00 = zero4, P01 = zero4, P10 = zero4, P11 = zero4;
#pragma unroll
            for (int s = 0; s < 2; ++s) {
                const bf16x8 a0 = *(const bf16x8*)(AR + fr * 72 + s * 32 + fq * 8), a1 = *(const bf16x8*)(AR + (16 + fr) * 72 + s * 32 + fq * 8);
                const bf16x8 b0 = *(const bf16x8*)(BK + fr * 72 + s * 32 + fq * 8), b1 = *(const bf16x8*)(BK + (16 + fr) * 72 + s * 32 + fq * 8);
                P00 = MFMA16(a0, b0, P00); P01 = MFMA16(a0, b1, P01); P10 = MFMA16(a1, b0, P10); P11 = MFMA16(a1, b1, P11);
            }
            WSYNC();
            float ak[4];
#pragma unroll
            for (int r = 0; r < 4; ++r) {
                const int i = 4 * fq + r, j = fr;
                Pab[i * 17 + j] = (j < i) ? P00[r] : 0.f;
                ak[r] = (j < i) ? P01[r] : 0.f;
                Arb[i * 24 + j] = f2bf((j <= i) ? P10[r] : 0.f);
                Ark[i * 24 + j] = f2bf((j <= i) ? P11[r] : 0.f);
            }
            *(u32x2*)(AakT + fr * 24 + 4 * fq) = (u32x2){pack2(ak[0], ak[1]), pack2(ak[2], ak[3])};
        }
        WSYNC();
        {
            float T[16];
#pragma unroll
            for (int i = 0; i < 16; ++i) {
                float acc = (i == fr) ? 1.f : 0.f;
#pragma unroll
                for (int j = 0; j < i; ++j) acc += Pab[i * 17 + j] * T[j];
                T[i] = acc;
            }
#pragma unroll
            for (int i = 0; i < 16; ++i) Tm[i * 24 + fr] = f2bf(T[i]);
            *(u32x2*)(ARBg + (u * 64 + lane) * 8) = *(const u32x2*)(Arb + fr * 24 + 4 * fq);
        }
        WSYNC();
        const bf16x8 Tld = *(const bf16x8*)(Tm + fr * 24 + (fq & 1) * 8);
        const bf16x8 Tf = (fq < 2) ? Tld : zero8;
        {
            f32x4 D[4];
#pragma unroll
            for (int ta = 0; ta < 4; ++ta) {
                const bf16x8 ald = *(const bf16x8*)(AtT + (16 * ta + fr) * 16 + (fq & 1) * 8);
                D[ta] = MFMA16((fq < 2) ? ald : zero8, Tf, zero4);
            }
            *(u32x4*)(AFg + (u * 64 + lane) * 32) = (u32x4){pack2(D[0][0], D[0][1]), pack2(D[0][2], D[0][3]), pack2(D[1][0], D[1][1]), pack2(D[1][2], D[1][3])};
            *(u32x4*)(AFg + (u * 64 + lane) * 32 + 16) = (u32x4){pack2(D[2][0], D[2][1]), pack2(D[2][2], D[2][3]), pack2(D[3][0], D[3][1]), pack2(D[3][2], D[3][3])};
            const bf16x8 akld = *(const bf16x8*)(AakT + fr * 24 + (fq & 1) * 8);
            const f32x4 M1 = MFMA16(Tf, (fq < 2) ? akld : zero8, zero4);
#pragma unroll
            for (int r = 0; r < 4; ++r) M1m[(4 * fq + r) * 24 + fr] = f2bf(M1[r]);
        }
        WSYNC();
        {
            const bf16x8 m1ld = *(const bf16x8*)(M1m + fr * 24 + (fq & 1) * 8), rkld = *(const bf16x8*)(Ark + fr * 24 + (fq & 1) * 8);
            const bf16x8 M1f = (fq < 2) ? m1ld : zero8, Arkf = (fq < 2) ? rkld : zero8;
#pragma unroll
            for (int sl = 0; sl < 4; ++sl) {
                const bf16x8 vld = *(const bf16x8*)(VT + (16 * sl + fr) * 16 + (fq & 1) * 8);
                const bf16x8 Vb = (fq < 2) ? vld : zero8;
                const f32x4 Uh = MFMA16(M1f, Vb, zero4), Y0 = MFMA16(Arkf, Vb, zero4);
                *(u32x2*)(CHVg + (((u * 4 + sl) * 3 + 0) * 64 + lane) * 8) = (u32x2){pack2(Uh[0], Uh[1]), pack2(Uh[2], Uh[3])};
                *(u32x2*)(CHVg + (((u * 4 + sl) * 3 + 1) * 64 + lane) * 8) = (u32x2){pack2(Y0[0], Y0[1]), pack2(Y0[2], Y0[3])};
            }
        }
        WSYNC();
    }
}

struct ChunkOps { u32x4 af0, af1, rf0, rf1, bk0, bk1, bk2, bk3; u32x2 arb, uh, y0, vf; f32x4 g0, g1, g2, g3; };
constexpr int RING_SLOT = 17408, RING_NS = 7, RING_D = 6;
__device__ __forceinline__ void lds_chunk_ops(ChunkOps& o, const LAS unsigned char* s, int sl, int lane, int fq) {
    o.af0 = *(const LAS u32x4*)(s + lane * 32); o.af1 = *(const LAS u32x4*)(s + lane * 32 + 16);
    o.rf0 = *(const LAS u32x4*)(s + 2048 + lane * 32); o.rf1 = *(const LAS u32x4*)(s + 2048 + lane * 32 + 16);
    o.bk0 = *(const LAS u32x4*)(s + 4096 + (0 * 64 + lane) * 16); o.bk1 = *(const LAS u32x4*)(s + 4096 + (1 * 64 + lane) * 16);
    o.bk2 = *(const LAS u32x4*)(s + 4096 + (2 * 64 + lane) * 16); o.bk3 = *(const LAS u32x4*)(s + 4096 + (3 * 64 + lane) * 16);
    o.uh = *(const LAS u32x2*)(s + 8192 + ((sl * 3 + 0) * 64 + lane) * 8);
    o.y0 = *(const LAS u32x2*)(s + 8192 + ((sl * 3 + 1) * 64 + lane) * 8);
    o.vf = *(const LAS u32x2*)(s + 8192 + ((sl * 3 + 2) * 64 + lane) * 8);
    o.arb = *(const LAS u32x2*)(s + 16384 + lane * 8);
    o.g0 = *(const LAS f32x4*)(s + 16896 + 16 * fq); o.g1 = *(const LAS f32x4*)(s + 16896 + 64 + 16 * fq);
    o.g2 = *(const LAS f32x4*)(s + 16896 + 128 + 16 * fq); o.g3 = *(const LAS f32x4*)(s + 16896 + 192 + 16 * fq);
}
template <int LW> __device__ __forceinline__ void ring_issue(const Params& p, LAS unsigned char* ring, int bh, int c, int lane) {
    const size_t u = (size_t)bh * 128 + c;
    LAS unsigned char* slot = ring + (c % RING_NS) * RING_SLOT;
    const unsigned char* ws = p.ws; const unsigned char* od = (const unsigned char*)p.out;
#pragma unroll
    for (int j = 0; j < 8; ++j) {
        constexpr int Q0 = LW * 8; const int q = Q0 + j;
        const unsigned char* g;
        if (q < 2) g = ws + CH_AF + u * 2048 + q * 1024 + lane * 16;
        else if (q < 4) g = ws + CH_RF + u * 2048 + (q - 2) * 1024 + lane * 16;
        else if (q < 8) g = ws + CH_BKF + u * 4096 + (q - 4) * 1024 + lane * 16;
        else if (q < 14) g = od + OUT_CHV + u * 6144 + (q - 8) * 1024 + lane * 16;
        else { const int i = (q - 14) * 64 + lane; g = od + OUT_GB + (((size_t)(bh >> 3) * 2048 + c * 16 + (i >> 3)) * 512 + (bh & 7) * 64) * 2 + (i & 7) * 16; }
        __builtin_amdgcn_global_load_lds((const unsigned*)g, (LAS unsigned*)(slot + q * 1024), 16, 0, 0);
    }
    if (LW == 0) {
        __builtin_amdgcn_global_load_lds((const unsigned*)(ws + CH_ARB + u * 512 + lane * 4), (LAS unsigned*)(slot + 16384), 4, 0, 0);
        __builtin_amdgcn_global_load_lds((const unsigned*)(ws + CH_ARB + u * 512 + 256 + lane * 4), (LAS unsigned*)(slot + 16384 + 256), 4, 0, 0);
    } else {
        __builtin_amdgcn_global_load_lds((const unsigned*)(ws + CH_G15 + u * 256 + lane * 4), (LAS unsigned*)(slot + 16896), 4, 0, 0);
        __builtin_amdgcn_global_load_lds((const unsigned*)(ws + WS_BONUS + ((size_t)bh * 2048 + c * 16) * 4 + (lane & 15) * 4), (LAS unsigned*)(slot + 17152), 4, 0, 0);
    }
}
template <int CTRL> __device__ __forceinline__ float dpp_add_q(float v) {
    const int t = __builtin_amdgcn_update_dpp(0, __float_as_int(v), CTRL, 0xf, 0xf, false);
    return v + __int_as_float(t);
}
__device__ __forceinline__ float oct_allsum(float v) {
    v = dpp_add_q<0xB1>(v); v = dpp_add_q<0x4E>(v); v = dpp_add_q<0x141>(v);
    return v;
}
struct EpiIn { u32x4 gb; float bon; u16 v[8]; };
__device__ __forceinline__ void epi_load(EpiIn& e, const LAS unsigned char* s, int t, int v0) {
    e.gb = *(const LAS u32x4*)(s + 14336 + t * 128 + v0 * 2);
    e.bon = *(const LAS float*)(s + 17152 + t * 4);
    const LAS unsigned char* vp = s + 8192 + (((v0 >> 4) * 3 + 2) * 64 + (t >> 2) * 16 + (v0 & 15)) * 8 + (t & 3) * 2;
#pragma unroll
    for (int i = 0; i < 8; ++i) e.v[i] = *(const LAS u16*)(vp + 8 * i);
}
template <int LW> __device__ __forceinline__ void p3_loader(const Params& p, LAS unsigned char* ring, int bh, int lane) {
#pragma unroll
    for (int c = 0; c < RING_D; ++c) ring_issue<LW>(p, ring, bh, c, lane);
    asm volatile("s_waitcnt vmcnt(40)" ::: "memory");
    __builtin_amdgcn_s_barrier();
#pragma unroll 1
    for (int c = 0; c < 128; ++c) {
        const int cn = (c + RING_D < 128) ? c + RING_D : 127;
        ring_issue<LW>(p, ring, bh, cn, lane);
        asm volatile("s_waitcnt vmcnt(40)" ::: "memory");
        __builtin_amdgcn_s_barrier();
    }
    asm volatile("s_waitcnt vmcnt(0)" ::: "memory");
}
__device__ void phase3(const Params& p) {
    const int tid = threadIdx.x, lane = tid & 63, wave = __builtin_amdgcn_readfirstlane(tid >> 6), fr = lane & 15, fq = lane >> 4;
    const int bh = blockIdx.x;
    if (bh >= 64) return;
    LAS unsigned char* ring = (LAS unsigned char*)dyn_smem;
    LAS float* ybuf = (LAS float*)(ring + RING_NS * RING_SLOT);
    if (wave >= 6) {
        const int e = (wave - 6) * 64 + lane, t = e >> 3, v0 = (e & 7) * 8, b = bh >> 3, h = bh & 7;
        f32x4 ga0 = *(const f32x4*)(p.gn_gain + h * 64 + v0), ga1 = *(const f32x4*)(p.gn_gain + h * 64 + v0 + 4);
        f32x4 bi0 = *(const f32x4*)(p.gn_bias + h * 64 + v0), bi1 = *(const f32x4*)(p.gn_bias + h * 64 + v0 + 4);
        u16* Y = (u16*)(p.ws + WS_Y);
        EpiIn cur, nxt;
        __builtin_amdgcn_s_barrier();
        epi_load(cur, ring, t, v0);
#pragma unroll 1
        for (int c = 0; c <= 128; ++c) {
            if (c >= 1) {
                const int cc = c - 1;
                { const int cn = (c < 128) ? c : 127; epi_load(nxt, ring + (cn % RING_NS) * RING_SLOT, t, v0); }
                const LAS float* yb = ybuf + (cc & 1) * (16 * 68) + t * 68 + v0;
                const f32x4 y0 = *(const LAS f32x4*)(yb), y1 = *(const LAS f32x4*)(yb + 4);
                float s1 = (y0[0] + y0[1]) + (y0[2] + y0[3]) + (y1[0] + y1[1]) + (y1[2] + y1[3]);
                float s2 = y0[0] * y0[0] + y0[1] * y0[1] + y0[2] * y0[2] + y0[3] * y0[3] + y1[0] * y1[0] + y1[1] * y1[1] + y1[2] * y1[2] + y1[3] * y1[3];
                s1 = oct_allsum(s1); s2 = oct_allsum(s2);
                const float mean = s1 * (1.f / 64.f);
                const float var = fmaxf(s2 * (1.f / 64.f) - mean * mean, 0.f);
                const float rstd = rsq_(var + 64e-5f);
                const float vvf[8] = {bf2f(cur.v[0]), bf2f(cur.v[1]), bf2f(cur.v[2]), bf2f(cur.v[3]), bf2f(cur.v[4]), bf2f(cur.v[5]), bf2f(cur.v[6]), bf2f(cur.v[7])};
                const float gbf[8] = {bflo(cur.gb.x), bfhi(cur.gb.x), bflo(cur.gb.y), bfhi(cur.gb.y), bflo(cur.gb.z), bfhi(cur.gb.z), bflo(cur.gb.w), bfhi(cur.gb.w)};
                float o[8];
#pragma unroll
                for (int i = 0; i < 8; ++i) {
                    const float yv = (i < 4) ? y0[i & 3] : y1[i & 3];
                    const float gn = (i < 4) ? ga0[i & 3] : ga1[i & 3], bs = (i < 4) ? bi0[i & 3] : bi1[i & 3];
                    const float yn = (yv - mean) * rstd * gn + bs;
                    o[i] = (yn + cur.bon * vvf[i]) * gbf[i] * sigmoidf_(gbf[i]);
                }
                *(u32x4*)(Y + ((size_t)b * 2048 + cc * 16 + t) * 1024 + 512 + h * 64 + v0) = (u32x4){pack2(o[0], o[1]), pack2(o[2], o[3]), pack2(o[4], o[5]), pack2(o[6], o[7])};
                cur = nxt;
            }
            if (c < 128) __builtin_amdgcn_s_barrier();
        }
        return;
    }
    if (wave >= 4) { if (wave == 4) p3_loader<0>(p, ring, bh, lane); else p3_loader<1>(p, ring, bh, lane); return; }
    const int sl = wave;
    f32x4 acc0 = (f32x4){0.f, 0.f, 0.f, 0.f}, acc1 = acc0, acc2 = acc0, acc3 = acc0;
    ChunkOps cur, nxt;
    __builtin_amdgcn_s_barrier();
    lds_chunk_ops(cur, ring, sl, lane, fq);
#pragma unroll 2
    for (int c = 0; c < 128; ++c) {
        { const int cn = (c + 1 < 128) ? c + 1 : c; lds_chunk_ops(nxt, ring + (cn % RING_NS) * RING_SLOT, sl, lane, fq); }
        const bf16x8 sb0 = as_bf8((u32x4){pack2(acc0[0], acc0[1]), pack2(acc0[2], acc0[3]), pack2(acc1[0], acc1[1]), pack2(acc1[2], acc1[3])});
        const bf16x8 sb1 = as_bf8((u32x4){pack2(acc2[0], acc2[1]), pack2(acc2[2], acc2[3]), pack2(acc3[0], acc3[1]), pack2(acc3[2], acc3[3])});
        f32x4 U = (f32x4){bflo(cur.uh.x), bfhi(cur.uh.x), bflo(cur.uh.y), bfhi(cur.uh.y)};
        U = MFMA16(as_bf8(cur.af0), sb0, U); U = MFMA16(as_bf8(cur.af1), sb1, U);
        f32x4 Yv = (f32x4){bflo(cur.y0.x), bfhi(cur.y0.x), bflo(cur.y0.y), bfhi(cur.y0.y)};
        Yv = MFMA16(as_bf8(cur.rf0), sb0, Yv); Yv = MFMA16(as_bf8(cur.rf1), sb1, Yv);
        const unsigned u01 = pack2(U[0], U[1]), u23 = pack2(U[2], U[3]);
        Yv = MFMA16(as_bf8((u32x4){cur.arb.x, cur.arb.y, 0u, 0u}), as_bf8((u32x4){u01, u23, 0u, 0u}), Yv);
        const bf16x8 uvb = as_bf8((u32x4){u01, u23, cur.vf.x, cur.vf.y});
        acc0 = MFMA16(as_bf8(cur.bk0), uvb, acc0 * cur.g0); acc1 = MFMA16(as_bf8(cur.bk1), uvb, acc1 * cur.g1);
        acc2 = MFMA16(as_bf8(cur.bk2), uvb, acc2 * cur.g2); acc3 = MFMA16(as_bf8(cur.bk3), uvb, acc3 * cur.g3);
        LAS float* yb = ybuf + (c & 1) * (16 * 68) + (4 * fq) * 68 + sl * 16 + fr;
        yb[0] = Yv[0]; yb[68] = Yv[1]; yb[136] = Yv[2]; yb[204] = Yv[3];
        asm volatile("s_waitcnt lgkmcnt(0)" ::: "memory");
        __builtin_amdgcn_s_barrier();
        asm volatile("" ::: "memory");
        cur = nxt;
    }
}

__device__ void phase5(const Params& p) {
    const int tid = threadIdx.x, lane = tid & 63, wave = tid >> 6, blk = blockIdx.x;
#pragma unroll 1
    for (int r0 = 0; r0 < 8; r0 += 4) {
        f32x4 v[4][4]; float ss[4];
#pragma unroll
        for (int i = 0; i < 4; ++i) {
            const f32x4* xr = (const f32x4*)(p.out + (size_t)(blk * 64 + wave * 8 + r0 + i) * DM);
#pragma unroll
            for (int q = 0; q < 4; ++q) v[i][q] = xr[lane + 64 * q];
        }
#pragma unroll
        for (int i = 0; i < 4; ++i) {
            float s = 0.f;
#pragma unroll
            for (int q = 0; q < 4; ++q) s += v[i][q][0] * v[i][q][0] + v[i][q][1] * v[i][q][1] + v[i][q][2] * v[i][q][2] + v[i][q][3] * v[i][q][3];
            ss[i] = wave_sum(s);
        }
#pragma unroll
        for (int i = 0; i < 4; ++i) {
            f32x4* xr = (f32x4*)(p.out + (size_t)(blk * 64 + wave * 8 + r0 + i) * DM);
            const float inv = rsq_(ss[i] * (1.f / 1024.f) + 1e-6f);
#pragma unroll
            for (int q = 0; q < 4; ++q) { const f32x4 g = ((const f32x4*)p.final_gain)[lane + 64 * q]; xr[lane + 64 * q] = v[i][q] * inv * g; }
        }
    }
}

__global__ void __launch_bounds__(512, 2) hybrid_fwd(Params p) {
    __shared__ uint4 xb_words;
    if (threadIdx.x == 0) xb_words = make_uint4(0u, 0u, 0u, 0u);
    __syncthreads();
    XcdBarrier bar; bar.bar = (unsigned*)(p.ws + WS_CTL); bar.x = 0; bar.st = (volatile LAS unsigned*)&xb_words;
    const int lo = p.ph_lo, hi = p.ph_hi;
    if (hi - lo > 1) bar = xcd_barrier_post((unsigned*)(p.ws + WS_CTL), (volatile LAS unsigned*)&xb_words);
#define IN(k) (lo <= (k) && (k) < hi)
#define SEAM(k) do { if (IN(k) && IN((k) + 1)) xcd_barrier(bar); } while (0)
#define RUN(k, f) do { if (IN(k)) { if (PROBE_DUP == (k)) { for (int _r = 0; _r < p.dup_n; ++_r) { if (_r) __syncthreads(); f(p); } } else f(p); } } while (0)
    RUN(0, phase0);
    SEAM(0);
    RUN(1, phase1);
    SEAM(1);
    RUN(2, phase2);
    SEAM(2);
    RUN(3, phase3);
    SEAM(3);
    RUN(4, phase4);
}

extern "C" void kernel_launch(void* const* d_in, const int* in_sizes, int n_in, void* d_out, int out_size, void* d_ws, size_t ws_size, hipStream_t stream) {
    static int grid = 0;
    if (grid == 0) {
        if (n_in != 17 || out_size != NTOK * DM || ws_size < WS_END) { fprintf(stderr, "kernel_launch: unexpected problem (n_in %d out %d ws %zu need %zu)\n", n_in, out_size, ws_size, (size_t)WS_END); grid = -1; return; }
        if (hipFuncSetAttribute((const void*)hybrid_fwd, hipFuncAttributeMaxDynamicSharedMemorySize, LDS_BYTES) != hipSuccess) { fprintf(stderr, "kernel_launch: hipFuncSetAttribute failed\n"); grid = -1; return; }
        int per_cu = 0;
        if (hipOccupancyMaxActiveBlocksPerMultiprocessor(&per_cu, (const void*)hybrid_fwd, 512, LDS_BYTES) != hipSuccess || per_cu < 1) fprintf(stderr, "kernel_launch: occupancy query says %d blocks per CU\n", per_cu);
        (void)hipGetLastError();
        grid = 256;
    }
    if (grid < 0) return;
    (void)hipMemsetAsync((char*)d_ws + WS_CTL, 0, 16384, stream);
    Params p{};
    p.x = (const float*)d_in[0]; p.norm_gain = (const float*)d_in[1]; p.w_in = (const float*)d_in[2]; p.pool_w = (const float*)d_in[3];
    p.pool_scale = (const float*)d_in[4]; p.shift_mu = (const float*)d_in[5]; p.w0 = (const float*)d_in[6]; p.w_up = (const float*)d_in[7];
    p.a0 = (const float*)d_in[8]; p.a_up = (const float*)d_in[9]; p.k_k = (const float*)d_in[10]; p.k_a = (const float*)d_in[11];
    p.r_k = (const float*)d_in[12]; p.gn_gain = (const float*)d_in[13]; p.gn_bias = (const float*)d_in[14]; p.w_out = (const float*)d_in[15];
    p.final_gain = (const float*)d_in[16];
    p.out = (float*)d_out; p.ws = (unsigned char*)d_ws; p.dup_n = 2;
#if N_LAUNCHES == 1
    p.ph_lo = 0; p.ph_hi = NPH;
    hipLaunchKernelGGL(hybrid_fwd, dim3(grid), dim3(512), LDS_BYTES, stream, p);
#else
    for (int k = 0; k < NPH; ++k) { p.ph_lo = k; p.ph_hi = k + 1; hipLaunchKernelGGL(hybrid_fwd, dim3(grid), dim3(512), LDS_BYTES, stream, p); }
#endif
}
```

```cpp
#include <hip/hip_runtime.h>
#include <stdint.h>
#include <cstdio>

typedef unsigned short u16;
typedef short bf16x8 __attribute__((ext_vector_type(8)));
typedef float f32x4 __attribute__((ext_vector_type(4)));
typedef float f32x2 __attribute__((ext_vector_type(2)));
typedef unsigned u32x2 __attribute__((ext_vector_type(2)));
typedef unsigned u32x4 __attribute__((ext_vector_type(4)));

#ifndef PROBE_DUP
#define PROBE_DUP -1
#endif
#ifndef N_LAUNCHES
#define N_LAUNCHES 1
#endif

constexpr int NTOK = 16384, DM = 1024, SEQ = 2048, DIN = 3200, DINP = 3328;
constexpr int NPH = 5;
constexpr int LDS_BYTES = 18432 + 8 * 17408;

constexpr size_t WS_CTL = 0;
constexpr size_t WS_WINT = 16384;
constexpr size_t WS_WOUTT = WS_WINT + (size_t)DINP * 1024 * 2;
constexpr size_t WS_WUPT = WS_WOUTT + (size_t)1024 * 1024 * 2;
constexpr size_t WS_AUPT = WS_WUPT + 512 * 64 * 2;
constexpr size_t WS_POOLT = WS_AUPT + 512 * 64 * 2;
constexpr size_t WS_Z = WS_POOLT + 4 * 128 * 128 * 2;
constexpr size_t WS_REC = WS_Z + (size_t)NTOK * DIN * 2;
constexpr size_t WS_Y = WS_REC + (size_t)64 * 2048 * 896;
constexpr size_t WS_BONUS = WS_Y + (size_t)NTOK * 1024 * 2;
constexpr size_t WS_PART = WS_BONUS + (size_t)64 * 2048 * 4;
constexpr size_t WS_END = WS_PART + (size_t)64 * 4 * 256 * 4;
constexpr int CTL_CNT_WORD = 3584;
constexpr int NUNIT = 64 * 128;
constexpr size_t CH_AF = WS_REC;
constexpr size_t CH_RF = CH_AF + (size_t)NUNIT * 2048;
constexpr size_t CH_BKF = CH_RF + (size_t)NUNIT * 2048;
constexpr size_t CH_ARB = CH_BKF + (size_t)NUNIT * 4096;
constexpr size_t CH_G15 = CH_ARB + (size_t)NUNIT * 512;
constexpr size_t CH_END = CH_G15 + (size_t)NUNIT * 256;
constexpr size_t WS_VB = CH_END;
static_assert(WS_VB + (size_t)NTOK * 512 * 2 <= WS_Y, "chunk operands + v must fit in the record region");
constexpr size_t OUT_CHV = 0;
constexpr size_t OUT_GB = (size_t)NUNIT * 4 * 3 * 512;
static_assert(OUT_GB + (size_t)NTOK * 512 * 2 <= (size_t)NTOK * DM * 4, "d_out scratch");

struct Params {
    const float* x; const float* norm_gain; const float* w_in; const float* pool_w; const float* pool_scale;
    const float* shift_mu; const float* w0; const float* w_up; const float* a0; const float* a_up;
    const float* k_k; const float* k_a; const float* r_k; const float* gn_gain; const float* gn_bias;
    const float* w_out; const float* final_gain;
    float* out; unsigned char* ws;
    int ph_lo, ph_hi, dup_n, pad;
};

extern __shared__ __attribute__((aligned(16))) unsigned char dyn_smem[];

__device__ __forceinline__ float bf2f(u16 v) { return __uint_as_float(((unsigned)v) << 16); }
__device__ __forceinline__ float bflo(unsigned v) { return __uint_as_float(v << 16); }
__device__ __forceinline__ float bfhi(unsigned v) { return __uint_as_float(v & 0xffff0000u); }
typedef __bf16 bf16x2_t __attribute__((ext_vector_type(2)));
__device__ __forceinline__ unsigned pack2(float lo, float hi) { bf16x2_t v = {(__bf16)lo, (__bf16)hi}; return __builtin_bit_cast(unsigned, v); }
__device__ __forceinline__ u16 f2bf(float f) { return (u16)(pack2(f, 0.f) & 0xffffu); }
__device__ __forceinline__ float wave_sum(float v) {
#pragma unroll
    for (int m = 32; m >= 1; m >>= 1) v += __shfl_xor(v, m, 64);
    return v;
}
__device__ __forceinline__ float rcp_(float v) { return __builtin_amdgcn_rcpf(v); }
__device__ __forceinline__ float rsq_(float v) { return __builtin_amdgcn_rsqf(v); }
__device__ __forceinline__ float sigmoidf_(float v) { return rcp_(1.f + __expf(-v)); }
__device__ __forceinline__ float tanhf_(float v) { return 1.f - 2.f * rcp_(1.f + __expf(2.f * v)); }

#define XB_TMO      128
#define XB_XCNT(j)  (256  + 64 * (j))
#define XB_XSUB(j)  (1280 + 64 * (j))
#define XB_XGEN(j)  (2304 + 64 * (j))
#define XB_TOP      3328
#define XB_TOPGEN   3392
#define XCD_BAR_WORDS 3456
#define XB_SPIN_CAP (1u << 22)
#define LAS __attribute__((address_space(3)))

__device__ __forceinline__ unsigned xb_ld(unsigned* p)              { return __hip_atomic_load(p, __ATOMIC_RELAXED, __HIP_MEMORY_SCOPE_AGENT); }
__device__ __forceinline__ unsigned xb_add(unsigned* p, unsigned v) { return __hip_atomic_fetch_add(p, v, __ATOMIC_RELAXED, __HIP_MEMORY_SCOPE_AGENT); }
__device__ __forceinline__ unsigned xb_xcc_id() { return (unsigned)__builtin_amdgcn_s_getreg((3 << 11) | 20) & 0xFu; }
#define XB_SPIN(cond, bar) do { unsigned _sp = 0; while (cond) { __builtin_amdgcn_s_sleep(1); \
    if ((++_sp & 255u) == 0u) { if (xb_ld(&(bar)[XB_TMO])) break; if (_sp > XB_SPIN_CAP) { atomicAdd(&(bar)[XB_TMO], 1u); break; } } } } while (0)

struct XcdBarrier { unsigned* bar; unsigned x; volatile LAS unsigned* st; };

__device__ __forceinline__ XcdBarrier xcd_barrier_post(unsigned* bar, volatile LAS unsigned* st) {
    XcdBarrier b; b.bar = bar; b.x = xb_xcc_id(); b.st = st;
    if (threadIdx.x == 0) (void)xb_add(&bar[XB_XCNT(b.x)], 1u);
    return b;
}
__device__ __forceinline__ void xcd_barrier_complete(unsigned* bar, unsigned x, unsigned& nloc, unsigned& nx) {
    const unsigned G = gridDim.x * gridDim.y * gridDim.z;
    unsigned sum, cnt, mine, sp = 0u;
    for (;;) {
        sum = 0u; cnt = 0u; mine = 0u;
#pragma unroll
        for (unsigned j = 0; j < 16; ++j) { const unsigned c = xb_ld(&bar[XB_XCNT(j)]); sum += c; cnt += (c > 0u) ? 1u : 0u; mine = (j == x) ? c : mine; }
        if (sum == G) break;
        __builtin_amdgcn_s_sleep(1);
        if ((++sp & 255u) == 0u) { if (xb_ld(&bar[XB_TMO])) break; if (sp > XB_SPIN_CAP) { atomicAdd(&bar[XB_TMO], 1u); break; } }
    }
    nloc = mine > 0u ? mine : 1u; nx = cnt > 0u ? cnt : 1u;
}
__device__ __forceinline__ void xcd_barrier(const XcdBarrier& b) {
    asm volatile("s_waitcnt vmcnt(0)" ::: "memory");
    __syncthreads();
    if (threadIdx.x == 0) {
        unsigned* bar = b.bar;
        __builtin_amdgcn_s_waitcnt(0);
        unsigned nloc = b.st[0], nx = b.st[1];
        if (nloc == 0u) { xcd_barrier_complete(bar, b.x, nloc, nx); b.st[0] = nloc; b.st[1] = nx; }
        const unsigned old = xb_add(&bar[XB_XSUB(b.x)], 1u);
        const unsigned gen = old / nloc;
        if (old + 1u == (gen + 1u) * nloc) {
            __builtin_amdgcn_fence(__ATOMIC_RELEASE, "agent");
            asm volatile("s_waitcnt vmcnt(0)" ::: "memory");
            const unsigned og = xb_add(&bar[XB_TOP], 1u);
            const unsigned tg = og / nx;
            if (og + 1u == (tg + 1u) * nx) xb_add(&bar[XB_TOPGEN], 1u);
            else XB_SPIN(xb_ld(&bar[XB_TOPGEN]) == tg, bar);
            __builtin_amdgcn_fence(__ATOMIC_ACQUIRE, "agent");
            xb_add(&bar[XB_XGEN(b.x)], 1u);
            asm volatile("s_waitcnt vmcnt(0)" ::: "memory");
        } else {
            XB_SPIN(xb_ld(&bar[XB_XGEN(b.x)]) == gen, bar);
            __builtin_amdgcn_fence(__ATOMIC_ACQUIRE, "agent");
            asm volatile("s_waitcnt vmcnt(0)" ::: "memory");
        }
    }
    __syncthreads();
}

constexpr int BM = 256, BK = 64, HALF = 128, HTB = HALF * BK * 2, STAGE_BYTES = 8 * HTB, NXCD = 8, WGM = 8;
__device__ __forceinline__ int lds_byte(int r, int c) { const int st = (r >> 4) * 2 + (c >> 5), rr = r & 15, cc = c & 31, ob = rr * 64 + cc * 2; return st * 1024 + (ob ^ (((ob >> 9) & 1) << 5)); }
__device__ __forceinline__ void stage_rc(int b, int& R, int& C) { const int st = b / 1024, sb = b % 1024, swz = sb ^ (((sb >> 9) & 1) << 5); R = (st >> 1) * 16 + swz / 64; C = (st & 1) * 32 + (swz % 64) / 2; }
__device__ __forceinline__ int perm32(int rho) { const int n = rho >> 4, i = rho & 15; return 8 * (i >> 2) + 4 * n + (i & 3); }

struct Unit { int pm, pn; };
struct Gemm { const u16* A; const u16* Bt; int M, N, K, Nvalid; };
struct StaticOrder {
    int nM, nN, nwg, G, c;
    __device__ void init(int M, int N, int G_, int c_) { nM = M / BM; nN = N / BM; nwg = nM * nN; G = G_; c = c_; }
    __device__ bool next(int i, Unit& u) const {
        const long L = (long)i * G + c; if (L >= nwg) return false;
        int wgid = (int)L; { const int q = nwg / NXCD, r = nwg % NXCD, xcd = wgid % NXCD, off = wgid / NXCD; wgid = (xcd < r ? xcd * (q + 1) : r * (q + 1) + (xcd - r) * q) + off; }
        const int nig = WGM * nN, gid = wgid / nig, fm = gid * WGM, gsz = (nM - fm) < WGM ? (nM - fm) : WGM;
        u.pm = fm + ((wgid % nig) % gsz); u.pn = (wgid % nig) / gsz; return true;
    }
};
struct EpiZ {
    static constexpr bool PERM = true, AFTER_DRAIN = false;
    u16* Z;
    __device__ __forceinline__ void operator()(const f32x4 (&acc)[2][2][4][2], const Unit& u, int wr, int wc, int fr, int fq) const {
        const int row0 = u.pm * BM + wr * 64 + fr, col0 = u.pn * BM + wc * 32 + 8 * fq;
#pragma unroll
        for (int ai = 0; ai < 2; ++ai)
#pragma unroll
            for (int m = 0; m < 4; ++m) { u16* rowp = Z + (size_t)(row0 + ai * HALF + m * 16) * DIN;
#pragma unroll
                for (int bj = 0; bj < 2; ++bj) { const int col = col0 + bj * HALF; const f32x4 v0 = acc[ai][bj][m][0], v1 = acc[ai][bj][m][1];
                    if (col < DIN) *(u32x4*)(rowp + col) = (u32x4){pack2(v0[0], v0[1]), pack2(v0[2], v0[3]), pack2(v1[0], v1[1]), pack2(v1[2], v1[3])}; } }
    }
};
struct EpiRes {
    static constexpr bool PERM = false, AFTER_DRAIN = false;
    const float* x; float* out;
    __device__ __forceinline__ void operator()(const f32x4 (&acc)[2][2][4][2], const Unit& u, int wr, int wc, int fr, int fq) const {
        const int row0 = u.pm * BM + wr * 64 + fr, col0 = u.pn * BM + wc * 32 + 4 * fq;
#pragma unroll
        for (int ai = 0; ai < 2; ++ai)
#pragma unroll
            for (int m = 0; m < 4; ++m) { const size_t ro = (size_t)(row0 + ai * HALF + m * 16) * DM + col0;
#pragma unroll
                for (int bj = 0; bj < 2; ++bj)
#pragma unroll
                    for (int n = 0; n < 2; ++n) { const f32x4 xv = *(const f32x4*)(x + ro + bj * HALF + n * 16); *(f32x4*)(out + ro + bj * HALF + n * 16) = xv + acc[ai][bj][m][n]; } }
    }
};
struct EpiResNorm {
    static constexpr bool PERM = false, AFTER_DRAIN = true;
    const float* x; const float* gain; float* out; float* part; unsigned* cnt;
    __device__ __forceinline__ void fused(f32x4 (&acc)[2][2][4][2], const Unit& u, int wr, int wc, int fr, int fq, LAS unsigned char* lds) const {
        const int row0 = u.pm * BM + wr * 64 + fr, col0 = u.pn * BM + wc * 32 + 4 * fq;
        LAS float* red = (LAS float*)lds;
        LAS float* tot = red + 1024;
        float rs[2][4];
#pragma unroll
        for (int ai = 0; ai < 2; ++ai)
#pragma unroll
            for (int m = 0; m < 4; ++m) { const size_t ro = (size_t)(row0 + ai * HALF + m * 16) * DM + col0; float s = 0.f;
#pragma unroll
                for (int bj = 0; bj < 2; ++bj)
#pragma unroll
                    for (int n = 0; n < 2; ++n) { const f32x4 v = __builtin_nontemporal_load((const f32x4*)(x + ro + bj * HALF + n * 16)) + acc[ai][bj][m][n]; acc[ai][bj][m][n] = v; s += v[0] * v[0] + v[1] * v[1] + v[2] * v[2] + v[3] * v[3]; }
                s += __shfl_xor(s, 16, 64); s += __shfl_xor(s, 32, 64);
                rs[ai][m] = s; }
        if (fq == 0) {
#pragma unroll
            for (int ai = 0; ai < 2; ++ai)
#pragma unroll
                for (int m = 0; m < 4; ++m) red[((wr * 4 + wc) * 8 + ai * 4 + m) * 16 + fr] = rs[ai][m];
        }
        __syncthreads();
        if (threadIdx.x < 256) {
            const int rl = threadIdx.x, ai = rl >> 7, wr_ = (rl >> 6) & 1, m = (rl >> 4) & 3, fr_ = rl & 15;
            const int o = ((wr_ * 4) * 8 + ai * 4 + m) * 16 + fr_;
            const float s = red[o] + red[o + 128] + red[o + 256] + red[o + 384];
            __hip_atomic_store(part + ((size_t)u.pm * 4 + u.pn) * 256 + rl, s, __ATOMIC_RELAXED, __HIP_MEMORY_SCOPE_AGENT);
        }
        asm volatile("s_waitcnt vmcnt(0)" ::: "memory");
        __syncthreads();
        if (threadIdx.x == 0) {
            __builtin_amdgcn_fence(__ATOMIC_RELEASE, "agent");
            asm volatile("s_waitcnt vmcnt(0)" ::: "memory");
            __hip_atomic_fetch_add(cnt + u.pm, 1u, __ATOMIC_RELAXED, __HIP_MEMORY_SCOPE_AGENT);
            unsigned sp = 0;
            while (__hip_atomic_load(cnt + u.pm, __ATOMIC_RELAXED, __HIP_MEMORY_SCOPE_AGENT) < 4u) { __builtin_amdgcn_s_sleep(1); if (++sp > (1u << 24)) break; }
            __builtin_amdgcn_fence(__ATOMIC_ACQUIRE, "agent");
            asm volatile("s_waitcnt vmcnt(0)" ::: "memory");
        }
        __syncthreads();
        for (int e = threadIdx.x; e < 1024; e += 512) tot[e] = __hip_atomic_load(part + (size_t)u.pm * 1024 + e, __ATOMIC_RELAXED, __HIP_MEMORY_SCOPE_AGENT);
        __syncthreads();
#pragma unroll
        for (int ai = 0; ai < 2; ++ai)
#pragma unroll
            for (int m = 0; m < 4; ++m) { const int rl = ai * 128 + wr * 64 + m * 16 + fr;
                const float inv = rsq_((tot[rl] + tot[256 + rl] + tot[512 + rl] + tot[768 + rl]) * (1.f / 1024.f) + 1e-6f);
                const size_t ro = (size_t)(row0 + ai * HALF + m * 16) * DM + col0;
#pragma unroll
                for (int bj = 0; bj < 2; ++bj)
#pragma unroll
                    for (int n = 0; n < 2; ++n) { const f32x4 g = *(const f32x4*)(gain + col0 + bj * HALF + n * 16); __builtin_nontemporal_store(acc[ai][bj][m][n] * inv * g, (f32x4*)(out + ro + bj * HALF + n * 16)); } }
    }
};

template <class Epi, class Sched>
__device__ __forceinline__ void gemm_phase(LAS unsigned char* lds, const Gemm g, const Sched& S, const Epi& E) {
    const int tid = threadIdx.x, wid = __builtin_amdgcn_readfirstlane(tid >> 6), lane = tid & 63, wr = wid >> 2, wc = wid & 3, fr = lane & 15, fq = lane >> 4;
    const int K = g.K, nt = K / BK;
    unsigned voffA[2], voffB[2];
#pragma unroll
    for (int i = 0; i < 2; ++i) { int R, C; stage_rc(tid * 16 + i * 8192, R, C); const int Rb = Epi::PERM ? ((R & ~31) + perm32(R & 31)) : R;
        voffA[i] = (unsigned)(R * K + C) * 2u; voffB[i] = (unsigned)(Rb * K + C) * 2u; }
    const size_t kstep = (size_t)(BK * 2);
    const size_t hstep = (size_t)HALF * K * 2;
    const size_t tstep = 2 * hstep;
    const unsigned ldsw = (unsigned)wid * 1024u;
    const int aoff = lds_byte(wr * 64 + fr, fq * 8), boff = lds_byte(wc * 32 + fr, fq * 8);
#define PG8_SA(b, h) (((b) * 2 + (h)) * HTB)
#define PG8_SB(b, h) ((4 + (b) * 2 + (h)) * HTB)
#define PG8_STAGE(bufoff, gbase, voff) do { _Pragma("unroll") for (int _i = 0; _i < 2; ++_i) \
        __builtin_amdgcn_global_load_lds((const unsigned*)((const char*)(gbase) + (voff)[_i]), (LAS unsigned*)(lds + (bufoff) + ldsw + _i * 8192), 16, 0, 0); } while (0)
#define PG8_LDA(dst, b, h) do { _Pragma("unroll") for (int m = 0; m < 4; ++m) _Pragma("unroll") for (int k = 0; k < 2; ++k) dst[m][k] = *(const LAS bf16x8*)(lds + PG8_SA(b, h) + aoff + m * 2048 + k * 1024); } while (0)
#define PG8_LDB(dst, b, h) do { _Pragma("unroll") for (int n = 0; n < 2; ++n) _Pragma("unroll") for (int k = 0; k < 2; ++k) dst[n][k] = *(const LAS bf16x8*)(lds + PG8_SB(b, h) + boff + n * 2048 + k * 1024); } while (0)
#define PG8_MMA(ai, bj, At, Bt) do { __builtin_amdgcn_s_setprio(1); _Pragma("unroll") for (int m = 0; m < 4; ++m) _Pragma("unroll") for (int n = 0; n < 2; ++n) _Pragma("unroll") for (int k = 0; k < 2; ++k) \
        acc[ai][bj][m][n] = __builtin_amdgcn_mfma_f32_16x16x32_bf16(Bt[n][k], At[m][k], acc[ai][bj][m][n], 0, 0, 0); __builtin_amdgcn_s_setprio(0); } while (0)
#define PG8_WAIT_V(n) asm volatile("s_waitcnt vmcnt(" #n ")" ::: "memory")
#define PG8_WAIT_L(n) asm volatile("s_waitcnt lgkmcnt(" #n ")" ::: "memory")
#define PG8_BAR __builtin_amdgcn_s_barrier()
#define PG8_SCHED __builtin_amdgcn_sched_barrier(0)
    Unit cur, nxt; int ui = 0;
    if (!S.next(0, cur)) return;
    f32x4 acc[2][2][4][2];
#pragma unroll
    for (int a = 0; a < 2; ++a)
#pragma unroll
        for (int b = 0; b < 2; ++b)
#pragma unroll
            for (int m = 0; m < 4; ++m)
#pragma unroll
                for (int n = 0; n < 2; ++n) acc[a][b][m][n] = (f32x4){0.f, 0.f, 0.f, 0.f};
    bf16x8 At[4][2], B0[2][2], B1[2][2];
    const char* cA = (const char*)g.A + (size_t)cur.pm * tstep; const char* cB = (const char*)g.Bt + (size_t)cur.pn * tstep;
    PG8_STAGE(PG8_SB(0, 0), cB, voffB); PG8_STAGE(PG8_SA(0, 0), cA, voffA); PG8_STAGE(PG8_SB(0, 1), cB + hstep, voffB); PG8_STAGE(PG8_SA(0, 1), cA + hstep, voffA);
    if (wr == 1) PG8_BAR;
    PG8_WAIT_V(4); PG8_BAR;
    PG8_STAGE(PG8_SB(1, 0), cB + kstep, voffB); PG8_STAGE(PG8_SA(1, 0), cA + kstep, voffA); PG8_STAGE(PG8_SB(1, 1), cB + hstep + kstep, voffB);
    PG8_WAIT_V(6); PG8_BAR;
    for (;;) {
        const bool has_next = S.next(ui + 1, nxt);
        const char* nA = has_next ? (const char*)g.A + (size_t)nxt.pm * tstep : cA; const char* nB = has_next ? (const char*)g.Bt + (size_t)nxt.pn * tstep : cB;
        const bool rhalf = (cur.pn * BM + HALF) < g.Nvalid;
        for (int t = 0; t < nt; t += 2) {
            const bool last = (t == nt - 2);
            const char* a1 = cA + (size_t)(t + 1) * kstep;
            const char* a2 = last ? nA : cA + (size_t)(t + 2) * kstep; const char* b2 = last ? nB : cB + (size_t)(t + 2) * kstep;
            const char* a3 = a2 + kstep; const char* b3 = b2 + kstep;
            PG8_LDB(B0, 0, 0); PG8_SCHED; PG8_LDA(At, 0, 0); PG8_STAGE(PG8_SA(1, 1), a1 + hstep, voffA);
            PG8_WAIT_L(8); PG8_BAR; PG8_WAIT_L(0); PG8_MMA(0, 0, At, B0); PG8_BAR; PG8_SCHED;
            PG8_LDB(B1, 0, 1); PG8_STAGE(PG8_SB(0, 0), b2, voffB);
            PG8_BAR; PG8_WAIT_L(0); if (rhalf) PG8_MMA(0, 1, At, B1); PG8_BAR;
            PG8_LDA(At, 0, 1); PG8_STAGE(PG8_SA(0, 0), a2, voffA);
            PG8_BAR; PG8_WAIT_L(0); PG8_MMA(1, 0, At, B0); PG8_BAR; PG8_SCHED;
            PG8_STAGE(PG8_SB(0, 1), b2 + hstep, voffB);
            PG8_WAIT_V(6); PG8_BAR; if (rhalf) PG8_MMA(1, 1, At, B1); PG8_BAR;
            PG8_LDB(B0, 1, 0); PG8_SCHED; PG8_LDA(At, 1, 0); PG8_STAGE(PG8_SA(0, 1), a2 + hstep, voffA);
            PG8_WAIT_L(8); PG8_BAR; PG8_WAIT_L(0); PG8_MMA(0, 0, At, B0); PG8_BAR; PG8_SCHED;
            PG8_LDB(B1, 1, 1); PG8_STAGE(PG8_SB(1, 0), b3, voffB);
            PG8_BAR; PG8_WAIT_L(0); if (rhalf) PG8_MMA(0, 1, At, B1); PG8_BAR;
            PG8_LDA(At, 1, 1); PG8_STAGE(PG8_SA(1, 0), a3, voffA);
            PG8_BAR; PG8_WAIT_L(0); PG8_MMA(1, 0, At, B0); PG8_BAR; PG8_SCHED;
            PG8_STAGE(PG8_SB(1, 1), b3 + hstep, voffB);
            PG8_WAIT_V(6); PG8_BAR; if (rhalf) PG8_MMA(1, 1, At, B1); PG8_BAR;
        }
        if constexpr (!Epi::AFTER_DRAIN) E(acc, cur, wr, wc, fr, fq);
        if (!has_next) break;
#pragma unroll
        for (int a = 0; a < 2; ++a)
#pragma unroll
            for (int b = 0; b < 2; ++b)
#pragma unroll
                for (int m = 0; m < 4; ++m)
#pragma unroll
                    for (int n = 0; n < 2; ++n) acc[a][b][m][n] = (f32x4){0.f, 0.f, 0.f, 0.f};
        cur = nxt; cA = nA; cB = nB; ++ui;
    }
    PG8_WAIT_V(0);
    if (wr == 0) PG8_BAR;
    PG8_BAR;
    if constexpr (Epi::AFTER_DRAIN) E.fused(acc, cur, wr, wc, fr, fq, lds);
#undef PG8_SA
#undef PG8_SB
#undef PG8_STAGE
#undef PG8_LDA
#undef PG8_LDB
#undef PG8_MMA
#undef PG8_WAIT_V
#undef PG8_WAIT_L
#undef PG8_BAR
#undef PG8_SCHED
}

#define WSYNC() do { __builtin_amdgcn_wave_barrier(); asm volatile("s_waitcnt lgkmcnt(0)" ::: "memory"); __builtin_amdgcn_wave_barrier(); } while (0)
__device__ void phase0(const Params& p) {
    const int tid = threadIdx.x, lane = tid & 63, wave = tid >> 6, blk = blockIdx.x;
    u16* Hbf = (u16*)p.out;
#pragma unroll 1
    for (int r0 = 0; r0 < 8; r0 += 4) {
        f32x4 v[4][4]; float ss[4];
#pragma unroll
        for (int i = 0; i < 4; ++i) {
            const f32x4* xr = (const f32x4*)(p.x + (size_t)(blk * 64 + wave * 8 + r0 + i) * DM);
#pragma unroll
            for (int q = 0; q < 4; ++q) v[i][q] = __builtin_nontemporal_load(xr + lane + 64 * q);
        }
#pragma unroll
        for (int i = 0; i < 4; ++i) {
            float s = 0.f;
#pragma unroll
            for (int q = 0; q < 4; ++q) s += v[i][q][0] * v[i][q][0] + v[i][q][1] * v[i][q][1] + v[i][q][2] * v[i][q][2] + v[i][q][3] * v[i][q][3];
            ss[i] = wave_sum(s);
        }
#pragma unroll
        for (int i = 0; i < 4; ++i) {
            const int row = blk * 64 + wave * 8 + r0 + i;
            const float inv = rsq_(ss[i] * (1.f / 1024.f) + 1e-6f);
#pragma unroll
            for (int q = 0; q < 4; ++q) {
                const f32x4 g = ((const f32x4*)p.norm_gain)[lane + 64 * q];
                u32x2 o; o.x = pack2(v[i][q][0] * inv * g[0], v[i][q][1] * inv * g[1]); o.y = pack2(v[i][q][2] * inv * g[2], v[i][q][3] * inv * g[3]);
                *(u32x2*)(Hbf + (size_t)row * DM + (lane + 64 * q) * 4) = o;
            }
        }
    }
    u16* WinT = (u16*)(p.ws + WS_WINT); u16* WoutT = (u16*)(p.ws + WS_WOUTT);
    {
        float* tl = (float*)dyn_smem + wave * (64 * 65);
        const int t = blk + 256 * wave;
        if (t < 832 + 256) {
            const float* src; u16* dst; int kt, ntile, N;
            if (t < 832) { kt = t & 15; ntile = t >> 4; src = p.w_in; N = DIN; dst = WinT; }
            else { const int t2 = t - 832; kt = t2 & 15; ntile = t2 >> 4; src = p.w_out; N = 1024; dst = WoutT; }
            const int k0 = kt * 64, n0 = ntile * 64, n4 = (lane & 15) * 4;
            f32x4 v[16];
#pragma unroll
            for (int i = 0; i < 16; ++i) { const int kk = (lane >> 4) + 4 * i; v[i] = (n0 + n4 < N) ? *(const f32x4*)(src + (size_t)(k0 + kk) * N + n0 + n4) : (f32x4){0.f, 0.f, 0.f, 0.f}; }
#pragma unroll
            for (int i = 0; i < 16; ++i) { const int kk = (lane >> 4) + 4 * i; float* d = tl + kk * 65 + n4; d[0] = v[i][0]; d[1] = v[i][1]; d[2] = v[i][2]; d[3] = v[i][3]; }
            WSYNC();
            const int kp = lane & 31, nh = lane >> 5;
#pragma unroll 8
            for (int i = 0; i < 32; ++i) { const int nn = 2 * i + nh;
                *(unsigned*)(dst + (size_t)(n0 + nn) * 1024 + k0 + 2 * kp) = pack2(tl[(2 * kp) * 65 + nn], tl[(2 * kp + 1) * 65 + nn]); }
        }
    }
    u16* WupT = (u16*)(p.ws + WS_WUPT); u16* AupT = (u16*)(p.ws + WS_AUPT); u16* PoolT = (u16*)(p.ws + WS_POOLT);
    const int gt = blk * 512 + tid;
    if (gt < 32768) { const int c = gt >> 6, j = gt & 63; WupT[gt] = f2bf(p.w_up[j * 512 + c]); AupT[gt] = f2bf(p.a_up[j * 512 + c]); }
    if (gt < 65536) { const int g = gt >> 14, d = (gt >> 7) & 127, c = gt & 127; PoolT[gt] = f2bf(p.pool_w[(g * 128 + c) * 128 + d]); }
}

__device__ void phase1(const Params& p) {
    Gemm g; g.A = (const u16*)p.out; g.Bt = (const u16*)(p.ws + WS_WINT); g.M = NTOK; g.N = DINP; g.K = 1024; g.Nvalid = DIN;
    StaticOrder S; S.init(NTOK, DINP, 256, blockIdx.x);
    EpiZ E; E.Z = (u16*)(p.ws + WS_Z);
    gemm_phase((LAS unsigned char*)dyn_smem, g, S, E);
}
__device__ void phase4(const Params& p) {
    Gemm g; g.A = (const u16*)(p.ws + WS_Y); g.Bt = (const u16*)(p.ws + WS_WOUTT); g.M = NTOK; g.N = 1024; g.K = 1024; g.Nvalid = 1024;
    StaticOrder S; S.init(NTOK, 1024, 256, blockIdx.x);
    EpiResNorm E; E.x = p.x; E.gain = p.final_gain; E.out = p.out; E.part = (float*)(p.ws + WS_PART); E.cnt = (unsigned*)(p.ws + WS_CTL) + CTL_CNT_WORD;
    gemm_phase((LAS unsigned char*)dyn_smem, g, S, E);
}

template <int CTRL> __device__ __forceinline__ float dpp_add(float v) {
    const int t = __builtin_amdgcn_update_dpp(0, __float_as_int(v), CTRL, 0xf, 0xf, false);
    return v + __int_as_float(t);
}
__device__ __forceinline__ float row16_allsum(float v) {
    v = dpp_add<0x128>(v); v = dpp_add<0x124>(v); v = dpp_add<0x122>(v); v = dpp_add<0x121>(v);
    return v;
}
#define MFMA16(a, b, c) __builtin_amdgcn_mfma_f32_16x16x32_bf16((a), (b), (c), 0, 0, 0)
__device__ __forceinline__ bf16x8 as_bf8(u32x4 v) { return __builtin_bit_cast(bf16x8, v); }
template <int W> __device__ __forceinline__ void pooled_run(const u16* __restrict__ Z, u16* pooled, int t0, int s0, int cp, int hf) {
    const int c0 = 2 * cp, tb = hf * 32;
    unsigned raw[W - 1 + 32];
#pragma unroll
    for (int i = 0; i < W - 1 + 32; ++i) { const int tt = tb - (W - 1) + i; raw[i] = (s0 + tt >= 0) ? *(const unsigned*)(Z + (size_t)(t0 + tt) * DIN + c0) : 0u; }
    float sum0 = 0.f, sum1 = 0.f;
#pragma unroll
    for (int i = 0; i < W - 1; ++i) { sum0 += bflo(raw[i]); sum1 += bfhi(raw[i]); }
#pragma unroll
    for (int j = 0; j < 32; ++j) {
        const int tt = tb + j, s = s0 + tt;
        const float u0 = bflo(raw[W - 1 + j]), u1 = bfhi(raw[W - 1 + j]);
        sum0 += u0; sum1 += u1;
        const float rc = rcp_((float)((s + 1 < W) ? (s + 1) : W));
        *(unsigned*)(pooled + tt * 520 + c0) = pack2(sum0 * rc - u0, sum1 * rc - u1);
        sum0 -= bflo(raw[j]); sum1 -= bfhi(raw[j]);
    }
}
constexpr int RST = 912;
__device__ __forceinline__ void p2_zload(u32x4 (&zq)[7], const u16* __restrict__ Z, size_t T0, bool has_halo, int h, int lane) {
#pragma unroll
    for (int q = 0; q < 7; ++q) {
        const int pidx = lane + 64 * q, rr = pidx / 24, w = pidx - rr * 24, a = w >> 3, pc = w & 7;
        u32x4 v = (u32x4){0u, 0u, 0u, 0u};
        if (pidx < 17 * 24) {
            if (rr < 16) v = *(const u32x4*)(Z + (T0 + rr) * DIN + 1024 + a * 512 + h * 64 + pc * 8);
            else if (has_halo) v = *(const u32x4*)(Z + (T0 - 1) * DIN + 1024 + a * 512 + h * 64 + pc * 8);
        }
        zq[q] = v;
    }
}
constexpr int P2_WREG = 17408;
__device__ void phase2(const Params& p) {
    const int tid = threadIdx.x, lane = tid & 63, wave = tid >> 6, blk = blockIdx.x, fr = lane & 15, fq = lane >> 4;
    const int t0 = blk * 64, b = t0 >> 11, s0 = t0 & 2047;
    const u16* Z = (const u16*)(p.ws + WS_Z);
    u16* twb = (u16*)dyn_smem;
    u16* alb = twb + 64 * 72;
    u16* pooled = alb + 64 * 72;
    for (int e = tid; e < 64 * 128; e += 512) {
        const int tt = e >> 7, j = e & 127;
        const size_t zi = (size_t)(t0 + tt) * DIN + 2560 + j;
        const float cur = bf2f(Z[zi]);
        const float prev = (s0 + tt > 0) ? bf2f(Z[zi - DIN]) : 0.f;
        const float val = cur + p.shift_mu[1536 + j] * (prev - cur);
        if (j < 64) twb[tt * 72 + j] = f2bf(tanhf_(val)); else alb[tt * 72 + (j - 64)] = f2bf(val);
    }
    {
        const int cp = tid & 255, hf = tid >> 8;
        switch (wave & 3) {
            case 0: pooled_run<2>(Z, pooled, t0, s0, cp, hf); break;
            case 1: pooled_run<4>(Z, pooled, t0, s0, cp, hf); break;
            case 2: pooled_run<8>(Z, pooled, t0, s0, cp, hf); break;
            default: pooled_run<16>(Z, pooled, t0, s0, cp, hf); break;
        }
    }
    __syncthreads();
    {
        const int g = wave >> 1, dbase = (wave & 1) * 64, ch0 = g * 128 + dbase;
        const u16* PoolT = (const u16*)(p.ws + WS_POOLT); u16* Y = (u16*)(p.ws + WS_Y);
        unsigned char* gt = dyn_smem + 84992 + wave * 8704;
        u32x4 gq[8];
#pragma unroll
        for (int q = 0; q < 8; ++q) { const int idx = lane + 64 * q, row = idx >> 3, pc = idx & 7; gq[q] = *(const u32x4*)(Z + (size_t)(t0 + row) * DIN + 512 + ch0 + pc * 8); }
        f32x4 acc[4][4];
#pragma unroll
        for (int mt = 0; mt < 4; ++mt)
#pragma unroll
            for (int nt = 0; nt < 4; ++nt) acc[mt][nt] = (f32x4){0.f, 0.f, 0.f, 0.f};
#pragma unroll
        for (int ks = 0; ks < 4; ++ks) {
            bf16x8 Bf[4];
#pragma unroll
            for (int nt = 0; nt < 4; ++nt) Bf[nt] = *(const bf16x8*)(PoolT + (size_t)(ch0 + nt * 16 + fr) * 128 + ks * 32 + fq * 8);
#pragma unroll
            for (int mt = 0; mt < 4; ++mt) {
                const bf16x8 Af = *(const bf16x8*)(pooled + (mt * 16 + fr) * 520 + g * 128 + ks * 32 + fq * 8);
#pragma unroll
                for (int nt = 0; nt < 4; ++nt) acc[mt][nt] = MFMA16(Bf[nt], Af, acc[mt][nt]);
            }
        }
#pragma unroll
        for (int q = 0; q < 8; ++q) { const int idx = lane + 64 * q, row = idx >> 3, pc = idx & 7;
            *(u32x2*)(gt + row * 136 + pc * 16) = (u32x2){gq[q].x, gq[q].y}; *(u32x2*)(gt + row * 136 + pc * 16 + 8) = (u32x2){gq[q].z, gq[q].w}; }
        WSYNC();
#pragma unroll
        for (int mt = 0; mt < 4; ++mt) {
#pragma unroll
            for (int nt = 0; nt < 4; ++nt) {
                const int cl = nt * 16 + fq * 4;
                u32x2* slot = (u32x2*)(gt + (mt * 16 + fr) * 136 + cl * 2);
                const u32x2 ga = *slot;
                const f32x4 ps = *(const f32x4*)(p.pool_scale + ch0 + cl);
                const f32x4 gv = (f32x4){bflo(ga.x), bfhi(ga.x), bflo(ga.y), bfhi(ga.y)};
                f32x4 y;
#pragma unroll
                for (int jj = 0; jj < 4; ++jj) y[jj] = acc[mt][nt][jj] * ps[jj] * gv[jj] * sigmoidf_(gv[jj]);
                *slot = (u32x2){pack2(y[0], y[1]), pack2(y[2], y[3])};
            }
        }
        WSYNC();
#pragma unroll
        for (int q = 0; q < 8; ++q) { const int idx = lane + 64 * q, row = idx >> 3, pc = idx & 7;
            const u32x2 a = *(const u32x2*)(gt + row * 136 + pc * 16), b2 = *(const u32x2*)(gt + row * 136 + pc * 16 + 8);
            *(u32x4*)(Y + (size_t)(t0 + row) * 1024 + ch0 + pc * 8) = (u32x4){a.x, a.y, b2.x, b2.y}; }
    }
    {
        u16* GB = (u16*)((unsigned char*)p.out + OUT_GB);
        for (int e = tid; e < 64 * 64; e += 512) { const int tt = e >> 6, q = e & 63;
            *(u32x4*)(GB + (size_t)(t0 + tt) * 512 + q * 8) = *(const u32x4*)(Z + (size_t)(t0 + tt) * DIN + 2688 + q * 8); }
    }
    __syncthreads();
    const int h = wave, bh = b * 8 + h;
    unsigned char* WL = dyn_smem + 18432 + wave * P2_WREG;
    unsigned char* recl = WL;
    u16* AR = (u16*)WL;
    u16* BK = AR + 32 * 72;
    u16* AtT = BK + 32 * 72;
    u16* BhT = AtT + 64 * 16;
    u16* KhT = BhT + 64 * 16;
    u16* VT = KhT + 64 * 16;
    float* Pab = (float*)WL;
    u16* Tm = (u16*)(Pab + 16 * 17);
    u16* AakT = Tm + 16 * 24;
    u16* M1m = AakT + 16 * 24;
    u16* Ark = M1m + 16 * 24;
    u16* Arb = Ark + 16 * 24;
    const u16* WupT = (const u16*)(p.ws + WS_WUPT); const u16* AupT = (const u16*)(p.ws + WS_AUPT);
    float* BON = (float*)(p.ws + WS_BONUS); u16* VB = (u16*)(p.ws + WS_VB);
    unsigned char* AFg = p.ws + CH_AF; unsigned char* RFg = p.ws + CH_RF; unsigned char* BKFg = p.ws + CH_BKF; unsigned char* ARBg = p.ws + CH_ARB;
    float* G15g = (float*)(p.ws + CH_G15); unsigned char* CHVg = (unsigned char*)p.out + OUT_CHV;
    const bf16x8 zero8 = (bf16x8){0, 0, 0, 0, 0, 0, 0, 0};
    const f32x4 zero4 = (f32x4){0.f, 0.f, 0.f, 0.f};
#pragma unroll 1
    for (int mt = 0; mt < 4; ++mt) {
        const size_t u = (size_t)bh * 128 + (s0 >> 4) + mt;
        {
            u32x4 zq[7];
            p2_zload(zq, Z, (size_t)(t0 + mt * 16), (s0 + mt * 16) > 0, h, lane);
            f32x4 aw[4], aa[4];
#pragma unroll
            for (int nt = 0; nt < 4; ++nt) { aw[nt] = zero4; aa[nt] = zero4; }
#pragma unroll
            for (int ks = 0; ks < 2; ++ks) {
                const bf16x8 Aw = *(const bf16x8*)(twb + (mt * 16 + fr) * 72 + ks * 32 + fq * 8);
                const bf16x8 Aa = *(const bf16x8*)(alb + (mt * 16 + fr) * 72 + ks * 32 + fq * 8);
#pragma unroll
                for (int nt = 0; nt < 4; ++nt) {
                    const bf16x8 Bw = *(const bf16x8*)(WupT + (h * 64 + nt * 16 + fr) * 64 + ks * 32 + fq * 8);
                    const bf16x8 Ba = *(const bf16x8*)(AupT + (h * 64 + nt * 16 + fr) * 64 + ks * 32 + fq * 8);
                    aw[nt] = MFMA16(Bw, Aw, aw[nt]);
                    aa[nt] = MFMA16(Ba, Aa, aa[nt]);
                }
            }
#pragma unroll
            for (int q = 0; q < 7; ++q) {
                const int pidx = lane + 64 * q, rr = pidx / 24, w = pidx - rr * 24, a = w >> 3, pc = w & 7;
                if (pidx < 17 * 24) *(u32x4*)(recl + ((rr < 16) ? rr * RST + 256 : 16 * RST) + a * 128 + pc * 16) = zq[q];
            }
            WSYNC();
            const int tt = mt * 16 + fr, s = s0 + tt; const size_t T = (size_t)(t0 + tt);
            f32x4 Kr[4], Av[4];
            float n2 = 0.f, bon = 0.f;
            unsigned char* rec = recl + fr * RST;
            const unsigned char* prec = (fr > 0) ? (recl + (fr - 1) * RST) : (recl + 16 * RST - 256);
#pragma unroll
            for (int nt = 0; nt < 4; ++nt) {
                const int cb = h * 64 + nt * 16 + fq * 4, ci = nt * 16 + fq * 4;
                const u32x2 zr = *(const u32x2*)(rec + 256 + ci * 2), zk = *(const u32x2*)(rec + 384 + ci * 2), zv = *(const u32x2*)(rec + 512 + ci * 2);
                const u32x2 pr = *(const u32x2*)(prec + 256 + ci * 2), pk = *(const u32x2*)(prec + 384 + ci * 2), pv = *(const u32x2*)(prec + 512 + ci * 2);
                const f32x4 mur = *(const f32x4*)(p.shift_mu + cb), muk = *(const f32x4*)(p.shift_mu + 512 + cb), muv = *(const f32x4*)(p.shift_mu + 1024 + cb);
                const f32x4 w0v = *(const f32x4*)(p.w0 + cb), a0v = *(const f32x4*)(p.a0 + cb), kkv = *(const f32x4*)(p.k_k + cb), kav = *(const f32x4*)(p.k_a + cb), rkv = *(const f32x4*)(p.r_k + cb);
                const f32x4 cr = (f32x4){bflo(zr.x), bfhi(zr.x), bflo(zr.y), bfhi(zr.y)}, ck = (f32x4){bflo(zk.x), bfhi(zk.x), bflo(zk.y), bfhi(zk.y)}, cv = (f32x4){bflo(zv.x), bfhi(zv.x), bflo(zv.y), bfhi(zv.y)};
                const f32x4 qr = (f32x4){bflo(pr.x), bfhi(pr.x), bflo(pr.y), bfhi(pr.y)}, qk = (f32x4){bflo(pk.x), bfhi(pk.x), bflo(pk.y), bfhi(pk.y)}, qv = (f32x4){bflo(pv.x), bfhi(pv.x), bflo(pv.y), bfhi(pv.y)};
                f32x4 Rr, Kp, Vv, Dc;
#pragma unroll
                for (int jj = 0; jj < 4; ++jj) {
                    const float r = cr[jj] + mur[jj] * (qr[jj] - cr[jj]);
                    const float k = ck[jj] + muk[jj] * (qk[jj] - ck[jj]);
                    const float v = cv[jj] + muv[jj] * (qv[jj] - cv[jj]);
                    const float ww = aw[nt][jj] + w0v[jj];
                    const float a = sigmoidf_(aa[nt][jj] + a0v[jj]);
                    const float dec = __expf(-0.6065306597126334f * sigmoidf_(ww));
                    const float kr = k * kkv[jj];
                    n2 += kr * kr;
                    const float kp = k * (1.f + (a - 1.f) * kav[jj]);
                    bon += r * kp * rkv[jj];
                    Rr[jj] = r; Kp[jj] = kp; Vv[jj] = v; Kr[nt][jj] = kr; Av[nt][jj] = a; Dc[jj] = dec;
                }
                *(f32x4*)(rec + ci * 4) = Dc;
                *(u32x2*)(rec + 256 + ci * 2) = (u32x2){pack2(Rr[0], Rr[1]), pack2(Rr[2], Rr[3])};
                *(u32x2*)(rec + 384 + ci * 2) = (u32x2){pack2(Kp[0], Kp[1]), pack2(Kp[2], Kp[3])};
                const u32x2 vpk = (u32x2){pack2(Vv[0], Vv[1]), pack2(Vv[2], Vv[3])};
                *(u32x2*)(rec + 512 + ci * 2) = vpk;
            }
            n2 += __shfl_xor(n2, 16, 64); n2 += __shfl_xor(n2, 32, 64);
            bon += __shfl_xor(bon, 16, 64); bon += __shfl_xor(bon, 32, 64);
            const float inv = rsq_(fmaxf(n2, 1e-24f));
#pragma unroll
            for (int nt = 0; nt < 4; ++nt) {
                const int ci = nt * 16 + fq * 4;
                const f32x4 kk = Kr[nt] * inv;
                *(u32x2*)(rec + 640 + ci * 2) = (u32x2){pack2(kk[0], kk[1]), pack2(kk[2], kk[3])};
                const f32x4 nb = -(kk * Av[nt]);
                *(u32x2*)(rec + 768 + ci * 2) = (u32x2){pack2(nb[0], nb[1]), pack2(nb[2], nb[3])};
            }
            if (fq == 0) BON[(size_t)bh * 2048 + s] = bon;
        }
        WSYNC();
        {
#pragma unroll
            for (int q = 0; q < 2; ++q) { const int idx = lane + 64 * q, row = idx >> 3, pc = idx & 7;
                *(u32x4*)(VB + (size_t)(t0 + mt * 16 + row) * 512 + h * 64 + pc * 8) = *(const u32x4*)(recl + row * RST + 512 + pc * 16); }
        }
        {
            float w_[16], r_[16], kp_[16], v_[16], kk_[16], nb_[16];
#pragma unroll
            for (int t = 0; t < 16; ++t) {
                const unsigned char* rt = recl + t * RST;
                w_[t] = *(const float*)(rt + lane * 4);
                r_[t] = bf2f(*(const u16*)(rt + 256 + lane * 2)); kp_[t] = bf2f(*(const u16*)(rt + 384 + lane * 2)); v_[t] = bf2f(*(const u16*)(rt + 512 + lane * 2));
                kk_[t] = bf2f(*(const u16*)(rt + 640 + lane * 2)); nb_[t] = bf2f(*(const u16*)(rt + 768 + lane * 2));
            }
            WSYNC();
            float g = 1.f;
            float At[16], Bt[16], Kt[16];
#pragma unroll
            for (int t = 0; t < 16; ++t) {
                const float gp = g; g = g * w_[t]; const float ig = rcp_(g);
                const float a = kk_[t] * gp, rr = r_[t] * g, bb = nb_[t] * ig, kt = kp_[t] * ig;
                AR[t * 72 + lane] = f2bf(a); AR[(16 + t) * 72 + lane] = f2bf(rr); BK[t * 72 + lane] = f2bf(bb); BK[(16 + t) * 72 + lane] = f2bf(kt);
                At[t] = a; Bt[t] = bb; Kt[t] = kt;
            }
            u32x4 o0, o1;
            o0 = (u32x4){pack2(At[0], At[1]), pack2(At[2], At[3]), pack2(At[4], At[5]), pack2(At[6], At[7])};
            o1 = (u32x4){pack2(At[8], At[9]), pack2(At[10], At[11]), pack2(At[12], At[13]), pack2(At[14], At[15])};
            *(u32x4*)(AtT + lane * 16) = o0; *(u32x4*)(AtT + lane * 16 + 8) = o1;
            o0 = (u32x4){pack2(Bt[0] * g, Bt[1] * g), pack2(Bt[2] * g, Bt[3] * g), pack2(Bt[4] * g, Bt[5] * g), pack2(Bt[6] * g, Bt[7] * g)};
            o1 = (u32x4){pack2(Bt[8] * g, Bt[9] * g), pack2(Bt[10] * g, Bt[11] * g), pack2(Bt[12] * g, Bt[13] * g), pack2(Bt[14] * g, Bt[15] * g)};
            *(u32x4*)(BhT + lane * 16) = o0; *(u32x4*)(BhT + lane * 16 + 8) = o1;
            o0 = (u32x4){pack2(Kt[0] * g, Kt[1] * g), pack2(Kt[2] * g, Kt[3] * g), pack2(Kt[4] * g, Kt[5] * g), pack2(Kt[6] * g, Kt[7] * g)};
            o1 = (u32x4){pack2(Kt[8] * g, Kt[9] * g), pack2(Kt[10] * g, Kt[11] * g), pack2(Kt[12] * g, Kt[13] * g), pack2(Kt[14] * g, Kt[15] * g)};
            *(u32x4*)(KhT + lane * 16) = o0; *(u32x4*)(KhT + lane * 16 + 8) = o1;
            o0 = (u32x4){pack2(v_[0], v_[1]), pack2(v_[2], v_[3]), pack2(v_[4], v_[5]), pack2(v_[6], v_[7])};
            o1 = (u32x4){pack2(v_[8], v_[9]), pack2(v_[10], v_[11]), pack2(v_[12], v_[13]), pack2(v_[14], v_[15])};
            *(u32x4*)(VT + lane * 16) = o0; *(u32x4*)(VT + lane * 16 + 8) = o1;
            G15g[u * 64 + lane] = g;
        }
        WSYNC();
        {
            u32x2 rp[4];
#pragma unroll
            for (int ta = 0; ta < 4; ++ta) rp[ta] = *(const u32x2*)(AR + (16 + fr) * 72 + 16 * ta + 4 * fq);
            *(u32x4*)(RFg + (u * 64 + lane) * 32) = (u32x4){rp[0].x, rp[0].y, rp[1].x, rp[1].y};
            *(u32x4*)(RFg + (u * 64 + lane) * 32 + 16) = (u32x4){rp[2].x, rp[2].y, rp[3].x, rp[3].y};
#pragma unroll
            for (int ta = 0; ta < 4; ++ta) {
                const u32x2 b2 = *(const u32x2*)(BhT + (16 * ta + fr) * 16 + 4 * fq), k2 = *(const u32x2*)(KhT + (16 * ta + fr) * 16 + 4 * fq);
                *(u32x4*)(BKFg + ((u * 4 + ta) * 64 + lane) * 16) = (u32x4){b2.x, b2.y, k2.x, k2.y};
            }
#pragma unroll
            for (int sl = 0; sl < 4; ++sl) *(u32x2*)(CHVg + (((u * 4 + sl) * 3 + 2) * 64 + lane) * 8) = *(const u32x2*)(VT + (16 * sl + fr) * 16 + 4 * fq);
        }
        {
            f32x4 P00 = zero4, P01 = zero4, P10 = zero4, P11 = zero4;
#pragma unroll
            for (int s = 0; s < 2; ++s) {
                const bf16x8 a0 = *(const bf16x8*)(AR + fr * 72 + s * 32 + fq * 8), a1 = *(const bf16x8*)(AR + (16 + fr) * 72 + s * 32 + fq * 8);
                const bf16x8 b0 = *(const bf16x8*)(BK + fr * 72 + s * 32 + fq * 8), b1 = *(const bf16x8*)(BK + (16 + fr) * 72 + s * 32 + fq * 8);
                P00 = MFMA16(a0, b0, P00); P01 = MFMA16(a0, b1, P01); P10 = MFMA16(a1, b0, P10); P11 = MFMA16(a1, b1, P11);
            }
            WSYNC();
            float ak[4];
#pragma unroll
            for (int r = 0; r < 4; ++r) {
                const int i = 4 * fq + r, j = fr;
                Pab[i * 17 + j] = (j < i) ? P00[r] : 0.f;
                ak[r] = (j < i) ? P01[r] : 0.f;
                Arb[i * 24 + j] = f2bf((j <= i) ? P10[r] : 0.f);
                Ark[i * 24 + j] = f2bf((j <= i) ? P11[r] : 0.f);
            }
            *(u32x2*)(AakT + fr * 24 + 4 * fq) = (u32x2){pack2(ak[0], ak[1]), pack2(ak[2], ak[3])};
        }
        WSYNC();
        {
            float T[16];
#pragma unroll
            for (int i = 0; i < 16; ++i) {
                float acc = (i == fr) ? 1.f : 0.f;
#pragma unroll
                for (int j = 0; j < i; ++j) acc += Pab[i * 17 + j] * T[j];
                T[i] = acc;
            }
#pragma unroll
            for (int i = 0; i < 16; ++i) Tm[i * 24 + fr] = f2bf(T[i]);
            *(u32x2*)(ARBg + (u * 64 + lane) * 8) = *(const u32x2*)(Arb + fr * 24 + 4 * fq);
        }
        WSYNC();
        const bf16x8 Tld = *(const bf16x8*)(Tm + fr * 24 + (fq & 1) * 8);
        const bf16x8 Tf = (fq < 2) ? Tld : zero8;
        {
            f32x4 D[4];
#pragma unroll
            for (int ta = 0; ta < 4; ++ta) {
                const bf16x8 ald = *(const bf16x8*)(AtT + (16 * ta + fr) * 16 + (fq & 1) * 8);
                D[ta] = MFMA16((fq < 2) ? ald : zero8, Tf, zero4);
            }
            *(u32x4*)(AFg + (u * 64 + lane) * 32) = (u32x4){pack2(D[0][0], D[0][1]), pack2(D[0][2], D[0][3]), pack2(D[1][0], D[1][1]), pack2(D[1][2], D[1][3])};
            *(u32x4*)(AFg + (u * 64 + lane) * 32 + 16) = (u32x4){pack2(D[2][0], D[2][1]), pack2(D[2][2], D[2][3]), pack2(D[3][0], D[3][1]), pack2(D[3][2], D[3][3])};
            const bf16x8 akld = *(const bf16x8*)(AakT + fr * 24 + (fq & 1) * 8);
            const f32x4 M1 = MFMA16(Tf, (fq < 2) ? akld : zero8, zero4);
#pragma unroll
            for (int r = 0; r < 4; ++r) M1m[(4 * fq + r) * 24 + fr] = f2bf(M1[r]);
        }
        WSYNC();
        {
            const bf16x8 m1ld = *(const bf16x8*)(M1m + fr * 24 + (fq & 1) * 8), rkld = *(const bf16x8*)(Ark + fr * 24 + (fq & 1) * 8);
            const bf16x8 M1f = (fq < 2) ? m1ld : zero8, Arkf = (fq < 2) ? rkld : zero8;
#pragma unroll
            for (int sl = 0; sl < 4; ++sl) {
                const bf16x8 vld = *(const bf16x8*)(VT + (16 * sl + fr) * 16 + (fq & 1) * 8);
                const bf16x8 Vb = (fq < 2) ? vld : zero8;
                const f32x4 Uh = MFMA16(M1f, Vb, zero4), Y0 = MFMA16(Arkf, Vb, zero4);
                *(u32x2*)(CHVg + (((u * 4 + sl) * 3 + 0) * 64 + lane) * 8) = (u32x2){pack2(Uh[0], Uh[1]), pack2(Uh[2], Uh[3])};
                *(u32x2*)(CHVg + (((u * 4 + sl) * 3 + 1) * 64 + lane) * 8) = (u32x2){pack2(Y0[0], Y0[1]), pack2(Y0[2], Y0[3])};
            }
        }
        WSYNC();
    }
}

struct ChunkOps { u32x4 af0, af1, rf0, rf1, bk0, bk1, bk2, bk3; u32x2 arb, uh, y0, vf; f32x4 g0, g1, g2, g3; };
constexpr int RING_SLOT = 17408, RING_NS = 7, RING_D = 6;
__device__ __forceinline__ void lds_chunk_ops(ChunkOps& o, const LAS unsigned char* s, int sl, int lane, int fq) {
    o.af0 = *(const LAS u32x4*)(s + lane * 32); o.af1 = *(const LAS u32x4*)(s + lane * 32 + 16);
    o.rf0 = *(const LAS u32x4*)(s + 2048 + lane * 32); o.rf1 = *(const LAS u32x4*)(s + 2048 + lane * 32 + 16);
    o.bk0 = *(const LAS u32x4*)(s + 4096 + (0 * 64 + lane) * 16); o.bk1 = *(const LAS u32x4*)(s + 4096 + (1 * 64 + lane) * 16);
    o.bk2 = *(const LAS u32x4*)(s + 4096 + (2 * 64 + lane) * 16); o.bk3 = *(const LAS u32x4*)(s + 4096 + (3 * 64 + lane) * 16);
    o.uh = *(const LAS u32x2*)(s + 8192 + ((sl * 3 + 0) * 64 + lane) * 8);
    o.y0 = *(const LAS u32x2*)(s + 8192 + ((sl * 3 + 1) * 64 + lane) * 8);
    o.vf = *(const LAS u32x2*)(s + 8192 + ((sl * 3 + 2) * 64 + lane) * 8);
    o.arb = *(const LAS u32x2*)(s + 16384 + lane * 8);
    o.g0 = *(const LAS f32x4*)(s + 16896 + 16 * fq); o.g1 = *(const LAS f32x4*)(s + 16896 + 64 + 16 * fq);
    o.g2 = *(const LAS f32x4*)(s + 16896 + 128 + 16 * fq); o.g3 = *(const LAS f32x4*)(s + 16896 + 192 + 16 * fq);
}
template <int LW> __device__ __forceinline__ void ring_issue(const Params& p, LAS unsigned char* ring, int bh, int c, int lane) {
    const size_t u = (size_t)bh * 128 + c;
    LAS unsigned char* slot = ring + (c % RING_NS) * RING_SLOT;
    const unsigned char* ws = p.ws; const unsigned char* od = (const unsigned char*)p.out;
#pragma unroll
    for (int j = 0; j < 8; ++j) {
        constexpr int Q0 = LW * 8; const int q = Q0 + j;
        const unsigned char* g;
        if (q < 2) g = ws + CH_AF + u * 2048 + q * 1024 + lane * 16;
        else if (q < 4) g = ws + CH_RF + u * 2048 + (q - 2) * 1024 + lane * 16;
        else if (q < 8) g = ws + CH_BKF + u * 4096 + (q - 4) * 1024 + lane * 16;
        else if (q < 14) g = od + OUT_CHV + u * 6144 + (q - 8) * 1024 + lane * 16;
        else { const int i = (q - 14) * 64 + lane; g = od + OUT_GB + (((size_t)(bh >> 3) * 2048 + c * 16 + (i >> 3)) * 512 + (bh & 7) * 64) * 2 + (i & 7) * 16; }
        __builtin_amdgcn_global_load_lds((const unsigned*)g, (LAS unsigned*)(slot + q * 1024), 16, 0, 0);
    }
    if (LW == 0) {
        __builtin_amdgcn_global_load_lds((const unsigned*)(ws + CH_ARB + u * 512 + lane * 4), (LAS unsigned*)(slot + 16384), 4, 0, 0);
        __builtin_amdgcn_global_load_lds((const unsigned*)(ws + CH_ARB + u * 512 + 256 + lane * 4), (LAS unsigned*)(slot + 16384 + 256), 4, 0, 0);
    } else {
        __builtin_amdgcn_global_load_lds((const unsigned*)(ws + CH_G15 + u * 256 + lane * 4), (LAS unsigned*)(slot + 16896), 4, 0, 0);
        __builtin_amdgcn_global_load_lds((const unsigned*)(ws + WS_BONUS + ((size_t)bh * 2048 + c * 16) * 4 + (lane & 15) * 4), (LAS unsigned*)(slot + 17152), 4, 0, 0);
    }
}
template <int CTRL> __device__ __forceinline__ float dpp_add_q(float v) {
    const int t = __builtin_amdgcn_update_dpp(0, __float_as_int(v), CTRL, 0xf, 0xf, false);
    return v + __int_as_float(t);
}
__device__ __forceinline__ float oct_allsum(float v) {
    v = dpp_add_q<0xB1>(v); v = dpp_add_q<0x4E>(v); v = dpp_add_q<0x141>(v);
    return v;
}
struct EpiIn { u32x4 gb; float bon; u16 v[8]; };
__device__ __forceinline__ void epi_load(EpiIn& e, const LAS unsigned char* s, int t, int v0) {
    e.gb = *(const LAS u32x4*)(s + 14336 + t * 128 + v0 * 2);
    e.bon = *(const LAS float*)(s + 17152 + t * 4);
    const LAS unsigned char* vp = s + 8192 + (((v0 >> 4) * 3 + 2) * 64 + (t >> 2) * 16 + (v0 & 15)) * 8 + (t & 3) * 2;
#pragma unroll
    for (int i = 0; i < 8; ++i) e.v[i] = *(const LAS u16*)(vp + 8 * i);
}
template <int LW> __device__ __forceinline__ void p3_loader(const Params& p, LAS unsigned char* ring, int bh, int lane) {
#pragma unroll
    for (int c = 0; c < RING_D; ++c) ring_issue<LW>(p, ring, bh, c, lane);
    asm volatile("s_waitcnt vmcnt(40)" ::: "memory");
    __builtin_amdgcn_s_barrier();
#pragma unroll 1
    for (int c = 0; c < 128; ++c) {
        const int cn = (c + RING_D < 128) ? c + RING_D : 127;
        ring_issue<LW>(p, ring, bh, cn, lane);
        asm volatile("s_waitcnt vmcnt(40)" ::: "memory");
        __builtin_amdgcn_s_barrier();
    }
    asm volatile("s_waitcnt vmcnt(0)" ::: "memory");
}
__device__ void phase3(const Params& p) {
    const int tid = threadIdx.x, lane = tid & 63, wave = __builtin_amdgcn_readfirstlane(tid >> 6), fr = lane & 15, fq = lane >> 4;
    const int bh = blockIdx.x;
    if (bh >= 64) return;
    LAS unsigned char* ring = (LAS unsigned char*)dyn_smem;
    LAS float* ybuf = (LAS float*)(ring + RING_NS * RING_SLOT);
    if (wave >= 6) {
        const int e = (wave - 6) * 64 + lane, t = e >> 3, v0 = (e & 7) * 8, b = bh >> 3, h = bh & 7;
        f32x4 ga0 = *(const f32x4*)(p.gn_gain + h * 64 + v0), ga1 = *(const f32x4*)(p.gn_gain + h * 64 + v0 + 4);
        f32x4 bi0 = *(const f32x4*)(p.gn_bias + h * 64 + v0), bi1 = *(const f32x4*)(p.gn_bias + h * 64 + v0 + 4);
        u16* Y = (u16*)(p.ws + WS_Y);
        EpiIn cur, nxt;
        __builtin_amdgcn_s_barrier();
        epi_load(cur, ring, t, v0);
#pragma unroll 1
        for (int c = 0; c <= 128; ++c) {
            if (c >= 1) {
                const int cc = c - 1;
                { const int cn = (c < 128) ? c : 127; epi_load(nxt, ring + (cn % RING_NS) * RING_SLOT, t, v0); }
                const LAS float* yb = ybuf + (cc & 1) * (16 * 68) + t * 68 + v0;
                const f32x4 y0 = *(const LAS f32x4*)(yb), y1 = *(const LAS f32x4*)(yb + 4);
                float s1 = (y0[0] + y0[1]) + (y0[2] + y0[3]) + (y1[0] + y1[1]) + (y1[2] + y1[3]);
                float s2 = y0[0] * y0[0] + y0[1] * y0[1] + y0[2] * y0[2] + y0[3] * y0[3] + y1[0] * y1[0] + y1[1] * y1[1] + y1[2] * y1[2] + y1[3] * y1[3];
                s1 = oct_allsum(s1); s2 = oct_allsum(s2);
                const float mean = s1 * (1.f / 64.f);
                const float var = fmaxf(s2 * (1.f / 64.f) - mean * mean, 0.f);
                const float rstd = rsq_(var + 64e-5f);
                const float vvf[8] = {bf2f(cur.v[0]), bf2f(cur.v[1]), bf2f(cur.v[2]), bf2f(cur.v[3]), bf2f(cur.v[4]), bf2f(cur.v[5]), bf2f(cur.v[6]), bf2f(cur.v[7])};
                const float gbf[8] = {bflo(cur.gb.x), bfhi(cur.gb.x), bflo(cur.gb.y), bfhi(cur.gb.y), bflo(cur.gb.z), bfhi(cur.gb.z), bflo(cur.gb.w), bfhi(cur.gb.w)};
                float o[8];
#pragma unroll
                for (int i = 0; i < 8; ++i) {
                    const float yv = (i < 4) ? y0[i & 3] : y1[i & 3];
                    const float gn = (i < 4) ? ga0[i & 3] : ga1[i & 3], bs = (i < 4) ? bi0[i & 3] : bi1[i & 3];
                    const float yn = (yv - mean) * rstd * gn + bs;
                    o[i] = (yn + cur.bon * vvf[i]) * gbf[i] * sigmoidf_(gbf[i]);
                }
                *(u32x4*)(Y + ((size_t)b * 2048 + cc * 16 + t) * 1024 + 512 + h * 64 + v0) = (u32x4){pack2(o[0], o[1]), pack2(o[2], o[3]), pack2(o[4], o[5]), pack2(o[6], o[7])};
                cur = nxt;
            }
            if (c < 128) __builtin_amdgcn_s_barrier();
        }
        return;
    }
    if (wave >= 4) { if (wave == 4) p3_loader<0>(p, ring, bh, lane); else p3_loader<1>(p, ring, bh, lane); return; }
    const int sl = wave;
    f32x4 acc0 = (f32x4){0.f, 0.f, 0.f, 0.f}, acc1 = acc0, acc2 = acc0, acc3 = acc0;
    ChunkOps cur, nxt;
    __builtin_amdgcn_s_barrier();
    lds_chunk_ops(cur, ring, sl, lane, fq);
#pragma unroll 2
    for (int c = 0; c < 128; ++c) {
        { const int cn = (c + 1 < 128) ? c + 1 : c; lds_chunk_ops(nxt, ring + (cn % RING_NS) * RING_SLOT, sl, lane, fq); }
        const bf16x8 sb0 = as_bf8((u32x4){pack2(acc0[0], acc0[1]), pack2(acc0[2], acc0[3]), pack2(acc1[0], acc1[1]), pack2(acc1[2], acc1[3])});
        const bf16x8 sb1 = as_bf8((u32x4){pack2(acc2[0], acc2[1]), pack2(acc2[2], acc2[3]), pack2(acc3[0], acc3[1]), pack2(acc3[2], acc3[3])});
        f32x4 U = (f32x4){bflo(cur.uh.x), bfhi(cur.uh.x), bflo(cur.uh.y), bfhi(cur.uh.y)};
        U = MFMA16(as_bf8(cur.af0), sb0, U); U = MFMA16(as_bf8(cur.af1), sb1, U);
        f32x4 Yv = (f32x4){bflo(cur.y0.x), bfhi(cur.y0.x), bflo(cur.y0.y), bfhi(cur.y0.y)};
        Yv = MFMA16(as_bf8(cur.rf0), sb0, Yv); Yv = MFMA16(as_bf8(cur.rf1), sb1, Yv);
        const unsigned u01 = pack2(U[0], U[1]), u23 = pack2(U[2], U[3]);
        Yv = MFMA16(as_bf8((u32x4){cur.arb.x, cur.arb.y, 0u, 0u}), as_bf8((u32x4){u01, u23, 0u, 0u}), Yv);
        const bf16x8 uvb = as_bf8((u32x4){u01, u23, cur.vf.x, cur.vf.y});
        acc0 = MFMA16(as_bf8(cur.bk0), uvb, acc0 * cur.g0); acc1 = MFMA16(as_bf8(cur.bk1), uvb, acc1 * cur.g1);
        acc2 = MFMA16(as_bf8(cur.bk2), uvb, acc2 * cur.g2); acc3 = MFMA16(as_bf8(cur.bk3), uvb, acc3 * cur.g3);
        LAS float* yb = ybuf + (c & 1) * (16 * 68) + (4 * fq) * 68 + sl * 16 + fr;
        yb[0] = Yv[0]; yb[68] = Yv[1]; yb[136] = Yv[2]; yb[204] = Yv[3];
        asm volatile("s_waitcnt lgkmcnt(0)" ::: "memory");
        __builtin_amdgcn_s_barrier();
        asm volatile("" ::: "memory");
        cur = nxt;
    }
}

__device__ void phase5(const Params& p) {
    const int tid = threadIdx.x, lane = tid & 63, wave = tid >> 6, blk = blockIdx.x;
#pragma unroll 1
    for (int r0 = 0; r0 < 8; r0 += 4) {
        f32x4 v[4][4]; float ss[4];
#pragma unroll
        for (int i = 0; i < 4; ++i) {
            const f32x4* xr = (const f32x4*)(p.out + (size_t)(blk * 64 + wave * 8 + r0 + i) * DM);
#pragma unroll
            for (int q = 0; q < 4; ++q) v[i][q] = xr[lane + 64 * q];
        }
#pragma unroll
        for (int i = 0; i < 4; ++i) {
            float s = 0.f;
#pragma unroll
            for (int q = 0; q < 4; ++q) s += v[i][q][0] * v[i][q][0] + v[i][q][1] * v[i][q][1] + v[i][q][2] * v[i][q][2] + v[i][q][3] * v[i][q][3];
            ss[i] = wave_sum(s);
        }
#pragma unroll
        for (int i = 0; i < 4; ++i) {
            f32x4* xr = (f32x4*)(p.out + (size_t)(blk * 64 + wave * 8 + r0 + i) * DM);
            const float inv = rsq_(ss[i] * (1.f / 1024.f) + 1e-6f);
#pragma unroll
            for (int q = 0; q < 4; ++q) { const f32x4 g = ((const f32x4*)p.final_gain)[lane + 64 * q]; xr[lane + 64 * q] = v[i][q] * inv * g; }
        }
    }
}

__global__ void __launch_bounds__(512, 2) hybrid_fwd(Params p) {
    __shared__ uint4 xb_words;
    if (threadIdx.x == 0) xb_words = make_uint4(0u, 0u, 0u, 0u);
    __syncthreads();
    XcdBarrier bar; bar.bar = (unsigned*)(p.ws + WS_CTL); bar.x = 0; bar.st = (volatile LAS unsigned*)&xb_words;
    const int lo = p.ph_lo, hi = p.ph_hi;
    if (hi - lo > 1) bar = xcd_barrier_post((unsigned*)(p.ws + WS_CTL), (volatile LAS unsigned*)&xb_words);
#define IN(k) (lo <= (k) && (k) < hi)
#define SEAM(k) do { if (IN(k) && IN((k) + 1)) xcd_barrier(bar); } while (0)
#define RUN(k, f) do { if (IN(k)) { if (PROBE_DUP == (k)) { for (int _r = 0; _r < p.dup_n; ++_r) { if (_r) __syncthreads(); f(p); } } else f(p); } } while (0)
    RUN(0, phase0);
    SEAM(0);
    RUN(1, phase1);
    SEAM(1);
    RUN(2, phase2);
    SEAM(2);
    RUN(3, phase3);
    SEAM(3);
    RUN(4, phase4);
}

extern "C" void kernel_launch(void* const* d_in, const int* in_sizes, int n_in, void* d_out, int out_size, void* d_ws, size_t ws_size, hipStream_t stream) {
    static int grid = 0;
    if (grid == 0) {
        if (n_in != 17 || out_size != NTOK * DM || ws_size < WS_END) { fprintf(stderr, "kernel_launch: unexpected problem (n_in %d out %d ws %zu need %zu)\n", n_in, out_size, ws_size, (size_t)WS_END); grid = -1; return; }
        if (hipFuncSetAttribute((const void*)hybrid_fwd, hipFuncAttributeMaxDynamicSharedMemorySize, LDS_BYTES) != hipSuccess) { fprintf(stderr, "kernel_launch: hipFuncSetAttribute failed\n"); grid = -1; return; }
        int per_cu = 0;
        if (hipOccupancyMaxActiveBlocksPerMultiprocessor(&per_cu, (const void*)hybrid_fwd, 512, LDS_BYTES) != hipSuccess || per_cu < 1) fprintf(stderr, "kernel_launch: occupancy query says %d blocks per CU\n", per_cu);
        (void)hipGetLastError();
        grid = 256;
    }
    if (grid < 0) return;
    (void)hipMemsetAsync((char*)d_ws + WS_CTL, 0, 16384, stream);
    Params p{};
    p.x = (const float*)d_in[0]; p.norm_gain = (const float*)d_in[1]; p.w_in = (const float*)d_in[2]; p.pool_w = (const float*)d_in[3];
    p.pool_scale = (const float*)d_in[4]; p.shift_mu = (const float*)d_in[5]; p.w0 = (const float*)d_in[6]; p.w_up = (const float*)d_in[7];
    p.a0 = (const float*)d_in[8]; p.a_up = (const float*)d_in[9]; p.k_k = (const float*)d_in[10]; p.k_a = (const float*)d_in[11];
    p.r_k = (const float*)d_in[12]; p.gn_gain = (const float*)d_in[13]; p.gn_bias = (const float*)d_in[14]; p.w_out = (const float*)d_in[15];
    p.final_gain = (const float*)d_in[16];
    p.out = (float*)d_out; p.ws = (unsigned char*)d_ws; p.dup_n = 2;
#if N_LAUNCHES == 1
    p.ph_lo = 0; p.ph_hi = NPH;
    hipLaunchKernelGGL(hybrid_fwd, dim3(grid), dim3(512), LDS_BYTES, stream, p);
#else
    for (int k = 0; k < NPH; ++k) { p.ph_lo = k; p.ph_hi = k + 1; hipLaunchKernelGGL(hybrid_fwd, dim3(grid), dim3(512), LDS_BYTES, stream, p); }
#endif
}
```

```cpp
#include <hip/hip_runtime.h>
#include <stdint.h>
#include <cstdio>

typedef unsigned short u16;
typedef short bf16x8 __attribute__((ext_vector_type(8)));
typedef float f32x4 __attribute__((ext_vector_type(4)));
typedef float f32x2 __attribute__((ext_vector_type(2)));
typedef unsigned u32x2 __attribute__((ext_vector_type(2)));
typedef unsigned u32x4 __attribute__((ext_vector_type(4)));

#ifndef PROBE_DUP
#define PROBE_DUP -1
#endif
#ifndef N_LAUNCHES
#define N_LAUNCHES 1
#endif

constexpr int NTOK = 16384, DM = 1024, SEQ = 2048, DIN = 3200, DINP = 3328;
constexpr int NPH = 5;
constexpr int LDS_BYTES = 18432 + 8 * 17408;

constexpr size_t WS_CTL = 0;
constexpr size_t WS_WINT = 16384;
constexpr size_t WS_WOUTT = WS_WINT + (size_t)DINP * 1024 * 2;
constexpr size_t WS_WUPT = WS_WOUTT + (size_t)1024 * 1024 * 2;
constexpr size_t WS_AUPT = WS_WUPT + 512 * 64 * 2;
constexpr size_t WS_POOLT = WS_AUPT + 512 * 64 * 2;
constexpr size_t WS_Z = WS_POOLT + 4 * 128 * 128 * 2;
constexpr size_t WS_REC = WS_Z + (size_t)NTOK * DIN * 2;
constexpr size_t WS_Y = WS_REC + (size_t)64 * 2048 * 896;
constexpr size_t WS_BONUS = WS_Y + (size_t)NTOK * 1024 * 2;
constexpr size_t WS_PART = WS_BONUS + (size_t)64 * 2048 * 4;
constexpr size_t WS_END = WS_PART + (size_t)64 * 4 * 256 * 4;
constexpr int CTL_CNT_WORD = 3584;
constexpr int NUNIT = 64 * 128;
constexpr size_t CH_AF = WS_REC;
constexpr size_t CH_RF = CH_AF + (size_t)NUNIT * 2048;
constexpr size_t CH_BKF = CH_RF + (size_t)NUNIT * 2048;
constexpr size_t CH_ARB = CH_BKF + (size_t)NUNIT * 4096;
constexpr size_t CH_G15 = CH_ARB + (size_t)NUNIT * 512;
constexpr size_t CH_END = CH_G15 + (size_t)NUNIT * 256;
constexpr size_t WS_VB = CH_END;
static_assert(WS_VB + (size_t)NTOK * 512 * 2 <= WS_Y, "chunk operands + v must fit in the record region");
constexpr size_t OUT_CHV = 0;
constexpr size_t OUT_GB = (size_t)NUNIT * 4 * 3 * 512;
static_assert(OUT_GB + (size_t)NTOK * 512 * 2 <= (size_t)NTOK * DM * 4, "d_out scratch");

struct Params {
    const float* x; const float* norm_gain; const float* w_in; const float* pool_w; const float* pool_scale;
    const float* shift_mu; const float* w0; const float* w_up; const float* a0; const float* a_up;
    const float* k_k; const float* k_a; const float* r_k; const float* gn_gain; const float* gn_bias;
    const float* w_out; const float* final_gain;
    float* out; unsigned char* ws;
    int ph_lo, ph_hi, dup_n, pad;
};

extern __shared__ __attribute__((aligned(16))) unsigned char dyn_smem[];

__device__ __forceinline__ float bf2f(u16 v) { return __uint_as_float(((unsigned)v) << 16); }
__device__ __forceinline__ float bflo(unsigned v) { return __uint_as_float(v << 16); }
__device__ __forceinline__ float bfhi(unsigned v) { return __uint_as_float(v & 0xffff0000u); }
typedef __bf16 bf16x2_t __attribute__((ext_vector_type(2)));
__device__ __forceinline__ unsigned pack2(float lo, float hi) { bf16x2_t v = {(__bf16)lo, (__bf16)hi}; return __builtin_bit_cast(unsigned, v); }
__device__ __forceinline__ u16 f2bf(float f) { return (u16)(pack2(f, 0.f) & 0xffffu); }
__device__ __forceinline__ float wave_sum(float v) {
#pragma unroll
    for (int m = 32; m >= 1; m >>= 1) v += __shfl_xor(v, m, 64);
    return v;
}
__device__ __forceinline__ float rcp_(float v) { return __builtin_amdgcn_rcpf(v); }
__device__ __forceinline__ float rsq_(float v) { return __builtin_amdgcn_rsqf(v); }
__device__ __forceinline__ float sigmoidf_(float v) { return rcp_(1.f + __expf(-v)); }
__device__ __forceinline__ float tanhf_(float v) { return 1.f - 2.f * rcp_(1.f + __expf(2.f * v)); }

#define XB_TMO      128
#define XB_XCNT(j)  (256  + 64 * (j))
#define XB_XSUB(j)  (1280 + 64 * (j))
#define XB_XGEN(j)  (2304 + 64 * (j))
#define XB_TOP      3328
#define XB_TOPGEN   3392
#define XCD_BAR_WORDS 3456
#define XB_SPIN_CAP (1u << 22)
#define LAS __attribute__((address_space(3)))

__device__ __forceinline__ unsigned xb_ld(unsigned* p)              { return __hip_atomic_load(p, __ATOMIC_RELAXED, __HIP_MEMORY_SCOPE_AGENT); }
__device__ __forceinline__ unsigned xb_add(unsigned* p, unsigned v) { return __hip_atomic_fetch_add(p, v, __ATOMIC_RELAXED, __HIP_MEMORY_SCOPE_AGENT); }
__device__ __forceinline__ unsigned xb_xcc_id() { return (unsigned)__builtin_amdgcn_s_getreg((3 << 11) | 20) & 0xFu; }
#define XB_SPIN(cond, bar) do { unsigned _sp = 0; while (cond) { __builtin_amdgcn_s_sleep(1); \
    if ((++_sp & 255u) == 0u) { if (xb_ld(&(bar)[XB_TMO])) break; if (_sp > XB_SPIN_CAP) { atomicAdd(&(bar)[XB_TMO], 1u); break; } } } } while (0)

struct XcdBarrier { unsigned* bar; unsigned x; volatile LAS unsigned* st; };

__device__ __forceinline__ XcdBarrier xcd_barrier_post(unsigned* bar, volatile LAS unsigned* st) {
    XcdBarrier b; b.bar = bar; b.x = xb_xcc_id(); b.st = st;
    if (threadIdx.x == 0) (void)xb_add(&bar[XB_XCNT(b.x)], 1u);
    return b;
}
__device__ __forceinline__ void xcd_barrier_complete(unsigned* bar, unsigned x, unsigned& nloc, unsigned& nx) {
    const unsigned G = gridDim.x * gridDim.y * gridDim.z;
    unsigned sum, cnt, mine, sp = 0u;
    for (;;) {
        sum = 0u; cnt = 0u; mine = 0u;
#pragma unroll
        for (unsigned j = 0; j < 16; ++j) { const unsigned c = xb_ld(&bar[XB_XCNT(j)]); sum += c; cnt += (c > 0u) ? 1u : 0u; mine = (j == x) ? c : mine; }
        if (sum == G) break;
        __builtin_amdgcn_s_sleep(1);
        if ((++sp & 255u) == 0u) { if (xb_ld(&bar[XB_TMO])) break; if (sp > XB_SPIN_CAP) { atomicAdd(&bar[XB_TMO], 1u); break; } }
    }
    nloc = mine > 0u ? mine : 1u; nx = cnt > 0u ? cnt : 1u;
}
__device__ __forceinline__ void xcd_barrier(const XcdBarrier& b) {
    asm volatile("s_waitcnt vmcnt(0)" ::: "memory");
    __syncthreads();
    if (threadIdx.x == 0) {
        unsigned* bar = b.bar;
        __builtin_amdgcn_s_waitcnt(0);
        unsigned nloc = b.st[0], nx = b.st[1];
        if (nloc == 0u) { xcd_barrier_complete(bar, b.x, nloc, nx); b.st[0] = nloc; b.st[1] = nx; }
        const unsigned old = xb_add(&bar[XB_XSUB(b.x)], 1u);
        const unsigned gen = old / nloc;
        if (old + 1u == (gen + 1u) * nloc) {
            __builtin_amdgcn_fence(__ATOMIC_RELEASE, "agent");
            asm volatile("s_waitcnt vmcnt(0)" ::: "memory");
            const unsigned og = xb_add(&bar[XB_TOP], 1u);
            const unsigned tg = og / nx;
            if (og + 1u == (tg + 1u) * nx) xb_add(&bar[XB_TOPGEN], 1u);
            else XB_SPIN(xb_ld(&bar[XB_TOPGEN]) == tg, bar);
            __builtin_amdgcn_fence(__ATOMIC_ACQUIRE, "agent");
            xb_add(&bar[XB_XGEN(b.x)], 1u);
            asm volatile("s_waitcnt vmcnt(0)" ::: "memory");
        } else {
            XB_SPIN(xb_ld(&bar[XB_XGEN(b.x)]) == gen, bar);
            __builtin_amdgcn_fence(__ATOMIC_ACQUIRE, "agent");
            asm volatile("s_waitcnt vmcnt(0)" ::: "memory");
        }
    }
    __syncthreads();
}

constexpr int BM = 256, BK = 64, HALF = 128, HTB = HALF * BK * 2, STAGE_BYTES = 8 * HTB, NXCD = 8, WGM = 8;
__device__ __forceinline__ int lds_byte(int r, int c) { const int st = (r >> 4) * 2 + (c >> 5), rr = r & 15, cc = c & 31, ob = rr * 64 + cc * 2; return st * 1024 + (ob ^ (((ob >> 9) & 1) << 5)); }
__device__ __forceinline__ void stage_rc(int b, int& R, int& C) { const int st = b / 1024, sb = b % 1024, swz = sb ^ (((sb >> 9) & 1) << 5); R = (st >> 1) * 16 + swz / 64; C = (st & 1) * 32 + (swz % 64) / 2; }
__device__ __forceinline__ int perm32(int rho) { const int n = rho >> 4, i = rho & 15; return 8 * (i >> 2) + 4 * n + (i & 3); }

struct Unit { int pm, pn; };
struct Gemm { const u16* A; const u16* Bt; int M, N, K, Nvalid; };
struct StaticOrder {
    int nM, nN, nwg, G, c;
    __device__ void init(int M, int N, int G_, int c_) { nM = M / BM; nN = N / BM; nwg = nM * nN; G = G_; c = c_; }
    __device__ bool next(int i, Unit& u) const {
        const long L = (long)i * G + c; if (L >= nwg) return false;
        int wgid = (int)L; { const int q = nwg / NXCD, r = nwg % NXCD, xcd = wgid % NXCD, off = wgid / NXCD; wgid = (xcd < r ? xcd * (q + 1) : r * (q + 1) + (xcd - r) * q) + off; }
        const int nig = WGM * nN, gid = wgid / nig, fm = gid * WGM, gsz = (nM - fm) < WGM ? (nM - fm) : WGM;
        u.pm = fm + ((wgid % nig) % gsz); u.pn = (wgid % nig) / gsz; return true;
    }
};
struct EpiZ {
    static constexpr bool PERM = true, AFTER_DRAIN = false;
    u16* Z;
    __device__ __forceinline__ void operator()(const f32x4 (&acc)[2][2][4][2], const Unit& u, int wr, int wc, int fr, int fq) const {
        const int row0 = u.pm * BM + wr * 64 + fr, col0 = u.pn * BM + wc * 32 + 8 * fq;
#pragma unroll
        for (int ai = 0; ai < 2; ++ai)
#pragma unroll
            for (int m = 0; m < 4; ++m) { u16* rowp = Z + (size_t)(row0 + ai * HALF + m * 16) * DIN;
#pragma unroll
                for (int bj = 0; bj < 2; ++bj) { const int col = col0 + bj * HALF; const f32x4 v0 = acc[ai][bj][m][0], v1 = acc[ai][bj][m][1];
                    if (col < DIN) *(u32x4*)(rowp + col) = (u32x4){pack2(v0[0], v0[1]), pack2(v0[2], v0[3]), pack2(v1[0], v1[1]), pack2(v1[2], v1[3])}; } }
    }
};
struct EpiRes {
    static constexpr bool PERM = false, AFTER_DRAIN = false;
    const float* x; float* out;
    __device__ __forceinline__ void operator()(const f32x4 (&acc)[2][2][4][2], const Unit& u, int wr, int wc, int fr, int fq) const {
        const int row0 = u.pm * BM + wr * 64 + fr, col0 = u.pn * BM + wc * 32 + 4 * fq;
#pragma unroll
        for (int ai = 0; ai < 2; ++ai)
#pragma unroll
            for (int m = 0; m < 4; ++m) { const size_t ro = (size_t)(row0 + ai * HALF + m * 16) * DM + col0;
#pragma unroll
                for (int bj = 0; bj < 2; ++bj)
#pragma unroll
                    for (int n = 0; n < 2; ++n) { const f32x4 xv = *(const f32x4*)(x + ro + bj * HALF + n * 16); *(f32x4*)(out + ro + bj * HALF + n * 16) = xv + acc[ai][bj][m][n]; } }
    }
};
struct EpiResNorm {
    static constexpr bool PERM = false, AFTER_DRAIN = true;
    const float* x; const float* gain; float* out; float* part; unsigned* cnt;
    __device__ __forceinline__ void fused(f32x4 (&acc)[2][2][4][2], const Unit& u, int wr, int wc, int fr, int fq, LAS unsigned char* lds) const {
        const int row0 = u.pm * BM + wr * 64 + fr, col0 = u.pn * BM + wc * 32 + 4 * fq;
        LAS float* red = (LAS float*)lds;
        LAS float* tot = red + 1024;
        float rs[2][4];
#pragma unroll
        for (int ai = 0; ai < 2; ++ai)
#pragma unroll
            for (int m = 0; m < 4; ++m) { const size_t ro = (size_t)(row0 + ai * HALF + m * 16) * DM + col0; float s = 0.f;
#pragma unroll
                for (int bj = 0; bj < 2; ++bj)
#pragma unroll
                    for (int n = 0; n < 2; ++n) { const f32x4 v = __builtin_nontemporal_load((const f32x4*)(x + ro + bj * HALF + n * 16)) + acc[ai][bj][m][n]; acc[ai][bj][m][n] = v; s += v[0] * v[0] + v[1] * v[1] + v[2] * v[2] + v[3] * v[3]; }
                s += __shfl_xor(s, 16, 64); s += __shfl_xor(s, 32, 64);
                rs[ai][m] = s; }
        if (fq == 0) {
#pragma unroll
            for (int ai = 0; ai < 2; ++ai)
#pragma unroll
                for (int m = 0; m < 4; ++m) red[((wr * 4 + wc) * 8 + ai * 4 + m) * 16 + fr] = rs[ai][m];
        }
        __syncthreads();
        if (threadIdx.x < 256) {
            const int rl = threadIdx.x, ai = rl >> 7, wr_ = (rl >> 6) & 1, m = (rl >> 4) & 3, fr_ = rl & 15;
            const int o = ((wr_ * 4) * 8 + ai * 4 + m) * 16 + fr_;
            const float s = red[o] + red[o + 128] + red[o + 256] + red[o + 384];
            __hip_atomic_store(part + ((size_t)u.pm * 4 + u.pn) * 256 + rl, s, __ATOMIC_RELAXED, __HIP_MEMORY_SCOPE_AGENT);
        }
        asm volatile("s_waitcnt vmcnt(0)" ::: "memory");
        __syncthreads();
        if (threadIdx.x == 0) {
            __builtin_amdgcn_fence(__ATOMIC_RELEASE, "agent");
            asm volatile("s_waitcnt vmcnt(0)" ::: "memory");
            __hip_atomic_fetch_add(cnt + u.pm, 1u, __ATOMIC_RELAXED, __HIP_MEMORY_SCOPE_AGENT);
            unsigned sp = 0;
            while (__hip_atomic_load(cnt + u.pm, __ATOMIC_RELAXED, __HIP_MEMORY_SCOPE_AGENT) < 4u) { __builtin_amdgcn_s_sleep(1); if (++sp > (1u << 24)) break; }
            __builtin_amdgcn_fence(__ATOMIC_ACQUIRE, "agent");
            asm volatile("s_waitcnt vmcnt(0)" ::: "memory");
        }
        __syncthreads();
        for (int e = threadIdx.x; e < 1024; e += 512) tot[e] = __hip_atomic_load(part + (size_t)u.pm * 1024 + e, __ATOMIC_RELAXED, __HIP_MEMORY_SCOPE_AGENT);
        __syncthreads();
#pragma unroll
        for (int ai = 0; ai < 2; ++ai)
#pragma unroll
            for (int m = 0; m < 4; ++m) { const int rl = ai * 128 + wr * 64 + m * 16 + fr;
                const float inv = rsq_((tot[rl] + tot[256 + rl] + tot[512 + rl] + tot[768 + rl]) * (1.f / 1024.f) + 1e-6f);
                const size_t ro = (size_t)(row0 + ai * HALF + m * 16) * DM + col0;
#pragma unroll
                for (int bj = 0; bj < 2; ++bj)
#pragma unroll
                    for (int n = 0; n < 2; ++n) { const f32x4 g = *(const f32x4*)(gain + col0 + bj * HALF + n * 16); __builtin_nontemporal_store(acc[ai][bj][m][n] * inv * g, (f32x4*)(out + ro + bj * HALF + n * 16)); } }
    }
};

template <class Epi, class Sched>
__device__ __forceinline__ void gemm_phase(LAS unsigned char* lds, const Gemm g, const Sched& S, const Epi& E) {
    const int tid = threadIdx.x, wid = __builtin_amdgcn_readfirstlane(tid >> 6), lane = tid & 63, wr = wid >> 2, wc = wid & 3, fr = lane & 15, fq = lane >> 4;
    const int K = g.K, nt = K / BK;
    unsigned voffA[2], voffB[2];
#pragma unroll
    for (int i = 0; i < 2; ++i) { int R, C; stage_rc(tid * 16 + i * 8192, R, C); const int Rb = Epi::PERM ? ((R & ~31) + perm32(R & 31)) : R;
        voffA[i] = (unsigned)(R * K + C) * 2u; voffB[i] = (unsigned)(Rb * K + C) * 2u; }
    const size_t kstep = (size_t)(BK * 2);
    const size_t hstep = (size_t)HALF * K * 2;
    const size_t tstep = 2 * hstep;
    const unsigned ldsw = (unsigned)wid * 1024u;
    const int aoff = lds_byte(wr * 64 + fr, fq * 8), boff = lds_byte(wc * 32 + fr, fq * 8);
#define PG8_SA(b, h) (((b) * 2 + (h)) * HTB)
#define PG8_SB(b, h) ((4 + (b) * 2 + (h)) * HTB)
#define PG8_STAGE(bufoff, gbase, voff) do { _Pragma("unroll") for (int _i = 0; _i < 2; ++_i) \
        __builtin_amdgcn_global_load_lds((const unsigned*)((const char*)(gbase) + (voff)[_i]), (LAS unsigned*)(lds + (bufoff) + ldsw + _i * 8192), 16, 0, 0); } while (0)
#define PG8_LDA(dst, b, h) do { _Pragma("unroll") for (int m = 0; m < 4; ++m) _Pragma("unroll") for (int k = 0; k < 2; ++k) dst[m][k] = *(const LAS bf16x8*)(lds + PG8_SA(b, h) + aoff + m * 2048 + k * 1024); } while (0)
#define PG8_LDB(dst, b, h) do { _Pragma("unroll") for (int n = 0; n < 2; ++n) _Pragma("unroll") for (int k = 0; k < 2; ++k) dst[n][k] = *(const LAS bf16x8*)(lds + PG8_SB(b, h) + boff + n * 2048 + k * 1024); } while (0)
#define PG8_MMA(ai, bj, At, Bt) do { __builtin_amdgcn_s_setprio(1); _Pragma("unroll") for (int m = 0; m < 4; ++m) _Pragma("unroll") for (int n = 0; n < 2; ++n) _Pragma("unroll") for (int k = 0; k < 2; ++k) \
        acc[ai][bj][m][n] = __builtin_amdgcn_mfma_f32_16x16x32_bf16(Bt[n][k], At[m][k], acc[ai][bj][m][n], 0, 0, 0); __builtin_amdgcn_s_setprio(0); } while (0)
#define PG8_WAIT_V(n) asm volatile("s_waitcnt vmcnt(" #n ")" ::: "memory")
#define PG8_WAIT_L(n) asm volatile("s_waitcnt lgkmcnt(" #n ")" ::: "memory")
#define PG8_BAR __builtin_amdgcn_s_barrier()
#define PG8_SCHED __builtin_amdgcn_sched_barrier(0)
    Unit cur, nxt; int ui = 0;
    if (!S.next(0, cur)) return;
    f32x4 acc[2][2][4][2];
#pragma unroll
    for (int a = 0; a < 2; ++a)
#pragma unroll
        for (int b = 0; b < 2; ++b)
#pragma unroll
            for (int m = 0; m < 4; ++m)
#pragma unroll
                for (int n = 0; n < 2; ++n) acc[a][b][m][n] = (f32x4){0.f, 0.f, 0.f, 0.f};
    bf16x8 At[4][2], B0[2][2], B1[2][2];
    const char* cA = (const char*)g.A + (size_t)cur.pm * tstep; const char* cB = (const char*)g.Bt + (size_t)cur.pn * tstep;
    PG8_STAGE(PG8_SB(0, 0), cB, voffB); PG8_STAGE(PG8_SA(0, 0), cA, voffA); PG8_STAGE(PG8_SB(0, 1), cB + hstep, voffB); PG8_STAGE(PG8_SA(0, 1), cA + hstep, voffA);
    if (wr == 1) PG8_BAR;
    PG8_WAIT_V(4); PG8_BAR;
    PG8_STAGE(PG8_SB(1, 0), cB + kstep, voffB); PG8_STAGE(PG8_SA(1, 0), cA + kstep, voffA); PG8_STAGE(PG8_SB(1, 1), cB + hstep + kstep, voffB);
    PG8_WAIT_V(6); PG8_BAR;
    for (;;) {
        const bool has_next = S.next(ui + 1, nxt);
        const char* nA = has_next ? (const char*)g.A + (size_t)nxt.pm * tstep : cA; const char* nB = has_next ? (const char*)g.Bt + (size_t)nxt.pn * tstep : cB;
        const bool rhalf = (cur.pn * BM + HALF) < g.Nvalid;
        for (int t = 0; t < nt; t += 2) {
            const bool last = (t == nt - 2);
            const char* a1 = cA + (size_t)(t + 1) * kstep;
            const char* a2 = last ? nA : cA + (size_t)(t + 2) * kstep; const char* b2 = last ? nB : cB + (size_t)(t + 2) * kstep;
            const char* a3 = a2 + kstep; const char* b3 = b2 + kstep;
            PG8_LDB(B0, 0, 0); PG8_SCHED; PG8_LDA(At, 0, 0); PG8_STAGE(PG8_SA(1, 1), a1 + hstep, voffA);
            PG8_WAIT_L(8); PG8_BAR; PG8_WAIT_L(0); PG8_MMA(0, 0, At, B0); PG8_BAR; PG8_SCHED;
            PG8_LDB(B1, 0, 1); PG8_STAGE(PG8_SB(0, 0), b2, voffB);
            PG8_BAR; PG8_WAIT_L(0); if (rhalf) PG8_MMA(0, 1, At, B1); PG8_BAR;
            PG8_LDA(At, 0, 1); PG8_STAGE(PG8_SA(0, 0), a2, voffA);
            PG8_BAR; PG8_WAIT_L(0); PG8_MMA(1, 0, At, B0); PG8_BAR; PG8_SCHED;
            PG8_STAGE(PG8_SB(0, 1), b2 + hstep, voffB);
            PG8_WAIT_V(6); PG8_BAR; if (rhalf) PG8_MMA(1, 1, At, B1); PG8_BAR;
            PG8_LDB(B0, 1, 0); PG8_SCHED; PG8_LDA(At, 1, 0); PG8_STAGE(PG8_SA(0, 1), a2 + hstep, voffA);
            PG8_WAIT_L(8); PG8_BAR; PG8_WAIT_L(0); PG8_MMA(0, 0, At, B0); PG8_BAR; PG8_SCHED;
            PG8_LDB(B1, 1, 1); PG8_STAGE(PG8_SB(1, 0), b3, voffB);
            PG8_BAR; PG8_WAIT_L(0); if (rhalf) PG8_MMA(0, 1, At, B1); PG8_BAR;
            PG8_LDA(At, 1, 1); PG8_STAGE(PG8_SA(1, 0), a3, voffA);
            PG8_BAR; PG8_WAIT_L(0); PG8_MMA(1, 0, At, B0); PG8_BAR; PG8_SCHED;
            PG8_STAGE(PG8_SB(1, 1), b3 + hstep, voffB);
            PG8_WAIT_V(6); PG8_BAR; if (rhalf) PG8_MMA(1, 1, At, B1); PG8_BAR;
        }
        if constexpr (!Epi::AFTER_DRAIN) E(acc, cur, wr, wc, fr, fq);
        if (!has_next) break;
#pragma unroll
        for (int a = 0; a < 2; ++a)
#pragma unroll
            for (int b = 0; b < 2; ++b)
#pragma unroll
                for (int m = 0; m < 4; ++m)
#pragma unroll
                    for (int n = 0; n < 2; ++n) acc[a][b][m][n] = (f32x4){0.f, 0.f, 0.f, 0.f};
        cur = nxt; cA = nA; cB = nB; ++ui;
    }
    PG8_WAIT_V(0);
    if (wr == 0) PG8_BAR;
    PG8_BAR;
    if constexpr (Epi::AFTER_DRAIN) E.fused(acc, cur, wr, wc, fr, fq, lds);
#undef PG8_SA
#undef PG8_SB
#undef PG8_STAGE
#undef PG8_LDA
#undef PG8_LDB
#undef PG8_MMA
#undef PG8_WAIT_V
#undef PG8_WAIT_L
#undef PG8_BAR
#undef PG8_SCHED
}

#define WSYNC() do { __builtin_amdgcn_wave_barrier(); asm volatile("s_waitcnt lgkmcnt(0)" ::: "memory"); __builtin_amdgcn_wave_barrier(); } while (0)
__device__ void phase0(const Params& p) {
    const int tid = threadIdx.x, lane = tid & 63, wave = tid >> 6, blk = blockIdx.x;
    u16* Hbf = (u16*)p.out;
#pragma unroll 1
    for (int r0 = 0; r0 < 8; r0 += 4) {
        f32x4 v[4][4]; float ss[4];
#pragma unroll
        for (int i = 0; i < 4; ++i) {
            const f32x4* xr = (const f32x4*)(p.x + (size_t)(blk * 64 + wave * 8 + r0 + i) * DM);
#pragma unroll
            for (int q = 0; q < 4; ++q) v[i][q] = __builtin_nontemporal_load(xr + lane + 64 * q);
        }
#pragma unroll
        for (int i = 0; i < 4; ++i) {
            float s = 0.f;
#pragma unroll
            for (int q = 0; q < 4; ++q) s += v[i][q][0] * v[i][q][0] + v[i][q][1] * v[i][q][1] + v[i][q][2] * v[i][q][2] + v[i][q][3] * v[i][q][3];
            ss[i] = wave_sum(s);
        }
#pragma unroll
        for (int i = 0; i < 4; ++i) {
            const int row = blk * 64 + wave * 8 + r0 + i;
            const float inv = rsq_(ss[i] * (1.f / 1024.f) + 1e-6f);
#pragma unroll
            for (int q = 0; q < 4; ++q) {
                const f32x4 g = ((const f32x4*)p.norm_gain)[lane + 64 * q];
                u32x2 o; o.x = pack2(v[i][q][0] * inv * g[0], v[i][q][1] * inv * g[1]); o.y = pack2(v[i][q][2] * inv * g[2], v[i][q][3] * inv * g[3]);
                *(u32x2*)(Hbf + (size_t)row * DM + (lane + 64 * q) * 4) = o;
            }
        }
    }
    u16* WinT = (u16*)(p.ws + WS_WINT); u16* WoutT = (u16*)(p.ws + WS_WOUTT);
    {
        float* tl = (float*)dyn_smem + wave * (64 * 65);
        const int t = blk + 256 * wave;
        if (t < 832 + 256) {
            const float* src; u16* dst; int kt, ntile, N;
            if (t < 832) { kt = t & 15; ntile = t >> 4; src = p.w_in; N = DIN; dst = WinT; }
            else { const int t2 = t - 832; kt = t2 & 15; ntile = t2 >> 4; src = p.w_out; N = 1024; dst = WoutT; }
            const int k0 = kt * 64, n0 = ntile * 64, n4 = (lane & 15) * 4;
            f32x4 v[16];
#pragma unroll
            for (int i = 0; i < 16; ++i) { const int kk = (lane >> 4) + 4 * i; v[i] = (n0 + n4 < N) ? *(const f32x4*)(src + (size_t)(k0 + kk) * N + n0 + n4) : (f32x4){0.f, 0.f, 0.f, 0.f}; }
#pragma unroll
            for (int i = 0; i < 16; ++i) { const int kk = (lane >> 4) + 4 * i; float* d = tl + kk * 65 + n4; d[0] = v[i][0]; d[1] = v[i][1]; d[2] = v[i][2]; d[3] = v[i][3]; }
            WSYNC();
            const int kp = lane & 31, nh = lane >> 5;
#pragma unroll 8
            for (int i = 0; i < 32; ++i) { const int nn = 2 * i + nh;
                *(unsigned*)(dst + (size_t)(n0 + nn) * 1024 + k0 + 2 * kp) = pack2(tl[(2 * kp) * 65 + nn], tl[(2 * kp + 1) * 65 + nn]); }
        }
    }
    u16* WupT = (u16*)(p.ws + WS_WUPT); u16* AupT = (u16*)(p.ws + WS_AUPT); u16* PoolT = (u16*)(p.ws + WS_POOLT);
    const int gt = blk * 512 + tid;
    if (gt < 32768) { const int c = gt >> 6, j = gt & 63; WupT[gt] = f2bf(p.w_up[j * 512 + c]); AupT[gt] = f2bf(p.a_up[j * 512 + c]); }
    if (gt < 65536) { const int g = gt >> 14, d = (gt >> 7) & 127, c = gt & 127; PoolT[gt] = f2bf(p.pool_w[(g * 128 + c) * 128 + d]); }
}

__device__ void phase1(const Params& p) {
    Gemm g; g.A = (const u16*)p.out; g.Bt = (const u16*)(p.ws + WS_WINT); g.M = NTOK; g.N = DINP; g.K = 1024; g.Nvalid = DIN;
    StaticOrder S; S.init(NTOK, DINP, 256, blockIdx.x);
    EpiZ E; E.Z = (u16*)(p.ws + WS_Z);
    gemm_phase((LAS unsigned char*)dyn_smem, g, S, E);
}
__device__ void phase4(const Params& p) {
    Gemm g; g.A = (const u16*)(p.ws + WS_Y); g.Bt = (const u16*)(p.ws + WS_WOUTT); g.M = NTOK; g.N = 1024; g.K = 1024; g.Nvalid = 1024;
    StaticOrder S; S.init(NTOK, 1024, 256, blockIdx.x);
    EpiResNorm E; E.x = p.x; E.gain = p.final_gain; E.out = p.out; E.part = (float*)(p.ws + WS_PART); E.cnt = (unsigned*)(p.ws + WS_CTL) + CTL_CNT_WORD;
    gemm_phase((LAS unsigned char*)dyn_smem, g, S, E);
}

template <int CTRL> __device__ __forceinline__ float dpp_add(float v) {
    const int t = __builtin_amdgcn_update_dpp(0, __float_as_int(v), CTRL, 0xf, 0xf, false);
    return v + __int_as_float(t);
}
__device__ __forceinline__ float row16_allsum(float v) {
    v = dpp_add<0x128>(v); v = dpp_add<0x124>(v); v = dpp_add<0x122>(v); v = dpp_add<0x121>(v);
    return v;
}
#define MFMA16(a, b, c) __builtin_amdgcn_mfma_f32_16x16x32_bf16((a), (b), (c), 0, 0, 0)
__device__ __forceinline__ bf16x8 as_bf8(u32x4 v) { return __builtin_bit_cast(bf16x8, v); }
template <int W> __device__ __forceinline__ void pooled_run(const u16* __restrict__ Z, u16* pooled, int t0, int s0, int cp, int hf) {
    const int c0 = 2 * cp, tb = hf * 32;
    unsigned raw[W - 1 + 32];
#pragma unroll
    for (int i = 0; i < W - 1 + 32; ++i) { const int tt = tb - (W - 1) + i; raw[i] = (s0 + tt >= 0) ? *(const unsigned*)(Z + (size_t)(t0 + tt) * DIN + c0) : 0u; }
    float sum0 = 0.f, sum1 = 0.f;
#pragma unroll
    for (int i = 0; i < W - 1; ++i) { sum0 += bflo(raw[i]); sum1 += bfhi(raw[i]); }
#pragma unroll
    for (int j = 0; j < 32; ++j) {
        const int tt = tb + j, s = s0 + tt;
        const float u0 = bflo(raw[W - 1 + j]), u1 = bfhi(raw[W - 1 + j]);
        sum0 += u0; sum1 += u1;
        const float rc = rcp_((float)((s + 1 < W) ? (s + 1) : W));
        *(unsigned*)(pooled + tt * 520 + c0) = pack2(sum0 * rc - u0, sum1 * rc - u1);
        sum0 -= bflo(raw[j]); sum1 -= bfhi(raw[j]);
    }
}
constexpr int RST = 912;
__device__ __forceinline__ void p2_zload(u32x4 (&zq)[7], const u16* __restrict__ Z, size_t T0, bool has_halo, int h, int lane) {
#pragma unroll
    for (int q = 0; q < 7; ++q) {
        const int pidx = lane + 64 * q, rr = pidx / 24, w = pidx - rr * 24, a = w >> 3, pc = w & 7;
        u32x4 v = (u32x4){0u, 0u, 0u, 0u};
        if (pidx < 17 * 24) {
            if (rr < 16) v = *(const u32x4*)(Z + (T0 + rr) * DIN + 1024 + a * 512 + h * 64 + pc * 8);
            else if (has_halo) v = *(const u32x4*)(Z + (T0 - 1) * DIN + 1024 + a * 512 + h * 64 + pc * 8);
        }
        zq[q] = v;
    }
}
constexpr int P2_WREG = 17408;
__device__ void phase2(const Params& p) {
    const int tid = threadIdx.x, lane = tid & 63, wave = tid >> 6, blk = blockIdx.x, fr = lane & 15, fq = lane >> 4;
    const int t0 = blk * 64, b = t0 >> 11, s0 = t0 & 2047;
    const u16* Z = (const u16*)(p.ws + WS_Z);
    u16* twb = (u16*)dyn_smem;
    u16* alb = twb + 64 * 72;
    u16* pooled = alb + 64 * 72;
    for (int e = tid; e < 64 * 128; e += 512) {
        const int tt = e >> 7, j = e & 127;
        const size_t zi = (size_t)(t0 + tt) * DIN + 2560 + j;
        const float cur = bf2f(Z[zi]);
        const float prev = (s0 + tt > 0) ? bf2f(Z[zi - DIN]) : 0.f;
        const float val = cur + p.shift_mu[1536 + j] * (prev - cur);
        if (j < 64) twb[tt * 72 + j] = f2bf(tanhf_(val)); else alb[tt * 72 + (j - 64)] = f2bf(val);
    }
    {
        const int cp = tid & 255, hf = tid >> 8;
        switch (wave & 3) {
            case 0: pooled_run<2>(Z, pooled, t0, s0, cp, hf); break;
            case 1: pooled_run<4>(Z, pooled, t0, s0, cp, hf); break;
            case 2: pooled_run<8>(Z, pooled, t0, s0, cp, hf); break;
            default: pooled_run<16>(Z, pooled, t0, s0, cp, hf); break;
        }
    }
    __syncthreads();
    {
        const int g = wave >> 1, dbase = (wave & 1) * 64, ch0 = g * 128 + dbase;
        const u16* PoolT = (const u16*)(p.ws + WS_POOLT); u16* Y = (u16*)(p.ws + WS_Y);
        unsigned char* gt = dyn_smem + 84992 + wave * 8704;
        u32x4 gq[8];
#pragma unroll
        for (int q = 0; q < 8; ++q) { const int idx = lane + 64 * q, row = idx >> 3, pc = idx & 7; gq[q] = *(const u32x4*)(Z + (size_t)(t0 + row) * DIN + 512 + ch0 + pc * 8); }
        f32x4 acc[4][4];
#pragma unroll
        for (int mt = 0; mt < 4; ++mt)
#pragma unroll
            for (int nt = 0; nt < 4; ++nt) acc[mt][nt] = (f32x4){0.f, 0.f, 0.f, 0.f};
#pragma unroll
        for (int ks = 0; ks < 4; ++ks) {
            bf16x8 Bf[4];
#pragma unroll
            for (int nt = 0; nt < 4; ++nt) Bf[nt] = *(const bf16x8*)(PoolT + (size_t)(ch0 + nt * 16 + fr) * 128 + ks * 32 + fq * 8);
#pragma unroll
            for (int mt = 0; mt < 4; ++mt) {
                const bf16x8 Af = *(const bf16x8*)(pooled + (mt * 16 + fr) * 520 + g * 128 + ks * 32 + fq * 8);
#pragma unroll
                for (int nt = 0; nt < 4; ++nt) acc[mt][nt] = MFMA16(Bf[nt], Af, acc[mt][nt]);
            }
        }
#pragma unroll
        for (int q = 0; q < 8; ++q) { const int idx = lane + 64 * q, row = idx >> 3, pc = idx & 7;
            *(u32x2*)(gt + row * 136 + pc * 16) = (u32x2){gq[q].x, gq[q].y}; *(u32x2*)(gt + row * 136 + pc * 16 + 8) = (u32x2){gq[q].z, gq[q].w}; }
        WSYNC();
#pragma unroll
        for (int mt = 0; mt < 4; ++mt) {
#pragma unroll
            for (int nt = 0; nt < 4; ++nt) {
                const int cl = nt * 16 + fq * 4;
                u32x2* slot = (u32x2*)(gt + (mt * 16 + fr) * 136 + cl * 2);
                const u32x2 ga = *slot;
                const f32x4 ps = *(const f32x4*)(p.pool_scale + ch0 + cl);
                const f32x4 gv = (f32x4){bflo(ga.x), bfhi(ga.x), bflo(ga.y), bfhi(ga.y)};
                f32x4 y;
#pragma unroll
                for (int jj = 0; jj < 4; ++jj) y[jj] = acc[mt][nt][jj] * ps[jj] * gv[jj] * sigmoidf_(gv[jj]);
                *slot = (u32x2){pack2(y[0], y[1]), pack2(y[2], y[3])};
            }
        }
        WSYNC();
#pragma unroll
        for (int q = 0; q < 8; ++q) { const int idx = lane + 64 * q, row = idx >> 3, pc = idx & 7;
            const u32x2 a = *(const u32x2*)(gt + row * 136 + pc * 16), b2 = *(const u32x2*)(gt + row * 136 + pc * 16 + 8);
            *(u32x4*)(Y + (size_t)(t0 + row) * 1024 + ch0 + pc * 8) = (u32x4){a.x, a.y, b2.x, b2.y}; }
    }
    {
        u16* GB = (u16*)((unsigned char*)p.out + OUT_GB);
        for (int e = tid; e < 64 * 64; e += 512) { const int tt = e >> 6, q = e & 63;
            *(u32x4*)(GB + (size_t)(t0 + tt) * 512 + q * 8) = *(const u32x4*)(Z + (size_t)(t0 + tt) * DIN + 2688 + q * 8); }
    }
    __syncthreads();
    const int h = wave, bh = b * 8 + h;
    unsigned char* WL = dyn_smem + 18432 + wave * P2_WREG;
    unsigned char* recl = WL;
    u16* AR = (u16*)WL;
    u16* BK = AR + 32 * 72;
    u16* AtT = BK + 32 * 72;
    u16* BhT = AtT + 64 * 16;
    u16* KhT = BhT + 64 * 16;
    u16* VT = KhT + 64 * 16;
    float* Pab = (float*)WL;
    u16* Tm = (u16*)(Pab + 16 * 17);
    u16* AakT = Tm + 16 * 24;
    u16* M1m = AakT + 16 * 24;
    u16* Ark = M1m + 16 * 24;
    u16* Arb = Ark + 16 * 24;
    const u16* WupT = (const u16*)(p.ws + WS_WUPT); const u16* AupT = (const u16*)(p.ws + WS_AUPT);
    float* BON = (float*)(p.ws + WS_BONUS); u16* VB = (u16*)(p.ws + WS_VB);
    unsigned char* AFg = p.ws + CH_AF; unsigned char* RFg = p.ws + CH_RF; unsigned char* BKFg = p.ws + CH_BKF; unsigned char* ARBg = p.ws + CH_ARB;
    float* G15g = (float*)(p.ws + CH_G15); unsigned char* CHVg = (unsigned char*)p.out + OUT_CHV;
    const bf16x8 zero8 = (bf16x8){0, 0, 0, 0, 0, 0, 0, 0};
    const f32x4 zero4 = (f32x4){0.f, 0.f, 0.f, 0.f};
#pragma unroll 1
    for (int mt = 0; mt < 4; ++mt) {
        const size_t u = (size_t)bh * 128 + (s0 >> 4) + mt;
        {
            u32x4 zq[7];
            p2_zload(zq, Z, (size_t)(t0 + mt * 16), (s0 + mt * 16) > 0, h, lane);
            f32x4 aw[4], aa[4];
#pragma unroll
            for (int nt = 0; nt < 4; ++nt) { aw[nt] = zero4; aa[nt] = zero4; }
#pragma unroll
            for (int ks = 0; ks < 2; ++ks) {
                const bf16x8 Aw = *(const bf16x8*)(twb + (mt * 16 + fr) * 72 + ks * 32 + fq * 8);
                const bf16x8 Aa = *(const bf16x8*)(alb + (mt * 16 + fr) * 72 + ks * 32 + fq * 8);
#pragma unroll
                for (int nt = 0; nt < 4; ++nt) {
                    const bf16x8 Bw = *(const bf16x8*)(WupT + (h * 64 + nt * 16 + fr) * 64 + ks * 32 + fq * 8);
                    const bf16x8 Ba = *(const bf16x8*)(AupT + (h * 64 + nt * 16 + fr) * 64 + ks * 32 + fq * 8);
                    aw[nt] = MFMA16(Bw, Aw, aw[nt]);
                    aa[nt] = MFMA16(Ba, Aa, aa[nt]);
                }
            }
#pragma unroll
            for (int q = 0; q < 7; ++q) {
                const int pidx = lane + 64 * q, rr = pidx / 24, w = pidx - rr * 24, a = w >> 3, pc = w & 7;
                if (pidx < 17 * 24) *(u32x4*)(recl + ((rr < 16) ? rr * RST + 256 : 16 * RST) + a * 128 + pc * 16) = zq[q];
            }
            WSYNC();
            const int tt = mt * 16 + fr, s = s0 + tt; const size_t T = (size_t)(t0 + tt);
            f32x4 Kr[4], Av[4];
            float n2 = 0.f, bon = 0.f;
            unsigned char* rec = recl + fr * RST;
            const unsigned char* prec = (fr > 0) ? (recl + (fr - 1) * RST) : (recl + 16 * RST - 256);
#pragma unroll
            for (int nt = 0; nt < 4; ++nt) {
                const int cb = h * 64 + nt * 16 + fq * 4, ci = nt * 16 + fq * 4;
                const u32x2 zr = *(const u32x2*)(rec + 256 + ci * 2), zk = *(const u32x2*)(rec + 384 + ci * 2), zv = *(const u32x2*)(rec + 512 + ci * 2);
                const u32x2 pr = *(const u32x2*)(prec + 256 + ci * 2), pk = *(const u32x2*)(prec + 384 + ci * 2), pv = *(const u32x2*)(prec + 512 + ci * 2);
                const f32x4 mur = *(const f32x4*)(p.shift_mu + cb), muk = *(const f32x4*)(p.shift_mu + 512 + cb), muv = *(const f32x4*)(p.shift_mu + 1024 + cb);
                const f32x4 w0v = *(const f32x4*)(p.w0 + cb), a0v = *(const f32x4*)(p.a0 + cb), kkv = *(const f32x4*)(p.k_k + cb), kav = *(const f32x4*)(p.k_a + cb), rkv = *(const f32x4*)(p.r_k + cb);
                const f32x4 cr = (f32x4){bflo(zr.x), bfhi(zr.x), bflo(zr.y), bfhi(zr.y)}, ck = (f32x4){bflo(zk.x), bfhi(zk.x), bflo(zk.y), bfhi(zk.y)}, cv = (f32x4){bflo(zv.x), bfhi(zv.x), bflo(zv.y), bfhi(zv.y)};
                const f32x4 qr = (f32x4){bflo(pr.x), bfhi(pr.x), bflo(pr.y), bfhi(pr.y)}, qk = (f32x4){bflo(pk.x), bfhi(pk.x), bflo(pk.y), bfhi(pk.y)}, qv = (f32x4){bflo(pv.x), bfhi(pv.x), bflo(pv.y), bfhi(pv.y)};
                f32x4 Rr, Kp, Vv, Dc;
#pragma unroll
                for (int jj = 0; jj < 4; ++jj) {
                    const float r = cr[jj] + mur[jj] * (qr[jj] - cr[jj]);
                    const float k = ck[jj] + muk[jj] * (qk[jj] - ck[jj]);
                    const float v = cv[jj] + muv[jj] * (qv[jj] - cv[jj]);
                    const float ww = aw[nt][jj] + w0v[jj];
                    const float a = sigmoidf_(aa[nt][jj] + a0v[jj]);
                    const float dec = __expf(-0.6065306597126334f * sigmoidf_(ww));
                    const float kr = k * kkv[jj];
                    n2 += kr * kr;
                    const float kp = k * (1.f + (a - 1.f) * kav[jj]);
                    bon += r * kp * rkv[jj];
                    Rr[jj] = r; Kp[jj] = kp; Vv[jj] = v; Kr[nt][jj] = kr; Av[nt][jj] = a; Dc[jj] = dec;
                }
                *(f32x4*)(rec + ci * 4) = Dc;
                *(u32x2*)(rec + 256 + ci * 2) = (u32x2){pack2(Rr[0], Rr[1]), pack2(Rr[2], Rr[3])};
                *(u32x2*)(rec + 384 + ci * 2) = (u32x2){pack2(Kp[0], Kp[1]), pack2(Kp[2], Kp[3])};
                const u32x2 vpk = (u32x2){pack2(Vv[0], Vv[1]), pack2(Vv[2], Vv[3])};
                *(u32x2*)(rec + 512 + ci * 2) = vpk;
            }
            n2 += __shfl_xor(n2, 16, 64); n2 += __shfl_xor(n2, 32, 64);
            bon += __shfl_xor(bon, 16, 64); bon += __shfl_xor(bon, 32, 64);
            const float inv = rsq_(fmaxf(n2, 1e-24f));
#pragma unroll
            for (int nt = 0; nt < 4; ++nt) {
                const int ci = nt * 16 + fq * 4;
                const f32x4 kk = Kr[nt] * inv;
                *(u32x2*)(rec + 640 + ci * 2) = (u32x2){pack2(kk[0], kk[1]), pack2(kk[2], kk[3])};
                const f32x4 nb = -(kk * Av[nt]);
                *(u32x2*)(rec + 768 + ci * 2) = (u32x2){pack2(nb[0], nb[1]), pack2(nb[2], nb[3])};
            }
            if (fq == 0) BON[(size_t)bh * 2048 + s] = bon;
        }
        WSYNC();
        {
#pragma unroll
            for (int q = 0; q < 2; ++q) { const int idx = lane + 64 * q, row = idx >> 3, pc = idx & 7;
                *(u32x4*)(VB + (size_t)(t0 + mt * 16 + row) * 512 + h * 64 + pc * 8) = *(const u32x4*)(recl + row * RST + 512 + pc * 16); }
        }
        {
            float w_[16], r_[16], kp_[16], v_[16], kk_[16], nb_[16];
#pragma unroll
            for (int t = 0; t < 16; ++t) {
                const unsigned char* rt = recl + t * RST;
                w_[t] = *(const float*)(rt + lane * 4);
                r_[t] = bf2f(*(const u16*)(rt + 256 + lane * 2)); kp_[t] = bf2f(*(const u16*)(rt + 384 + lane * 2)); v_[t] = bf2f(*(const u16*)(rt + 512 + lane * 2));
                kk_[t] = bf2f(*(const u16*)(rt + 640 + lane * 2)); nb_[t] = bf2f(*(const u16*)(rt + 768 + lane * 2));
            }
            WSYNC();
            float g = 1.f;
            float At[16], Bt[16], Kt[16];
#pragma unroll
            for (int t = 0; t < 16; ++t) {
                const float gp = g; g = g * w_[t]; const float ig = rcp_(g);
                const float a = kk_[t] * gp, rr = r_[t] * g, bb = nb_[t] * ig, kt = kp_[t] * ig;
                AR[t * 72 + lane] = f2bf(a); AR[(16 + t) * 72 + lane] = f2bf(rr); BK[t * 72 + lane] = f2bf(bb); BK[(16 + t) * 72 + lane] = f2bf(kt);
                At[t] = a; Bt[t] = bb; Kt[t] = kt;
            }
            u32x4 o0, o1;
            o0 = (u32x4){pack2(At[0], At[1]), pack2(At[2], At[3]), pack2(At[4], At[5]), pack2(At[6], At[7])};
            o1 = (u32x4){pack2(At[8], At[9]), pack2(At[10], At[11]), pack2(At[12], At[13]), pack2(At[14], At[15])};
            *(u32x4*)(AtT + lane * 16) = o0; *(u32x4*)(AtT + lane * 16 + 8) = o1;
            o0 = (u32x4){pack2(Bt[0] * g, Bt[1] * g), pack2(Bt[2] * g, Bt[3] * g), pack2(Bt[4] * g, Bt[5] * g), pack2(Bt[6] * g, Bt[7] * g)};
            o1 = (u32x4){pack2(Bt[8] * g, Bt[9] * g), pack2(Bt[10] * g, Bt[11] * g), pack2(Bt[12] * g, Bt[13] * g), pack2(Bt[14] * g, Bt[15] * g)};
            *(u32x4*)(BhT + lane * 16) = o0; *(u32x4*)(BhT + lane * 16 + 8) = o1;
            o0 = (u32x4){pack2(Kt[0] * g, Kt[1] * g), pack2(Kt[2] * g, Kt[3] * g), pack2(Kt[4] * g, Kt[5] * g), pack2(Kt[6] * g, Kt[7] * g)};
            o1 = (u32x4){pack2(Kt[8] * g, Kt[9] * g), pack2(Kt[10] * g, Kt[11] * g), pack2(Kt[12] * g, Kt[13] * g), pack2(Kt[14] * g, Kt[15] * g)};
            *(u32x4*)(KhT + lane * 16) = o0; *(u32x4*)(KhT + lane * 16 + 8) = o1;
            o0 = (u32x4){pack2(v_[0], v_[1]), pack2(v_[2], v_[3]), pack2(v_[4], v_[5]), pack2(v_[6], v_[7])};
            o1 = (u32x4){pack2(v_[8], v_[9]), pack2(v_[10], v_[11]), pack2(v_[12], v_[13]), pack2(v_[14], v_[15])};
            *(u32x4*)(VT + lane * 16) = o0; *(u32x4*)(VT + lane * 16 + 8) = o1;
            G15g[u * 64 + lane] = g;
        }
        WSYNC();
        {
            u32x2 rp[4];
#pragma unroll
            for (int ta = 0; ta < 4; ++ta) rp[ta] = *(const u32x2*)(AR + (16 + fr) * 72 + 16 * ta + 4 * fq);
            *(u32x4*)(RFg + (u * 64 + lane) * 32) = (u32x4){rp[0].x, rp[0].y, rp[1].x, rp[1].y};
            *(u32x4*)(RFg + (u * 64 + lane) * 32 + 16) = (u32x4){rp[2].x, rp[2].y, rp[3].x, rp[3].y};
#pragma unroll
            for (int ta = 0; ta < 4; ++ta) {
                const u32x2 b2 = *(const u32x2*)(BhT + (16 * ta + fr) * 16 + 4 * fq), k2 = *(const u32x2*)(KhT + (16 * ta + fr) * 16 + 4 * fq);
                *(u32x4*)(BKFg + ((u * 4 + ta) * 64 + lane) * 16) = (u32x4){b2.x, b2.y, k2.x, k2.y};
            }
#pragma unroll
            for (int sl = 0; sl < 4; ++sl) *(u32x2*)(CHVg + (((u * 4 + sl) * 3 + 2) * 64 + lane) * 8) = *(const u32x2*)(VT + (16 * sl + fr) * 16 + 4 * fq);
        }
        {
            f32x4 P00 = zero4, P01 = zero4, P10 = zero4, P11 = zero4;
#pragma unroll
            for (int s = 0; s < 2; ++s) {
                const bf16x8 a0 = *(const bf16x8*)(AR + fr * 72 + s * 32 + fq * 8), a1 = *(const bf16x8*)(AR + (16 + fr) * 72 + s * 32 + fq * 8);
                const bf16x8 b0 = *(const bf16x8*)(BK + fr * 72 + s * 32 + fq * 8), b1 = *(const bf16x8*)(BK + (16 + fr) * 72 + s * 32 + fq * 8);
                P00 = MFMA16(a0, b0, P00); P01 = MFMA16(a0, b1, P01); P10 = MFMA16(a1, b0, P10); P11 = MFMA16(a1, b1, P11);
            }
            WSYNC();
            float ak[4];
#pragma unroll
            for (int r = 0; r < 4; ++r) {
                const int i = 4 * fq + r, j = fr;
                Pab[i * 17 + j] = (j < i) ? P00[r] : 0.f;
                ak[r] = (j < i) ? P01[r] : 0.f;
                Arb[i * 24 + j] = f2bf((j <= i) ? P10[r] : 0.f);
                Ark[i * 24 + j] = f2bf((j <= i) ? P11[r] : 0.f);
            }
            *(u32x2*)(AakT + fr * 24 + 4 * fq) = (u32x2){pack2(ak[0], ak[1]), pack2(ak[2], ak[3])};
        }
        WSYNC();
        {
            float T[16];
#pragma unroll
            for (int i = 0; i < 16; ++i) T[i] = (i == fr) ? 1.f : 0.f;
#pragma unroll
            for (int j = 0; j < 15; ++j) {
#pragma unroll
                for (int i = j + 1; i < 16; ++i) T[i] += Pab[i * 17 + j] * T[j];
            }
#pragma unroll
            for (int i = 0; i < 16; ++i) Tm[i * 24 + fr] = f2bf(T[i]);
            *(u32x2*)(ARBg + (u * 64 + lane) * 8) = *(const u32x2*)(Arb + fr * 24 + 4 * fq);
        }
        WSYNC();
        const bf16x8 Tld = *(const bf16x8*)(Tm + fr * 24 + (fq & 1) * 8);
        const bf16x8 Tf = (fq < 2) ? Tld : zero8;
        {
            f32x4 D[4];
#pragma unroll
            for (int ta = 0; ta < 4; ++ta) {
                const bf16x8 ald = *(const bf16x8*)(AtT + (16 * ta + fr) * 16 + (fq & 1) * 8);
                D[ta] = MFMA16((fq < 2) ? ald : zero8, Tf, zero4);
            }
            *(u32x4*)(AFg + (u * 64 + lane) * 32) = (u32x4){pack2(D[0][0], D[0][1]), pack2(D[0][2], D[0][3]), pack2(D[1][0], D[1][1]), pack2(D[1][2], D[1][3])};
            *(u32x4*)(AFg + (u * 64 + lane) * 32 + 16) = (u32x4){pack2(D[2][0], D[2][1]), pack2(D[2][2], D[2][3]), pack2(D[3][0], D[3][1]), pack2(D[3][2], D[3][3])};
            const bf16x8 akld = *(const bf16x8*)(AakT + fr * 24 + (fq & 1) * 8);
            const f32x4 M1 = MFMA16(Tf, (fq < 2) ? akld : zero8, zero4);
#pragma unroll
            for (int r = 0; r < 4; ++r) M1m[(4 * fq + r) * 24 + fr] = f2bf(M1[r]);
        }
        WSYNC();
        {
            const bf16x8 m1ld = *(const bf16x8*)(M1m + fr * 24 + (fq & 1) * 8), rkld = *(const bf16x8*)(Ark + fr * 24 + (fq & 1) * 8);
            const bf16x8 M1f = (fq < 2) ? m1ld : zero8, Arkf = (fq < 2) ? rkld : zero8;
#pragma unroll
            for (int sl = 0; sl < 4; ++sl) {
                const bf16x8 vld = *(const bf16x8*)(VT + (16 * sl + fr) * 16 + (fq & 1) * 8);
                const bf16x8 Vb = (fq < 2) ? vld : zero8;
                const f32x4 Uh = MFMA16(M1f, Vb, zero4), Y0 = MFMA16(Arkf, Vb, zero4);
                *(u32x2*)(CHVg + (((u * 4 + sl) * 3 + 0) * 64 + lane) * 8) = (u32x2){pack2(Uh[0], Uh[1]), pack2(Uh[2], Uh[3])};
                *(u32x2*)(CHVg + (((u * 4 + sl) * 3 + 1) * 64 + lane) * 8) = (u32x2){pack2(Y0[0], Y0[1]), pack2(Y0[2], Y0[3])};
            }
        }
        WSYNC();
    }
}

struct ChunkOps { u32x4 af0, af1, rf0, rf1, bk0, bk1, bk2, bk3; u32x2 arb, uh, y0, vf; f32x4 g0, g1, g2, g3; };
constexpr int RING_SLOT = 17408, RING_NS = 7, RING_D = 6;
__device__ __forceinline__ void lds_chunk_ops(ChunkOps& o, const LAS unsigned char* s, int sl, int lane, int fq) {
    o.af0 = *(const LAS u32x4*)(s + lane * 32); o.af1 = *(const LAS u32x4*)(s + lane * 32 + 16);
    o.rf0 = *(const LAS u32x4*)(s + 2048 + lane * 32); o.rf1 = *(const LAS u32x4*)(s + 2048 + lane * 32 + 16);
    o.bk0 = *(const LAS u32x4*)(s + 4096 + (0 * 64 + lane) * 16); o.bk1 = *(const LAS u32x4*)(s + 4096 + (1 * 64 + lane) * 16);
    o.bk2 = *(const LAS u32x4*)(s + 4096 + (2 * 64 + lane) * 16); o.bk3 = *(const LAS u32x4*)(s + 4096 + (3 * 64 + lane) * 16);
    o.uh = *(const LAS u32x2*)(s + 8192 + ((sl * 3 + 0) * 64 + lane) * 8);
    o.y0 = *(const LAS u32x2*)(s + 8192 + ((sl * 3 + 1) * 64 + lane) * 8);
    o.vf = *(const LAS u32x2*)(s + 8192 + ((sl * 3 + 2) * 64 + lane) * 8);
    o.arb = *(const LAS u32x2*)(s + 16384 + lane * 8);
    o.g0 = *(const LAS f32x4*)(s + 16896 + 16 * fq); o.g1 = *(const LAS f32x4*)(s + 16896 + 64 + 16 * fq);
    o.g2 = *(const LAS f32x4*)(s + 16896 + 128 + 16 * fq); o.g3 = *(const LAS f32x4*)(s + 16896 + 192 + 16 * fq);
}
template <int LW> __device__ __forceinline__ void ring_issue(const Params& p, LAS unsigned char* ring, int bh, int c, int lane) {
    const size_t u = (size_t)bh * 128 + c;
    LAS unsigned char* slot = ring + (c % RING_NS) * RING_SLOT;
    const unsigned char* ws = p.ws; const unsigned char* od = (const unsigned char*)p.out;
#pragma unroll
    for (int j = 0; j < 8; ++j) {
        constexpr int Q0 = LW * 8; const int q = Q0 + j;
        const unsigned char* g;
        if (q < 2) g = ws + CH_AF + u * 2048 + q * 1024 + lane * 16;
        else if (q < 4) g = ws + CH_RF + u * 2048 + (q - 2) * 1024 + lane * 16;
        else if (q < 8) g = ws + CH_BKF + u * 4096 + (q - 4) * 1024 + lane * 16;
        else if (q < 14) g = od + OUT_CHV + u * 6144 + (q - 8) * 1024 + lane * 16;
        else { const int i = (q - 14) * 64 + lane; g = od + OUT_GB + (((size_t)(bh >> 3) * 2048 + c * 16 + (i >> 3)) * 512 + (bh & 7) * 64) * 2 + (i & 7) * 16; }
        __builtin_amdgcn_global_load_lds((const unsigned*)g, (LAS unsigned*)(slot + q * 1024), 16, 0, 0);
    }
    if (LW == 0) {
        __builtin_amdgcn_global_load_lds((const unsigned*)(ws + CH_ARB + u * 512 + lane * 4), (LAS unsigned*)(slot + 16384), 4, 0, 0);
        __builtin_amdgcn_global_load_lds((const unsigned*)(ws + CH_ARB + u * 512 + 256 + lane * 4), (LAS unsigned*)(slot + 16384 + 256), 4, 0, 0);
    } else {
        __builtin_amdgcn_global_load_lds((const unsigned*)(ws + CH_G15 + u * 256 + lane * 4), (LAS unsigned*)(slot + 16896), 4, 0, 0);
        __builtin_amdgcn_global_load_lds((const unsigned*)(ws + WS_BONUS + ((size_t)bh * 2048 + c * 16) * 4 + (lane & 15) * 4), (LAS unsigned*)(slot + 17152), 4, 0, 0);
    }
}
template <int CTRL> __device__ __forceinline__ float dpp_add_q(float v) {
    const int t = __builtin_amdgcn_update_dpp(0, __float_as_int(v), CTRL, 0xf, 0xf, false);
    return v + __int_as_float(t);
}
__device__ __forceinline__ float oct_allsum(float v) {
    v = dpp_add_q<0xB1>(v); v = dpp_add_q<0x4E>(v); v = dpp_add_q<0x141>(v);
    return v;
}
struct EpiIn { u32x4 gb; float bon; u16 v[8]; };
__device__ __forceinline__ void epi_load(EpiIn& e, const LAS unsigned char* s, int t, int v0) {
    e.gb = *(const LAS u32x4*)(s + 14336 + t * 128 + v0 * 2);
    e.bon = *(const LAS float*)(s + 17152 + t * 4);
    const LAS unsigned char* vp = s + 8192 + (((v0 >> 4) * 3 + 2) * 64 + (t >> 2) * 16 + (v0 & 15)) * 8 + (t & 3) * 2;
#pragma unroll
    for (int i = 0; i < 8; ++i) e.v[i] = *(const LAS u16*)(vp + 8 * i);
}
template <int LW> __device__ __forceinline__ void p3_loader(const Params& p, LAS unsigned char* ring, int bh, int lane) {
#pragma unroll
    for (int c = 0; c < RING_D; ++c) ring_issue<LW>(p, ring, bh, c, lane);
    asm volatile("s_waitcnt vmcnt(40)" ::: "memory");
    __builtin_amdgcn_s_barrier();
#pragma unroll 1
    for (int c = 0; c < 128; ++c) {
        const int cn = (c + RING_D < 128) ? c + RING_D : 127;
        ring_issue<LW>(p, ring, bh, cn, lane);
        asm volatile("s_waitcnt vmcnt(40)" ::: "memory");
        __builtin_amdgcn_s_barrier();
    }
    asm volatile("s_waitcnt vmcnt(0)" ::: "memory");
}
__device__ void phase3(const Params& p) {
    const int tid = threadIdx.x, lane = tid & 63, wave = __builtin_amdgcn_readfirstlane(tid >> 6), fr = lane & 15, fq = lane >> 4;
    const int bh = blockIdx.x;
    if (bh >= 64) return;
    LAS unsigned char* ring = (LAS unsigned char*)dyn_smem;
    LAS float* ybuf = (LAS float*)(ring + RING_NS * RING_SLOT);
    if (wave >= 6) {
        const int e = (wave - 6) * 64 + lane, t = e >> 3, v0 = (e & 7) * 8, b = bh >> 3, h = bh & 7;
        f32x4 ga0 = *(const f32x4*)(p.gn_gain + h * 64 + v0), ga1 = *(const f32x4*)(p.gn_gain + h * 64 + v0 + 4);
        f32x4 bi0 = *(const f32x4*)(p.gn_bias + h * 64 + v0), bi1 = *(const f32x4*)(p.gn_bias + h * 64 + v0 + 4);
        u16* Y = (u16*)(p.ws + WS_Y);
        EpiIn cur, nxt;
        __builtin_amdgcn_s_barrier();
        epi_load(cur, ring, t, v0);
#pragma unroll 1
        for (int c = 0; c <= 128; ++c) {
            if (c >= 1) {
                const int cc = c - 1;
                { const int cn = (c < 128) ? c : 127; epi_load(nxt, ring + (cn % RING_NS) * RING_SLOT, t, v0); }
                const LAS float* yb = ybuf + (cc & 1) * (16 * 68) + t * 68 + v0;
                const f32x4 y0 = *(const LAS f32x4*)(yb), y1 = *(const LAS f32x4*)(yb + 4);
                float s1 = (y0[0] + y0[1]) + (y0[2] + y0[3]) + (y1[0] + y1[1]) + (y1[2] + y1[3]);
                float s2 = y0[0] * y0[0] + y0[1] * y0[1] + y0[2] * y0[2] + y0[3] * y0[3] + y1[0] * y1[0] + y1[1] * y1[1] + y1[2] * y1[2] + y1[3] * y1[3];
                s1 = oct_allsum(s1); s2 = oct_allsum(s2);
                const float mean = s1 * (1.f / 64.f);
                const float var = fmaxf(s2 * (1.f / 64.f) - mean * mean, 0.f);
                const float rstd = rsq_(var + 64e-5f);
                const float vvf[8] = {bf2f(cur.v[0]), bf2f(cur.v[1]), bf2f(cur.v[2]), bf2f(cur.v[3]), bf2f(cur.v[4]), bf2f(cur.v[5]), bf2f(cur.v[6]), bf2f(cur.v[7])};
                const float gbf[8] = {bflo(cur.gb.x), bfhi(cur.gb.x), bflo(cur.gb.y), bfhi(cur.gb.y), bflo(cur.gb.z), bfhi(cur.gb.z), bflo(cur.gb.w), bfhi(cur.gb.w)};
                float o[8];
#pragma unroll
                for (int i = 0; i < 8; ++i) {
                    const float yv = (i < 4) ? y0[i & 3] : y1[i & 3];
                    const float gn = (i < 4) ? ga0[i & 3] : ga1[i & 3], bs = (i < 4) ? bi0[i & 3] : bi1[i & 3];
                    const float yn = (yv - mean) * rstd * gn + bs;
                    o[i] = (yn + cur.bon * vvf[i]) * gbf[i] * sigmoidf_(gbf[i]);
                }
                *(u32x4*)(Y + ((size_t)b * 2048 + cc * 16 + t) * 1024 + 512 + h * 64 + v0) = (u32x4){pack2(o[0], o[1]), pack2(o[2], o[3]), pack2(o[4], o[5]), pack2(o[6], o[7])};
                cur = nxt;
            }
            if (c < 128) __builtin_amdgcn_s_barrier();
        }
        return;
    }
    if (wave >= 4) { if (wave == 4) p3_loader<0>(p, ring, bh, lane); else p3_loader<1>(p, ring, bh, lane); return; }
    const int sl = wave;
    f32x4 acc0 = (f32x4){0.f, 0.f, 0.f, 0.f}, acc1 = acc0, acc2 = acc0, acc3 = acc0;
    ChunkOps cur, nxt;
    __builtin_amdgcn_s_barrier();
    lds_chunk_ops(cur, ring, sl, lane, fq);
#pragma unroll 2
    for (int c = 0; c < 128; ++c) {
        { const int cn = (c + 1 < 128) ? c + 1 : c; lds_chunk_ops(nxt, ring + (cn % RING_NS) * RING_SLOT, sl, lane, fq); }
        const bf16x8 sb0 = as_bf8((u32x4){pack2(acc0[0], acc0[1]), pack2(acc0[2], acc0[3]), pack2(acc1[0], acc1[1]), pack2(acc1[2], acc1[3])});
        const bf16x8 sb1 = as_bf8((u32x4){pack2(acc2[0], acc2[1]), pack2(acc2[2], acc2[3]), pack2(acc3[0], acc3[1]), pack2(acc3[2], acc3[3])});
        f32x4 U = (f32x4){bflo(cur.uh.x), bfhi(cur.uh.x), bflo(cur.uh.y), bfhi(cur.uh.y)};
        U = MFMA16(as_bf8(cur.af0), sb0, U); U = MFMA16(as_bf8(cur.af1), sb1, U);
        f32x4 Yv = (f32x4){bflo(cur.y0.x), bfhi(cur.y0.x), bflo(cur.y0.y), bfhi(cur.y0.y)};
        Yv = MFMA16(as_bf8(cur.rf0), sb0, Yv); Yv = MFMA16(as_bf8(cur.rf1), sb1, Yv);
        const unsigned u01 = pack2(U[0], U[1]), u23 = pack2(U[2], U[3]);
        Yv = MFMA16(as_bf8((u32x4){cur.arb.x, cur.arb.y, 0u, 0u}), as_bf8((u32x4){u01, u23, 0u, 0u}), Yv);
        const bf16x8 uvb = as_bf8((u32x4){u01, u23, cur.vf.x, cur.vf.y});
        acc0 = MFMA16(as_bf8(cur.bk0), uvb, acc0 * cur.g0); acc1 = MFMA16(as_bf8(cur.bk1), uvb, acc1 * cur.g1);
        acc2 = MFMA16(as_bf8(cur.bk2), uvb, acc2 * cur.g2); acc3 = MFMA16(as_bf8(cur.bk3), uvb, acc3 * cur.g3);
        LAS float* yb = ybuf + (c & 1) * (16 * 68) + (4 * fq) * 68 + sl * 16 + fr;
        yb[0] = Yv[0]; yb[68] = Yv[1]; yb[136] = Yv[2]; yb[204] = Yv[3];
        asm volatile("s_waitcnt lgkmcnt(0)" ::: "memory");
        __builtin_amdgcn_s_barrier();
        asm volatile("" ::: "memory");
        cur = nxt;
    }
}

__device__ void phase5(const Params& p) {
    const int tid = threadIdx.x, lane = tid & 63, wave = tid >> 6, blk = blockIdx.x;
#pragma unroll 1
    for (int r0 = 0; r0 < 8; r0 += 4) {
        f32x4 v[4][4]; float ss[4];
#pragma unroll
        for (int i = 0; i < 4; ++i) {
            const f32x4* xr = (const f32x4*)(p.out + (size_t)(blk * 64 + wave * 8 + r0 + i) * DM);
#pragma unroll
            for (int q = 0; q < 4; ++q) v[i][q] = xr[lane + 64 * q];
        }
#pragma unroll
        for (int i = 0; i < 4; ++i) {
            float s = 0.f;
#pragma unroll
            for (int q = 0; q < 4; ++q) s += v[i][q][0] * v[i][q][0] + v[i][q][1] * v[i][q][1] + v[i][q][2] * v[i][q][2] + v[i][q][3] * v[i][q][3];
            ss[i] = wave_sum(s);
        }
#pragma unroll
        for (int i = 0; i < 4; ++i) {
            f32x4* xr = (f32x4*)(p.out + (size_t)(blk * 64 + wave * 8 + r0 + i) * DM);
            const float inv = rsq_(ss[i] * (1.f / 1024.f) + 1e-6f);
#pragma unroll
            for (int q = 0; q < 4; ++q) { const f32x4 g = ((const f32x4*)p.final_gain)[lane + 64 * q]; xr[lane + 64 * q] = v[i][q] * inv * g; }
        }
    }
}

__global__ void __launch_bounds__(512, 2) hybrid_fwd(Params p) {
    __shared__ uint4 xb_words;
    if (threadIdx.x == 0) xb_words = make_uint4(0u, 0u, 0u, 0u);
    __syncthreads();
    XcdBarrier bar; bar.bar = (unsigned*)(p.ws + WS_CTL); bar.x = 0; bar.st = (volatile LAS unsigned*)&xb_words;
    const int lo = p.ph_lo, hi = p.ph_hi;
    if (hi - lo > 1) bar = xcd_barrier_post((unsigned*)(p.ws + WS_CTL), (volatile LAS unsigned*)&xb_words);
#define IN(k) (lo <= (k) && (k) < hi)
#define SEAM(k) do { if (IN(k) && IN((k) + 1)) xcd_barrier(bar); } while (0)
#define RUN(k, f) do { if (IN(k)) { if (PROBE_DUP == (k)) { for (int _r = 0; _r < p.dup_n; ++_r) { if (_r) __syncthreads(); f(p); } } else f(p); } } while (0)
    RUN(0, phase0);
    SEAM(0);
    RUN(1, phase1);
    SEAM(1);
    RUN(2, phase2);
    SEAM(2);
    RUN(3, phase3);
    SEAM(3);
    RUN(4, phase4);
}

extern "C" void kernel_launch(void* const* d_in, const int* in_sizes, int n_in, void* d_out, int out_size, void* d_ws, size_t ws_size, hipStream_t stream) {
    static int grid = 0;
    if (grid == 0) {
        if (n_in != 17 || out_size != NTOK * DM || ws_size < WS_END) { fprintf(stderr, "kernel_launch: unexpected problem (n_in %d out %d ws %zu need %zu)\n", n_in, out_size, ws_size, (size_t)WS_END); grid = -1; return; }
        if (hipFuncSetAttribute((const void*)hybrid_fwd, hipFuncAttributeMaxDynamicSharedMemorySize, LDS_BYTES) != hipSuccess) { fprintf(stderr, "kernel_launch: hipFuncSetAttribute failed\n"); grid = -1; return; }
        int per_cu = 0;
        if (hipOccupancyMaxActiveBlocksPerMultiprocessor(&per_cu, (const void*)hybrid_fwd, 512, LDS_BYTES) != hipSuccess || per_cu < 1) fprintf(stderr, "kernel_launch: occupancy query says %d blocks per CU\n", per_cu);
        (void)hipGetLastError();
        grid = 256;
    }
    if (grid < 0) return;
    (void)hipMemsetAsync((char*)d_ws + WS_CTL, 0, 16384, stream);
    Params p{};
    p.x = (const float*)d_in[0]; p.norm_gain = (const float*)d_in[1]; p.w_in = (const float*)d_in[2]; p.pool_w = (const float*)d_in[3];
    p.pool_scale = (const float*)d_in[4]; p.shift_mu = (const float*)d_in[5]; p.w0 = (const float*)d_in[6]; p.w_up = (const float*)d_in[7];
    p.a0 = (const float*)d_in[8]; p.a_up = (const float*)d_in[9]; p.k_k = (const float*)d_in[10]; p.k_a = (const float*)d_in[11];
    p.r_k = (const float*)d_in[12]; p.gn_gain = (const float*)d_in[13]; p.gn_bias = (const float*)d_in[14]; p.w_out = (const float*)d_in[15];
    p.final_gain = (const float*)d_in[16];
    p.out = (float*)d_out; p.ws = (unsigned char*)d_ws; p.dup_n = 2;
#if N_LAUNCHES == 1
    p.ph_lo = 0; p.ph_hi = NPH;
    hipLaunchKernelGGL(hybrid_fwd, dim3(grid), dim3(512), LDS_BYTES, stream, p);
#else
    for (int k = 0; k < NPH; ++k) { p.ph_lo = k; p.ph_hi = k + 1; hipLaunchKernelGGL(hybrid_fwd, dim3(grid), dim3(512), LDS_BYTES, stream, p); }
#endif
}
```

```cpp
#include <hip/hip_runtime.h>
#include <stdint.h>
#include <cstdio>

typedef unsigned short u16;
typedef short bf16x8 __attribute__((ext_vector_type(8)));
typedef float f32x4 __attribute__((ext_vector_type(4)));
typedef float f32x2 __attribute__((ext_vector_type(2)));
typedef unsigned u32x2 __attribute__((ext_vector_type(2)));
typedef unsigned u32x4 __attribute__((ext_vector_type(4)));

#ifndef PROBE_DUP
#define PROBE_DUP -1
#endif
#ifndef N_LAUNCHES
#define N_LAUNCHES 1
#endif

constexpr int NTOK = 16384, DM = 1024, SEQ = 2048, DIN = 3200, DINP = 3328;
constexpr int NPH = 5;
constexpr int LDS_BYTES = 18432 + 8 * 17408;

constexpr size_t WS_CTL = 0;
constexpr size_t WS_WINT = 16384;
constexpr size_t WS_WOUTT = WS_WINT + (size_t)DINP * 1024 * 2;
constexpr size_t WS_WUPT = WS_WOUTT + (size_t)1024 * 1024 * 2;
constexpr size_t WS_AUPT = WS_WUPT + 512 * 64 * 2;
constexpr size_t WS_POOLT = WS_AUPT + 512 * 64 * 2;
constexpr size_t WS_Z = WS_POOLT + 4 * 128 * 128 * 2;
constexpr size_t WS_REC = WS_Z + (size_t)NTOK * DIN * 2;
constexpr size_t WS_Y = WS_REC + (size_t)64 * 2048 * 896;
constexpr size_t WS_BONUS = WS_Y + (size_t)NTOK * 1024 * 2;
constexpr size_t WS_PART = WS_BONUS + (size_t)64 * 2048 * 4;
constexpr size_t WS_END = WS_PART + (size_t)64 * 4 * 256 * 4;
constexpr int CTL_CNT_WORD = 3584;
constexpr int NUNIT = 64 * 128;
constexpr size_t CH_AF = WS_REC;
constexpr size_t CH_RF = CH_AF + (size_t)NUNIT * 2048;
constexpr size_t CH_BKF = CH_RF + (size_t)NUNIT * 2048;
constexpr size_t CH_ARB = CH_BKF + (size_t)NUNIT * 4096;
constexpr size_t CH_G15 = CH_ARB + (size_t)NUNIT * 512;
constexpr size_t CH_END = CH_G15 + (size_t)NUNIT * 256;
constexpr size_t WS_VB = CH_END;
static_assert(WS_VB + (size_t)NTOK * 512 * 2 <= WS_Y, "chunk operands + v must fit in the record region");
constexpr size_t OUT_CHV = 0;
constexpr size_t OUT_GB = (size_t)NUNIT * 4 * 3 * 512;
static_assert(OUT_GB + (size_t)NTOK * 512 * 2 <= (size_t)NTOK * DM * 4, "d_out scratch");

struct Params {
    const float* x; const float* norm_gain; const float* w_in; const float* pool_w; const float* pool_scale;
    const float* shift_mu; const float* w0; const float* w_up; const float* a0; const float* a_up;
    const float* k_k; const float* k_a; const float* r_k; const float* gn_gain; const float* gn_bias;
    const float* w_out; const float* final_gain;
    float* out; unsigned char* ws;
    int ph_lo, ph_hi, dup_n, pad;
};

extern __shared__ __attribute__((aligned(16))) unsigned char dyn_smem[];

__device__ __forceinline__ float bf2f(u16 v) { return __uint_as_float(((unsigned)v) << 16); }
__device__ __forceinline__ float bflo(unsigned v) { return __uint_as_float(v << 16); }
__device__ __forceinline__ float bfhi(unsigned v) { return __uint_as_float(v & 0xffff0000u); }
typedef __bf16 bf16x2_t __attribute__((ext_vector_type(2)));
__device__ __forceinline__ unsigned pack2(float lo, float hi) { bf16x2_t v = {(__bf16)lo, (__bf16)hi}; return __builtin_bit_cast(unsigned, v); }
__device__ __forceinline__ u16 f2bf(float f) { return (u16)(pack2(f, 0.f) & 0xffffu); }
__device__ __forceinline__ float wave_sum(float v) {
#pragma unroll
    for (int m = 32; m >= 1; m >>= 1) v += __shfl_xor(v, m, 64);
    return v;
}
__device__ __forceinline__ float rcp_(float v) { return __builtin_amdgcn_rcpf(v); }
__device__ __forceinline__ float rsq_(float v) { return __builtin_amdgcn_rsqf(v); }
__device__ __forceinline__ float sigmoidf_(float v) { return rcp_(1.f + __expf(-v)); }
__device__ __forceinline__ float tanhf_(float v) { return 1.f - 2.f * rcp_(1.f + __expf(2.f * v)); }

#define XB_TMO      128
#define XB_XCNT(j)  (256  + 64 * (j))
#define XB_XSUB(j)  (1280 + 64 * (j))
#define XB_XGEN(j)  (2304 + 64 * (j))
#define XB_TOP      3328
#define XB_TOPGEN   3392
#define XCD_BAR_WORDS 3456
#define XB_SPIN_CAP (1u << 22)
#define LAS __attribute__((address_space(3)))

__device__ __forceinline__ unsigned xb_ld(unsigned* p)              { return __hip_atomic_load(p, __ATOMIC_RELAXED, __HIP_MEMORY_SCOPE_AGENT); }
__device__ __forceinline__ unsigned xb_add(unsigned* p, unsigned v) { return __hip_atomic_fetch_add(p, v, __ATOMIC_RELAXED, __HIP_MEMORY_SCOPE_AGENT); }
__device__ __forceinline__ unsigned xb_xcc_id() { return (unsigned)__builtin_amdgcn_s_getreg((3 << 11) | 20) & 0xFu; }
#define XB_SPIN(cond, bar) do { unsigned _sp = 0; while (cond) { __builtin_amdgcn_s_sleep(1); \
    if ((++_sp & 255u) == 0u) { if (xb_ld(&(bar)[XB_TMO])) break; if (_sp > XB_SPIN_CAP) { atomicAdd(&(bar)[XB_TMO], 1u); break; } } } } while (0)

struct XcdBarrier { unsigned* bar; unsigned x; volatile LAS unsigned* st; };

__device__ __forceinline__ XcdBarrier xcd_barrier_post(unsigned* bar, volatile LAS unsigned* st) {
    XcdBarrier b; b.bar = bar; b.x = xb_xcc_id(); b.st = st;
    if (threadIdx.x == 0) (void)xb_add(&bar[XB_XCNT(b.x)], 1u);
    return b;
}
__device__ __forceinline__ void xcd_barrier_complete(unsigned* bar, unsigned x, unsigned& nloc, unsigned& nx) {
    const unsigned G = gridDim.x * gridDim.y * gridDim.z;
    unsigned sum, cnt, mine, sp = 0u;
    for (;;) {
        sum = 0u; cnt = 0u; mine = 0u;
#pragma unroll
        for (unsigned j = 0; j < 16; ++j) { const unsigned c = xb_ld(&bar[XB_XCNT(j)]); sum += c; cnt += (c > 0u) ? 1u : 0u; mine = (j == x) ? c : mine; }
        if (sum == G) break;
        __builtin_amdgcn_s_sleep(1);
        if ((++sp & 255u) == 0u) { if (xb_ld(&bar[XB_TMO])) break; if (sp > XB_SPIN_CAP) { atomicAdd(&bar[XB_TMO], 1u); break; } }
    }
    nloc = mine > 0u ? mine : 1u; nx = cnt > 0u ? cnt : 1u;
}
__device__ __forceinline__ void xcd_barrier(const XcdBarrier& b) {
    asm volatile("s_waitcnt vmcnt(0)" ::: "memory");
    __syncthreads();
    if (threadIdx.x == 0) {
        unsigned* bar = b.bar;
        __builtin_amdgcn_s_waitcnt(0);
        unsigned nloc = b.st[0], nx = b.st[1];
        if (nloc == 0u) { xcd_barrier_complete(bar, b.x, nloc, nx); b.st[0] = nloc; b.st[1] = nx; }
        const unsigned old = xb_add(&bar[XB_XSUB(b.x)], 1u);
        const unsigned gen = old / nloc;
        if (old + 1u == (gen + 1u) * nloc) {
            __builtin_amdgcn_fence(__ATOMIC_RELEASE, "agent");
            asm volatile("s_waitcnt vmcnt(0)" ::: "memory");
            const unsigned og = xb_add(&bar[XB_TOP], 1u);
            const unsigned tg = og / nx;
            if (og + 1u == (tg + 1u) * nx) xb_add(&bar[XB_TOPGEN], 1u);
            else XB_SPIN(xb_ld(&bar[XB_TOPGEN]) == tg, bar);
            __builtin_amdgcn_fence(__ATOMIC_ACQUIRE, "agent");
            xb_add(&bar[XB_XGEN(b.x)], 1u);
            asm volatile("s_waitcnt vmcnt(0)" ::: "memory");
        } else {
            XB_SPIN(xb_ld(&bar[XB_XGEN(b.x)]) == gen, bar);
            __builtin_amdgcn_fence(__ATOMIC_ACQUIRE, "agent");
            asm volatile("s_waitcnt vmcnt(0)" ::: "memory");
        }
    }
    __syncthreads();
}

constexpr int BM = 256, BK = 64, HALF = 128, HTB = HALF * BK * 2, STAGE_BYTES = 8 * HTB, NXCD = 8, WGM = 8;
__device__ __forceinline__ int lds_byte(int r, int c) { const int st = (r >> 4) * 2 + (c >> 5), rr = r & 15, cc = c & 31, ob = rr * 64 + cc * 2; return st * 1024 + (ob ^ (((ob >> 9) & 1) << 5)); }
__device__ __forceinline__ void stage_rc(int b, int& R, int& C) { const int st = b / 1024, sb = b % 1024, swz = sb ^ (((sb >> 9) & 1) << 5); R = (st >> 1) * 16 + swz / 64; C = (st & 1) * 32 + (swz % 64) / 2; }
__device__ __forceinline__ int perm32(int rho) { const int n = rho >> 4, i = rho & 15; return 8 * (i >> 2) + 4 * n + (i & 3); }

struct Unit { int pm, pn; };
struct Gemm { const u16* A; const u16* Bt; int M, N, K, Nvalid; };
struct StaticOrder {
    int nM, nN, nwg, G, c;
    __device__ void init(int M, int N, int G_, int c_) { nM = M / BM; nN = N / BM; nwg = nM * nN; G = G_; c = c_; }
    __device__ bool next(int i, Unit& u) const {
        const long L = (long)i * G + c; if (L >= nwg) return false;
        int wgid = (int)L; { const int q = nwg / NXCD, r = nwg % NXCD, xcd = wgid % NXCD, off = wgid / NXCD; wgid = (xcd < r ? xcd * (q + 1) : r * (q + 1) + (xcd - r) * q) + off; }
        const int nig = WGM * nN, gid = wgid / nig, fm = gid * WGM, gsz = (nM - fm) < WGM ? (nM - fm) : WGM;
        u.pm = fm + ((wgid % nig) % gsz); u.pn = (wgid % nig) / gsz; return true;
    }
};
struct EpiZ {
    static constexpr bool PERM = true, AFTER_DRAIN = false;
    u16* Z;
    __device__ __forceinline__ void operator()(const f32x4 (&acc)[2][2][4][2], const Unit& u, int wr, int wc, int fr, int fq) const {
        const int row0 = u.pm * BM + wr * 64 + fr, col0 = u.pn * BM + wc * 32 + 8 * fq;
#pragma unroll
        for (int ai = 0; ai < 2; ++ai)
#pragma unroll
            for (int m = 0; m < 4; ++m) { u16* rowp = Z + (size_t)(row0 + ai * HALF + m * 16) * DIN;
#pragma unroll
                for (int bj = 0; bj < 2; ++bj) { const int col = col0 + bj * HALF; const f32x4 v0 = acc[ai][bj][m][0], v1 = acc[ai][bj][m][1];
                    if (col < DIN) *(u32x4*)(rowp + col) = (u32x4){pack2(v0[0], v0[1]), pack2(v0[2], v0[3]), pack2(v1[0], v1[1]), pack2(v1[2], v1[3])}; } }
    }
};
struct EpiRes {
    static constexpr bool PERM = false, AFTER_DRAIN = false;
    const float* x; float* out;
    __device__ __forceinline__ void operator()(const f32x4 (&acc)[2][2][4][2], const Unit& u, int wr, int wc, int fr, int fq) const {
        const int row0 = u.pm * BM + wr * 64 + fr, col0 = u.pn * BM + wc * 32 + 4 * fq;
#pragma unroll
        for (int ai = 0; ai < 2; ++ai)
#pragma unroll
            for (int m = 0; m < 4; ++m) { const size_t ro = (size_t)(row0 + ai * HALF + m * 16) * DM + col0;
#pragma unroll
                for (int bj = 0; bj < 2; ++bj)
#pragma unroll
                    for (int n = 0; n < 2; ++n) { const f32x4 xv = *(const f32x4*)(x + ro + bj * HALF + n * 16); *(f32x4*)(out + ro + bj * HALF + n * 16) = xv + acc[ai][bj][m][n]; } }
    }
};
struct EpiResNorm {
    static constexpr bool PERM = false, AFTER_DRAIN = true;
    const float* x; const float* gain; float* out; float* part; unsigned* cnt;
    __device__ __forceinline__ void fused(f32x4 (&acc)[2][2][4][2], const Unit& u, int wr, int wc, int fr, int fq, LAS unsigned char* lds) const {
        const int row0 = u.pm * BM + wr * 64 + fr, col0 = u.pn * BM + wc * 32 + 4 * fq;
        LAS float* red = (LAS float*)lds;
        LAS float* tot = red + 1024;
        float rs[2][4];
#pragma unroll
        for (int ai = 0; ai < 2; ++ai)
#pragma unroll
            for (int m = 0; m < 4; ++m) { const size_t ro = (size_t)(row0 + ai * HALF + m * 16) * DM + col0; float s = 0.f;
#pragma unroll
                for (int bj = 0; bj < 2; ++bj)
#pragma unroll
                    for (int n = 0; n < 2; ++n) { const f32x4 v = __builtin_nontemporal_load((const f32x4*)(x + ro + bj * HALF + n * 16)) + acc[ai][bj][m][n]; acc[ai][bj][m][n] = v; s += v[0] * v[0] + v[1] * v[1] + v[2] * v[2] + v[3] * v[3]; }
                s += __shfl_xor(s, 16, 64); s += __shfl_xor(s, 32, 64);
                rs[ai][m] = s; }
        if (fq == 0) {
#pragma unroll
            for (int ai = 0; ai < 2; ++ai)
#pragma unroll
                for (int m = 0; m < 4; ++m) red[((wr * 4 + wc) * 8 + ai * 4 + m) * 16 + fr] = rs[ai][m];
        }
        __syncthreads();
        if (threadIdx.x < 256) {
            const int rl = threadIdx.x, ai = rl >> 7, wr_ = (rl >> 6) & 1, m = (rl >> 4) & 3, fr_ = rl & 15;
            const int o = ((wr_ * 4) * 8 + ai * 4 + m) * 16 + fr_;
            const float s = red[o] + red[o + 128] + red[o + 256] + red[o + 384];
            __hip_atomic_store(part + ((size_t)u.pm * 4 + u.pn) * 256 + rl, s, __ATOMIC_RELAXED, __HIP_MEMORY_SCOPE_AGENT);
        }
        asm volatile("s_waitcnt vmcnt(0)" ::: "memory");
        __syncthreads();
        if (threadIdx.x == 0) {
            __builtin_amdgcn_fence(__ATOMIC_RELEASE, "agent");
            asm volatile("s_waitcnt vmcnt(0)" ::: "memory");
            __hip_atomic_fetch_add(cnt + u.pm, 1u, __ATOMIC_RELAXED, __HIP_MEMORY_SCOPE_AGENT);
            unsigned sp = 0;
            while (__hip_atomic_load(cnt + u.pm, __ATOMIC_RELAXED, __HIP_MEMORY_SCOPE_AGENT) < 4u) { __builtin_amdgcn_s_sleep(1); if (++sp > (1u << 24)) break; }
            __builtin_amdgcn_fence(__ATOMIC_ACQUIRE, "agent");
            asm volatile("s_waitcnt vmcnt(0)" ::: "memory");
        }
        __syncthreads();
        for (int e = threadIdx.x; e < 1024; e += 512) tot[e] = __hip_atomic_load(part + (size_t)u.pm * 1024 + e, __ATOMIC_RELAXED, __HIP_MEMORY_SCOPE_AGENT);
        __syncthreads();
#pragma unroll
        for (int ai = 0; ai < 2; ++ai)
#pragma unroll
            for (int m = 0; m < 4; ++m) { const int rl = ai * 128 + wr * 64 + m * 16 + fr;
                const float inv = rsq_((tot[rl] + tot[256 + rl] + tot[512 + rl] + tot[768 + rl]) * (1.f / 1024.f) + 1e-6f);
                const size_t ro = (size_t)(row0 + ai * HALF + m * 16) * DM + col0;
#pragma unroll
                for (int bj = 0; bj < 2; ++bj)
#pragma unroll
                    for (int n = 0; n < 2; ++n) { const f32x4 g = *(const f32x4*)(gain + col0 + bj * HALF + n * 16); __builtin_nontemporal_store(acc[ai][bj][m][n] * inv * g, (f32x4*)(out + ro + bj * HALF + n * 16)); } }
    }
};

template <class Epi, class Sched>
__device__ __forceinline__ void gemm_phase(LAS unsigned char* lds, const Gemm g, const Sched& S, const Epi& E) {
    const int tid = threadIdx.x, wid = __builtin_amdgcn_readfirstlane(tid >> 6), lane = tid & 63, wr = wid >> 2, wc = wid & 3, fr = lane & 15, fq = lane >> 4;
    const int K = g.K, nt = K / BK;
    unsigned voffA[2], voffB[2];
#pragma unroll
    for (int i = 0; i < 2; ++i) { int R, C; stage_rc(tid * 16 + i * 8192, R, C); const int Rb = Epi::PERM ? ((R & ~31) + perm32(R & 31)) : R;
        voffA[i] = (unsigned)(R * K + C) * 2u; voffB[i] = (unsigned)(Rb * K + C) * 2u; }
    const size_t kstep = (size_t)(BK * 2);
    const size_t hstep = (size_t)HALF * K * 2;
    const size_t tstep = 2 * hstep;
    const unsigned ldsw = (unsigned)wid * 1024u;
    const int aoff = lds_byte(wr * 64 + fr, fq * 8), boff = lds_byte(wc * 32 + fr, fq * 8);
#define PG8_SA(b, h) (((b) * 2 + (h)) * HTB)
#define PG8_SB(b, h) ((4 + (b) * 2 + (h)) * HTB)
#define PG8_STAGE(bufoff, gbase, voff) do { _Pragma("unroll") for (int _i = 0; _i < 2; ++_i) \
        __builtin_amdgcn_global_load_lds((const unsigned*)((const char*)(gbase) + (voff)[_i]), (LAS unsigned*)(lds + (bufoff) + ldsw + _i * 8192), 16, 0, 0); } while (0)
#define PG8_LDA(dst, b, h) do { _Pragma("unroll") for (int m = 0; m < 4; ++m) _Pragma("unroll") for (int k = 0; k < 2; ++k) dst[m][k] = *(const LAS bf16x8*)(lds + PG8_SA(b, h) + aoff + m * 2048 + k * 1024); } while (0)
#define PG8_LDB(dst, b, h) do { _Pragma("unroll") for (int n = 0; n < 2; ++n) _Pragma("unroll") for (int k = 0; k < 2; ++k) dst[n][k] = *(const LAS bf16x8*)(lds + PG8_SB(b, h) + boff + n * 2048 + k * 1024); } while (0)
#define PG8_MMA(ai, bj, At, Bt) do { __builtin_amdgcn_s_setprio(1); _Pragma("unroll") for (int m = 0; m < 4; ++m) _Pragma("unroll") for (int n = 0; n < 2; ++n) _Pragma("unroll") for (int k = 0; k < 2; ++k) \
        acc[ai][bj][m][n] = __builtin_amdgcn_mfma_f32_16x16x32_bf16(Bt[n][k], At[m][k], acc[ai][bj][m][n], 0, 0, 0); __builtin_amdgcn_s_setprio(0); } while (0)
#define PG8_WAIT_V(n) asm volatile("s_waitcnt vmcnt(" #n ")" ::: "memory")
#define PG8_WAIT_L(n) asm volatile("s_waitcnt lgkmcnt(" #n ")" ::: "memory")
#define PG8_BAR __builtin_amdgcn_s_barrier()
#define PG8_SCHED __builtin_amdgcn_sched_barrier(0)
    Unit cur, nxt; int ui = 0;
    if (!S.next(0, cur)) return;
    f32x4 acc[2][2][4][2];
#pragma unroll
    for (int a = 0; a < 2; ++a)
#pragma unroll
        for (int b = 0; b < 2; ++b)
#pragma unroll
            for (int m = 0; m < 4; ++m)
#pragma unroll
                for (int n = 0; n < 2; ++n) acc[a][b][m][n] = (f32x4){0.f, 0.f, 0.f, 0.f};
    bf16x8 At[4][2], B0[2][2], B1[2][2];
    const char* cA = (const char*)g.A + (size_t)cur.pm * tstep; const char* cB = (const char*)g.Bt + (size_t)cur.pn * tstep;
    PG8_STAGE(PG8_SB(0, 0), cB, voffB); PG8_STAGE(PG8_SA(0, 0), cA, voffA); PG8_STAGE(PG8_SB(0, 1), cB + hstep, voffB); PG8_STAGE(PG8_SA(0, 1), cA + hstep, voffA);
    if (wr == 1) PG8_BAR;
    PG8_WAIT_V(4); PG8_BAR;
    PG8_STAGE(PG8_SB(1, 0), cB + kstep, voffB); PG8_STAGE(PG8_SA(1, 0), cA + kstep, voffA); PG8_STAGE(PG8_SB(1, 1), cB + hstep + kstep, voffB);
    PG8_WAIT_V(6); PG8_BAR;
    for (;;) {
        const bool has_next = S.next(ui + 1, nxt);
        const char* nA = has_next ? (const char*)g.A + (size_t)nxt.pm * tstep : cA; const char* nB = has_next ? (const char*)g.Bt + (size_t)nxt.pn * tstep : cB;
        const bool rhalf = (cur.pn * BM + HALF) < g.Nvalid;
        for (int t = 0; t < nt; t += 2) {
            const bool last = (t == nt - 2);
            const char* a1 = cA + (size_t)(t + 1) * kstep;
            const char* a2 = last ? nA : cA + (size_t)(t + 2) * kstep; const char* b2 = last ? nB : cB + (size_t)(t + 2) * kstep;
            const char* a3 = a2 + kstep; const char* b3 = b2 + kstep;
            PG8_LDB(B0, 0, 0); PG8_SCHED; PG8_LDA(At, 0, 0); PG8_STAGE(PG8_SA(1, 1), a1 + hstep, voffA);
            PG8_WAIT_L(8); PG8_BAR; PG8_WAIT_L(0); PG8_MMA(0, 0, At, B0); PG8_BAR; PG8_SCHED;
            PG8_LDB(B1, 0, 1); PG8_STAGE(PG8_SB(0, 0), b2, voffB);
            PG8_BAR; PG8_WAIT_L(0); if (rhalf) PG8_MMA(0, 1, At, B1); PG8_BAR;
            PG8_LDA(At, 0, 1); PG8_STAGE(PG8_SA(0, 0), a2, voffA);
            PG8_BAR; PG8_WAIT_L(0); PG8_MMA(1, 0, At, B0); PG8_BAR; PG8_SCHED;
            PG8_STAGE(PG8_SB(0, 1), b2 + hstep, voffB);
            PG8_WAIT_V(6); PG8_BAR; if (rhalf) PG8_MMA(1, 1, At, B1); PG8_BAR;
            PG8_LDB(B0, 1, 0); PG8_SCHED; PG8_LDA(At, 1, 0); PG8_STAGE(PG8_SA(0, 1), a2 + hstep, voffA);
            PG8_WAIT_L(8); PG8_BAR; PG8_WAIT_L(0); PG8_MMA(0, 0, At, B0); PG8_BAR; PG8_SCHED;
            PG8_LDB(B1, 1, 1); PG8_STAGE(PG8_SB(1, 0), b3, voffB);
            PG8_BAR; PG8_WAIT_L(0); if (rhalf) PG8_MMA(0, 1, At, B1); PG8_BAR;
            PG8_LDA(At, 1, 1); PG8_STAGE(PG8_SA(1, 0), a3, voffA);
            PG8_BAR; PG8_WAIT_L(0); PG8_MMA(1, 0, At, B0); PG8_BAR; PG8_SCHED;
            PG8_STAGE(PG8_SB(1, 1), b3 + hstep, voffB);
            PG8_WAIT_V(6); PG8_BAR; if (rhalf) PG8_MMA(1, 1, At, B1); PG8_BAR;
        }
        if constexpr (!Epi::AFTER_DRAIN) E(acc, cur, wr, wc, fr, fq);
        if (!has_next) break;
#pragma unroll
        for (int a = 0; a < 2; ++a)
#pragma unroll
            for (int b = 0; b < 2; ++b)
#pragma unroll
                for (int m = 0; m < 4; ++m)
#pragma unroll
                    for (int n = 0; n < 2; ++n) acc[a][b][m][n] = (f32x4){0.f, 0.f, 0.f, 0.f};
        cur = nxt; cA = nA; cB = nB; ++ui;
    }
    PG8_WAIT_V(0);
    if (wr == 0) PG8_BAR;
    PG8_BAR;
    if constexpr (Epi::AFTER_DRAIN) E.fused(acc, cur, wr, wc, fr, fq, lds);
#undef PG8_SA
#undef PG8_SB
#undef PG8_STAGE
#undef PG8_LDA
#undef PG8_LDB
#undef PG8_MMA
#undef PG8_WAIT_V
#undef PG8_WAIT_L
#undef PG8_BAR
#undef PG8_SCHED
}

#define WSYNC() do { __builtin_amdgcn_wave_barrier(); asm volatile("s_waitcnt lgkmcnt(0)" ::: "memory"); __builtin_amdgcn_wave_barrier(); } while (0)
__device__ void phase0(const Params& p) {
    const int tid = threadIdx.x, lane = tid & 63, wave = tid >> 6, blk = blockIdx.x;
    u16* Hbf = (u16*)p.out;
#pragma unroll 1
    for (int r0 = 0; r0 < 8; r0 += 4) {
        f32x4 v[4][4]; float ss[4];
#pragma unroll
        for (int i = 0; i < 4; ++i) {
            const f32x4* xr = (const f32x4*)(p.x + (size_t)(blk * 64 + wave * 8 + r0 + i) * DM);
#pragma unroll
            for (int q = 0; q < 4; ++q) v[i][q] = __builtin_nontemporal_load(xr + lane + 64 * q);
        }
#pragma unroll
        for (int i = 0; i < 4; ++i) {
            float s = 0.f;
#pragma unroll
            for (int q = 0; q < 4; ++q) s += v[i][q][0] * v[i][q][0] + v[i][q][1] * v[i][q][1] + v[i][q][2] * v[i][q][2] + v[i][q][3] * v[i][q][3];
            ss[i] = wave_sum(s);
        }
#pragma unroll
        for (int i = 0; i < 4; ++i) {
            const int row = blk * 64 + wave * 8 + r0 + i;
            const float inv = rsq_(ss[i] * (1.f / 1024.f) + 1e-6f);
#pragma unroll
            for (int q = 0; q < 4; ++q) {
                const f32x4 g = ((const f32x4*)p.norm_gain)[lane + 64 * q];
                u32x2 o; o.x = pack2(v[i][q][0] * inv * g[0], v[i][q][1] * inv * g[1]); o.y = pack2(v[i][q][2] * inv * g[2], v[i][q][3] * inv * g[3]);
                *(u32x2*)(Hbf + (size_t)row * DM + (lane + 64 * q) * 4) = o;
            }
        }
    }
    u16* WinT = (u16*)(p.ws + WS_WINT); u16* WoutT = (u16*)(p.ws + WS_WOUTT);
    {
        float* tl = (float*)dyn_smem + wave * (64 * 65);
        const int t = blk + 256 * wave;
        if (t < 832 + 256) {
            const float* src; u16* dst; int kt, ntile, N;
            if (t < 832) { kt = t & 15; ntile = t >> 4; src = p.w_in; N = DIN; dst = WinT; }
            else { const int t2 = t - 832; kt = t2 & 15; ntile = t2 >> 4; src = p.w_out; N = 1024; dst = WoutT; }
            const int k0 = kt * 64, n0 = ntile * 64, n4 = (lane & 15) * 4;
            f32x4 v[16];
#pragma unroll
            for (int i = 0; i < 16; ++i) { const int kk = (lane >> 4) + 4 * i; v[i] = (n0 + n4 < N) ? *(const f32x4*)(src + (size_t)(k0 + kk) * N + n0 + n4) : (f32x4){0.f, 0.f, 0.f, 0.f}; }
#pragma unroll
            for (int i = 0; i < 16; ++i) { const int kk = (lane >> 4) + 4 * i; float* d = tl + kk * 65 + n4; d[0] = v[i][0]; d[1] = v[i][1]; d[2] = v[i][2]; d[3] = v[i][3]; }
            WSYNC();
            const int kp = lane & 31, nh = lane >> 5;
#pragma unroll 8
            for (int i = 0; i < 32; ++i) { const int nn = 2 * i + nh;
                *(unsigned*)(dst + (size_t)(n0 + nn) * 1024 + k0 + 2 * kp) = pack2(tl[(2 * kp) * 65 + nn], tl[(2 * kp + 1) * 65 + nn]); }
        }
    }
    u16* WupT = (u16*)(p.ws + WS_WUPT); u16* AupT = (u16*)(p.ws + WS_AUPT); u16* PoolT = (u16*)(p.ws + WS_POOLT);
    const int gt = blk * 512 + tid;
    if (gt < 32768) { const int c = gt >> 6, j = gt & 63; WupT[gt] = f2bf(p.w_up[j * 512 + c]); AupT[gt] = f2bf(p.a_up[j * 512 + c]); }
    if (gt < 65536) { const int g = gt >> 14, d = (gt >> 7) & 127, c = gt & 127; PoolT[gt] = f2bf(p.pool_w[(g * 128 + c) * 128 + d]); }
}

__device__ void phase1(const Params& p) {
    Gemm g; g.A = (const u16*)p.out; g.Bt = (const u16*)(p.ws + WS_WINT); g.M = NTOK; g.N = DINP; g.K = 1024; g.Nvalid = DIN;
    StaticOrder S; S.init(NTOK, DINP, 256, blockIdx.x);
    EpiZ E; E.Z = (u16*)(p.ws + WS_Z);
    gemm_phase((LAS unsigned char*)dyn_smem, g, S, E);
}
__device__ void phase4(const Params& p) {
    Gemm g; g.A = (const u16*)(p.ws + WS_Y); g.Bt = (const u16*)(p.ws + WS_WOUTT); g.M = NTOK; g.N = 1024; g.K = 1024; g.Nvalid = 1024;
    StaticOrder S; S.init(NTOK, 1024, 256, blockIdx.x);
    EpiResNorm E; E.x = p.x; E.gain = p.final_gain; E.out = p.out; E.part = (float*)(p.ws + WS_PART); E.cnt = (unsigned*)(p.ws + WS_CTL) + CTL_CNT_WORD;
    gemm_phase((LAS unsigned char*)dyn_smem, g, S, E);
}

template <int CTRL> __device__ __forceinline__ float dpp_add(float v) {
    const int t = __builtin_amdgcn_update_dpp(0, __float_as_int(v), CTRL, 0xf, 0xf, false);
    return v + __int_as_float(t);
}
__device__ __forceinline__ float row16_allsum(float v) {
    v = dpp_add<0x128>(v); v = dpp_add<0x124>(v); v = dpp_add<0x122>(v); v = dpp_add<0x121>(v);
    return v;
}
#define MFMA16(a, b, c) __builtin_amdgcn_mfma_f32_16x16x32_bf16((a), (b), (c), 0, 0, 0)
__device__ __forceinline__ bf16x8 as_bf8(u32x4 v) { return __builtin_bit_cast(bf16x8, v); }
template <int W> __device__ __forceinline__ void pooled_run(const u16* __restrict__ Z, u16* pooled, int t0, int s0, int cp, int hf) {
    const int c0 = 2 * cp, tb = hf * 32;
    unsigned raw[W - 1 + 32];
#pragma unroll
    for (int i = 0; i < W - 1 + 32; ++i) { const int tt = tb - (W - 1) + i; raw[i] = (s0 + tt >= 0) ? *(const unsigned*)(Z + (size_t)(t0 + tt) * DIN + c0) : 0u; }
    float sum0 = 0.f, sum1 = 0.f;
#pragma unroll
    for (int i = 0; i < W - 1; ++i) { sum0 += bflo(raw[i]); sum1 += bfhi(raw[i]); }
#pragma unroll
    for (int j = 0; j < 32; ++j) {
        const int tt = tb + j, s = s0 + tt;
        const float u0 = bflo(raw[W - 1 + j]), u1 = bfhi(raw[W - 1 + j]);
        sum0 += u0; sum1 += u1;
        const float rc = rcp_((float)((s + 1 < W) ? (s + 1) : W));
        *(unsigned*)(pooled + tt * 520 + c0) = pack2(sum0 * rc - u0, sum1 * rc - u1);
        sum0 -= bflo(raw[j]); sum1 -= bfhi(raw[j]);
    }
}
constexpr int RST = 912;
__device__ __forceinline__ void p2_zload(u32x4 (&zq)[7], const u16* __restrict__ Z, size_t T0, bool has_halo, int h, int lane) {
#pragma unroll
    for (int q = 0; q < 7; ++q) {
        const int pidx = lane + 64 * q, rr = pidx / 24, w = pidx - rr * 24, a = w >> 3, pc = w & 7;
        u32x4 v = (u32x4){0u, 0u, 0u, 0u};
        if (pidx < 17 * 24) {
            if (rr < 16) v = *(const u32x4*)(Z + (T0 + rr) * DIN + 1024 + a * 512 + h * 64 + pc * 8);
            else if (has_halo) v = *(const u32x4*)(Z + (T0 - 1) * DIN + 1024 + a * 512 + h * 64 + pc * 8);
        }
        zq[q] = v;
    }
}
constexpr int P2_WREG = 17408;
__device__ void phase2(const Params& p) {
    const int tid = threadIdx.x, lane = tid & 63, wave = tid >> 6, blk = blockIdx.x, fr = lane & 15, fq = lane >> 4;
    const int t0 = blk * 64, b = t0 >> 11, s0 = t0 & 2047;
    const u16* Z = (const u16*)(p.ws + WS_Z);
    u16* twb = (u16*)dyn_smem;
    u16* alb = twb + 64 * 72;
    u16* pooled = alb + 64 * 72;
    for (int e = tid; e < 64 * 128; e += 512) {
        const int tt = e >> 7, j = e & 127;
        const size_t zi = (size_t)(t0 + tt) * DIN + 2560 + j;
        const float cur = bf2f(Z[zi]);
        const float prev = (s0 + tt > 0) ? bf2f(Z[zi - DIN]) : 0.f;
        const float val = cur + p.shift_mu[1536 + j] * (prev - cur);
        if (j < 64) twb[tt * 72 + j] = f2bf(tanhf_(val)); else alb[tt * 72 + (j - 64)] = f2bf(val);
    }
    {
        const int cp = tid & 255, hf = tid >> 8;
        switch (wave & 3) {
            case 0: pooled_run<2>(Z, pooled, t0, s0, cp, hf); break;
            case 1: pooled_run<4>(Z, pooled, t0, s0, cp, hf); break;
            case 2: pooled_run<8>(Z, pooled, t0, s0, cp, hf); break;
            default: pooled_run<16>(Z, pooled, t0, s0, cp, hf); break;
        }
    }
    __syncthreads();
    {
        const int g = wave >> 1, dbase = (wave & 1) * 64, ch0 = g * 128 + dbase;
        const u16* PoolT = (const u16*)(p.ws + WS_POOLT); u16* Y = (u16*)(p.ws + WS_Y);
        unsigned char* gt = dyn_smem + 84992 + wave * 8704;
        u32x4 gq[8];
#pragma unroll
        for (int q = 0; q < 8; ++q) { const int idx = lane + 64 * q, row = idx >> 3, pc = idx & 7; gq[q] = *(const u32x4*)(Z + (size_t)(t0 + row) * DIN + 512 + ch0 + pc * 8); }
        f32x4 acc[4][4];
#pragma unroll
        for (int mt = 0; mt < 4; ++mt)
#pragma unroll
            for (int nt = 0; nt < 4; ++nt) acc[mt][nt] = (f32x4){0.f, 0.f, 0.f, 0.f};
#pragma unroll
        for (int ks = 0; ks < 4; ++ks) {
            bf16x8 Bf[4];
#pragma unroll
            for (int nt = 0; nt < 4; ++nt) Bf[nt] = *(const bf16x8*)(PoolT + (size_t)(ch0 + nt * 16 + fr) * 128 + ks * 32 + fq * 8);
#pragma unroll
            for (int mt = 0; mt < 4; ++mt) {
                const bf16x8 Af = *(const bf16x8*)(pooled + (mt * 16 + fr) * 520 + g * 128 + ks * 32 + fq * 8);
#pragma unroll
                for (int nt = 0; nt < 4; ++nt) acc[mt][nt] = MFMA16(Bf[nt], Af, acc[mt][nt]);
            }
        }
#pragma unroll
        for (int q = 0; q < 8; ++q) { const int idx = lane + 64 * q, row = idx >> 3, pc = idx & 7;
            *(u32x2*)(gt + row * 136 + pc * 16) = (u32x2){gq[q].x, gq[q].y}; *(u32x2*)(gt + row * 136 + pc * 16 + 8) = (u32x2){gq[q].z, gq[q].w}; }
        WSYNC();
#pragma unroll
        for (int mt = 0; mt < 4; ++mt) {
#pragma unroll
            for (int nt = 0; nt < 4; ++nt) {
                const int cl = nt * 16 + fq * 4;
                u32x2* slot = (u32x2*)(gt + (mt * 16 + fr) * 136 + cl * 2);
                const u32x2 ga = *slot;
                const f32x4 ps = *(const f32x4*)(p.pool_scale + ch0 + cl);
                const f32x4 gv = (f32x4){bflo(ga.x), bfhi(ga.x), bflo(ga.y), bfhi(ga.y)};
                f32x4 y;
#pragma unroll
                for (int jj = 0; jj < 4; ++jj) y[jj] = acc[mt][nt][jj] * ps[jj] * gv[jj] * sigmoidf_(gv[jj]);
                *slot = (u32x2){pack2(y[0], y[1]), pack2(y[2], y[3])};
            }
        }
        WSYNC();
#pragma unroll
        for (int q = 0; q < 8; ++q) { const int idx = lane + 64 * q, row = idx >> 3, pc = idx & 7;
            const u32x2 a = *(const u32x2*)(gt + row * 136 + pc * 16), b2 = *(const u32x2*)(gt + row * 136 + pc * 16 + 8);
            *(u32x4*)(Y + (size_t)(t0 + row) * 1024 + ch0 + pc * 8) = (u32x4){a.x, a.y, b2.x, b2.y}; }
    }
    __syncthreads();
    const int h = wave, bh = b * 8 + h;
    unsigned char* WL = dyn_smem + 18432 + wave * P2_WREG;
    unsigned char* recl = WL;
    u16* AR = (u16*)WL;
    u16* BK = AR + 32 * 72;
    u16* AtT = BK + 32 * 72;
    u16* BhT = AtT + 64 * 16;
    u16* KhT = BhT + 64 * 16;
    u16* VT = KhT + 64 * 16;
    float* Pab = (float*)WL;
    u16* Tm = (u16*)(Pab + 16 * 17);
    u16* AakT = Tm + 16 * 24;
    u16* M1m = AakT + 16 * 24;
    u16* Ark = M1m + 16 * 24;
    u16* Arb = Ark + 16 * 24;
    const u16* WupT = (const u16*)(p.ws + WS_WUPT); const u16* AupT = (const u16*)(p.ws + WS_AUPT);
    float* BON = (float*)(p.ws + WS_BONUS); u16* VB = (u16*)(p.ws + WS_VB);
    unsigned char* AFg = p.ws + CH_AF; unsigned char* RFg = p.ws + CH_RF; unsigned char* BKFg = p.ws + CH_BKF; unsigned char* ARBg = p.ws + CH_ARB;
    float* G15g = (float*)(p.ws + CH_G15); unsigned char* CHVg = (unsigned char*)p.out + OUT_CHV;
    const bf16x8 zero8 = (bf16x8){0, 0, 0, 0, 0, 0, 0, 0};
    const f32x4 zero4 = (f32x4){0.f, 0.f, 0.f, 0.f};
#pragma unroll 1
    for (int mt = 0; mt < 4; ++mt) {
        const size_t u = (size_t)bh * 128 + (s0 >> 4) + mt;
        {
            u32x4 zq[7];
            p2_zload(zq, Z, (size_t)(t0 + mt * 16), (s0 + mt * 16) > 0, h, lane);
            f32x4 aw[4], aa[4];
#pragma unroll
            for (int nt = 0; nt < 4; ++nt) { aw[nt] = zero4; aa[nt] = zero4; }
#pragma unroll
            for (int ks = 0; ks < 2; ++ks) {
                const bf16x8 Aw = *(const bf16x8*)(twb + (mt * 16 + fr) * 72 + ks * 32 + fq * 8);
                const bf16x8 Aa = *(const bf16x8*)(alb + (mt * 16 + fr) * 72 + ks * 32 + fq * 8);
#pragma unroll
                for (int nt = 0; nt < 4; ++nt) {
                    const bf16x8 Bw = *(const bf16x8*)(WupT + (h * 64 + nt * 16 + fr) * 64 + ks * 32 + fq * 8);
                    const bf16x8 Ba = *(const bf16x8*)(AupT + (h * 64 + nt * 16 + fr) * 64 + ks * 32 + fq * 8);
                    aw[nt] = MFMA16(Bw, Aw, aw[nt]);
                    aa[nt] = MFMA16(Ba, Aa, aa[nt]);
                }
            }
#pragma unroll
            for (int q = 0; q < 7; ++q) {
                const int pidx = lane + 64 * q, rr = pidx / 24, w = pidx - rr * 24, a = w >> 3, pc = w & 7;
                if (pidx < 17 * 24) *(u32x4*)(recl + ((rr < 16) ? rr * RST + 256 : 16 * RST) + a * 128 + pc * 16) = zq[q];
            }
            WSYNC();
            const int tt = mt * 16 + fr, s = s0 + tt; const size_t T = (size_t)(t0 + tt);
            f32x4 Kr[4], Av[4];
            float n2 = 0.f, bon = 0.f;
            unsigned char* rec = recl + fr * RST;
            const unsigned char* prec = (fr > 0) ? (recl + (fr - 1) * RST) : (recl + 16 * RST - 256);
#pragma unroll
            for (int nt = 0; nt < 4; ++nt) {
                const int cb = h * 64 + nt * 16 + fq * 4, ci = nt * 16 + fq * 4;
                const u32x2 zr = *(const u32x2*)(rec + 256 + ci * 2), zk = *(const u32x2*)(rec + 384 + ci * 2), zv = *(const u32x2*)(rec + 512 + ci * 2);
                const u32x2 pr = *(const u32x2*)(prec + 256 + ci * 2), pk = *(const u32x2*)(prec + 384 + ci * 2), pv = *(const u32x2*)(prec + 512 + ci * 2);
                const f32x4 mur = *(const f32x4*)(p.shift_mu + cb), muk = *(const f32x4*)(p.shift_mu + 512 + cb), muv = *(const f32x4*)(p.shift_mu + 1024 + cb);
                const f32x4 w0v = *(const f32x4*)(p.w0 + cb), a0v = *(const f32x4*)(p.a0 + cb), kkv = *(const f32x4*)(p.k_k + cb), kav = *(const f32x4*)(p.k_a + cb), rkv = *(const f32x4*)(p.r_k + cb);
                const f32x4 cr = (f32x4){bflo(zr.x), bfhi(zr.x), bflo(zr.y), bfhi(zr.y)}, ck = (f32x4){bflo(zk.x), bfhi(zk.x), bflo(zk.y), bfhi(zk.y)}, cv = (f32x4){bflo(zv.x), bfhi(zv.x), bflo(zv.y), bfhi(zv.y)};
                const f32x4 qr = (f32x4){bflo(pr.x), bfhi(pr.x), bflo(pr.y), bfhi(pr.y)}, qk = (f32x4){bflo(pk.x), bfhi(pk.x), bflo(pk.y), bfhi(pk.y)}, qv = (f32x4){bflo(pv.x), bfhi(pv.x), bflo(pv.y), bfhi(pv.y)};
                f32x4 Rr, Kp, Vv, Dc;
#pragma unroll
                for (int jj = 0; jj < 4; ++jj) {
                    const float r = cr[jj] + mur[jj] * (qr[jj] - cr[jj]);
                    const float k = ck[jj] + muk[jj] * (qk[jj] - ck[jj]);
                    const float v = cv[jj] + muv[jj] * (qv[jj] - cv[jj]);
                    const float ww = aw[nt][jj] + w0v[jj];
                    const float a = sigmoidf_(aa[nt][jj] + a0v[jj]);
                    const float dec = __expf(-0.6065306597126334f * sigmoidf_(ww));
                    const float kr = k * kkv[jj];
                    n2 += kr * kr;
                    const float kp = k * (1.f + (a - 1.f) * kav[jj]);
                    bon += r * kp * rkv[jj];
                    Rr[jj] = r; Kp[jj] = kp; Vv[jj] = v; Kr[nt][jj] = kr; Av[nt][jj] = a; Dc[jj] = dec;
                }
                *(f32x4*)(rec + ci * 4) = Dc;
                *(u32x2*)(rec + 256 + ci * 2) = (u32x2){pack2(Rr[0], Rr[1]), pack2(Rr[2], Rr[3])};
                *(u32x2*)(rec + 384 + ci * 2) = (u32x2){pack2(Kp[0], Kp[1]), pack2(Kp[2], Kp[3])};
                const u32x2 vpk = (u32x2){pack2(Vv[0], Vv[1]), pack2(Vv[2], Vv[3])};
                *(u32x2*)(rec + 512 + ci * 2) = vpk;
            }
            n2 += __shfl_xor(n2, 16, 64); n2 += __shfl_xor(n2, 32, 64);
            bon += __shfl_xor(bon, 16, 64); bon += __shfl_xor(bon, 32, 64);
            const float inv = rsq_(fmaxf(n2, 1e-24f));
#pragma unroll
            for (int nt = 0; nt < 4; ++nt) {
                const int ci = nt * 16 + fq * 4;
                const f32x4 kk = Kr[nt] * inv;
                *(u32x2*)(rec + 640 + ci * 2) = (u32x2){pack2(kk[0], kk[1]), pack2(kk[2], kk[3])};
                const f32x4 nb = -(kk * Av[nt]);
                *(u32x2*)(rec + 768 + ci * 2) = (u32x2){pack2(nb[0], nb[1]), pack2(nb[2], nb[3])};
            }
            if (fq == 0) BON[(size_t)bh * 2048 + s] = bon;
        }
        WSYNC();
        {
            float w_[16], r_[16], kp_[16], v_[16], kk_[16], nb_[16];
#pragma unroll
            for (int t = 0; t < 16; ++t) {
                const unsigned char* rt = recl + t * RST;
                w_[t] = *(const float*)(rt + lane * 4);
                r_[t] = bf2f(*(const u16*)(rt + 256 + lane * 2)); kp_[t] = bf2f(*(const u16*)(rt + 384 + lane * 2)); v_[t] = bf2f(*(const u16*)(rt + 512 + lane * 2));
                kk_[t] = bf2f(*(const u16*)(rt + 640 + lane * 2)); nb_[t] = bf2f(*(const u16*)(rt + 768 + lane * 2));
            }
            WSYNC();
            float g = 1.f;
            float At[16], Bt[16], Kt[16];
#pragma unroll
            for (int t = 0; t < 16; ++t) {
                const float gp = g; g = g * w_[t]; const float ig = rcp_(g);
                const float a = kk_[t] * gp, rr = r_[t] * g, bb = nb_[t] * ig, kt = kp_[t] * ig;
                AR[t * 72 + lane] = f2bf(a); AR[(16 + t) * 72 + lane] = f2bf(rr); BK[t * 72 + lane] = f2bf(bb); BK[(16 + t) * 72 + lane] = f2bf(kt);
                At[t] = a; Bt[t] = bb; Kt[t] = kt;
            }
            u32x4 o0, o1;
            o0 = (u32x4){pack2(At[0], At[1]), pack2(At[2], At[3]), pack2(At[4], At[5]), pack2(At[6], At[7])};
            o1 = (u32x4){pack2(At[8], At[9]), pack2(At[10], At[11]), pack2(At[12], At[13]), pack2(At[14], At[15])};
            *(u32x4*)(AtT + lane * 16) = o0; *(u32x4*)(AtT + lane * 16 + 8) = o1;
            o0 = (u32x4){pack2(Bt[0] * g, Bt[1] * g), pack2(Bt[2] * g, Bt[3] * g), pack2(Bt[4] * g, Bt[5] * g), pack2(Bt[6] * g, Bt[7] * g)};
            o1 = (u32x4){pack2(Bt[8] * g, Bt[9] * g), pack2(Bt[10] * g, Bt[11] * g), pack2(Bt[12] * g, Bt[13] * g), pack2(Bt[14] * g, Bt[15] * g)};
            *(u32x4*)(BhT + lane * 16) = o0; *(u32x4*)(BhT + lane * 16 + 8) = o1;
            o0 = (u32x4){pack2(Kt[0] * g, Kt[1] * g), pack2(Kt[2] * g, Kt[3] * g), pack2(Kt[4] * g, Kt[5] * g), pack2(Kt[6] * g, Kt[7] * g)};
            o1 = (u32x4){pack2(Kt[8] * g, Kt[9] * g), pack2(Kt[10] * g, Kt[11] * g), pack2(Kt[12] * g, Kt[13] * g), pack2(Kt[14] * g, Kt[15] * g)};
            *(u32x4*)(KhT + lane * 16) = o0; *(u32x4*)(KhT + lane * 16 + 8) = o1;
            o0 = (u32x4){pack2(v_[0], v_[1]), pack2(v_[2], v_[3]), pack2(v_[4], v_[5]), pack2(v_[6], v_[7])};
            o1 = (u32x4){pack2(v_[8], v_[9]), pack2(v_[10], v_[11]), pack2(v_[12], v_[13]), pack2(v_[14], v_[15])};
            *(u32x4*)(VT + lane * 16) = o0; *(u32x4*)(VT + lane * 16 + 8) = o1;
            G15g[u * 64 + lane] = g;
        }
        WSYNC();
        {
            u32x2 rp[4];
#pragma unroll
            for (int ta = 0; ta < 4; ++ta) rp[ta] = *(const u32x2*)(AR + (16 + fr) * 72 + 16 * ta + 4 * fq);
            *(u32x4*)(RFg + (u * 64 + lane) * 32) = (u32x4){rp[0].x, rp[0].y, rp[1].x, rp[1].y};
            *(u32x4*)(RFg + (u * 64 + lane) * 32 + 16) = (u32x4){rp[2].x, rp[2].y, rp[3].x, rp[3].y};
#pragma unroll
            for (int ta = 0; ta < 4; ++ta) {
                const u32x2 b2 = *(const u32x2*)(BhT + (16 * ta + fr) * 16 + 4 * fq), k2 = *(const u32x2*)(KhT + (16 * ta + fr) * 16 + 4 * fq);
                *(u32x4*)(BKFg + ((u * 4 + ta) * 64 + lane) * 16) = (u32x4){b2.x, b2.y, k2.x, k2.y};
            }
#pragma unroll
            for (int sl = 0; sl < 4; ++sl) *(u32x2*)(CHVg + (((u * 4 + sl) * 3 + 2) * 64 + lane) * 8) = *(const u32x2*)(VT + (16 * sl + fr) * 16 + 4 * fq);
        }
        {
            f32x4 P00 = zero4, P01 = zero4, P10 = zero4, P11 = zero4;
#pragma unroll
            for (int s = 0; s < 2; ++s) {
                const bf16x8 a0 = *(const bf16x8*)(AR + fr * 72 + s * 32 + fq * 8), a1 = *(const bf16x8*)(AR + (16 + fr) * 72 + s * 32 + fq * 8);
                const bf16x8 b0 = *(const bf16x8*)(BK + fr * 72 + s * 32 + fq * 8), b1 = *(const bf16x8*)(BK + (16 + fr) * 72 + s * 32 + fq * 8);
                P00 = MFMA16(a0, b0, P00); P01 = MFMA16(a0, b1, P01); P10 = MFMA16(a1, b0, P10); P11 = MFMA16(a1, b1, P11);
            }
            WSYNC();
            float ak[4];
#pragma unroll
            for (int r = 0; r < 4; ++r) {
                const int i = 4 * fq + r, j = fr;
                Pab[i * 17 + j] = (j < i) ? P00[r] : 0.f;
                ak[r] = (j < i) ? P01[r] : 0.f;
                Arb[i * 24 + j] = f2bf((j <= i) ? P10[r] : 0.f);
                Ark[i * 24 + j] = f2bf((j <= i) ? P11[r] : 0.f);
            }
            *(u32x2*)(AakT + fr * 24 + 4 * fq) = (u32x2){pack2(ak[0], ak[1]), pack2(ak[2], ak[3])};
        }
        WSYNC();
        {
            float T[16];
#pragma unroll
            for (int i = 0; i < 16; ++i) T[i] = (i == fr) ? 1.f : 0.f;
#pragma unroll
            for (int j = 0; j < 15; ++j) {
#pragma unroll
                for (int i = j + 1; i < 16; ++i) T[i] += Pab[i * 17 + j] * T[j];
            }
#pragma unroll
            for (int i = 0; i < 16; ++i) Tm[i * 24 + fr] = f2bf(T[i]);
            *(u32x2*)(ARBg + (u * 64 + lane) * 8) = *(const u32x2*)(Arb + fr * 24 + 4 * fq);
        }
        WSYNC();
        const bf16x8 Tld = *(const bf16x8*)(Tm + fr * 24 + (fq & 1) * 8);
        const bf16x8 Tf = (fq < 2) ? Tld : zero8;
        {
            f32x4 D[4];
#pragma unroll
            for (int ta = 0; ta < 4; ++ta) {
                const bf16x8 ald = *(const bf16x8*)(AtT + (16 * ta + fr) * 16 + (fq & 1) * 8);
                D[ta] = MFMA16((fq < 2) ? ald : zero8, Tf, zero4);
            }
            *(u32x4*)(AFg + (u * 64 + lane) * 32) = (u32x4){pack2(D[0][0], D[0][1]), pack2(D[0][2], D[0][3]), pack2(D[1][0], D[1][1]), pack2(D[1][2], D[1][3])};
            *(u32x4*)(AFg + (u * 64 + lane) * 32 + 16) = (u32x4){pack2(D[2][0], D[2][1]), pack2(D[2][2], D[2][3]), pack2(D[3][0], D[3][1]), pack2(D[3][2], D[3][3])};
            const bf16x8 akld = *(const bf16x8*)(AakT + fr * 24 + (fq & 1) * 8);
            const f32x4 M1 = MFMA16(Tf, (fq < 2) ? akld : zero8, zero4);
#pragma unroll
            for (int r = 0; r < 4; ++r) M1m[(4 * fq + r) * 24 + fr] = f2bf(M1[r]);
        }
        WSYNC();
        {
            const bf16x8 m1ld = *(const bf16x8*)(M1m + fr * 24 + (fq & 1) * 8), rkld = *(const bf16x8*)(Ark + fr * 24 + (fq & 1) * 8);
            const bf16x8 M1f = (fq < 2) ? m1ld : zero8, Arkf = (fq < 2) ? rkld : zero8;
#pragma unroll
            for (int sl = 0; sl < 4; ++sl) {
                const bf16x8 vld = *(const bf16x8*)(VT + (16 * sl + fr) * 16 + (fq & 1) * 8);
                const bf16x8 Vb = (fq < 2) ? vld : zero8;
                const f32x4 Uh = MFMA16(M1f, Vb, zero4), Y0 = MFMA16(Arkf, Vb, zero4);
                *(u32x2*)(CHVg + (((u * 4 + sl) * 3 + 0) * 64 + lane) * 8) = (u32x2){pack2(Uh[0], Uh[1]), pack2(Uh[2], Uh[3])};
                *(u32x2*)(CHVg + (((u * 4 + sl) * 3 + 1) * 64 + lane) * 8) = (u32x2){pack2(Y0[0], Y0[1]), pack2(Y0[2], Y0[3])};
            }
        }
        WSYNC();
    }
}

struct ChunkOps { u32x4 af0, af1, rf0, rf1, bk0, bk1, bk2, bk3; u32x2 arb, uh, y0, vf; f32x4 g0, g1, g2, g3; };
constexpr int RING_SLOT = 17408, RING_NS = 7, RING_D = 6;
__device__ __forceinline__ void lds_chunk_ops(ChunkOps& o, const LAS unsigned char* s, int sl, int lane, int fq) {
    o.af0 = *(const LAS u32x4*)(s + lane * 32); o.af1 = *(const LAS u32x4*)(s + lane * 32 + 16);
    o.rf0 = *(const LAS u32x4*)(s + 2048 + lane * 32); o.rf1 = *(const LAS u32x4*)(s + 2048 + lane * 32 + 16);
    o.bk0 = *(const LAS u32x4*)(s + 4096 + (0 * 64 + lane) * 16); o.bk1 = *(const LAS u32x4*)(s + 4096 + (1 * 64 + lane) * 16);
    o.bk2 = *(const LAS u32x4*)(s + 4096 + (2 * 64 + lane) * 16); o.bk3 = *(const LAS u32x4*)(s + 4096 + (3 * 64 + lane) * 16);
    o.uh = *(const LAS u32x2*)(s + 8192 + ((sl * 3 + 0) * 64 + lane) * 8);
    o.y0 = *(const LAS u32x2*)(s + 8192 + ((sl * 3 + 1) * 64 + lane) * 8);
    o.vf = *(const LAS u32x2*)(s + 8192 + ((sl * 3 + 2) * 64 + lane) * 8);
    o.arb = *(const LAS u32x2*)(s + 16384 + lane * 8);
    o.g0 = *(const LAS f32x4*)(s + 16896 + 16 * fq); o.g1 = *(const LAS f32x4*)(s + 16896 + 64 + 16 * fq);
    o.g2 = *(const LAS f32x4*)(s + 16896 + 128 + 16 * fq); o.g3 = *(const LAS f32x4*)(s + 16896 + 192 + 16 * fq);
}
template <int LW> __device__ __forceinline__ void ring_issue(const Params& p, LAS unsigned char* ring, int bh, int c, int lane) {
    const size_t u = (size_t)bh * 128 + c;
    LAS unsigned char* slot = ring + (c % RING_NS) * RING_SLOT;
    const unsigned char* ws = p.ws; const unsigned char* od = (const unsigned char*)p.out;
#pragma unroll
    for (int j = 0; j < 8; ++j) {
        constexpr int Q0 = LW * 8; const int q = Q0 + j;
        const unsigned char* g;
        if (q < 2) g = ws + CH_AF + u * 2048 + q * 1024 + lane * 16;
        else if (q < 4) g = ws + CH_RF + u * 2048 + (q - 2) * 1024 + lane * 16;
        else if (q < 8) g = ws + CH_BKF + u * 4096 + (q - 4) * 1024 + lane * 16;
        else if (q < 14) g = od + OUT_CHV + u * 6144 + (q - 8) * 1024 + lane * 16;
        else { const int i = (q - 14) * 64 + lane; g = ws + WS_Z + (((size_t)(bh >> 3) * 2048 + c * 16 + (i >> 3)) * DIN + 2688 + (bh & 7) * 64) * 2 + (i & 7) * 16; }
        __builtin_amdgcn_global_load_lds((const unsigned*)g, (LAS unsigned*)(slot + q * 1024), 16, 0, 0);
    }
    if (LW == 0) {
        __builtin_amdgcn_global_load_lds((const unsigned*)(ws + CH_ARB + u * 512 + lane * 4), (LAS unsigned*)(slot + 16384), 4, 0, 0);
        __builtin_amdgcn_global_load_lds((const unsigned*)(ws + CH_ARB + u * 512 + 256 + lane * 4), (LAS unsigned*)(slot + 16384 + 256), 4, 0, 0);
    } else {
        __builtin_amdgcn_global_load_lds((const unsigned*)(ws + CH_G15 + u * 256 + lane * 4), (LAS unsigned*)(slot + 16896), 4, 0, 0);
        __builtin_amdgcn_global_load_lds((const unsigned*)(ws + WS_BONUS + ((size_t)bh * 2048 + c * 16) * 4 + (lane & 15) * 4), (LAS unsigned*)(slot + 17152), 4, 0, 0);
    }
}
template <int CTRL> __device__ __forceinline__ float dpp_add_q(float v) {
    const int t = __builtin_amdgcn_update_dpp(0, __float_as_int(v), CTRL, 0xf, 0xf, false);
    return v + __int_as_float(t);
}
__device__ __forceinline__ float oct_allsum(float v) {
    v = dpp_add_q<0xB1>(v); v = dpp_add_q<0x4E>(v); v = dpp_add_q<0x141>(v);
    return v;
}
struct EpiIn { u32x4 gb; float bon; u16 v[8]; };
__device__ __forceinline__ void epi_load(EpiIn& e, const LAS unsigned char* s, int t, int v0) {
    e.gb = *(const LAS u32x4*)(s + 14336 + t * 128 + v0 * 2);
    e.bon = *(const LAS float*)(s + 17152 + t * 4);
    const LAS unsigned char* vp = s + 8192 + (((v0 >> 4) * 3 + 2) * 64 + (t >> 2) * 16 + (v0 & 15)) * 8 + (t & 3) * 2;
#pragma unroll
    for (int i = 0; i < 8; ++i) e.v[i] = *(const LAS u16*)(vp + 8 * i);
}
template <int LW> __device__ __forceinline__ void p3_loader(const Params& p, LAS unsigned char* ring, int bh, int lane) {
#pragma unroll
    for (int c = 0; c < RING_D; ++c) ring_issue<LW>(p, ring, bh, c, lane);
    asm volatile("s_waitcnt vmcnt(40)" ::: "memory");
    __builtin_amdgcn_s_barrier();
#pragma unroll 1
    for (int c = 0; c < 128; ++c) {
        const int cn = (c + RING_D < 128) ? c + RING_D : 127;
        ring_issue<LW>(p, ring, bh, cn, lane);
        asm volatile("s_waitcnt vmcnt(40)" ::: "memory");
        __builtin_amdgcn_s_barrier();
    }
    asm volatile("s_waitcnt vmcnt(0)" ::: "memory");
}
__device__ void phase3(const Params& p) {
    const int tid = threadIdx.x, lane = tid & 63, wave = __builtin_amdgcn_readfirstlane(tid >> 6), fr = lane & 15, fq = lane >> 4;
    const int bh = blockIdx.x;
    if (bh >= 64) return;
    LAS unsigned char* ring = (LAS unsigned char*)dyn_smem;
    LAS float* ybuf = (LAS float*)(ring + RING_NS * RING_SLOT);
    if (wave >= 6) {
        const int e = (wave - 6) * 64 + lane, t = e >> 3, v0 = (e & 7) * 8, b = bh >> 3, h = bh & 7;
        f32x4 ga0 = *(const f32x4*)(p.gn_gain + h * 64 + v0), ga1 = *(const f32x4*)(p.gn_gain + h * 64 + v0 + 4);
        f32x4 bi0 = *(const f32x4*)(p.gn_bias + h * 64 + v0), bi1 = *(const f32x4*)(p.gn_bias + h * 64 + v0 + 4);
        u16* Y = (u16*)(p.ws + WS_Y);
        EpiIn cur, nxt;
        __builtin_amdgcn_s_barrier();
        epi_load(cur, ring, t, v0);
#pragma unroll 1
        for (int c = 0; c <= 128; ++c) {
            if (c >= 1) {
                const int cc = c - 1;
                { const int cn = (c < 128) ? c : 127; epi_load(nxt, ring + (cn % RING_NS) * RING_SLOT, t, v0); }
                const LAS float* yb = ybuf + (cc & 1) * (16 * 68) + t * 68 + v0;
                const f32x4 y0 = *(const LAS f32x4*)(yb), y1 = *(const LAS f32x4*)(yb + 4);
                float s1 = (y0[0] + y0[1]) + (y0[2] + y0[3]) + (y1[0] + y1[1]) + (y1[2] + y1[3]);
                float s2 = y0[0] * y0[0] + y0[1] * y0[1] + y0[2] * y0[2] + y0[3] * y0[3] + y1[0] * y1[0] + y1[1] * y1[1] + y1[2] * y1[2] + y1[3] * y1[3];
                s1 = oct_allsum(s1); s2 = oct_allsum(s2);
                const float mean = s1 * (1.f / 64.f);
                const float var = fmaxf(s2 * (1.f / 64.f) - mean * mean, 0.f);
                const float rstd = rsq_(var + 64e-5f);
                const float vvf[8] = {bf2f(cur.v[0]), bf2f(cur.v[1]), bf2f(cur.v[2]), bf2f(cur.v[3]), bf2f(cur.v[4]), bf2f(cur.v[5]), bf2f(cur.v[6]), bf2f(cur.v[7])};
                const float gbf[8] = {bflo(cur.gb.x), bfhi(cur.gb.x), bflo(cur.gb.y), bfhi(cur.gb.y), bflo(cur.gb.z), bfhi(cur.gb.z), bflo(cur.gb.w), bfhi(cur.gb.w)};
                float o[8];
#pragma unroll
                for (int i = 0; i < 8; ++i) {
                    const float yv = (i < 4) ? y0[i & 3] : y1[i & 3];
                    const float gn = (i < 4) ? ga0[i & 3] : ga1[i & 3], bs = (i < 4) ? bi0[i & 3] : bi1[i & 3];
                    const float yn = (yv - mean) * rstd * gn + bs;
                    o[i] = (yn + cur.bon * vvf[i]) * gbf[i] * sigmoidf_(gbf[i]);
                }
                *(u32x4*)(Y + ((size_t)b * 2048 + cc * 16 + t) * 1024 + 512 + h * 64 + v0) = (u32x4){pack2(o[0], o[1]), pack2(o[2], o[3]), pack2(o[4], o[5]), pack2(o[6], o[7])};
                cur = nxt;
            }
            if (c < 128) __builtin_amdgcn_s_barrier();
        }
        return;
    }
    if (wave >= 4) { if (wave == 4) p3_loader<0>(p, ring, bh, lane); else p3_loader<1>(p, ring, bh, lane); return; }
    const int sl = wave;
    f32x4 acc0 = (f32x4){0.f, 0.f, 0.f, 0.f}, acc1 = acc0, acc2 = acc0, acc3 = acc0;
    ChunkOps cur, nxt;
    __builtin_amdgcn_s_barrier();
    lds_chunk_ops(cur, ring, sl, lane, fq);
#pragma unroll 2
    for (int c = 0; c < 128; ++c) {
        { const int cn = (c + 1 < 128) ? c + 1 : c; lds_chunk_ops(nxt, ring + (cn % RING_NS) * RING_SLOT, sl, lane, fq); }
        const bf16x8 sb0 = as_bf8((u32x4){pack2(acc0[0], acc0[1]), pack2(acc0[2], acc0[3]), pack2(acc1[0], acc1[1]), pack2(acc1[2], acc1[3])});
        const bf16x8 sb1 = as_bf8((u32x4){pack2(acc2[0], acc2[1]), pack2(acc2[2], acc2[3]), pack2(acc3[0], acc3[1]), pack2(acc3[2], acc3[3])});
        f32x4 U = (f32x4){bflo(cur.uh.x), bfhi(cur.uh.x), bflo(cur.uh.y), bfhi(cur.uh.y)};
        U = MFMA16(as_bf8(cur.af0), sb0, U); U = MFMA16(as_bf8(cur.af1), sb1, U);
        f32x4 Yv = (f32x4){bflo(cur.y0.x), bfhi(cur.y0.x), bflo(cur.y0.y), bfhi(cur.y0.y)};
        Yv = MFMA16(as_bf8(cur.rf0), sb0, Yv); Yv = MFMA16(as_bf8(cur.rf1), sb1, Yv);
        const unsigned u01 = pack2(U[0], U[1]), u23 = pack2(U[2], U[3]);
        Yv = MFMA16(as_bf8((u32x4){cur.arb.x, cur.arb.y, 0u, 0u}), as_bf8((u32x4){u01, u23, 0u, 0u}), Yv);
        const bf16x8 uvb = as_bf8((u32x4){u01, u23, cur.vf.x, cur.vf.y});
        acc0 = MFMA16(as_bf8(cur.bk0), uvb, acc0 * cur.g0); acc1 = MFMA16(as_bf8(cur.bk1), uvb, acc1 * cur.g1);
        acc2 = MFMA16(as_bf8(cur.bk2), uvb, acc2 * cur.g2); acc3 = MFMA16(as_bf8(cur.bk3), uvb, acc3 * cur.g3);
        LAS float* yb = ybuf + (c & 1) * (16 * 68) + (4 * fq) * 68 + sl * 16 + fr;
        yb[0] = Yv[0]; yb[68] = Yv[1]; yb[136] = Yv[2]; yb[204] = Yv[3];
        asm volatile("s_waitcnt lgkmcnt(0)" ::: "memory");
        __builtin_amdgcn_s_barrier();
        asm volatile("" ::: "memory");
        cur = nxt;
    }
}

__device__ void phase5(const Params& p) {
    const int tid = threadIdx.x, lane = tid & 63, wave = tid >> 6, blk = blockIdx.x;
#pragma unroll 1
    for (int r0 = 0; r0 < 8; r0 += 4) {
        f32x4 v[4][4]; float ss[4];
#pragma unroll
        for (int i = 0; i < 4; ++i) {
            const f32x4* xr = (const f32x4*)(p.out + (size_t)(blk * 64 + wave * 8 + r0 + i) * DM);
#pragma unroll
            for (int q = 0; q < 4; ++q) v[i][q] = xr[lane + 64 * q];
        }
#pragma unroll
        for (int i = 0; i < 4; ++i) {
            float s = 0.f;
#pragma unroll
            for (int q = 0; q < 4; ++q) s += v[i][q][0] * v[i][q][0] + v[i][q][1] * v[i][q][1] + v[i][q][2] * v[i][q][2] + v[i][q][3] * v[i][q][3];
            ss[i] = wave_sum(s);
        }
#pragma unroll
        for (int i = 0; i < 4; ++i) {
            f32x4* xr = (f32x4*)(p.out + (size_t)(blk * 64 + wave * 8 + r0 + i) * DM);
            const float inv = rsq_(ss[i] * (1.f / 1024.f) + 1e-6f);
#pragma unroll
            for (int q = 0; q < 4; ++q) { const f32x4 g = ((const f32x4*)p.final_gain)[lane + 64 * q]; xr[lane + 64 * q] = v[i][q] * inv * g; }
        }
    }
}

__global__ void __launch_bounds__(512, 2) hybrid_fwd(Params p) {
    __shared__ uint4 xb_words;
    if (threadIdx.x == 0) xb_words = make_uint4(0u, 0u, 0u, 0u);
    __syncthreads();
    XcdBarrier bar; bar.bar = (unsigned*)(p.ws + WS_CTL); bar.x = 0; bar.st = (volatile LAS unsigned*)&xb_words;
    const int lo = p.ph_lo, hi = p.ph_hi;
    if (hi - lo > 1) bar = xcd_barrier_post((unsigned*)(p.ws + WS_CTL), (volatile LAS unsigned*)&xb_words);
#define IN(k) (lo <= (k) && (k) < hi)
#define SEAM(k) do { if (IN(k) && IN((k) + 1)) xcd_barrier(bar); } while (0)
#define RUN(k, f) do { if (IN(k)) { if (PROBE_DUP == (k)) { for (int _r = 0; _r < p.dup_n; ++_r) { if (_r) __syncthreads(); f(p); } } else f(p); } } while (0)
    RUN(0, phase0);
    SEAM(0);
    RUN(1, phase1);
    SEAM(1);
    RUN(2, phase2);
    SEAM(2);
    RUN(3, phase3);
    SEAM(3);
    RUN(4, phase4);
}

extern "C" void kernel_launch(void* const* d_in, const int* in_sizes, int n_in, void* d_out, int out_size, void* d_ws, size_t ws_size, hipStream_t stream) {
    static int grid = 0;
    if (grid == 0) {
        if (n_in != 17 || out_size != NTOK * DM || ws_size < WS_END) { fprintf(stderr, "kernel_launch: unexpected problem (n_in %d out %d ws %zu need %zu)\n", n_in, out_size, ws_size, (size_t)WS_END); grid = -1; return; }
        if (hipFuncSetAttribute((const void*)hybrid_fwd, hipFuncAttributeMaxDynamicSharedMemorySize, LDS_BYTES) != hipSuccess) { fprintf(stderr, "kernel_launch: hipFuncSetAttribute failed\n"); grid = -1; return; }
        int per_cu = 0;
        if (hipOccupancyMaxActiveBlocksPerMultiprocessor(&per_cu, (const void*)hybrid_fwd, 512, LDS_BYTES) != hipSuccess || per_cu < 1) fprintf(stderr, "kernel_launch: occupancy query says %d blocks per CU\n", per_cu);
        (void)hipGetLastError();
        grid = 256;
    }
    if (grid < 0) return;
    (void)hipMemsetAsync((char*)d_ws + WS_CTL, 0, 16384, stream);
    Params p{};
    p.x = (const float*)d_in[0]; p.norm_gain = (const float*)d_in[1]; p.w_in = (const float*)d_in[2]; p.pool_w = (const float*)d_in[3];
    p.pool_scale = (const float*)d_in[4]; p.shift_mu = (const float*)d_in[5]; p.w0 = (const float*)d_in[6]; p.w_up = (const float*)d_in[7];
    p.a0 = (const float*)d_in[8]; p.a_up = (const float*)d_in[9]; p.k_k = (const float*)d_in[10]; p.k_a = (const float*)d_in[11];
    p.r_k = (const float*)d_in[12]; p.gn_gain = (const float*)d_in[13]; p.gn_bias = (const float*)d_in[14]; p.w_out = (const float*)d_in[15];
    p.final_gain = (const float*)d_in[16];
    p.out = (float*)d_out; p.ws = (unsigned char*)d_ws; p.dup_n = 2;
#if N_LAUNCHES == 1
    p.ph_lo = 0; p.ph_hi = NPH;
    hipLaunchKernelGGL(hybrid_fwd, dim3(grid), dim3(512), LDS_BYTES, stream, p);
#else
    for (int k = 0; k < NPH; ++k) { p.ph_lo = k; p.ph_hi = k + 1; hipLaunchKernelGGL(hybrid_fwd, dim3(grid), dim3(512), LDS_BYTES, stream, p); }
#endif
}
```

```cpp
#include <hip/hip_runtime.h>
#include <stdint.h>
#include <cstdio>

typedef unsigned short u16;
typedef short bf16x8 __attribute__((ext_vector_type(8)));
typedef float f32x4 __attribute__((ext_vector_type(4)));
typedef float f32x2 __attribute__((ext_vector_type(2)));
typedef unsigned u32x2 __attribute__((ext_vector_type(2)));
typedef unsigned u32x4 __attribute__((ext_vector_type(4)));

#ifndef PROBE_DUP
#define PROBE_DUP -1
#endif
#ifndef N_LAUNCHES
#define N_LAUNCHES 1
#endif

constexpr int NTOK = 16384, DM = 1024, SEQ = 2048, DIN = 3200, DINP = 3328;
constexpr int NPH = 5;
constexpr int LDS_BYTES = 18432 + 8 * 17408;

constexpr size_t WS_CTL = 0;
constexpr size_t WS_WINT = 16384;
constexpr size_t WS_WOUTT = WS_WINT + (size_t)DINP * 1024 * 2;
constexpr size_t WS_WUPT = WS_WOUTT + (size_t)1024 * 1024 * 2;
constexpr size_t WS_AUPT = WS_WUPT + 512 * 64 * 2;
constexpr size_t WS_POOLT = WS_AUPT + 512 * 64 * 2;
constexpr size_t WS_Z = WS_POOLT + 4 * 128 * 128 * 2;
constexpr size_t WS_REC = WS_Z + (size_t)NTOK * DIN * 2;
constexpr size_t WS_Y = WS_REC + (size_t)64 * 2048 * 896;
constexpr size_t WS_BONUS = WS_Y + (size_t)NTOK * 1024 * 2;
constexpr size_t WS_PART = WS_BONUS + (size_t)64 * 2048 * 4;
constexpr size_t WS_END = WS_PART + (size_t)64 * 4 * 256 * 4;
constexpr int CTL_CNT_WORD = 3584;
constexpr int NUNIT = 64 * 128;
constexpr size_t CH_AF = WS_REC;
constexpr size_t CH_RF = CH_AF + (size_t)NUNIT * 2048;
constexpr size_t CH_BKF = CH_RF + (size_t)NUNIT * 2048;
constexpr size_t CH_ARB = CH_BKF + (size_t)NUNIT * 4096;
constexpr size_t CH_G15 = CH_ARB + (size_t)NUNIT * 512;
constexpr size_t CH_END = CH_G15 + (size_t)NUNIT * 256;
constexpr size_t WS_VB = CH_END;
static_assert(WS_VB + (size_t)NTOK * 512 * 2 <= WS_Y, "chunk operands + v must fit in the record region");
constexpr size_t OUT_CHV = 0;
constexpr size_t OUT_GB = (size_t)NUNIT * 4 * 3 * 512;
static_assert(OUT_GB + (size_t)NTOK * 512 * 2 <= (size_t)NTOK * DM * 4, "d_out scratch");

struct Params {
    const float* x; const float* norm_gain; const float* w_in; const float* pool_w; const float* pool_scale;
    const float* shift_mu; const float* w0; const float* w_up; const float* a0; const float* a_up;
    const float* k_k; const float* k_a; const float* r_k; const float* gn_gain; const float* gn_bias;
    const float* w_out; const float* final_gain;
    float* out; unsigned char* ws;
    int ph_lo, ph_hi, dup_n, pad;
};

extern __shared__ __attribute__((aligned(16))) unsigned char dyn_smem[];

__device__ __forceinline__ float bf2f(u16 v) { return __uint_as_float(((unsigned)v) << 16); }
__device__ __forceinline__ float bflo(unsigned v) { return __uint_as_float(v << 16); }
__device__ __forceinline__ float bfhi(unsigned v) { return __uint_as_float(v & 0xffff0000u); }
typedef __bf16 bf16x2_t __attribute__((ext_vector_type(2)));
__device__ __forceinline__ unsigned pack2(float lo, float hi) { bf16x2_t v = {(__bf16)lo, (__bf16)hi}; return __builtin_bit_cast(unsigned, v); }
__device__ __forceinline__ u16 f2bf(float f) { return (u16)(pack2(f, 0.f) & 0xffffu); }
__device__ __forceinline__ float wave_sum(float v) {
#pragma unroll
    for (int m = 32; m >= 1; m >>= 1) v += __shfl_xor(v, m, 64);
    return v;
}
__device__ __forceinline__ float rcp_(float v) { return __builtin_amdgcn_rcpf(v); }
__device__ __forceinline__ float rsq_(float v) { return __builtin_amdgcn_rsqf(v); }
__device__ __forceinline__ float sigmoidf_(float v) { return rcp_(1.f + __expf(-v)); }
__device__ __forceinline__ float tanhf_(float v) { return 1.f - 2.f * rcp_(1.f + __expf(2.f * v)); }

#define XB_TMO      128
#define XB_XCNT(j)  (256  + 64 * (j))
#define XB_XSUB(j)  (1280 + 64 * (j))
#define XB_XGEN(j)  (2304 + 64 * (j))
#define XB_TOP      3328
#define XB_TOPGEN   3392
#define XCD_BAR_WORDS 3456
#define XB_SPIN_CAP (1u << 22)
#define LAS __attribute__((address_space(3)))

__device__ __forceinline__ unsigned xb_ld(unsigned* p)              { return __hip_atomic_load(p, __ATOMIC_RELAXED, __HIP_MEMORY_SCOPE_AGENT); }
__device__ __forceinline__ unsigned xb_add(unsigned* p, unsigned v) { return __hip_atomic_fetch_add(p, v, __ATOMIC_RELAXED, __HIP_MEMORY_SCOPE_AGENT); }
__device__ __forceinline__ unsigned xb_xcc_id() { return (unsigned)__builtin_amdgcn_s_getreg((3 << 11) | 20) & 0xFu; }
#define XB_SPIN(cond, bar) do { unsigned _sp = 0; while (cond) { __builtin_amdgcn_s_sleep(8); \
    if ((++_sp & 255u) == 0u) { if (xb_ld(&(bar)[XB_TMO])) break; if (_sp > XB_SPIN_CAP) { atomicAdd(&(bar)[XB_TMO], 1u); break; } } } } while (0)

struct XcdBarrier { unsigned* bar; unsigned x; volatile LAS unsigned* st; };

__device__ __forceinline__ XcdBarrier xcd_barrier_post(unsigned* bar, volatile LAS unsigned* st) {
    XcdBarrier b; b.bar = bar; b.x = xb_xcc_id(); b.st = st;
    if (threadIdx.x == 0) (void)xb_add(&bar[XB_XCNT(b.x)], 1u);
    return b;
}
__device__ __forceinline__ void xcd_barrier_complete(unsigned* bar, unsigned x, unsigned& nloc, unsigned& nx) {
    const unsigned G = gridDim.x * gridDim.y * gridDim.z;
    unsigned sum, cnt, mine, sp = 0u;
    for (;;) {
        sum = 0u; cnt = 0u; mine = 0u;
#pragma unroll
        for (unsigned j = 0; j < 16; ++j) { const unsigned c = xb_ld(&bar[XB_XCNT(j)]); sum += c; cnt += (c > 0u) ? 1u : 0u; mine = (j == x) ? c : mine; }
        if (sum == G) break;
        __builtin_amdgcn_s_sleep(1);
        if ((++sp & 255u) == 0u) { if (xb_ld(&bar[XB_TMO])) break; if (sp > XB_SPIN_CAP) { atomicAdd(&bar[XB_TMO], 1u); break; } }
    }
    nloc = mine > 0u ? mine : 1u; nx = cnt > 0u ? cnt : 1u;
}
__device__ __forceinline__ void xcd_barrier(const XcdBarrier& b) {
    asm volatile("s_waitcnt vmcnt(0)" ::: "memory");
    __syncthreads();
    if (threadIdx.x == 0) {
        unsigned* bar = b.bar;
        __builtin_amdgcn_s_waitcnt(0);
        unsigned nloc = b.st[0], nx = b.st[1];
        if (nloc == 0u) { xcd_barrier_complete(bar, b.x, nloc, nx); b.st[0] = nloc; b.st[1] = nx; }
        const unsigned old = xb_add(&bar[XB_XSUB(b.x)], 1u);
        const unsigned gen = old / nloc;
        if (old + 1u == (gen + 1u) * nloc) {
            __builtin_amdgcn_fence(__ATOMIC_RELEASE, "agent");
            asm volatile("s_waitcnt vmcnt(0)" ::: "memory");
            const unsigned og = xb_add(&bar[XB_TOP], 1u);
            const unsigned tg = og / nx;
            if (og + 1u == (tg + 1u) * nx) xb_add(&bar[XB_TOPGEN], 1u);
            else XB_SPIN(xb_ld(&bar[XB_TOPGEN]) == tg, bar);
            __builtin_amdgcn_fence(__ATOMIC_ACQUIRE, "agent");
            xb_add(&bar[XB_XGEN(b.x)], 1u);
            asm volatile("s_waitcnt vmcnt(0)" ::: "memory");
        } else {
            XB_SPIN(xb_ld(&bar[XB_XGEN(b.x)]) == gen, bar);
            __builtin_amdgcn_fence(__ATOMIC_ACQUIRE, "agent");
            asm volatile("s_waitcnt vmcnt(0)" ::: "memory");
        }
    }
    __syncthreads();
}

constexpr int BM = 256, BK = 64, HALF = 128, HTB = HALF * BK * 2, STAGE_BYTES = 8 * HTB, NXCD = 8, WGM = 8;
__device__ __forceinline__ int lds_byte(int r, int c) { const int st = (r >> 4) * 2 + (c >> 5), rr = r & 15, cc = c & 31, ob = rr * 64 + cc * 2; return st * 1024 + (ob ^ (((ob >> 9) & 1) << 5)); }
__device__ __forceinline__ void stage_rc(int b, int& R, int& C) { const int st = b / 1024, sb = b % 1024, swz = sb ^ (((sb >> 9) & 1) << 5); R = (st >> 1) * 16 + swz / 64; C = (st & 1) * 32 + (swz % 64) / 2; }
__device__ __forceinline__ int perm32(int rho) { const int n = rho >> 4, i = rho & 15; return 8 * (i >> 2) + 4 * n + (i & 3); }

struct Unit { int pm, pn; };
struct Gemm { const u16* A; const u16* Bt; int M, N, K, Nvalid; };
struct StaticOrder {
    int nM, nN, nwg, G, c;
    __device__ void init(int M, int N, int G_, int c_) { nM = M / BM; nN = N / BM; nwg = nM * nN; G = G_; c = c_; }
    __device__ bool next(int i, Unit& u) const {
        const long L = (long)i * G + c; if (L >= nwg) return false;
        int wgid = (int)L; { const int q = nwg / NXCD, r = nwg % NXCD, xcd = wgid % NXCD, off = wgid / NXCD; wgid = (xcd < r ? xcd * (q + 1) : r * (q + 1) + (xcd - r) * q) + off; }
        const int nig = WGM * nN, gid = wgid / nig, fm = gid * WGM, gsz = (nM - fm) < WGM ? (nM - fm) : WGM;
        u.pm = fm + ((wgid % nig) % gsz); u.pn = (wgid % nig) / gsz; return true;
    }
};
struct EpiZ {
    static constexpr bool PERM = true, AFTER_DRAIN = false;
    u16* Z;
    __device__ __forceinline__ void operator()(const f32x4 (&acc)[2][2][4][2], const Unit& u, int wr, int wc, int fr, int fq) const {
        const int row0 = u.pm * BM + wr * 64 + fr, col0 = u.pn * BM + wc * 32 + 8 * fq;
#pragma unroll
        for (int ai = 0; ai < 2; ++ai)
#pragma unroll
            for (int m = 0; m < 4; ++m) { u16* rowp = Z + (size_t)(row0 + ai * HALF + m * 16) * DIN;
#pragma unroll
                for (int bj = 0; bj < 2; ++bj) { const int col = col0 + bj * HALF; const f32x4 v0 = acc[ai][bj][m][0], v1 = acc[ai][bj][m][1];
                    if (col < DIN) *(u32x4*)(rowp + col) = (u32x4){pack2(v0[0], v0[1]), pack2(v0[2], v0[3]), pack2(v1[0], v1[1]), pack2(v1[2], v1[3])}; } }
    }
};
struct EpiRes {
    static constexpr bool PERM = false, AFTER_DRAIN = false;
    const float* x; float* out;
    __device__ __forceinline__ void operator()(const f32x4 (&acc)[2][2][4][2], const Unit& u, int wr, int wc, int fr, int fq) const {
        const int row0 = u.pm * BM + wr * 64 + fr, col0 = u.pn * BM + wc * 32 + 4 * fq;
#pragma unroll
        for (int ai = 0; ai < 2; ++ai)
#pragma unroll
            for (int m = 0; m < 4; ++m) { const size_t ro = (size_t)(row0 + ai * HALF + m * 16) * DM + col0;
#pragma unroll
                for (int bj = 0; bj < 2; ++bj)
#pragma unroll
                    for (int n = 0; n < 2; ++n) { const f32x4 xv = *(const f32x4*)(x + ro + bj * HALF + n * 16); *(f32x4*)(out + ro + bj * HALF + n * 16) = xv + acc[ai][bj][m][n]; } }
    }
};
struct EpiResNorm {
    static constexpr bool PERM = false, AFTER_DRAIN = true;
    const float* x; const float* gain; float* out; float* part; unsigned* cnt;
    __device__ __forceinline__ void fused(f32x4 (&acc)[2][2][4][2], const Unit& u, int wr, int wc, int fr, int fq, LAS unsigned char* lds) const {
        const int row0 = u.pm * BM + wr * 64 + fr, col0 = u.pn * BM + wc * 32 + 4 * fq;
        LAS float* red = (LAS float*)lds;
        LAS float* tot = red + 1024;
        float rs[2][4];
#pragma unroll
        for (int ai = 0; ai < 2; ++ai)
#pragma unroll
            for (int m = 0; m < 4; ++m) { const size_t ro = (size_t)(row0 + ai * HALF + m * 16) * DM + col0; float s = 0.f;
#pragma unroll
                for (int bj = 0; bj < 2; ++bj)
#pragma unroll
                    for (int n = 0; n < 2; ++n) { const f32x4 v = __builtin_nontemporal_load((const f32x4*)(x + ro + bj * HALF + n * 16)) + acc[ai][bj][m][n]; acc[ai][bj][m][n] = v; s += v[0] * v[0] + v[1] * v[1] + v[2] * v[2] + v[3] * v[3]; }
                s += __shfl_xor(s, 16, 64); s += __shfl_xor(s, 32, 64);
                rs[ai][m] = s; }
        if (fq == 0) {
#pragma unroll
            for (int ai = 0; ai < 2; ++ai)
#pragma unroll
                for (int m = 0; m < 4; ++m) red[((wr * 4 + wc) * 8 + ai * 4 + m) * 16 + fr] = rs[ai][m];
        }
        __syncthreads();
        if (threadIdx.x < 256) {
            const int rl = threadIdx.x, ai = rl >> 7, wr_ = (rl >> 6) & 1, m = (rl >> 4) & 3, fr_ = rl & 15;
            const int o = ((wr_ * 4) * 8 + ai * 4 + m) * 16 + fr_;
            const float s = red[o] + red[o + 128] + red[o + 256] + red[o + 384];
            __hip_atomic_store(part + ((size_t)u.pm * 4 + u.pn) * 256 + rl, s, __ATOMIC_RELAXED, __HIP_MEMORY_SCOPE_AGENT);
        }
        asm volatile("s_waitcnt vmcnt(0)" ::: "memory");
        __syncthreads();
        if (threadIdx.x == 0) {
            __builtin_amdgcn_fence(__ATOMIC_RELEASE, "agent");
            asm volatile("s_waitcnt vmcnt(0)" ::: "memory");
            __hip_atomic_fetch_add(cnt + u.pm, 1u, __ATOMIC_RELAXED, __HIP_MEMORY_SCOPE_AGENT);
            unsigned sp = 0;
            while (__hip_atomic_load(cnt + u.pm, __ATOMIC_RELAXED, __HIP_MEMORY_SCOPE_AGENT) < 4u) { __builtin_amdgcn_s_sleep(1); if (++sp > (1u << 24)) break; }
            __builtin_amdgcn_fence(__ATOMIC_ACQUIRE, "agent");
            asm volatile("s_waitcnt vmcnt(0)" ::: "memory");
        }
        __syncthreads();
        for (int e = threadIdx.x; e < 1024; e += 512) tot[e] = __hip_atomic_load(part + (size_t)u.pm * 1024 + e, __ATOMIC_RELAXED, __HIP_MEMORY_SCOPE_AGENT);
        __syncthreads();
#pragma unroll
        for (int ai = 0; ai < 2; ++ai)
#pragma unroll
            for (int m = 0; m < 4; ++m) { const int rl = ai * 128 + wr * 64 + m * 16 + fr;
                const float inv = rsq_((tot[rl] + tot[256 + rl] + tot[512 + rl] + tot[768 + rl]) * (1.f / 1024.f) + 1e-6f);
                const size_t ro = (size_t)(row0 + ai * HALF + m * 16) * DM + col0;
#pragma unroll
                for (int bj = 0; bj < 2; ++bj)
#pragma unroll
                    for (int n = 0; n < 2; ++n) { const f32x4 g = *(const f32x4*)(gain + col0 + bj * HALF + n * 16); __builtin_nontemporal_store(acc[ai][bj][m][n] * inv * g, (f32x4*)(out + ro + bj * HALF + n * 16)); } }
    }
};

template <class Epi, class Sched>
__device__ __forceinline__ void gemm_phase(LAS unsigned char* lds, const Gemm g, const Sched& S, const Epi& E) {
    const int tid = threadIdx.x, wid = __builtin_amdgcn_readfirstlane(tid >> 6), lane = tid & 63, wr = wid >> 2, wc = wid & 3, fr = lane & 15, fq = lane >> 4;
    const int K = g.K, nt = K / BK;
    unsigned voffA[2], voffB[2];
#pragma unroll
    for (int i = 0; i < 2; ++i) { int R, C; stage_rc(tid * 16 + i * 8192, R, C); const int Rb = Epi::PERM ? ((R & ~31) + perm32(R & 31)) : R;
        voffA[i] = (unsigned)(R * K + C) * 2u; voffB[i] = (unsigned)(Rb * K + C) * 2u; }
    const size_t kstep = (size_t)(BK * 2);
    const size_t hstep = (size_t)HALF * K * 2;
    const size_t tstep = 2 * hstep;
    const unsigned ldsw = (unsigned)wid * 1024u;
    const int aoff = lds_byte(wr * 64 + fr, fq * 8), boff = lds_byte(wc * 32 + fr, fq * 8);
#define PG8_SA(b, h) (((b) * 2 + (h)) * HTB)
#define PG8_SB(b, h) ((4 + (b) * 2 + (h)) * HTB)
#define PG8_STAGE(bufoff, gbase, voff) do { _Pragma("unroll") for (int _i = 0; _i < 2; ++_i) \
        __builtin_amdgcn_global_load_lds((const unsigned*)((const char*)(gbase) + (voff)[_i]), (LAS unsigned*)(lds + (bufoff) + ldsw + _i * 8192), 16, 0, 0); } while (0)
#define PG8_LDA(dst, b, h) do { _Pragma("unroll") for (int m = 0; m < 4; ++m) _Pragma("unroll") for (int k = 0; k < 2; ++k) dst[m][k] = *(const LAS bf16x8*)(lds + PG8_SA(b, h) + aoff + m * 2048 + k * 1024); } while (0)
#define PG8_LDB(dst, b, h) do { _Pragma("unroll") for (int n = 0; n < 2; ++n) _Pragma("unroll") for (int k = 0; k < 2; ++k) dst[n][k] = *(const LAS bf16x8*)(lds + PG8_SB(b, h) + boff + n * 2048 + k * 1024); } while (0)
#define PG8_MMA(ai, bj, At, Bt) do { __builtin_amdgcn_s_setprio(1); _Pragma("unroll") for (int m = 0; m < 4; ++m) _Pragma("unroll") for (int n = 0; n < 2; ++n) _Pragma("unroll") for (int k = 0; k < 2; ++k) \
        acc[ai][bj][m][n] = __builtin_amdgcn_mfma_f32_16x16x32_bf16(Bt[n][k], At[m][k], acc[ai][bj][m][n], 0, 0, 0); __builtin_amdgcn_s_setprio(0); } while (0)
#define PG8_WAIT_V(n) asm volatile("s_waitcnt vmcnt(" #n ")" ::: "memory")
#define PG8_WAIT_L(n) asm volatile("s_waitcnt lgkmcnt(" #n ")" ::: "memory")
#define PG8_BAR __builtin_amdgcn_s_barrier()
#define PG8_SCHED __builtin_amdgcn_sched_barrier(0)
    Unit cur, nxt; int ui = 0;
    if (!S.next(0, cur)) return;
    f32x4 acc[2][2][4][2];
#pragma unroll
    for (int a = 0; a < 2; ++a)
#pragma unroll
        for (int b = 0; b < 2; ++b)
#pragma unroll
            for (int m = 0; m < 4; ++m)
#pragma unroll
                for (int n = 0; n < 2; ++n) acc[a][b][m][n] = (f32x4){0.f, 0.f, 0.f, 0.f};
    bf16x8 At[4][2], B0[2][2], B1[2][2];
    const char* cA = (const char*)g.A + (size_t)cur.pm * tstep; const char* cB = (const char*)g.Bt + (size_t)cur.pn * tstep;
    PG8_STAGE(PG8_SB(0, 0), cB, voffB); PG8_STAGE(PG8_SA(0, 0), cA, voffA); PG8_STAGE(PG8_SB(0, 1), cB + hstep, voffB); PG8_STAGE(PG8_SA(0, 1), cA + hstep, voffA);
    if (wr == 1) PG8_BAR;
    PG8_WAIT_V(4); PG8_BAR;
    PG8_STAGE(PG8_SB(1, 0), cB + kstep, voffB); PG8_STAGE(PG8_SA(1, 0), cA + kstep, voffA); PG8_STAGE(PG8_SB(1, 1), cB + hstep + kstep, voffB);
    PG8_WAIT_V(6); PG8_BAR;
    for (;;) {
        const bool has_next = S.next(ui + 1, nxt);
        const char* nA = has_next ? (const char*)g.A + (size_t)nxt.pm * tstep : cA; const char* nB = has_next ? (const char*)g.Bt + (size_t)nxt.pn * tstep : cB;
        const bool rhalf = (cur.pn * BM + HALF) < g.Nvalid;
        for (int t = 0; t < nt; t += 2) {
            const bool last = (t == nt - 2);
            const char* a1 = cA + (size_t)(t + 1) * kstep;
            const char* a2 = last ? nA : cA + (size_t)(t + 2) * kstep; const char* b2 = last ? nB : cB + (size_t)(t + 2) * kstep;
            const char* a3 = a2 + kstep; const char* b3 = b2 + kstep;
            PG8_LDB(B0, 0, 0); PG8_SCHED; PG8_LDA(At, 0, 0); PG8_STAGE(PG8_SA(1, 1), a1 + hstep, voffA);
            PG8_WAIT_L(8); PG8_BAR; PG8_WAIT_L(0); PG8_MMA(0, 0, At, B0); PG8_BAR; PG8_SCHED;
            PG8_LDB(B1, 0, 1); PG8_STAGE(PG8_SB(0, 0), b2, voffB);
            PG8_BAR; PG8_WAIT_L(0); if (rhalf) PG8_MMA(0, 1, At, B1); PG8_BAR;
            PG8_LDA(At, 0, 1); PG8_STAGE(PG8_SA(0, 0), a2, voffA);
            PG8_BAR; PG8_WAIT_L(0); PG8_MMA(1, 0, At, B0); PG8_BAR; PG8_SCHED;
            PG8_STAGE(PG8_SB(0, 1), b2 + hstep, voffB);
            PG8_WAIT_V(6); PG8_BAR; if (rhalf) PG8_MMA(1, 1, At, B1); PG8_BAR;
            PG8_LDB(B0, 1, 0); PG8_SCHED; PG8_LDA(At, 1, 0); PG8_STAGE(PG8_SA(0, 1), a2 + hstep, voffA);
            PG8_WAIT_L(8); PG8_BAR; PG8_WAIT_L(0); PG8_MMA(0, 0, At, B0); PG8_BAR; PG8_SCHED;
            PG8_LDB(B1, 1, 1); PG8_STAGE(PG8_SB(1, 0), b3, voffB);
            PG8_BAR; PG8_WAIT_L(0); if (rhalf) PG8_MMA(0, 1, At, B1); PG8_BAR;
            PG8_LDA(At, 1, 1); PG8_STAGE(PG8_SA(1, 0), a3, voffA);
            PG8_BAR; PG8_WAIT_L(0); PG8_MMA(1, 0, At, B0); PG8_BAR; PG8_SCHED;
            PG8_STAGE(PG8_SB(1, 1), b3 + hstep, voffB);
            PG8_WAIT_V(6); PG8_BAR; if (rhalf) PG8_MMA(1, 1, At, B1); PG8_BAR;
        }
        if constexpr (!Epi::AFTER_DRAIN) E(acc, cur, wr, wc, fr, fq);
        if (!has_next) break;
#pragma unroll
        for (int a = 0; a < 2; ++a)
#pragma unroll
            for (int b = 0; b < 2; ++b)
#pragma unroll
                for (int m = 0; m < 4; ++m)
#pragma unroll
                    for (int n = 0; n < 2; ++n) acc[a][b][m][n] = (f32x4){0.f, 0.f, 0.f, 0.f};
        cur = nxt; cA = nA; cB = nB; ++ui;
    }
    PG8_WAIT_V(0);
    if (wr == 0) PG8_BAR;
    PG8_BAR;
    if constexpr (Epi::AFTER_DRAIN) E.fused(acc, cur, wr, wc, fr, fq, lds);
#undef PG8_SA
#undef PG8_SB
#undef PG8_STAGE
#undef PG8_LDA
#undef PG8_LDB
#undef PG8_MMA
#undef PG8_WAIT_V
#undef PG8_WAIT_L
#undef PG8_BAR
#undef PG8_SCHED
}

#define WSYNC() do { __builtin_amdgcn_wave_barrier(); asm volatile("s_waitcnt lgkmcnt(0)" ::: "memory"); __builtin_amdgcn_wave_barrier(); } while (0)
__device__ void phase0(const Params& p) {
    const int tid = threadIdx.x, lane = tid & 63, wave = tid >> 6, blk = blockIdx.x;
    u16* Hbf = (u16*)p.out;
#pragma unroll 1
    for (int r0 = 0; r0 < 8; r0 += 4) {
        f32x4 v[4][4]; float ss[4];
#pragma unroll
        for (int i = 0; i < 4; ++i) {
            const f32x4* xr = (const f32x4*)(p.x + (size_t)(blk * 64 + wave * 8 + r0 + i) * DM);
#pragma unroll
            for (int q = 0; q < 4; ++q) v[i][q] = __builtin_nontemporal_load(xr + lane + 64 * q);
        }
#pragma unroll
        for (int i = 0; i < 4; ++i) {
            float s = 0.f;
#pragma unroll
            for (int q = 0; q < 4; ++q) s += v[i][q][0] * v[i][q][0] + v[i][q][1] * v[i][q][1] + v[i][q][2] * v[i][q][2] + v[i][q][3] * v[i][q][3];
            ss[i] = wave_sum(s);
        }
#pragma unroll
        for (int i = 0; i < 4; ++i) {
            const int row = blk * 64 + wave * 8 + r0 + i;
            const float inv = rsq_(ss[i] * (1.f / 1024.f) + 1e-6f);
#pragma unroll
            for (int q = 0; q < 4; ++q) {
                const f32x4 g = ((const f32x4*)p.norm_gain)[lane + 64 * q];
                u32x2 o; o.x = pack2(v[i][q][0] * inv * g[0], v[i][q][1] * inv * g[1]); o.y = pack2(v[i][q][2] * inv * g[2], v[i][q][3] * inv * g[3]);
                *(u32x2*)(Hbf + (size_t)row * DM + (lane + 64 * q) * 4) = o;
            }
        }
    }
    u16* WinT = (u16*)(p.ws + WS_WINT); u16* WoutT = (u16*)(p.ws + WS_WOUTT);
    {
        float* tl = (float*)dyn_smem + wave * (64 * 65);
        const int t = blk + 256 * wave;
        if (t < 832 + 256) {
            const float* src; u16* dst; int kt, ntile, N;
            if (t < 832) { kt = t & 15; ntile = t >> 4; src = p.w_in; N = DIN; dst = WinT; }
            else { const int t2 = t - 832; kt = t2 & 15; ntile = t2 >> 4; src = p.w_out; N = 1024; dst = WoutT; }
            const int k0 = kt * 64, n0 = ntile * 64, n4 = (lane & 15) * 4;
            f32x4 v[16];
#pragma unroll
            for (int i = 0; i < 16; ++i) { const int kk = (lane >> 4) + 4 * i; v[i] = (n0 + n4 < N) ? *(const f32x4*)(src + (size_t)(k0 + kk) * N + n0 + n4) : (f32x4){0.f, 0.f, 0.f, 0.f}; }
#pragma unroll
            for (int i = 0; i < 16; ++i) { const int kk = (lane >> 4) + 4 * i; float* d = tl + kk * 65 + n4; d[0] = v[i][0]; d[1] = v[i][1]; d[2] = v[i][2]; d[3] = v[i][3]; }
            WSYNC();
            const int kp = lane & 31, nh = lane >> 5;
#pragma unroll 8
            for (int i = 0; i < 32; ++i) { const int nn = 2 * i + nh;
                *(unsigned*)(dst + (size_t)(n0 + nn) * 1024 + k0 + 2 * kp) = pack2(tl[(2 * kp) * 65 + nn], tl[(2 * kp + 1) * 65 + nn]); }
        }
    }
    u16* WupT = (u16*)(p.ws + WS_WUPT); u16* AupT = (u16*)(p.ws + WS_AUPT); u16* PoolT = (u16*)(p.ws + WS_POOLT);
    const int gt = blk * 512 + tid;
    if (gt < 32768) { const int c = gt >> 6, j = gt & 63; WupT[gt] = f2bf(p.w_up[j * 512 + c]); AupT[gt] = f2bf(p.a_up[j * 512 + c]); }
    if (gt < 65536) { const int g = gt >> 14, d = (gt >> 7) & 127, c = gt & 127; PoolT[gt] = f2bf(p.pool_w[(g * 128 + c) * 128 + d]); }
}

__device__ void phase1(const Params& p) {
    Gemm g; g.A = (const u16*)p.out; g.Bt = (const u16*)(p.ws + WS_WINT); g.M = NTOK; g.N = DINP; g.K = 1024; g.Nvalid = DIN;
    StaticOrder S; S.init(NTOK, DINP, 256, blockIdx.x);
    EpiZ E; E.Z = (u16*)(p.ws + WS_Z);
    gemm_phase((LAS unsigned char*)dyn_smem, g, S, E);
}
__device__ void phase4(const Params& p) {
    Gemm g; g.A = (const u16*)(p.ws + WS_Y); g.Bt = (const u16*)(p.ws + WS_WOUTT); g.M = NTOK; g.N = 1024; g.K = 1024; g.Nvalid = 1024;
    StaticOrder S; S.init(NTOK, 1024, 256, blockIdx.x);
    EpiResNorm E; E.x = p.x; E.gain = p.final_gain; E.out = p.out; E.part = (float*)(p.ws + WS_PART); E.cnt = (unsigned*)(p.ws + WS_CTL) + CTL_CNT_WORD;
    gemm_phase((LAS unsigned char*)dyn_smem, g, S, E);
}

template <int CTRL> __device__ __forceinline__ float dpp_add(float v) {
    const int t = __builtin_amdgcn_update_dpp(0, __float_as_int(v), CTRL, 0xf, 0xf, false);
    return v + __int_as_float(t);
}
__device__ __forceinline__ float row16_allsum(float v) {
    v = dpp_add<0x128>(v); v = dpp_add<0x124>(v); v = dpp_add<0x122>(v); v = dpp_add<0x121>(v);
    return v;
}
#define MFMA16(a, b, c) __builtin_amdgcn_mfma_f32_16x16x32_bf16((a), (b), (c), 0, 0, 0)
__device__ __forceinline__ bf16x8 as_bf8(u32x4 v) { return __builtin_bit_cast(bf16x8, v); }
template <int W> __device__ __forceinline__ void pooled_run(const u16* __restrict__ Z, u16* pooled, int t0, int s0, int cp, int hf) {
    const int c0 = 2 * cp, tb = hf * 32;
    unsigned raw[W - 1 + 32];
#pragma unroll
    for (int i = 0; i < W - 1 + 32; ++i) { const int tt = tb - (W - 1) + i; raw[i] = (s0 + tt >= 0) ? *(const unsigned*)(Z + (size_t)(t0 + tt) * DIN + c0) : 0u; }
    float sum0 = 0.f, sum1 = 0.f;
#pragma unroll
    for (int i = 0; i < W - 1; ++i) { sum0 += bflo(raw[i]); sum1 += bfhi(raw[i]); }
#pragma unroll
    for (int j = 0; j < 32; ++j) {
        const int tt = tb + j, s = s0 + tt;
        const float u0 = bflo(raw[W - 1 + j]), u1 = bfhi(raw[W - 1 + j]);
        sum0 += u0; sum1 += u1;
        const float rc = rcp_((float)((s + 1 < W) ? (s + 1) : W));
        *(unsigned*)(pooled + tt * 520 + c0) = pack2(sum0 * rc - u0, sum1 * rc - u1);
        sum0 -= bflo(raw[j]); sum1 -= bfhi(raw[j]);
    }
}
constexpr int RST = 912;
__device__ __forceinline__ void p2_zload(u32x4 (&zq)[7], const u16* __restrict__ Z, size_t T0, bool has_halo, int h, int lane) {
#pragma unroll
    for (int q = 0; q < 7; ++q) {
        const int pidx = lane + 64 * q, rr = pidx / 24, w = pidx - rr * 24, a = w >> 3, pc = w & 7;
        u32x4 v = (u32x4){0u, 0u, 0u, 0u};
        if (pidx < 17 * 24) {
            if (rr < 16) v = *(const u32x4*)(Z + (T0 + rr) * DIN + 1024 + a * 512 + h * 64 + pc * 8);
            else if (has_halo) v = *(const u32x4*)(Z + (T0 - 1) * DIN + 1024 + a * 512 + h * 64 + pc * 8);
        }
        zq[q] = v;
    }
}
constexpr int P2_WREG = 17408;
__device__ void phase2(const Params& p) {
    const int tid = threadIdx.x, lane = tid & 63, wave = tid >> 6, blk = blockIdx.x, fr = lane & 15, fq = lane >> 4;
    const int t0 = blk * 64, b = t0 >> 11, s0 = t0 & 2047;
    const u16* Z = (const u16*)(p.ws + WS_Z);
    u16* twb = (u16*)dyn_smem;
    u16* alb = twb + 64 * 72;
    u16* pooled = alb + 64 * 72;
    for (int e = tid; e < 64 * 128; e += 512) {
        const int tt = e >> 7, j = e & 127;
        const size_t zi = (size_t)(t0 + tt) * DIN + 2560 + j;
        const float cur = bf2f(Z[zi]);
        const float prev = (s0 + tt > 0) ? bf2f(Z[zi - DIN]) : 0.f;
        const float val = cur + p.shift_mu[1536 + j] * (prev - cur);
        if (j < 64) twb[tt * 72 + j] = f2bf(tanhf_(val)); else alb[tt * 72 + (j - 64)] = f2bf(val);
    }
    {
        const int cp = tid & 255, hf = tid >> 8;
        switch (wave & 3) {
            case 0: pooled_run<2>(Z, pooled, t0, s0, cp, hf); break;
            case 1: pooled_run<4>(Z, pooled, t0, s0, cp, hf); break;
            case 2: pooled_run<8>(Z, pooled, t0, s0, cp, hf); break;
            default: pooled_run<16>(Z, pooled, t0, s0, cp, hf); break;
        }
    }
    __syncthreads();
    {
        const int g = wave >> 1, dbase = (wave & 1) * 64, ch0 = g * 128 + dbase;
        const u16* PoolT = (const u16*)(p.ws + WS_POOLT); u16* Y = (u16*)(p.ws + WS_Y);
        unsigned char* gt = dyn_smem + 84992 + wave * 8704;
        u32x4 gq[8];
#pragma unroll
        for (int q = 0; q < 8; ++q) { const int idx = lane + 64 * q, row = idx >> 3, pc = idx & 7; gq[q] = *(const u32x4*)(Z + (size_t)(t0 + row) * DIN + 512 + ch0 + pc * 8); }
        f32x4 acc[4][4];
#pragma unroll
        for (int mt = 0; mt < 4; ++mt)
#pragma unroll
            for (int nt = 0; nt < 4; ++nt) acc[mt][nt] = (f32x4){0.f, 0.f, 0.f, 0.f};
#pragma unroll
        for (int ks = 0; ks < 4; ++ks) {
            bf16x8 Bf[4];
#pragma unroll
            for (int nt = 0; nt < 4; ++nt) Bf[nt] = *(const bf16x8*)(PoolT + (size_t)(ch0 + nt * 16 + fr) * 128 + ks * 32 + fq * 8);
#pragma unroll
            for (int mt = 0; mt < 4; ++mt) {
                const bf16x8 Af = *(const bf16x8*)(pooled + (mt * 16 + fr) * 520 + g * 128 + ks * 32 + fq * 8);
#pragma unroll
                for (int nt = 0; nt < 4; ++nt) acc[mt][nt] = MFMA16(Bf[nt], Af, acc[mt][nt]);
            }
        }
#pragma unroll
        for (int q = 0; q < 8; ++q) { const int idx = lane + 64 * q, row = idx >> 3, pc = idx & 7;
            *(u32x2*)(gt + row * 136 + pc * 16) = (u32x2){gq[q].x, gq[q].y}; *(u32x2*)(gt + row * 136 + pc * 16 + 8) = (u32x2){gq[q].z, gq[q].w}; }
        WSYNC();
#pragma unroll
        for (int mt = 0; mt < 4; ++mt) {
#pragma unroll
            for (int nt = 0; nt < 4; ++nt) {
                const int cl = nt * 16 + fq * 4;
                u32x2* slot = (u32x2*)(gt + (mt * 16 + fr) * 136 + cl * 2);
                const u32x2 ga = *slot;
                const f32x4 ps = *(const f32x4*)(p.pool_scale + ch0 + cl);
                const f32x4 gv = (f32x4){bflo(ga.x), bfhi(ga.x), bflo(ga.y), bfhi(ga.y)};
                f32x4 y;
#pragma unroll
                for (int jj = 0; jj < 4; ++jj) y[jj] = acc[mt][nt][jj] * ps[jj] * gv[jj] * sigmoidf_(gv[jj]);
                *slot = (u32x2){pack2(y[0], y[1]), pack2(y[2], y[3])};
            }
        }
        WSYNC();
#pragma unroll
        for (int q = 0; q < 8; ++q) { const int idx = lane + 64 * q, row = idx >> 3, pc = idx & 7;
            const u32x2 a = *(const u32x2*)(gt + row * 136 + pc * 16), b2 = *(const u32x2*)(gt + row * 136 + pc * 16 + 8);
            *(u32x4*)(Y + (size_t)(t0 + row) * 1024 + ch0 + pc * 8) = (u32x4){a.x, a.y, b2.x, b2.y}; }
    }
    __syncthreads();
    const int h = wave, bh = b * 8 + h;
    unsigned char* WL = dyn_smem + 18432 + wave * P2_WREG;
    unsigned char* recl = WL;
    u16* AR = (u16*)WL;
    u16* BK = AR + 32 * 72;
    u16* AtT = BK + 32 * 72;
    u16* BhT = AtT + 64 * 16;
    u16* KhT = BhT + 64 * 16;
    u16* VT = KhT + 64 * 16;
    float* Pab = (float*)WL;
    u16* Tm = (u16*)(Pab + 16 * 17);
    u16* AakT = Tm + 16 * 24;
    u16* M1m = AakT + 16 * 24;
    u16* Ark = M1m + 16 * 24;
    u16* Arb = Ark + 16 * 24;
    const u16* WupT = (const u16*)(p.ws + WS_WUPT); const u16* AupT = (const u16*)(p.ws + WS_AUPT);
    float* BON = (float*)(p.ws + WS_BONUS); u16* VB = (u16*)(p.ws + WS_VB);
    unsigned char* AFg = p.ws + CH_AF; unsigned char* RFg = p.ws + CH_RF; unsigned char* BKFg = p.ws + CH_BKF; unsigned char* ARBg = p.ws + CH_ARB;
    float* G15g = (float*)(p.ws + CH_G15); unsigned char* CHVg = (unsigned char*)p.out + OUT_CHV;
    const bf16x8 zero8 = (bf16x8){0, 0, 0, 0, 0, 0, 0, 0};
    const f32x4 zero4 = (f32x4){0.f, 0.f, 0.f, 0.f};
#pragma unroll 1
    for (int mt = 0; mt < 4; ++mt) {
        const size_t u = (size_t)bh * 128 + (s0 >> 4) + mt;
        {
            u32x4 zq[7];
            p2_zload(zq, Z, (size_t)(t0 + mt * 16), (s0 + mt * 16) > 0, h, lane);
            f32x4 aw[4], aa[4];
#pragma unroll
            for (int nt = 0; nt < 4; ++nt) { aw[nt] = zero4; aa[nt] = zero4; }
#pragma unroll
            for (int ks = 0; ks < 2; ++ks) {
                const bf16x8 Aw = *(const bf16x8*)(twb + (mt * 16 + fr) * 72 + ks * 32 + fq * 8);
                const bf16x8 Aa = *(const bf16x8*)(alb + (mt * 16 + fr) * 72 + ks * 32 + fq * 8);
#pragma unroll
                for (int nt = 0; nt < 4; ++nt) {
                    const bf16x8 Bw = *(const bf16x8*)(WupT + (h * 64 + nt * 16 + fr) * 64 + ks * 32 + fq * 8);
                    const bf16x8 Ba = *(const bf16x8*)(AupT + (h * 64 + nt * 16 + fr) * 64 + ks * 32 + fq * 8);
                    aw[nt] = MFMA16(Bw, Aw, aw[nt]);
                    aa[nt] = MFMA16(Ba, Aa, aa[nt]);
                }
            }
#pragma unroll
            for (int q = 0; q < 7; ++q) {
                const int pidx = lane + 64 * q, rr = pidx / 24, w = pidx - rr * 24, a = w >> 3, pc = w & 7;
                if (pidx < 17 * 24) *(u32x4*)(recl + ((rr < 16) ? rr * RST + 256 : 16 * RST) + a * 128 + pc * 16) = zq[q];
            }
            WSYNC();
            const int tt = mt * 16 + fr, s = s0 + tt; const size_t T = (size_t)(t0 + tt);
            f32x4 Kr[4], Av[4];
            float n2 = 0.f, bon = 0.f;
            unsigned char* rec = recl + fr * RST;
            const unsigned char* prec = (fr > 0) ? (recl + (fr - 1) * RST) : (recl + 16 * RST - 256);
#pragma unroll
            for (int nt = 0; nt < 4; ++nt) {
                const int cb = h * 64 + nt * 16 + fq * 4, ci = nt * 16 + fq * 4;
                const u32x2 zr = *(const u32x2*)(rec + 256 + ci * 2), zk = *(const u32x2*)(rec + 384 + ci * 2), zv = *(const u32x2*)(rec + 512 + ci * 2);
                const u32x2 pr = *(const u32x2*)(prec + 256 + ci * 2), pk = *(const u32x2*)(prec + 384 + ci * 2), pv = *(const u32x2*)(prec + 512 + ci * 2);
                const f32x4 mur = *(const f32x4*)(p.shift_mu + cb), muk = *(const f32x4*)(p.shift_mu + 512 + cb), muv = *(const f32x4*)(p.shift_mu + 1024 + cb);
                const f32x4 w0v = *(const f32x4*)(p.w0 + cb), a0v = *(const f32x4*)(p.a0 + cb), kkv = *(const f32x4*)(p.k_k + cb), kav = *(const f32x4*)(p.k_a + cb), rkv = *(const f32x4*)(p.r_k + cb);
                const f32x4 cr = (f32x4){bflo(zr.x), bfhi(zr.x), bflo(zr.y), bfhi(zr.y)}, ck = (f32x4){bflo(zk.x), bfhi(zk.x), bflo(zk.y), bfhi(zk.y)}, cv = (f32x4){bflo(zv.x), bfhi(zv.x), bflo(zv.y), bfhi(zv.y)};
                const f32x4 qr = (f32x4){bflo(pr.x), bfhi(pr.x), bflo(pr.y), bfhi(pr.y)}, qk = (f32x4){bflo(pk.x), bfhi(pk.x), bflo(pk.y), bfhi(pk.y)}, qv = (f32x4){bflo(pv.x), bfhi(pv.x), bflo(pv.y), bfhi(pv.y)};
                f32x4 Rr, Kp, Vv, Dc;
#pragma unroll
                for (int jj = 0; jj < 4; ++jj) {
                    const float r = cr[jj] + mur[jj] * (qr[jj] - cr[jj]);
                    const float k = ck[jj] + muk[jj] * (qk[jj] - ck[jj]);
                    const float v = cv[jj] + muv[jj] * (qv[jj] - cv[jj]);
                    const float ww = aw[nt][jj] + w0v[jj];
                    const float a = sigmoidf_(aa[nt][jj] + a0v[jj]);
                    const float dec = __expf(-0.6065306597126334f * sigmoidf_(ww));
                    const float kr = k * kkv[jj];
                    n2 += kr * kr;
                    const float kp = k * (1.f + (a - 1.f) * kav[jj]);
                    bon += r * kp * rkv[jj];
                    Rr[jj] = r; Kp[jj] = kp; Vv[jj] = v; Kr[nt][jj] = kr; Av[nt][jj] = a; Dc[jj] = dec;
                }
                *(f32x4*)(rec + ci * 4) = Dc;
                *(u32x2*)(rec + 256 + ci * 2) = (u32x2){pack2(Rr[0], Rr[1]), pack2(Rr[2], Rr[3])};
                *(u32x2*)(rec + 384 + ci * 2) = (u32x2){pack2(Kp[0], Kp[1]), pack2(Kp[2], Kp[3])};
                const u32x2 vpk = (u32x2){pack2(Vv[0], Vv[1]), pack2(Vv[2], Vv[3])};
                *(u32x2*)(rec + 512 + ci * 2) = vpk;
            }
            n2 += __shfl_xor(n2, 16, 64); n2 += __shfl_xor(n2, 32, 64);
            bon += __shfl_xor(bon, 16, 64); bon += __shfl_xor(bon, 32, 64);
            const float inv = rsq_(fmaxf(n2, 1e-24f));
#pragma unroll
            for (int nt = 0; nt < 4; ++nt) {
                const int ci = nt * 16 + fq * 4;
                const f32x4 kk = Kr[nt] * inv;
                *(u32x2*)(rec + 640 + ci * 2) = (u32x2){pack2(kk[0], kk[1]), pack2(kk[2], kk[3])};
                const f32x4 nb = -(kk * Av[nt]);
                *(u32x2*)(rec + 768 + ci * 2) = (u32x2){pack2(nb[0], nb[1]), pack2(nb[2], nb[3])};
            }
            if (fq == 0) BON[(size_t)bh * 2048 + s] = bon;
        }
        WSYNC();
        {
            float w_[16], r_[16], kp_[16], v_[16], kk_[16], nb_[16];
#pragma unroll
            for (int t = 0; t < 16; ++t) {
                const unsigned char* rt = recl + t * RST;
                w_[t] = *(const float*)(rt + lane * 4);
                r_[t] = bf2f(*(const u16*)(rt + 256 + lane * 2)); kp_[t] = bf2f(*(const u16*)(rt + 384 + lane * 2)); v_[t] = bf2f(*(const u16*)(rt + 512 + lane * 2));
                kk_[t] = bf2f(*(const u16*)(rt + 640 + lane * 2)); nb_[t] = bf2f(*(const u16*)(rt + 768 + lane * 2));
            }
            WSYNC();
            float g = 1.f;
            float At[16], Bt[16], Kt[16];
#pragma unroll
            for (int t = 0; t < 16; ++t) {
                const float gp = g; g = g * w_[t]; const float ig = rcp_(g);
                const float a = kk_[t] * gp, rr = r_[t] * g, bb = nb_[t] * ig, kt = kp_[t] * ig;
                AR[t * 72 + lane] = f2bf(a); AR[(16 + t) * 72 + lane] = f2bf(rr); BK[t * 72 + lane] = f2bf(bb); BK[(16 + t) * 72 + lane] = f2bf(kt);
                At[t] = a; Bt[t] = bb; Kt[t] = kt;
            }
            u32x4 o0, o1;
            o0 = (u32x4){pack2(At[0], At[1]), pack2(At[2], At[3]), pack2(At[4], At[5]), pack2(At[6], At[7])};
            o1 = (u32x4){pack2(At[8], At[9]), pack2(At[10], At[11]), pack2(At[12], At[13]), pack2(At[14], At[15])};
            *(u32x4*)(AtT + lane * 16) = o0; *(u32x4*)(AtT + lane * 16 + 8) = o1;
            o0 = (u32x4){pack2(Bt[0] * g, Bt[1] * g), pack2(Bt[2] * g, Bt[3] * g), pack2(Bt[4] * g, Bt[5] * g), pack2(Bt[6] * g, Bt[7] * g)};
            o1 = (u32x4){pack2(Bt[8] * g, Bt[9] * g), pack2(Bt[10] * g, Bt[11] * g), pack2(Bt[12] * g, Bt[13] * g), pack2(Bt[14] * g, Bt[15] * g)};
            *(u32x4*)(BhT + lane * 16) = o0; *(u32x4*)(BhT + lane * 16 + 8) = o1;
            o0 = (u32x4){pack2(Kt[0] * g, Kt[1] * g), pack2(Kt[2] * g, Kt[3] * g), pack2(Kt[4] * g, Kt[5] * g), pack2(Kt[6] * g, Kt[7] * g)};
            o1 = (u32x4){pack2(Kt[8] * g, Kt[9] * g), pack2(Kt[10] * g, Kt[11] * g), pack2(Kt[12] * g, Kt[13] * g), pack2(Kt[14] * g, Kt[15] * g)};
            *(u32x4*)(KhT + lane * 16) = o0; *(u32x4*)(KhT + lane * 16 + 8) = o1;
            o0 = (u32x4){pack2(v_[0], v_[1]), pack2(v_[2], v_[3]), pack2(v_[4], v_[5]), pack2(v_[6], v_[7])};
            o1 = (u32x4){pack2(v_[8], v_[9]), pack2(v_[10], v_[11]), pack2(v_[12], v_[13]), pack2(v_[14], v_[15])};
            *(u32x4*)(VT + lane * 16) = o0; *(u32x4*)(VT + lane * 16 + 8) = o1;
            G15g[u * 64 + lane] = g;
        }
        WSYNC();
        {
            u32x2 rp[4];
#pragma unroll
            for (int ta = 0; ta < 4; ++ta) rp[ta] = *(const u32x2*)(AR + (16 + fr) * 72 + 16 * ta + 4 * fq);
            *(u32x4*)(RFg + (u * 64 + lane) * 32) = (u32x4){rp[0].x, rp[0].y, rp[1].x, rp[1].y};
            *(u32x4*)(RFg + (u * 64 + lane) * 32 + 16) = (u32x4){rp[2].x, rp[2].y, rp[3].x, rp[3].y};
#pragma unroll
            for (int ta = 0; ta < 4; ++ta) {
                const u32x2 b2 = *(const u32x2*)(BhT + (16 * ta + fr) * 16 + 4 * fq), k2 = *(const u32x2*)(KhT + (16 * ta + fr) * 16 + 4 * fq);
                *(u32x4*)(BKFg + ((u * 4 + ta) * 64 + lane) * 16) = (u32x4){b2.x, b2.y, k2.x, k2.y};
            }
#pragma unroll
            for (int sl = 0; sl < 4; ++sl) *(u32x2*)(CHVg + (((u * 4 + sl) * 3 + 2) * 64 + lane) * 8) = *(const u32x2*)(VT + (16 * sl + fr) * 16 + 4 * fq);
        }
        {
            f32x4 P00 = zero4, P01 = zero4, P10 = zero4, P11 = zero4;
#pragma unroll
            for (int s = 0; s < 2; ++s) {
                const bf16x8 a0 = *(const bf16x8*)(AR + fr * 72 + s * 32 + fq * 8), a1 = *(const bf16x8*)(AR + (16 + fr) * 72 + s * 32 + fq * 8);
                const bf16x8 b0 = *(const bf16x8*)(BK + fr * 72 + s * 32 + fq * 8), b1 = *(const bf16x8*)(BK + (16 + fr) * 72 + s * 32 + fq * 8);
                P00 = MFMA16(a0, b0, P00); P01 = MFMA16(a0, b1, P01); P10 = MFMA16(a1, b0, P10); P11 = MFMA16(a1, b1, P11);
            }
            WSYNC();
            float ak[4];
#pragma unroll
            for (int r = 0; r < 4; ++r) {
                const int i = 4 * fq + r, j = fr;
                Pab[i * 17 + j] = (j < i) ? P00[r] : 0.f;
                ak[r] = (j < i) ? P01[r] : 0.f;
                Arb[i * 24 + j] = f2bf((j <= i) ? P10[r] : 0.f);
                Ark[i * 24 + j] = f2bf((j <= i) ? P11[r] : 0.f);
            }
            *(u32x2*)(AakT + fr * 24 + 4 * fq) = (u32x2){pack2(ak[0], ak[1]), pack2(ak[2], ak[3])};
        }
        WSYNC();
        {
            float T[16];
#pragma unroll
            for (int i = 0; i < 16; ++i) T[i] = (i == fr) ? 1.f : 0.f;
#pragma unroll
            for (int j = 0; j < 15; ++j) {
#pragma unroll
                for (int i = j + 1; i < 16; ++i) T[i] += Pab[i * 17 + j] * T[j];
            }
#pragma unroll
            for (int i = 0; i < 16; ++i) Tm[i * 24 + fr] = f2bf(T[i]);
            *(u32x2*)(ARBg + (u * 64 + lane) * 8) = *(const u32x2*)(Arb + fr * 24 + 4 * fq);
        }
        WSYNC();
        const bf16x8 Tld = *(const bf16x8*)(Tm + fr * 24 + (fq & 1) * 8);
        const bf16x8 Tf = (fq < 2) ? Tld : zero8;
        {
            f32x4 D[4];
#pragma unroll
            for (int ta = 0; ta < 4; ++ta) {
                const bf16x8 ald = *(const bf16x8*)(AtT + (16 * ta + fr) * 16 + (fq & 1) * 8);
                D[ta] = MFMA16((fq < 2) ? ald : zero8, Tf, zero4);
            }
            *(u32x4*)(AFg + (u * 64 + lane) * 32) = (u32x4){pack2(D[0][0], D[0][1]), pack2(D[0][2], D[0][3]), pack2(D[1][0], D[1][1]), pack2(D[1][2], D[1][3])};
            *(u32x4*)(AFg + (u * 64 + lane) * 32 + 16) = (u32x4){pack2(D[2][0], D[2][1]), pack2(D[2][2], D[2][3]), pack2(D[3][0], D[3][1]), pack2(D[3][2], D[3][3])};
            const bf16x8 akld = *(const bf16x8*)(AakT + fr * 24 + (fq & 1) * 8);
            const f32x4 M1 = MFMA16(Tf, (fq < 2) ? akld : zero8, zero4);
#pragma unroll
            for (int r = 0; r < 4; ++r) M1m[(4 * fq + r) * 24 + fr] = f2bf(M1[r]);
        }
        WSYNC();
        {
            const bf16x8 m1ld = *(const bf16x8*)(M1m + fr * 24 + (fq & 1) * 8), rkld = *(const bf16x8*)(Ark + fr * 24 + (fq & 1) * 8);
            const bf16x8 M1f = (fq < 2) ? m1ld : zero8, Arkf = (fq < 2) ? rkld : zero8;
#pragma unroll
            for (int sl = 0; sl < 4; ++sl) {
                const bf16x8 vld = *(const bf16x8*)(VT + (16 * sl + fr) * 16 + (fq & 1) * 8);
                const bf16x8 Vb = (fq < 2) ? vld : zero8;
                const f32x4 Uh = MFMA16(M1f, Vb, zero4), Y0 = MFMA16(Arkf, Vb, zero4);
                *(u32x2*)(CHVg + (((u * 4 + sl) * 3 + 0) * 64 + lane) * 8) = (u32x2){pack2(Uh[0], Uh[1]), pack2(Uh[2], Uh[3])};
                *(u32x2*)(CHVg + (((u * 4 + sl) * 3 + 1) * 64 + lane) * 8) = (u32x2){pack2(Y0[0], Y0[1]), pack2(Y0[2], Y0[3])};
            }
        }
        WSYNC();
    }
}

struct ChunkOps { u32x4 af0, af1, rf0, rf1, bk0, bk1, bk2, bk3; u32x2 arb, uh, y0, vf; f32x4 g0, g1, g2, g3; };
constexpr int RING_SLOT = 17408, RING_NS = 7, RING_D = 6;
__device__ __forceinline__ void lds_chunk_ops(ChunkOps& o, const LAS unsigned char* s, int sl, int lane, int fq) {
    o.af0 = *(const LAS u32x4*)(s + lane * 32); o.af1 = *(const LAS u32x4*)(s + lane * 32 + 16);
    o.rf0 = *(const LAS u32x4*)(s + 2048 + lane * 32); o.rf1 = *(const LAS u32x4*)(s + 2048 + lane * 32 + 16);
    o.bk0 = *(const LAS u32x4*)(s + 4096 + (0 * 64 + lane) * 16); o.bk1 = *(const LAS u32x4*)(s + 4096 + (1 * 64 + lane) * 16);
    o.bk2 = *(const LAS u32x4*)(s + 4096 + (2 * 64 + lane) * 16); o.bk3 = *(const LAS u32x4*)(s + 4096 + (3 * 64 + lane) * 16);
    o.uh = *(const LAS u32x2*)(s + 8192 + ((sl * 3 + 0) * 64 + lane) * 8);
    o.y0 = *(const LAS u32x2*)(s + 8192 + ((sl * 3 + 1) * 64 + lane) * 8);
    o.vf = *(const LAS u32x2*)(s + 8192 + ((sl * 3 + 2) * 64 + lane) * 8);
    o.arb = *(const LAS u32x2*)(s + 16384 + lane * 8);
    o.g0 = *(const LAS f32x4*)(s + 16896 + 16 * fq); o.g1 = *(const LAS f32x4*)(s + 16896 + 64 + 16 * fq);
    o.g2 = *(const LAS f32x4*)(s + 16896 + 128 + 16 * fq); o.g3 = *(const LAS f32x4*)(s + 16896 + 192 + 16 * fq);
}
template <int LW> __device__ __forceinline__ void ring_issue(const Params& p, LAS unsigned char* ring, int bh, int c, int lane) {
    const size_t u = (size_t)bh * 128 + c;
    LAS unsigned char* slot = ring + (c % RING_NS) * RING_SLOT;
    const unsigned char* ws = p.ws; const unsigned char* od = (const unsigned char*)p.out;
#pragma unroll
    for (int j = 0; j < 8; ++j) {
        constexpr int Q0 = LW * 8; const int q = Q0 + j;
        const unsigned char* g;
        if (q < 2) g = ws + CH_AF + u * 2048 + q * 1024 + lane * 16;
        else if (q < 4) g = ws + CH_RF + u * 2048 + (q - 2) * 1024 + lane * 16;
        else if (q < 8) g = ws + CH_BKF + u * 4096 + (q - 4) * 1024 + lane * 16;
        else if (q < 14) g = od + OUT_CHV + u * 6144 + (q - 8) * 1024 + lane * 16;
        else { const int i = (q - 14) * 64 + lane; g = ws + WS_Z + (((size_t)(bh >> 3) * 2048 + c * 16 + (i >> 3)) * DIN + 2688 + (bh & 7) * 64) * 2 + (i & 7) * 16; }
        __builtin_amdgcn_global_load_lds((const unsigned*)g, (LAS unsigned*)(slot + q * 1024), 16, 0, 0);
    }
    if (LW == 0) {
        __builtin_amdgcn_global_load_lds((const unsigned*)(ws + CH_ARB + u * 512 + lane * 4), (LAS unsigned*)(slot + 16384), 4, 0, 0);
        __builtin_amdgcn_global_load_lds((const unsigned*)(ws + CH_ARB + u * 512 + 256 + lane * 4), (LAS unsigned*)(slot + 16384 + 256), 4, 0, 0);
    } else {
        __builtin_amdgcn_global_load_lds((const unsigned*)(ws + CH_G15 + u * 256 + lane * 4), (LAS unsigned*)(slot + 16896), 4, 0, 0);
        __builtin_amdgcn_global_load_lds((const unsigned*)(ws + WS_BONUS + ((size_t)bh * 2048 + c * 16) * 4 + (lane & 15) * 4), (LAS unsigned*)(slot + 17152), 4, 0, 0);
    }
}
template <int CTRL> __device__ __forceinline__ float dpp_add_q(float v) {
    const int t = __builtin_amdgcn_update_dpp(0, __float_as_int(v), CTRL, 0xf, 0xf, false);
    return v + __int_as_float(t);
}
__device__ __forceinline__ float oct_allsum(float v) {
    v = dpp_add_q<0xB1>(v); v = dpp_add_q<0x4E>(v); v = dpp_add_q<0x141>(v);
    return v;
}
struct EpiIn { u32x4 gb; float bon; u16 v[8]; };
__device__ __forceinline__ void epi_load(EpiIn& e, const LAS unsigned char* s, int t, int v0) {
    e.gb = *(const LAS u32x4*)(s + 14336 + t * 128 + v0 * 2);
    e.bon = *(const LAS float*)(s + 17152 + t * 4);
    const LAS unsigned char* vp = s + 8192 + (((v0 >> 4) * 3 + 2) * 64 + (t >> 2) * 16 + (v0 & 15)) * 8 + (t & 3) * 2;
#pragma unroll
    for (int i = 0; i < 8; ++i) e.v[i] = *(const LAS u16*)(vp + 8 * i);
}
template <int LW> __device__ __forceinline__ void p3_loader(const Params& p, LAS unsigned char* ring, int bh, int lane) {
#pragma unroll
    for (int c = 0; c < RING_D; ++c) ring_issue<LW>(p, ring, bh, c, lane);
    asm volatile("s_waitcnt vmcnt(40)" ::: "memory");
    __builtin_amdgcn_s_barrier();
#pragma unroll 1
    for (int c = 0; c < 128; ++c) {
        const int cn = (c + RING_D < 128) ? c + RING_D : 127;
        ring_issue<LW>(p, ring, bh, cn, lane);
        asm volatile("s_waitcnt vmcnt(40)" ::: "memory");
        __builtin_amdgcn_s_barrier();
    }
    asm volatile("s_waitcnt vmcnt(0)" ::: "memory");
}
__device__ void phase3(const Params& p) {
    const int tid = threadIdx.x, lane = tid & 63, wave = __builtin_amdgcn_readfirstlane(tid >> 6), fr = lane & 15, fq = lane >> 4;
    const int bh = blockIdx.x;
    if (bh >= 64) return;
    LAS unsigned char* ring = (LAS unsigned char*)dyn_smem;
    LAS float* ybuf = (LAS float*)(ring + RING_NS * RING_SLOT);
    if (wave >= 6) {
        const int e = (wave - 6) * 64 + lane, t = e >> 3, v0 = (e & 7) * 8, b = bh >> 3, h = bh & 7;
        f32x4 ga0 = *(const f32x4*)(p.gn_gain + h * 64 + v0), ga1 = *(const f32x4*)(p.gn_gain + h * 64 + v0 + 4);
        f32x4 bi0 = *(const f32x4*)(p.gn_bias + h * 64 + v0), bi1 = *(const f32x4*)(p.gn_bias + h * 64 + v0 + 4);
        u16* Y = (u16*)(p.ws + WS_Y);
        EpiIn cur, nxt;
        __builtin_amdgcn_s_barrier();
        epi_load(cur, ring, t, v0);
#pragma unroll 1
        for (int c = 0; c <= 128; ++c) {
            if (c >= 1) {
                const int cc = c - 1;
                { const int cn = (c < 128) ? c : 127; epi_load(nxt, ring + (cn % RING_NS) * RING_SLOT, t, v0); }
                const LAS float* yb = ybuf + (cc & 1) * (16 * 68) + t * 68 + v0;
                const f32x4 y0 = *(const LAS f32x4*)(yb), y1 = *(const LAS f32x4*)(yb + 4);
                float s1 = (y0[0] + y0[1]) + (y0[2] + y0[3]) + (y1[0] + y1[1]) + (y1[2] + y1[3]);
                float s2 = y0[0] * y0[0] + y0[1] * y0[1] + y0[2] * y0[2] + y0[3] * y0[3] + y1[0] * y1[0] + y1[1] * y1[1] + y1[2] * y1[2] + y1[3] * y1[3];
                s1 = oct_allsum(s1); s2 = oct_allsum(s2);
                const float mean = s1 * (1.f / 64.f);
                const float var = fmaxf(s2 * (1.f / 64.f) - mean * mean, 0.f);
                const float rstd = rsq_(var + 64e-5f);
                const float vvf[8] = {bf2f(cur.v[0]), bf2f(cur.v[1]), bf2f(cur.v[2]), bf2f(cur.v[3]), bf2f(cur.v[4]), bf2f(cur.v[5]), bf2f(cur.v[6]), bf2f(cur.v[7])};
                const float gbf[8] = {bflo(cur.gb.x), bfhi(cur.gb.x), bflo(cur.gb.y), bfhi(cur.gb.y), bflo(cur.gb.z), bfhi(cur.gb.z), bflo(cur.gb.w), bfhi(cur.gb.w)};
                float o[8];
#pragma unroll
                for (int i = 0; i < 8; ++i) {
                    const float yv = (i < 4) ? y0[i & 3] : y1[i & 3];
                    const float gn = (i < 4) ? ga0[i & 3] : ga1[i & 3], bs = (i < 4) ? bi0[i & 3] : bi1[i & 3];
                    const float yn = (yv - mean) * rstd * gn + bs;
                    o[i] = (yn + cur.bon * vvf[i]) * gbf[i] * sigmoidf_(gbf[i]);
                }
                *(u32x4*)(Y + ((size_t)b * 2048 + cc * 16 + t) * 1024 + 512 + h * 64 + v0) = (u32x4){pack2(o[0], o[1]), pack2(o[2], o[3]), pack2(o[4], o[5]), pack2(o[6], o[7])};
                cur = nxt;
            }
            if (c < 128) __builtin_amdgcn_s_barrier();
        }
        return;
    }
    if (wave >= 4) { if (wave == 4) p3_loader<0>(p, ring, bh, lane); else p3_loader<1>(p, ring, bh, lane); return; }
    const int sl = wave;
    f32x4 acc0 = (f32x4){0.f, 0.f, 0.f, 0.f}, acc1 = acc0, acc2 = acc0, acc3 = acc0;
    ChunkOps cur, nxt;
    __builtin_amdgcn_s_barrier();
    lds_chunk_ops(cur, ring, sl, lane, fq);
#pragma unroll 2
    for (int c = 0; c < 128; ++c) {
        { const int cn = (c + 1 < 128) ? c + 1 : c; lds_chunk_ops(nxt, ring + (cn % RING_NS) * RING_SLOT, sl, lane, fq); }
        const bf16x8 sb0 = as_bf8((u32x4){pack2(acc0[0], acc0[1]), pack2(acc0[2], acc0[3]), pack2(acc1[0], acc1[1]), pack2(acc1[2], acc1[3])});
        const bf16x8 sb1 = as_bf8((u32x4){pack2(acc2[0], acc2[1]), pack2(acc2[2], acc2[3]), pack2(acc3[0], acc3[1]), pack2(acc3[2], acc3[3])});
        f32x4 U = (f32x4){bflo(cur.uh.x), bfhi(cur.uh.x), bflo(cur.uh.y), bfhi(cur.uh.y)};
        U = MFMA16(as_bf8(cur.af0), sb0, U); U = MFMA16(as_bf8(cur.af1), sb1, U);
        f32x4 Yv = (f32x4){bflo(cur.y0.x), bfhi(cur.y0.x), bflo(cur.y0.y), bfhi(cur.y0.y)};
        Yv = MFMA16(as_bf8(cur.rf0), sb0, Yv); Yv = MFMA16(as_bf8(cur.rf1), sb1, Yv);
        const unsigned u01 = pack2(U[0], U[1]), u23 = pack2(U[2], U[3]);
        Yv = MFMA16(as_bf8((u32x4){cur.arb.x, cur.arb.y, 0u, 0u}), as_bf8((u32x4){u01, u23, 0u, 0u}), Yv);
        const bf16x8 uvb = as_bf8((u32x4){u01, u23, cur.vf.x, cur.vf.y});
        acc0 = MFMA16(as_bf8(cur.bk0), uvb, acc0 * cur.g0); acc1 = MFMA16(as_bf8(cur.bk1), uvb, acc1 * cur.g1);
        acc2 = MFMA16(as_bf8(cur.bk2), uvb, acc2 * cur.g2); acc3 = MFMA16(as_bf8(cur.bk3), uvb, acc3 * cur.g3);
        LAS float* yb = ybuf + (c & 1) * (16 * 68) + (4 * fq) * 68 + sl * 16 + fr;
        yb[0] = Yv[0]; yb[68] = Yv[1]; yb[136] = Yv[2]; yb[204] = Yv[3];
        asm volatile("s_waitcnt lgkmcnt(0)" ::: "memory");
        __builtin_amdgcn_s_barrier();
        asm volatile("" ::: "memory");
        cur = nxt;
    }
}

__device__ void phase5(const Params& p) {
    const int tid = threadIdx.x, lane = tid & 63, wave = tid >> 6, blk = blockIdx.x;
#pragma unroll 1
    for (int r0 = 0; r0 < 8; r0 += 4) {
        f32x4 v[4][4]; float ss[4];
#pragma unroll
        for (int i = 0; i < 4; ++i) {
            const f32x4* xr = (const f32x4*)(p.out + (size_t)(blk * 64 + wave * 8 + r0 + i) * DM);
#pragma unroll
            for (int q = 0; q < 4; ++q) v[i][q] = xr[lane + 64 * q];
        }
#pragma unroll
        for (int i = 0; i < 4; ++i) {
            float s = 0.f;
#pragma unroll
            for (int q = 0; q < 4; ++q) s += v[i][q][0] * v[i][q][0] + v[i][q][1] * v[i][q][1] + v[i][q][2] * v[i][q][2] + v[i][q][3] * v[i][q][3];
            ss[i] = wave_sum(s);
        }
#pragma unroll
        for (int i = 0; i < 4; ++i) {
            f32x4* xr = (f32x4*)(p.out + (size_t)(blk * 64 + wave * 8 + r0 + i) * DM);
            const float inv = rsq_(ss[i] * (1.f / 1024.f) + 1e-6f);
#pragma unroll
            for (int q = 0; q < 4; ++q) { const f32x4 g = ((const f32x4*)p.final_gain)[lane + 64 * q]; xr[lane + 64 * q] = v[i][q] * inv * g; }
        }
    }
}

__global__ void __launch_bounds__(512, 2) hybrid_fwd(Params p) {
    __shared__ uint4 xb_words;
    if (threadIdx.x == 0) xb_words = make_uint4(0u, 0u, 0u, 0u);
    __syncthreads();
    XcdBarrier bar; bar.bar = (unsigned*)(p.ws + WS_CTL); bar.x = 0; bar.st = (volatile LAS unsigned*)&xb_words;
    const int lo = p.ph_lo, hi = p.ph_hi;
    if (hi - lo > 1) bar = xcd_barrier_post((unsigned*)(p.ws + WS_CTL), (volatile LAS unsigned*)&xb_words);
#define IN(k) (lo <= (k) && (k) < hi)
#define SEAM(k) do { if (IN(k) && IN((k) + 1)) xcd_barrier(bar); } while (0)
#define RUN(k, f) do { if (IN(k)) { if (PROBE_DUP == (k)) { for (int _r = 0; _r < p.dup_n; ++_r) { if (_r) __syncthreads(); f(p); } } else f(p); } } while (0)
    RUN(0, phase0);
    SEAM(0);
    RUN(1, phase1);
    SEAM(1);
    RUN(2, phase2);
    SEAM(2);
    RUN(3, phase3);
    SEAM(3);
    RUN(4, phase4);
}

extern "C" void kernel_launch(void* const* d_in, const int* in_sizes, int n_in, void* d_out, int out_size, void* d_ws, size_t ws_size, hipStream_t stream) {
    static int grid = 0;
    if (grid == 0) {
        if (n_in != 17 || out_size != NTOK * DM || ws_size < WS_END) { fprintf(stderr, "kernel_launch: unexpected problem (n_in %d out %d ws %zu need %zu)\n", n_in, out_size, ws_size, (size_t)WS_END); grid = -1; return; }
        if (hipFuncSetAttribute((const void*)hybrid_fwd, hipFuncAttributeMaxDynamicSharedMemorySize, LDS_BYTES) != hipSuccess) { fprintf(stderr, "kernel_launch: hipFuncSetAttribute failed\n"); grid = -1; return; }
        int per_cu = 0;
        if (hipOccupancyMaxActiveBlocksPerMultiprocessor(&per_cu, (const void*)hybrid_fwd, 512, LDS_BYTES) != hipSuccess || per_cu < 1) fprintf(stderr, "kernel_launch: occupancy query says %d blocks per CU\n", per_cu);
        (void)hipGetLastError();
        grid = 256;
    }
    if (grid < 0) return;
    (void)hipMemsetAsync((char*)d_ws + WS_CTL, 0, 16384, stream);
    Params p{};
    p.x = (const float*)d_in[0]; p.norm_gain = (const float*)d_in[1]; p.w_in = (const float*)d_in[2]; p.pool_w = (const float*)d_in[3];
    p.pool_scale = (const float*)d_in[4]; p.shift_mu = (const float*)d_in[5]; p.w0 = (const float*)d_in[6]; p.w_up = (const float*)d_in[7];
    p.a0 = (const float*)d_in[8]; p.a_up = (const float*)d_in[9]; p.k_k = (const float*)d_in[10]; p.k_a = (const float*)d_in[11];
    p.r_k = (const float*)d_in[12]; p.gn_gain = (const float*)d_in[13]; p.gn_bias = (const float*)d_in[14]; p.w_out = (const float*)d_in[15];
    p.final_gain = (const float*)d_in[16];
    p.out = (float*)d_out; p.ws = (unsigned char*)d_ws; p.dup_n = 2;
#if N_LAUNCHES == 1
    p.ph_lo = 0; p.ph_hi = NPH;
    hipLaunchKernelGGL(hybrid_fwd, dim3(grid), dim3(512), LDS_BYTES, stream, p);
#else
    for (int k = 0; k < NPH; ++k) { p.ph_lo = k; p.ph_hi = k + 1; hipLaunchKernelGGL(hybrid_fwd, dim3(grid), dim3(512), LDS_BYTES, stream, p); }
#endif
}
```

```cpp
#include <hip/hip_runtime.h>
#include <stdint.h>
#include <cstdio>

typedef unsigned short u16;
typedef short bf16x8 __attribute__((ext_vector_type(8)));
typedef float f32x4 __attribute__((ext_vector_type(4)));
typedef float f32x2 __attribute__((ext_vector_type(2)));
typedef unsigned u32x2 __attribute__((ext_vector_type(2)));
typedef unsigned u32x4 __attribute__((ext_vector_type(4)));

#ifndef PROBE_DUP
#define PROBE_DUP -1
#endif
#ifndef N_LAUNCHES
#define N_LAUNCHES 1
#endif

constexpr int NTOK = 16384, DM = 1024, SEQ = 2048, DIN = 3200, DINP = 3328;
constexpr int NPH = 5;
constexpr int LDS_BYTES = 18432 + 8 * 17408;

constexpr size_t WS_CTL = 0;
constexpr size_t WS_WINT = 16384;
constexpr size_t WS_WOUTT = WS_WINT + (size_t)DINP * 1024 * 2;
constexpr size_t WS_WUPT = WS_WOUTT + (size_t)1024 * 1024 * 2;
constexpr size_t WS_AUPT = WS_WUPT + 512 * 64 * 2;
constexpr size_t WS_POOLT = WS_AUPT + 512 * 64 * 2;
constexpr size_t WS_Z = WS_POOLT + 4 * 128 * 128 * 2;
constexpr size_t WS_REC = WS_Z + (size_t)NTOK * DIN * 2;
constexpr size_t WS_Y = WS_REC + (size_t)64 * 2048 * 896;
constexpr size_t WS_BONUS = WS_Y + (size_t)NTOK * 1024 * 2;
constexpr size_t WS_PART = WS_BONUS + (size_t)64 * 2048 * 4;
constexpr size_t WS_END = WS_PART + (size_t)64 * 4 * 256 * 4;
constexpr int CTL_CNT_WORD = 3584;
constexpr int NUNIT = 64 * 128;
constexpr size_t CH_AF = WS_REC;
constexpr size_t CH_RF = CH_AF + (size_t)NUNIT * 2048;
constexpr size_t CH_BKF = CH_RF + (size_t)NUNIT * 2048;
constexpr size_t CH_ARB = CH_BKF + (size_t)NUNIT * 4096;
constexpr size_t CH_G15 = CH_ARB + (size_t)NUNIT * 512;
constexpr size_t CH_END = CH_G15 + (size_t)NUNIT * 256;
constexpr size_t WS_VB = CH_END;
static_assert(WS_VB + (size_t)NTOK * 512 * 2 <= WS_Y, "chunk operands + v must fit in the record region");
constexpr size_t OUT_CHV = 0;
constexpr size_t OUT_GB = (size_t)NUNIT * 4 * 3 * 512;
static_assert(OUT_GB + (size_t)NTOK * 512 * 2 <= (size_t)NTOK * DM * 4, "d_out scratch");

struct Params {
    const float* x; const float* norm_gain; const float* w_in; const float* pool_w; const float* pool_scale;
    const float* shift_mu; const float* w0; const float* w_up; const float* a0; const float* a_up;
    const float* k_k; const float* k_a; const float* r_k; const float* gn_gain; const float* gn_bias;
    const float* w_out; const float* final_gain;
    float* out; unsigned char* ws;
    int ph_lo, ph_hi, dup_n, pad;
};

extern __shared__ __attribute__((aligned(16))) unsigned char dyn_smem[];

__device__ __forceinline__ float bf2f(u16 v) { return __uint_as_float(((unsigned)v) << 16); }
__device__ __forceinline__ float bflo(unsigned v) { return __uint_as_float(v << 16); }
__device__ __forceinline__ float bfhi(unsigned v) { return __uint_as_float(v & 0xffff0000u); }
typedef __bf16 bf16x2_t __attribute__((ext_vector_type(2)));
__device__ __forceinline__ unsigned pack2(float lo, float hi) { bf16x2_t v = {(__bf16)lo, (__bf16)hi}; return __builtin_bit_cast(unsigned, v); }
__device__ __forceinline__ u16 f2bf(float f) { return (u16)(pack2(f, 0.f) & 0xffffu); }
__device__ __forceinline__ float wave_sum(float v) {
#pragma unroll
    for (int m = 32; m >= 1; m >>= 1) v += __shfl_xor(v, m, 64);
    return v;
}
__device__ __forceinline__ float rcp_(float v) { return __builtin_amdgcn_rcpf(v); }
__device__ __forceinline__ float rsq_(float v) { return __builtin_amdgcn_rsqf(v); }
__device__ __forceinline__ float sigmoidf_(float v) { return rcp_(1.f + __expf(-v)); }
__device__ __forceinline__ float tanhf_(float v) { return 1.f - 2.f * rcp_(1.f + __expf(2.f * v)); }

#define XB_TMO      128
#define XB_XCNT(j)  (256  + 64 * (j))
#define XB_XSUB(j)  (1280 + 64 * (j))
#define XB_XGEN(j)  (2304 + 64 * (j))
#define XB_TOP      3328
#define XB_TOPGEN   3392
#define XCD_BAR_WORDS 3456
#define XB_SPIN_CAP (1u << 22)
#define LAS __attribute__((address_space(3)))

__device__ __forceinline__ unsigned xb_ld(unsigned* p)              { return __hip_atomic_load(p, __ATOMIC_RELAXED, __HIP_MEMORY_SCOPE_AGENT); }
__device__ __forceinline__ unsigned xb_add(unsigned* p, unsigned v) { return __hip_atomic_fetch_add(p, v, __ATOMIC_RELAXED, __HIP_MEMORY_SCOPE_AGENT); }
__device__ __forceinline__ unsigned xb_xcc_id() { return (unsigned)__builtin_amdgcn_s_getreg((3 << 11) | 20) & 0xFu; }
#define XB_SPIN(cond, bar) do { unsigned _sp = 0; while (cond) { __builtin_amdgcn_s_sleep(8); \
    if ((++_sp & 255u) == 0u) { if (xb_ld(&(bar)[XB_TMO])) break; if (_sp > XB_SPIN_CAP) { atomicAdd(&(bar)[XB_TMO], 1u); break; } } } } while (0)

struct XcdBarrier { unsigned* bar; unsigned x; volatile LAS unsigned* st; };

__device__ __forceinline__ XcdBarrier xcd_barrier_post(unsigned* bar, volatile LAS unsigned* st) {
    XcdBarrier b; b.bar = bar; b.x = xb_xcc_id(); b.st = st;
    if (threadIdx.x == 0) (void)xb_add(&bar[XB_XCNT(b.x)], 1u);
    return b;
}
__device__ __forceinline__ void xcd_barrier_complete(unsigned* bar, unsigned x, unsigned& nloc, unsigned& nx) {
    const unsigned G = gridDim.x * gridDim.y * gridDim.z;
    unsigned sum, cnt, mine, sp = 0u;
    for (;;) {
        sum = 0u; cnt = 0u; mine = 0u;
#pragma unroll
        for (unsigned j = 0; j < 16; ++j) { const unsigned c = xb_ld(&bar[XB_XCNT(j)]); sum += c; cnt += (c > 0u) ? 1u : 0u; mine = (j == x) ? c : mine; }
        if (sum == G) break;
        __builtin_amdgcn_s_sleep(1);
        if ((++sp & 255u) == 0u) { if (xb_ld(&bar[XB_TMO])) break; if (sp > XB_SPIN_CAP) { atomicAdd(&bar[XB_TMO], 1u); break; } }
    }
    nloc = mine > 0u ? mine : 1u; nx = cnt > 0u ? cnt : 1u;
}
__device__ __forceinline__ void xcd_barrier(const XcdBarrier& b) {
    asm volatile("s_waitcnt vmcnt(0)" ::: "memory");
    __syncthreads();
    if (threadIdx.x == 0) {
        unsigned* bar = b.bar;
        __builtin_amdgcn_s_waitcnt(0);
        unsigned nloc = b.st[0], nx = b.st[1];
        if (nloc == 0u) { xcd_barrier_complete(bar, b.x, nloc, nx); b.st[0] = nloc; b.st[1] = nx; }
        const unsigned old = xb_add(&bar[XB_XSUB(b.x)], 1u);
        const unsigned gen = old / nloc;
        if (old + 1u == (gen + 1u) * nloc) {
            __builtin_amdgcn_fence(__ATOMIC_RELEASE, "agent");
            asm volatile("s_waitcnt vmcnt(0)" ::: "memory");
            const unsigned og = xb_add(&bar[XB_TOP], 1u);
            const unsigned tg = og / nx;
            if (og + 1u == (tg + 1u) * nx) xb_add(&bar[XB_TOPGEN], 1u);
            else XB_SPIN(xb_ld(&bar[XB_TOPGEN]) == tg, bar);
            __builtin_amdgcn_fence(__ATOMIC_ACQUIRE, "agent");
            xb_add(&bar[XB_XGEN(b.x)], 1u);
            asm volatile("s_waitcnt vmcnt(0)" ::: "memory");
        } else {
            XB_SPIN(xb_ld(&bar[XB_XGEN(b.x)]) == gen, bar);
            __builtin_amdgcn_fence(__ATOMIC_ACQUIRE, "agent");
            asm volatile("s_waitcnt vmcnt(0)" ::: "memory");
        }
    }
    __syncthreads();
}

constexpr int BM = 256, BK = 64, HALF = 128, HTB = HALF * BK * 2, STAGE_BYTES = 8 * HTB, NXCD = 8, WGM = 8;
__device__ __forceinline__ int lds_byte(int r, int c) { const int st = (r >> 4) * 2 + (c >> 5), rr = r & 15, cc = c & 31, ob = rr * 64 + cc * 2; return st * 1024 + (ob ^ (((ob >> 9) & 1) << 5)); }
__device__ __forceinline__ void stage_rc(int b, int& R, int& C) { const int st = b / 1024, sb = b % 1024, swz = sb ^ (((sb >> 9) & 1) << 5); R = (st >> 1) * 16 + swz / 64; C = (st & 1) * 32 + (swz % 64) / 2; }
__device__ __forceinline__ int perm32(int rho) { const int n = rho >> 4, i = rho & 15; return 8 * (i >> 2) + 4 * n + (i & 3); }

struct Unit { int pm, pn; };
struct Gemm { const u16* A; const u16* Bt; int M, N, K, Nvalid; };
struct StaticOrder {
    int nM, nN, nwg, G, c;
    __device__ void init(int M, int N, int G_, int c_) { nM = M / BM; nN = N / BM; nwg = nM * nN; G = G_; c = c_; }
    __device__ bool next(int i, Unit& u) const {
        const long L = (long)i * G + c; if (L >= nwg) return false;
        int wgid = (int)L; { const int q = nwg / NXCD, r = nwg % NXCD, xcd = wgid % NXCD, off = wgid / NXCD; wgid = (xcd < r ? xcd * (q + 1) : r * (q + 1) + (xcd - r) * q) + off; }
        const int nig = WGM * nN, gid = wgid / nig, fm = gid * WGM, gsz = (nM - fm) < WGM ? (nM - fm) : WGM;
        u.pm = fm + ((wgid % nig) % gsz); u.pn = (wgid % nig) / gsz; return true;
    }
};
struct EpiZ {
    static constexpr bool PERM = true, AFTER_DRAIN = false;
    u16* Z;
    __device__ __forceinline__ void operator()(const f32x4 (&acc)[2][2][4][2], const Unit& u, int wr, int wc, int fr, int fq) const {
        const int row0 = u.pm * BM + wr * 64 + fr, col0 = u.pn * BM + wc * 32 + 8 * fq;
#pragma unroll
        for (int ai = 0; ai < 2; ++ai)
#pragma unroll
            for (int m = 0; m < 4; ++m) { u16* rowp = Z + (size_t)(row0 + ai * HALF + m * 16) * DIN;
#pragma unroll
                for (int bj = 0; bj < 2; ++bj) { const int col = col0 + bj * HALF; const f32x4 v0 = acc[ai][bj][m][0], v1 = acc[ai][bj][m][1];
                    if (col < DIN) *(u32x4*)(rowp + col) = (u32x4){pack2(v0[0], v0[1]), pack2(v0[2], v0[3]), pack2(v1[0], v1[1]), pack2(v1[2], v1[3])}; } }
    }
};
struct EpiRes {
    static constexpr bool PERM = false, AFTER_DRAIN = false;
    const float* x; float* out;
    __device__ __forceinline__ void operator()(const f32x4 (&acc)[2][2][4][2], const Unit& u, int wr, int wc, int fr, int fq) const {
        const int row0 = u.pm * BM + wr * 64 + fr, col0 = u.pn * BM + wc * 32 + 4 * fq;
#pragma unroll
        for (int ai = 0; ai < 2; ++ai)
#pragma unroll
            for (int m = 0; m < 4; ++m) { const size_t ro = (size_t)(row0 + ai * HALF + m * 16) * DM + col0;
#pragma unroll
                for (int bj = 0; bj < 2; ++bj)
#pragma unroll
                    for (int n = 0; n < 2; ++n) { const f32x4 xv = *(const f32x4*)(x + ro + bj * HALF + n * 16); *(f32x4*)(out + ro + bj * HALF + n * 16) = xv + acc[ai][bj][m][n]; } }
    }
};
struct EpiResNorm {
    static constexpr bool PERM = false, AFTER_DRAIN = true;
    const float* x; const float* gain; float* out; float* part; unsigned* cnt;
    __device__ __forceinline__ void fused(f32x4 (&acc)[2][2][4][2], const Unit& u, int wr, int wc, int fr, int fq, LAS unsigned char* lds) const {
        const int row0 = u.pm * BM + wr * 64 + fr, col0 = u.pn * BM + wc * 32 + 4 * fq;
        LAS float* red = (LAS float*)lds;
        LAS float* tot = red + 1024;
        float rs[2][4];
#pragma unroll
        for (int ai = 0; ai < 2; ++ai)
#pragma unroll
            for (int m = 0; m < 4; ++m) { const size_t ro = (size_t)(row0 + ai * HALF + m * 16) * DM + col0; float s = 0.f;
#pragma unroll
                for (int bj = 0; bj < 2; ++bj)
#pragma unroll
                    for (int n = 0; n < 2; ++n) { const f32x4 v = __builtin_nontemporal_load((const f32x4*)(x + ro + bj * HALF + n * 16)) + acc[ai][bj][m][n]; acc[ai][bj][m][n] = v; s += v[0] * v[0] + v[1] * v[1] + v[2] * v[2] + v[3] * v[3]; }
                s += __shfl_xor(s, 16, 64); s += __shfl_xor(s, 32, 64);
                rs[ai][m] = s; }
        if (fq == 0) {
#pragma unroll
            for (int ai = 0; ai < 2; ++ai)
#pragma unroll
                for (int m = 0; m < 4; ++m) red[((wr * 4 + wc) * 8 + ai * 4 + m) * 16 + fr] = rs[ai][m];
        }
        __syncthreads();
        if (threadIdx.x < 256) {
            const int rl = threadIdx.x, ai = rl >> 7, wr_ = (rl >> 6) & 1, m = (rl >> 4) & 3, fr_ = rl & 15;
            const int o = ((wr_ * 4) * 8 + ai * 4 + m) * 16 + fr_;
            const float s = red[o] + red[o + 128] + red[o + 256] + red[o + 384];
            __hip_atomic_store(part + ((size_t)u.pm * 4 + u.pn) * 256 + rl, s, __ATOMIC_RELAXED, __HIP_MEMORY_SCOPE_AGENT);
        }
        asm volatile("s_waitcnt vmcnt(0)" ::: "memory");
        __syncthreads();
        if (threadIdx.x == 0) {
            __builtin_amdgcn_fence(__ATOMIC_RELEASE, "agent");
            asm volatile("s_waitcnt vmcnt(0)" ::: "memory");
            __hip_atomic_fetch_add(cnt + u.pm, 1u, __ATOMIC_RELAXED, __HIP_MEMORY_SCOPE_AGENT);
            unsigned sp = 0;
            while (__hip_atomic_load(cnt + u.pm, __ATOMIC_RELAXED, __HIP_MEMORY_SCOPE_AGENT) < 4u) { __builtin_amdgcn_s_sleep(1); if (++sp > (1u << 24)) break; }
            __builtin_amdgcn_fence(__ATOMIC_ACQUIRE, "agent");
            asm volatile("s_waitcnt vmcnt(0)" ::: "memory");
        }
        __syncthreads();
        for (int e = threadIdx.x; e < 1024; e += 512) tot[e] = __hip_atomic_load(part + (size_t)u.pm * 1024 + e, __ATOMIC_RELAXED, __HIP_MEMORY_SCOPE_AGENT);
        __syncthreads();
#pragma unroll
        for (int ai = 0; ai < 2; ++ai)
#pragma unroll
            for (int m = 0; m < 4; ++m) { const int rl = ai * 128 + wr * 64 + m * 16 + fr;
                const float inv = rsq_((tot[rl] + tot[256 + rl] + tot[512 + rl] + tot[768 + rl]) * (1.f / 1024.f) + 1e-6f);
                const size_t ro = (size_t)(row0 + ai * HALF + m * 16) * DM + col0;
#pragma unroll
                for (int bj = 0; bj < 2; ++bj)
#pragma unroll
                    for (int n = 0; n < 2; ++n) { const f32x4 g = *(const f32x4*)(gain + col0 + bj * HALF + n * 16); __builtin_nontemporal_store(acc[ai][bj][m][n] * inv * g, (f32x4*)(out + ro + bj * HALF + n * 16)); } }
    }
};

template <class Epi, class Sched>
__device__ __forceinline__ void gemm_phase(LAS unsigned char* lds, const Gemm g, const Sched& S, const Epi& E) {
    const int tid = threadIdx.x, wid = __builtin_amdgcn_readfirstlane(tid >> 6), lane = tid & 63, wr = wid >> 2, wc = wid & 3, fr = lane & 15, fq = lane >> 4;
    const int K = g.K, nt = K / BK;
    unsigned voffA[2], voffB[2];
#pragma unroll
    for (int i = 0; i < 2; ++i) { int R, C; stage_rc(tid * 16 + i * 8192, R, C); const int Rb = Epi::PERM ? ((R & ~31) + perm32(R & 31)) : R;
        voffA[i] = (unsigned)(R * K + C) * 2u; voffB[i] = (unsigned)(Rb * K + C) * 2u; }
    const size_t kstep = (size_t)(BK * 2);
    const size_t hstep = (size_t)HALF * K * 2;
    const size_t tstep = 2 * hstep;
    const unsigned ldsw = (unsigned)wid * 1024u;
    const int aoff = lds_byte(wr * 64 + fr, fq * 8), boff = lds_byte(wc * 32 + fr, fq * 8);
#define PG8_SA(b, h) (((b) * 2 + (h)) * HTB)
#define PG8_SB(b, h) ((4 + (b) * 2 + (h)) * HTB)
#define PG8_STAGE(bufoff, gbase, voff) do { _Pragma("unroll") for (int _i = 0; _i < 2; ++_i) \
        __builtin_amdgcn_global_load_lds((const unsigned*)((const char*)(gbase) + (voff)[_i]), (LAS unsigned*)(lds + (bufoff) + ldsw + _i * 8192), 16, 0, 0); } while (0)
#define PG8_LDA(dst, b, h) do { _Pragma("unroll") for (int m = 0; m < 4; ++m) _Pragma("unroll") for (int k = 0; k < 2; ++k) dst[m][k] = *(const LAS bf16x8*)(lds + PG8_SA(b, h) + aoff + m * 2048 + k * 1024); } while (0)
#define PG8_LDB(dst, b, h) do { _Pragma("unroll") for (int n = 0; n < 2; ++n) _Pragma("unroll") for (int k = 0; k < 2; ++k) dst[n][k] = *(const LAS bf16x8*)(lds + PG8_SB(b, h) + boff + n * 2048 + k * 1024); } while (0)
#define PG8_MMA(ai, bj, At, Bt) do { __builtin_amdgcn_s_setprio(1); _Pragma("unroll") for (int m = 0; m < 4; ++m) _Pragma("unroll") for (int n = 0; n < 2; ++n) _Pragma("unroll") for (int k = 0; k < 2; ++k) \
        acc[ai][bj][m][n] = __builtin_amdgcn_mfma_f32_16x16x32_bf16(Bt[n][k], At[m][k], acc[ai][bj][m][n], 0, 0, 0); __builtin_amdgcn_s_setprio(0); } while (0)
#define PG8_WAIT_V(n) asm volatile("s_waitcnt vmcnt(" #n ")" ::: "memory")
#define PG8_WAIT_L(n) asm volatile("s_waitcnt lgkmcnt(" #n ")" ::: "memory")
#define PG8_BAR __builtin_amdgcn_s_barrier()
#define PG8_SCHED __builtin_amdgcn_sched_barrier(0)
    Unit cur, nxt; int ui = 0;
    if (!S.next(0, cur)) return;
    f32x4 acc[2][2][4][2];
#pragma unroll
    for (int a = 0; a < 2; ++a)
#pragma unroll
        for (int b = 0; b < 2; ++b)
#pragma unroll
            for (int m = 0; m < 4; ++m)
#pragma unroll
                for (int n = 0; n < 2; ++n) acc[a][b][m][n] = (f32x4){0.f, 0.f, 0.f, 0.f};
    bf16x8 At[4][2], B0[2][2], B1[2][2];
    const char* cA = (const char*)g.A + (size_t)cur.pm * tstep; const char* cB = (const char*)g.Bt + (size_t)cur.pn * tstep;
    PG8_STAGE(PG8_SB(0, 0), cB, voffB); PG8_STAGE(PG8_SA(0, 0), cA, voffA); PG8_STAGE(PG8_SB(0, 1), cB + hstep, voffB); PG8_STAGE(PG8_SA(0, 1), cA + hstep, voffA);
    if (wr == 1) PG8_BAR;
    PG8_WAIT_V(4); PG8_BAR;
    PG8_STAGE(PG8_SB(1, 0), cB + kstep, voffB); PG8_STAGE(PG8_SA(1, 0), cA + kstep, voffA); PG8_STAGE(PG8_SB(1, 1), cB + hstep + kstep, voffB);
    PG8_WAIT_V(6); PG8_BAR;
    for (;;) {
        const bool has_next = S.next(ui + 1, nxt);
        const char* nA = has_next ? (const char*)g.A + (size_t)nxt.pm * tstep : cA; const char* nB = has_next ? (const char*)g.Bt + (size_t)nxt.pn * tstep : cB;
        const bool rhalf = (cur.pn * BM + HALF) < g.Nvalid;
        for (int t = 0; t < nt; t += 2) {
            const bool last = (t == nt - 2);
            const char* a1 = cA + (size_t)(t + 1) * kstep;
            const char* a2 = last ? nA : cA + (size_t)(t + 2) * kstep; const char* b2 = last ? nB : cB + (size_t)(t + 2) * kstep;
            const char* a3 = a2 + kstep; const char* b3 = b2 + kstep;
            PG8_LDB(B0, 0, 0); PG8_SCHED; PG8_LDA(At, 0, 0); PG8_STAGE(PG8_SA(1, 1), a1 + hstep, voffA);
            PG8_WAIT_L(8); PG8_BAR; PG8_WAIT_L(0); PG8_MMA(0, 0, At, B0); PG8_BAR; PG8_SCHED;
            PG8_LDB(B1, 0, 1); PG8_STAGE(PG8_SB(0, 0), b2, voffB);
            PG8_BAR; PG8_WAIT_L(0); if (rhalf) PG8_MMA(0, 1, At, B1); PG8_BAR;
            PG8_LDA(At, 0, 1); PG8_STAGE(PG8_SA(0, 0), a2, voffA);
            PG8_BAR; PG8_WAIT_L(0); PG8_MMA(1, 0, At, B0); PG8_BAR; PG8_SCHED;
            PG8_STAGE(PG8_SB(0, 1), b2 + hstep, voffB);
            PG8_WAIT_V(6); PG8_BAR; if (rhalf) PG8_MMA(1, 1, At, B1); PG8_BAR;
            PG8_LDB(B0, 1, 0); PG8_SCHED; PG8_LDA(At, 1, 0); PG8_STAGE(PG8_SA(0, 1), a2 + hstep, voffA);
            PG8_WAIT_L(8); PG8_BAR; PG8_WAIT_L(0); PG8_MMA(0, 0, At, B0); PG8_BAR; PG8_SCHED;
            PG8_LDB(B1, 1, 1); PG8_STAGE(PG8_SB(1, 0), b3, voffB);
            PG8_BAR; PG8_WAIT_L(0); if (rhalf) PG8_MMA(0, 1, At, B1); PG8_BAR;
            PG8_LDA(At, 1, 1); PG8_STAGE(PG8_SA(1, 0), a3, voffA);
            PG8_BAR; PG8_WAIT_L(0); PG8_MMA(1, 0, At, B0); PG8_BAR; PG8_SCHED;
            PG8_STAGE(PG8_SB(1, 1), b3 + hstep, voffB);
            PG8_WAIT_V(6); PG8_BAR; if (rhalf) PG8_MMA(1, 1, At, B1); PG8_BAR;
        }
        if constexpr (!Epi::AFTER_DRAIN) E(acc, cur, wr, wc, fr, fq);
        if (!has_next) break;
#pragma unroll
        for (int a = 0; a < 2; ++a)
#pragma unroll
            for (int b = 0; b < 2; ++b)
#pragma unroll
                for (int m = 0; m < 4; ++m)
#pragma unroll
                    for (int n = 0; n < 2; ++n) acc[a][b][m][n] = (f32x4){0.f, 0.f, 0.f, 0.f};
        cur = nxt; cA = nA; cB = nB; ++ui;
    }
    PG8_WAIT_V(0);
    if (wr == 0) PG8_BAR;
    PG8_BAR;
    if constexpr (Epi::AFTER_DRAIN) E.fused(acc, cur, wr, wc, fr, fq, lds);
#undef PG8_SA
#undef PG8_SB
#undef PG8_STAGE
#undef PG8_LDA
#undef PG8_LDB
#undef PG8_MMA
#undef PG8_WAIT_V
#undef PG8_WAIT_L
#undef PG8_BAR
#undef PG8_SCHED
}

#define WSYNC() do { __builtin_amdgcn_wave_barrier(); asm volatile("s_waitcnt lgkmcnt(0)" ::: "memory"); __builtin_amdgcn_wave_barrier(); } while (0)
__device__ void phase0(const Params& p) {
    const int tid = threadIdx.x, lane = tid & 63, wave = tid >> 6, blk = blockIdx.x;
    u16* Hbf = (u16*)p.out;
#pragma unroll 1
    for (int r0 = 0; r0 < 8; r0 += 4) {
        f32x4 v[4][4]; float ss[4];
#pragma unroll
        for (int i = 0; i < 4; ++i) {
            const f32x4* xr = (const f32x4*)(p.x + (size_t)(blk * 64 + wave * 8 + r0 + i) * DM);
#pragma unroll
            for (int q = 0; q < 4; ++q) v[i][q] = __builtin_nontemporal_load(xr + lane + 64 * q);
        }
#pragma unroll
        for (int i = 0; i < 4; ++i) {
            float s = 0.f;
#pragma unroll
            for (int q = 0; q < 4; ++q) s += v[i][q][0] * v[i][q][0] + v[i][q][1] * v[i][q][1] + v[i][q][2] * v[i][q][2] + v[i][q][3] * v[i][q][3];
            ss[i] = wave_sum(s);
        }
#pragma unroll
        for (int i = 0; i < 4; ++i) {
            const int row = blk * 64 + wave * 8 + r0 + i;
            const float inv = rsq_(ss[i] * (1.f / 1024.f) + 1e-6f);
#pragma unroll
            for (int q = 0; q < 4; ++q) {
                const f32x4 g = ((const f32x4*)p.norm_gain)[lane + 64 * q];
                u32x2 o; o.x = pack2(v[i][q][0] * inv * g[0], v[i][q][1] * inv * g[1]); o.y = pack2(v[i][q][2] * inv * g[2], v[i][q][3] * inv * g[3]);
                *(u32x2*)(Hbf + (size_t)row * DM + (lane + 64 * q) * 4) = o;
            }
        }
    }
    u16* WinT = (u16*)(p.ws + WS_WINT); u16* WoutT = (u16*)(p.ws + WS_WOUTT);
    {
        float* tl = (float*)dyn_smem + wave * (64 * 65);
        const int t = blk + 256 * wave;
        if (t < 832 + 256) {
            const float* src; u16* dst; int kt, ntile, N;
            if (t < 832) { kt = t & 15; ntile = t >> 4; src = p.w_in; N = DIN; dst = WinT; }
            else { const int t2 = t - 832; kt = t2 & 15; ntile = t2 >> 4; src = p.w_out; N = 1024; dst = WoutT; }
            const int k0 = kt * 64, n0 = ntile * 64, n4 = (lane & 15) * 4;
            f32x4 v[16];
#pragma unroll
            for (int i = 0; i < 16; ++i) { const int kk = (lane >> 4) + 4 * i; v[i] = (n0 + n4 < N) ? *(const f32x4*)(src + (size_t)(k0 + kk) * N + n0 + n4) : (f32x4){0.f, 0.f, 0.f, 0.f}; }
#pragma unroll
            for (int i = 0; i < 16; ++i) { const int kk = (lane >> 4) + 4 * i; float* d = tl + kk * 65 + n4; d[0] = v[i][0]; d[1] = v[i][1]; d[2] = v[i][2]; d[3] = v[i][3]; }
            WSYNC();
            const int kp = lane & 31, nh = lane >> 5;
#pragma unroll 8
            for (int i = 0; i < 32; ++i) { const int nn = 2 * i + nh;
                *(unsigned*)(dst + (size_t)(n0 + nn) * 1024 + k0 + 2 * kp) = pack2(tl[(2 * kp) * 65 + nn], tl[(2 * kp + 1) * 65 + nn]); }
        }
    }
    u16* WupT = (u16*)(p.ws + WS_WUPT); u16* AupT = (u16*)(p.ws + WS_AUPT); u16* PoolT = (u16*)(p.ws + WS_POOLT);
    const int gt = blk * 512 + tid;
    if (gt < 32768) { const int c = gt >> 6, j = gt & 63; WupT[gt] = f2bf(p.w_up[j * 512 + c]); AupT[gt] = f2bf(p.a_up[j * 512 + c]); }
    if (gt < 65536) { const int g = gt >> 14, d = (gt >> 7) & 127, c = gt & 127; PoolT[gt] = f2bf(p.pool_w[(g * 128 + c) * 128 + d]); }
}

__device__ void phase1(const Params& p) {
    Gemm g; g.A = (const u16*)p.out; g.Bt = (const u16*)(p.ws + WS_WINT); g.M = NTOK; g.N = DINP; g.K = 1024; g.Nvalid = DIN;
    StaticOrder S; S.init(NTOK, DINP, 256, blockIdx.x);
    EpiZ E; E.Z = (u16*)(p.ws + WS_Z);
    gemm_phase((LAS unsigned char*)dyn_smem, g, S, E);
}
__device__ void phase4(const Params& p) {
    Gemm g; g.A = (const u16*)(p.ws + WS_Y); g.Bt = (const u16*)(p.ws + WS_WOUTT); g.M = NTOK; g.N = 1024; g.K = 1024; g.Nvalid = 1024;
    StaticOrder S; S.init(NTOK, 1024, 256, blockIdx.x);
    EpiResNorm E; E.x = p.x; E.gain = p.final_gain; E.out = p.out; E.part = (float*)(p.ws + WS_PART); E.cnt = (unsigned*)(p.ws + WS_CTL) + CTL_CNT_WORD;
    gemm_phase((LAS unsigned char*)dyn_smem, g, S, E);
}

template <int CTRL> __device__ __forceinline__ float dpp_add(float v) {
    const int t = __builtin_amdgcn_update_dpp(0, __float_as_int(v), CTRL, 0xf, 0xf, false);
    return v + __int_as_float(t);
}
__device__ __forceinline__ float row16_allsum(float v) {
    v = dpp_add<0x128>(v); v = dpp_add<0x124>(v); v = dpp_add<0x122>(v); v = dpp_add<0x121>(v);
    return v;
}
#define MFMA16(a, b, c) __builtin_amdgcn_mfma_f32_16x16x32_bf16((a), (b), (c), 0, 0, 0)
__device__ __forceinline__ bf16x8 as_bf8(u32x4 v) { return __builtin_bit_cast(bf16x8, v); }
template <int W> __device__ __forceinline__ void pooled_run(const u16* __restrict__ Z, u16* pooled, int t0, int s0, int cp, int hf) {
    const int c0 = 2 * cp, tb = hf * 32;
    unsigned raw[W - 1 + 32];
#pragma unroll
    for (int i = 0; i < W - 1 + 32; ++i) { const int tt = tb - (W - 1) + i; raw[i] = (s0 + tt >= 0) ? *(const unsigned*)(Z + (size_t)(t0 + tt) * DIN + c0) : 0u; }
    float sum0 = 0.f, sum1 = 0.f;
#pragma unroll
    for (int i = 0; i < W - 1; ++i) { sum0 += bflo(raw[i]); sum1 += bfhi(raw[i]); }
#pragma unroll
    for (int j = 0; j < 32; ++j) {
        const int tt = tb + j, s = s0 + tt;
        const float u0 = bflo(raw[W - 1 + j]), u1 = bfhi(raw[W - 1 + j]);
        sum0 += u0; sum1 += u1;
        const float rc = rcp_((float)((s + 1 < W) ? (s + 1) : W));
        *(unsigned*)(pooled + tt * 520 + c0) = pack2(sum0 * rc - u0, sum1 * rc - u1);
        sum0 -= bflo(raw[j]); sum1 -= bfhi(raw[j]);
    }
}
constexpr int RST = 912;
__device__ __forceinline__ void p2_zload(u32x4 (&zq)[7], const u16* __restrict__ Z, size_t T0, bool has_halo, int h, int lane) {
#pragma unroll
    for (int q = 0; q < 7; ++q) {
        const int pidx = lane + 64 * q, rr = pidx / 24, w = pidx - rr * 24, a = w >> 3, pc = w & 7;
        u32x4 v = (u32x4){0u, 0u, 0u, 0u};
        if (pidx < 17 * 24) {
            if (rr < 16) v = *(const u32x4*)(Z + (T0 + rr) * DIN + 1024 + a * 512 + h * 64 + pc * 8);
            else if (has_halo) v = *(const u32x4*)(Z + (T0 - 1) * DIN + 1024 + a * 512 + h * 64 + pc * 8);
        }
        zq[q] = v;
    }
}
constexpr int P2_WREG = 17408;
__device__ void phase2(const Params& p) {
    const int tid = threadIdx.x, lane = tid & 63, wave = tid >> 6, blk = blockIdx.x, fr = lane & 15, fq = lane >> 4;
    const int t0 = blk * 64, b = t0 >> 11, s0 = t0 & 2047;
    const u16* Z = (const u16*)(p.ws + WS_Z);
    u16* twb = (u16*)dyn_smem;
    u16* alb = twb + 64 * 72;
    u16* pooled = alb + 64 * 72;
    for (int e = tid; e < 64 * 128; e += 512) {
        const int tt = e >> 7, j = e & 127;
        const size_t zi = (size_t)(t0 + tt) * DIN + 2560 + j;
        const float cur = bf2f(Z[zi]);
        const float prev = (s0 + tt > 0) ? bf2f(Z[zi - DIN]) : 0.f;
        const float val = cur + p.shift_mu[1536 + j] * (prev - cur);
        if (j < 64) twb[tt * 72 + j] = f2bf(tanhf_(val)); else alb[tt * 72 + (j - 64)] = f2bf(val);
    }
    {
        const int cp = tid & 255, hf = tid >> 8;
        switch (wave & 3) {
            case 0: pooled_run<2>(Z, pooled, t0, s0, cp, hf); break;
            case 1: pooled_run<4>(Z, pooled, t0, s0, cp, hf); break;
            case 2: pooled_run<8>(Z, pooled, t0, s0, cp, hf); break;
            default: pooled_run<16>(Z, pooled, t0, s0, cp, hf); break;
        }
    }
    __syncthreads();
    {
        const int g = wave >> 1, dbase = (wave & 1) * 64, ch0 = g * 128 + dbase;
        const u16* PoolT = (const u16*)(p.ws + WS_POOLT); u16* Y = (u16*)(p.ws + WS_Y);
        unsigned char* gt = dyn_smem + 84992 + wave * 8704;
        u32x4 gq[8];
#pragma unroll
        for (int q = 0; q < 8; ++q) { const int idx = lane + 64 * q, row = idx >> 3, pc = idx & 7; gq[q] = *(const u32x4*)(Z + (size_t)(t0 + row) * DIN + 512 + ch0 + pc * 8); }
        f32x4 acc[4][4];
#pragma unroll
        for (int mt = 0; mt < 4; ++mt)
#pragma unroll
            for (int nt = 0; nt < 4; ++nt) acc[mt][nt] = (f32x4){0.f, 0.f, 0.f, 0.f};
#pragma unroll
        for (int ks = 0; ks < 4; ++ks) {
            bf16x8 Bf[4];
#pragma unroll
            for (int nt = 0; nt < 4; ++nt) Bf[nt] = *(const bf16x8*)(PoolT + (size_t)(ch0 + nt * 16 + fr) * 128 + ks * 32 + fq * 8);
#pragma unroll
            for (int mt = 0; mt < 4; ++mt) {
                const bf16x8 Af = *(const bf16x8*)(pooled + (mt * 16 + fr) * 520 + g * 128 + ks * 32 + fq * 8);
#pragma unroll
                for (int nt = 0; nt < 4; ++nt) acc[mt][nt] = MFMA16(Bf[nt], Af, acc[mt][nt]);
            }
        }
#pragma unroll
        for (int q = 0; q < 8; ++q) { const int idx = lane + 64 * q, row = idx >> 3, pc = idx & 7;
            *(u32x2*)(gt + row * 136 + pc * 16) = (u32x2){gq[q].x, gq[q].y}; *(u32x2*)(gt + row * 136 + pc * 16 + 8) = (u32x2){gq[q].z, gq[q].w}; }
        WSYNC();
#pragma unroll
        for (int mt = 0; mt < 4; ++mt) {
#pragma unroll
            for (int nt = 0; nt < 4; ++nt) {
                const int cl = nt * 16 + fq * 4;
                u32x2* slot = (u32x2*)(gt + (mt * 16 + fr) * 136 + cl * 2);
                const u32x2 ga = *slot;
                const f32x4 ps = *(const f32x4*)(p.pool_scale + ch0 + cl);
                const f32x4 gv = (f32x4){bflo(ga.x), bfhi(ga.x), bflo(ga.y), bfhi(ga.y)};
                f32x4 y;
#pragma unroll
                for (int jj = 0; jj < 4; ++jj) y[jj] = acc[mt][nt][jj] * ps[jj] * gv[jj] * sigmoidf_(gv[jj]);
                *slot = (u32x2){pack2(y[0], y[1]), pack2(y[2], y[3])};
            }
        }
        WSYNC();
#pragma unroll
        for (int q = 0; q < 8; ++q) { const int idx = lane + 64 * q, row = idx >> 3, pc = idx & 7;
            const u32x2 a = *(const u32x2*)(gt + row * 136 + pc * 16), b2 = *(const u32x2*)(gt + row * 136 + pc * 16 + 8);
            *(u32x4*)(Y + (size_t)(t0 + row) * 1024 + ch0 + pc * 8) = (u32x4){a.x, a.y, b2.x, b2.y}; }
    }
    __syncthreads();
    const int h = wave, bh = b * 8 + h;
    unsigned char* WL = dyn_smem + 18432 + wave * P2_WREG;
    unsigned char* recl = WL;
    u16* AR = (u16*)WL;
    u16* BK = AR + 32 * 72;
    u16* AtT = BK + 32 * 72;
    u16* BhT = AtT + 64 * 16;
    u16* KhT = BhT + 64 * 16;
    u16* VT = KhT + 64 * 16;
    float* Pab = (float*)WL;
    u16* Tm = (u16*)(Pab + 16 * 17);
    u16* AakT = Tm + 16 * 24;
    u16* M1m = AakT + 16 * 24;
    u16* Ark = M1m + 16 * 24;
    u16* Arb = Ark + 16 * 24;
    const u16* WupT = (const u16*)(p.ws + WS_WUPT); const u16* AupT = (const u16*)(p.ws + WS_AUPT);
    float* BON = (float*)(p.ws + WS_BONUS); u16* VB = (u16*)(p.ws + WS_VB);
    unsigned char* AFg = p.ws + CH_AF; unsigned char* RFg = p.ws + CH_RF; unsigned char* BKFg = p.ws + CH_BKF; unsigned char* ARBg = p.ws + CH_ARB;
    float* G15g = (float*)(p.ws + CH_G15); unsigned char* CHVg = (unsigned char*)p.out + OUT_CHV;
    const bf16x8 zero8 = (bf16x8){0, 0, 0, 0, 0, 0, 0, 0};
    const f32x4 zero4 = (f32x4){0.f, 0.f, 0.f, 0.f};
    bf16x8 BwF[2][4];
#pragma unroll
    for (int ks = 0; ks < 2; ++ks)
#pragma unroll
        for (int nt = 0; nt < 4; ++nt) BwF[ks][nt] = *(const bf16x8*)(WupT + (h * 64 + nt * 16 + fr) * 64 + ks * 32 + fq * 8);
#pragma unroll 1
    for (int mt = 0; mt < 4; ++mt) {
        const size_t u = (size_t)bh * 128 + (s0 >> 4) + mt;
        {
            u32x4 zq[7];
            p2_zload(zq, Z, (size_t)(t0 + mt * 16), (s0 + mt * 16) > 0, h, lane);
            f32x4 aw[4], aa[4];
#pragma unroll
            for (int nt = 0; nt < 4; ++nt) { aw[nt] = zero4; aa[nt] = zero4; }
#pragma unroll
            for (int ks = 0; ks < 2; ++ks) {
                const bf16x8 Aw = *(const bf16x8*)(twb + (mt * 16 + fr) * 72 + ks * 32 + fq * 8);
                const bf16x8 Aa = *(const bf16x8*)(alb + (mt * 16 + fr) * 72 + ks * 32 + fq * 8);
#pragma unroll
                for (int nt = 0; nt < 4; ++nt) {
                    const bf16x8 Ba = *(const bf16x8*)(AupT + (h * 64 + nt * 16 + fr) * 64 + ks * 32 + fq * 8);
                    aw[nt] = MFMA16(BwF[ks][nt], Aw, aw[nt]);
                    aa[nt] = MFMA16(Ba, Aa, aa[nt]);
                }
            }
#pragma unroll
            for (int q = 0; q < 7; ++q) {
                const int pidx = lane + 64 * q, rr = pidx / 24, w = pidx - rr * 24, a = w >> 3, pc = w & 7;
                if (pidx < 17 * 24) *(u32x4*)(recl + ((rr < 16) ? rr * RST + 256 : 16 * RST) + a * 128 + pc * 16) = zq[q];
            }
            WSYNC();
            const int tt = mt * 16 + fr, s = s0 + tt; const size_t T = (size_t)(t0 + tt);
            f32x4 Kr[4], Av[4];
            float n2 = 0.f, bon = 0.f;
            unsigned char* rec = recl + fr * RST;
            const unsigned char* prec = (fr > 0) ? (recl + (fr - 1) * RST) : (recl + 16 * RST - 256);
#pragma unroll
            for (int nt = 0; nt < 4; ++nt) {
                const int cb = h * 64 + nt * 16 + fq * 4, ci = nt * 16 + fq * 4;
                const u32x2 zr = *(const u32x2*)(rec + 256 + ci * 2), zk = *(const u32x2*)(rec + 384 + ci * 2), zv = *(const u32x2*)(rec + 512 + ci * 2);
                const u32x2 pr = *(const u32x2*)(prec + 256 + ci * 2), pk = *(const u32x2*)(prec + 384 + ci * 2), pv = *(const u32x2*)(prec + 512 + ci * 2);
                const f32x4 mur = *(const f32x4*)(p.shift_mu + cb), muk = *(const f32x4*)(p.shift_mu + 512 + cb), muv = *(const f32x4*)(p.shift_mu + 1024 + cb);
                const f32x4 w0v = *(const f32x4*)(p.w0 + cb), a0v = *(const f32x4*)(p.a0 + cb), kkv = *(const f32x4*)(p.k_k + cb), kav = *(const f32x4*)(p.k_a + cb), rkv = *(const f32x4*)(p.r_k + cb);
                const f32x4 cr = (f32x4){bflo(zr.x), bfhi(zr.x), bflo(zr.y), bfhi(zr.y)}, ck = (f32x4){bflo(zk.x), bfhi(zk.x), bflo(zk.y), bfhi(zk.y)}, cv = (f32x4){bflo(zv.x), bfhi(zv.x), bflo(zv.y), bfhi(zv.y)};
                const f32x4 qr = (f32x4){bflo(pr.x), bfhi(pr.x), bflo(pr.y), bfhi(pr.y)}, qk = (f32x4){bflo(pk.x), bfhi(pk.x), bflo(pk.y), bfhi(pk.y)}, qv = (f32x4){bflo(pv.x), bfhi(pv.x), bflo(pv.y), bfhi(pv.y)};
                f32x4 Rr, Kp, Vv, Dc;
#pragma unroll
                for (int jj = 0; jj < 4; ++jj) {
                    const float r = cr[jj] + mur[jj] * (qr[jj] - cr[jj]);
                    const float k = ck[jj] + muk[jj] * (qk[jj] - ck[jj]);
                    const float v = cv[jj] + muv[jj] * (qv[jj] - cv[jj]);
                    const float ww = aw[nt][jj] + w0v[jj];
                    const float a = sigmoidf_(aa[nt][jj] + a0v[jj]);
                    const float dec = __expf(-0.6065306597126334f * sigmoidf_(ww));
                    const float kr = k * kkv[jj];
                    n2 += kr * kr;
                    const float kp = k * (1.f + (a - 1.f) * kav[jj]);
                    bon += r * kp * rkv[jj];
                    Rr[jj] = r; Kp[jj] = kp; Vv[jj] = v; Kr[nt][jj] = kr; Av[nt][jj] = a; Dc[jj] = dec;
                }
                *(f32x4*)(rec + ci * 4) = Dc;
                *(u32x2*)(rec + 256 + ci * 2) = (u32x2){pack2(Rr[0], Rr[1]), pack2(Rr[2], Rr[3])};
                *(u32x2*)(rec + 384 + ci * 2) = (u32x2){pack2(Kp[0], Kp[1]), pack2(Kp[2], Kp[3])};
                const u32x2 vpk = (u32x2){pack2(Vv[0], Vv[1]), pack2(Vv[2], Vv[3])};
                *(u32x2*)(rec + 512 + ci * 2) = vpk;
            }
            n2 += __shfl_xor(n2, 16, 64); n2 += __shfl_xor(n2, 32, 64);
            bon += __shfl_xor(bon, 16, 64); bon += __shfl_xor(bon, 32, 64);
            const float inv = rsq_(fmaxf(n2, 1e-24f));
#pragma unroll
            for (int nt = 0; nt < 4; ++nt) {
                const int ci = nt * 16 + fq * 4;
                const f32x4 kk = Kr[nt] * inv;
                *(u32x2*)(rec + 640 + ci * 2) = (u32x2){pack2(kk[0], kk[1]), pack2(kk[2], kk[3])};
                const f32x4 nb = -(kk * Av[nt]);
                *(u32x2*)(rec + 768 + ci * 2) = (u32x2){pack2(nb[0], nb[1]), pack2(nb[2], nb[3])};
            }
            if (fq == 0) BON[(size_t)bh * 2048 + s] = bon;
        }
        WSYNC();
        {
            float w_[16], r_[16], kp_[16], kk_[16], nb_[16];
            {
                unsigned vv[16];
#pragma unroll
                for (int t = 0; t < 16; ++t) vv[t] = *(const u16*)(recl + t * RST + 512 + lane * 2);
                *(u32x4*)(VT + lane * 16) = (u32x4){vv[0] | (vv[1] << 16), vv[2] | (vv[3] << 16), vv[4] | (vv[5] << 16), vv[6] | (vv[7] << 16)};
                *(u32x4*)(VT + lane * 16 + 8) = (u32x4){vv[8] | (vv[9] << 16), vv[10] | (vv[11] << 16), vv[12] | (vv[13] << 16), vv[14] | (vv[15] << 16)};
            }
#pragma unroll
            for (int t = 0; t < 16; ++t) {
                const unsigned char* rt = recl + t * RST;
                w_[t] = *(const float*)(rt + lane * 4);
                r_[t] = bf2f(*(const u16*)(rt + 256 + lane * 2)); kp_[t] = bf2f(*(const u16*)(rt + 384 + lane * 2));
                kk_[t] = bf2f(*(const u16*)(rt + 640 + lane * 2)); nb_[t] = bf2f(*(const u16*)(rt + 768 + lane * 2));
            }
            WSYNC();
            float g = 1.f;
            float At[16], Bt[16], Kt[16];
#pragma unroll
            for (int t = 0; t < 16; ++t) {
                const float gp = g; g = g * w_[t]; const float ig = rcp_(g);
                const float a = kk_[t] * gp, rr = r_[t] * g, bb = nb_[t] * ig, kt = kp_[t] * ig;
                AR[t * 72 + lane] = f2bf(a); AR[(16 + t) * 72 + lane] = f2bf(rr); BK[t * 72 + lane] = f2bf(bb); BK[(16 + t) * 72 + lane] = f2bf(kt);
                At[t] = a; Bt[t] = bb; Kt[t] = kt;
            }
            u32x4 o0, o1;
            o0 = (u32x4){pack2(At[0], At[1]), pack2(At[2], At[3]), pack2(At[4], At[5]), pack2(At[6], At[7])};
            o1 = (u32x4){pack2(At[8], At[9]), pack2(At[10], At[11]), pack2(At[12], At[13]), pack2(At[14], At[15])};
            *(u32x4*)(AtT + lane * 16) = o0; *(u32x4*)(AtT + lane * 16 + 8) = o1;
            o0 = (u32x4){pack2(Bt[0] * g, Bt[1] * g), pack2(Bt[2] * g, Bt[3] * g), pack2(Bt[4] * g, Bt[5] * g), pack2(Bt[6] * g, Bt[7] * g)};
            o1 = (u32x4){pack2(Bt[8] * g, Bt[9] * g), pack2(Bt[10] * g, Bt[11] * g), pack2(Bt[12] * g, Bt[13] * g), pack2(Bt[14] * g, Bt[15] * g)};
            *(u32x4*)(BhT + lane * 16) = o0; *(u32x4*)(BhT + lane * 16 + 8) = o1;
            o0 = (u32x4){pack2(Kt[0] * g, Kt[1] * g), pack2(Kt[2] * g, Kt[3] * g), pack2(Kt[4] * g, Kt[5] * g), pack2(Kt[6] * g, Kt[7] * g)};
            o1 = (u32x4){pack2(Kt[8] * g, Kt[9] * g), pack2(Kt[10] * g, Kt[11] * g), pack2(Kt[12] * g, Kt[13] * g), pack2(Kt[14] * g, Kt[15] * g)};
            *(u32x4*)(KhT + lane * 16) = o0; *(u32x4*)(KhT + lane * 16 + 8) = o1;
            G15g[u * 64 + lane] = g;
        }
        WSYNC();
        {
            u32x2 rp[4];
#pragma unroll
            for (int ta = 0; ta < 4; ++ta) rp[ta] = *(const u32x2*)(AR + (16 + fr) * 72 + 16 * ta + 4 * fq);
            *(u32x4*)(RFg + (u * 64 + lane) * 32) = (u32x4){rp[0].x, rp[0].y, rp[1].x, rp[1].y};
            *(u32x4*)(RFg + (u * 64 + lane) * 32 + 16) = (u32x4){rp[2].x, rp[2].y, rp[3].x, rp[3].y};
#pragma unroll
            for (int ta = 0; ta < 4; ++ta) {
                const u32x2 b2 = *(const u32x2*)(BhT + (16 * ta + fr) * 16 + 4 * fq), k2 = *(const u32x2*)(KhT + (16 * ta + fr) * 16 + 4 * fq);
                *(u32x4*)(BKFg + ((u * 4 + ta) * 64 + lane) * 16) = (u32x4){b2.x, b2.y, k2.x, k2.y};
            }
#pragma unroll
            for (int sl = 0; sl < 4; ++sl) *(u32x2*)(CHVg + (((u * 4 + sl) * 3 + 2) * 64 + lane) * 8) = *(const u32x2*)(VT + (16 * sl + fr) * 16 + 4 * fq);
        }
        {
            f32x4 P00 = zero4, P01 = zero4, P10 = zero4, P11 = zero4;
#pragma unroll
            for (int s = 0; s < 2; ++s) {
                const bf16x8 a0 = *(const bf16x8*)(AR + fr * 72 + s * 32 + fq * 8), a1 = *(const bf16x8*)(AR + (16 + fr) * 72 + s * 32 + fq * 8);
                const bf16x8 b0 = *(const bf16x8*)(BK + fr * 72 + s * 32 + fq * 8), b1 = *(const bf16x8*)(BK + (16 + fr) * 72 + s * 32 + fq * 8);
                P00 = MFMA16(a0, b0, P00); P01 = MFMA16(a0, b1, P01); P10 = MFMA16(a1, b0, P10); P11 = MFMA16(a1, b1, P11);
            }
            WSYNC();
            float ak[4];
#pragma unroll
            for (int r = 0; r < 4; ++r) {
                const int i = 4 * fq + r, j = fr;
                Pab[i * 17 + j] = (j < i) ? P00[r] : 0.f;
                ak[r] = (j < i) ? P01[r] : 0.f;
                Arb[i * 24 + j] = f2bf((j <= i) ? P10[r] : 0.f);
                Ark[i * 24 + j] = f2bf((j <= i) ? P11[r] : 0.f);
            }
            *(u32x2*)(AakT + fr * 24 + 4 * fq) = (u32x2){pack2(ak[0], ak[1]), pack2(ak[2], ak[3])};
        }
        WSYNC();
        {
            float T[16];
#pragma unroll
            for (int i = 0; i < 16; ++i) T[i] = (i == fr) ? 1.f : 0.f;
#pragma unroll
            for (int j = 0; j < 15; ++j) {
#pragma unroll
                for (int i = j + 1; i < 16; ++i) T[i] += Pab[i * 17 + j] * T[j];
            }
#pragma unroll
            for (int i = 0; i < 16; ++i) Tm[i * 24 + fr] = f2bf(T[i]);
            *(u32x2*)(ARBg + (u * 64 + lane) * 8) = *(const u32x2*)(Arb + fr * 24 + 4 * fq);
        }
        WSYNC();
        const bf16x8 Tld = *(const bf16x8*)(Tm + fr * 24 + (fq & 1) * 8);
        const bf16x8 Tf = (fq < 2) ? Tld : zero8;
        {
            f32x4 D[4];
#pragma unroll
            for (int ta = 0; ta < 4; ++ta) {
                const bf16x8 ald = *(const bf16x8*)(AtT + (16 * ta + fr) * 16 + (fq & 1) * 8);
                D[ta] = MFMA16((fq < 2) ? ald : zero8, Tf, zero4);
            }
            *(u32x4*)(AFg + (u * 64 + lane) * 32) = (u32x4){pack2(D[0][0], D[0][1]), pack2(D[0][2], D[0][3]), pack2(D[1][0], D[1][1]), pack2(D[1][2], D[1][3])};
            *(u32x4*)(AFg + (u * 64 + lane) * 32 + 16) = (u32x4){pack2(D[2][0], D[2][1]), pack2(D[2][2], D[2][3]), pack2(D[3][0], D[3][1]), pack2(D[3][2], D[3][3])};
            const bf16x8 akld = *(const bf16x8*)(AakT + fr * 24 + (fq & 1) * 8);
            const f32x4 M1 = MFMA16(Tf, (fq < 2) ? akld : zero8, zero4);
#pragma unroll
            for (int r = 0; r < 4; ++r) M1m[(4 * fq + r) * 24 + fr] = f2bf(M1[r]);
        }
        WSYNC();
        {
            const bf16x8 m1ld = *(const bf16x8*)(M1m + fr * 24 + (fq & 1) * 8), rkld = *(const bf16x8*)(Ark + fr * 24 + (fq & 1) * 8);
            const bf16x8 M1f = (fq < 2) ? m1ld : zero8, Arkf = (fq < 2) ? rkld : zero8;
#pragma unroll
            for (int sl = 0; sl < 4; ++sl) {
                const bf16x8 vld = *(const bf16x8*)(VT + (16 * sl + fr) * 16 + (fq & 1) * 8);
                const bf16x8 Vb = (fq < 2) ? vld : zero8;
                const f32x4 Uh = MFMA16(M1f, Vb, zero4), Y0 = MFMA16(Arkf, Vb, zero4);
                *(u32x2*)(CHVg + (((u * 4 + sl) * 3 + 0) * 64 + lane) * 8) = (u32x2){pack2(Uh[0], Uh[1]), pack2(Uh[2], Uh[3])};
                *(u32x2*)(CHVg + (((u * 4 + sl) * 3 + 1) * 64 + lane) * 8) = (u32x2){pack2(Y0[0], Y0[1]), pack2(Y0[2], Y0[3])};
            }
        }
        WSYNC();
    }
}

struct ChunkOps { u32x4 af0, af1, rf0, rf1, bk0, bk1, bk2, bk3; u32x2 arb, uh, y0, vf; f32x4 g0, g1, g2, g3; };
constexpr int RING_SLOT = 17408, RING_NS = 7, RING_D = 6;
__device__ __forceinline__ void lds_chunk_ops(ChunkOps& o, const LAS unsigned char* s, int sl, int lane, int fq) {
    o.af0 = *(const LAS u32x4*)(s + lane * 32); o.af1 = *(const LAS u32x4*)(s + lane * 32 + 16);
    o.rf0 = *(const LAS u32x4*)(s + 2048 + lane * 32); o.rf1 = *(const LAS u32x4*)(s + 2048 + lane * 32 + 16);
    o.bk0 = *(const LAS u32x4*)(s + 4096 + (0 * 64 + lane) * 16); o.bk1 = *(const LAS u32x4*)(s + 4096 + (1 * 64 + lane) * 16);
    o.bk2 = *(const LAS u32x4*)(s + 4096 + (2 * 64 + lane) * 16); o.bk3 = *(const LAS u32x4*)(s + 4096 + (3 * 64 + lane) * 16);
    o.uh = *(const LAS u32x2*)(s + 8192 + ((sl * 3 + 0) * 64 + lane) * 8);
    o.y0 = *(const LAS u32x2*)(s + 8192 + ((sl * 3 + 1) * 64 + lane) * 8);
    o.vf = *(const LAS u32x2*)(s + 8192 + ((sl * 3 + 2) * 64 + lane) * 8);
    o.arb = *(const LAS u32x2*)(s + 16384 + lane * 8);
    o.g0 = *(const LAS f32x4*)(s + 16896 + 16 * fq); o.g1 = *(const LAS f32x4*)(s + 16896 + 64 + 16 * fq);
    o.g2 = *(const LAS f32x4*)(s + 16896 + 128 + 16 * fq); o.g3 = *(const LAS f32x4*)(s + 16896 + 192 + 16 * fq);
}
template <int LW> __device__ __forceinline__ void ring_issue(const Params& p, LAS unsigned char* ring, int bh, int c, int lane) {
    const size_t u = (size_t)bh * 128 + c;
    LAS unsigned char* slot = ring + (c % RING_NS) * RING_SLOT;
    const unsigned char* ws = p.ws; const unsigned char* od = (const unsigned char*)p.out;
#pragma unroll
    for (int j = 0; j < 8; ++j) {
        constexpr int Q0 = LW * 8; const int q = Q0 + j;
        const unsigned char* g;
        if (q < 2) g = ws + CH_AF + u * 2048 + q * 1024 + lane * 16;
        else if (q < 4) g = ws + CH_RF + u * 2048 + (q - 2) * 1024 + lane * 16;
        else if (q < 8) g = ws + CH_BKF + u * 4096 + (q - 4) * 1024 + lane * 16;
        else if (q < 14) g = od + OUT_CHV + u * 6144 + (q - 8) * 1024 + lane * 16;
        else { const int i = (q - 14) * 64 + lane; g = ws + WS_Z + (((size_t)(bh >> 3) * 2048 + c * 16 + (i >> 3)) * DIN + 2688 + (bh & 7) * 64) * 2 + (i & 7) * 16; }
        __builtin_amdgcn_global_load_lds((const unsigned*)g, (LAS unsigned*)(slot + q * 1024), 16, 0, 0);
    }
    if (LW == 0) {
        __builtin_amdgcn_global_load_lds((const unsigned*)(ws + CH_ARB + u * 512 + lane * 4), (LAS unsigned*)(slot + 16384), 4, 0, 0);
        __builtin_amdgcn_global_load_lds((const unsigned*)(ws + CH_ARB + u * 512 + 256 + lane * 4), (LAS unsigned*)(slot + 16384 + 256), 4, 0, 0);
    } else {
        __builtin_amdgcn_global_load_lds((const unsigned*)(ws + CH_G15 + u * 256 + lane * 4), (LAS unsigned*)(slot + 16896), 4, 0, 0);
        __builtin_amdgcn_global_load_lds((const unsigned*)(ws + WS_BONUS + ((size_t)bh * 2048 + c * 16) * 4 + (lane & 15) * 4), (LAS unsigned*)(slot + 17152), 4, 0, 0);
    }
}
template <int CTRL> __device__ __forceinline__ float dpp_add_q(float v) {
    const int t = __builtin_amdgcn_update_dpp(0, __float_as_int(v), CTRL, 0xf, 0xf, false);
    return v + __int_as_float(t);
}
__device__ __forceinline__ float oct_allsum(float v) {
    v = dpp_add_q<0xB1>(v); v = dpp_add_q<0x4E>(v); v = dpp_add_q<0x141>(v);
    return v;
}
struct EpiIn { u32x4 gb; float bon; u16 v[8]; };
__device__ __forceinline__ void epi_load(EpiIn& e, const LAS unsigned char* s, int t, int v0) {
    e.gb = *(const LAS u32x4*)(s + 14336 + t * 128 + v0 * 2);
    e.bon = *(const LAS float*)(s + 17152 + t * 4);
    const LAS unsigned char* vp = s + 8192 + (((v0 >> 4) * 3 + 2) * 64 + (t >> 2) * 16 + (v0 & 15)) * 8 + (t & 3) * 2;
#pragma unroll
    for (int i = 0; i < 8; ++i) e.v[i] = *(const LAS u16*)(vp + 8 * i);
}
template <int LW> __device__ __forceinline__ void p3_loader(const Params& p, LAS unsigned char* ring, int bh, int lane) {
#pragma unroll
    for (int c = 0; c < RING_D; ++c) ring_issue<LW>(p, ring, bh, c, lane);
    asm volatile("s_waitcnt vmcnt(40)" ::: "memory");
    __builtin_amdgcn_s_barrier();
#pragma unroll 1
    for (int c = 0; c < 128; ++c) {
        const int cn = (c + RING_D < 128) ? c + RING_D : 127;
        ring_issue<LW>(p, ring, bh, cn, lane);
        asm volatile("s_waitcnt vmcnt(40)" ::: "memory");
        __builtin_amdgcn_s_barrier();
    }
    asm volatile("s_waitcnt vmcnt(0)" ::: "memory");
}
__device__ void phase3(const Params& p) {
    const int tid = threadIdx.x, lane = tid & 63, wave = __builtin_amdgcn_readfirstlane(tid >> 6), fr = lane & 15, fq = lane >> 4;
    const int bh = blockIdx.x;
    if (bh >= 64) return;
    LAS unsigned char* ring = (LAS unsigned char*)dyn_smem;
    LAS float* ybuf = (LAS float*)(ring + RING_NS * RING_SLOT);
    if (wave >= 6) {
        const int e = (wave - 6) * 64 + lane, t = e >> 3, v0 = (e & 7) * 8, b = bh >> 3, h = bh & 7;
        f32x4 ga0 = *(const f32x4*)(p.gn_gain + h * 64 + v0), ga1 = *(const f32x4*)(p.gn_gain + h * 64 + v0 + 4);
        f32x4 bi0 = *(const f32x4*)(p.gn_bias + h * 64 + v0), bi1 = *(const f32x4*)(p.gn_bias + h * 64 + v0 + 4);
        u16* Y = (u16*)(p.ws + WS_Y);
        EpiIn cur, nxt;
        __builtin_amdgcn_s_barrier();
        epi_load(cur, ring, t, v0);
#pragma unroll 1
        for (int c = 0; c <= 128; ++c) {
            if (c >= 1) {
                const int cc = c - 1;
                { const int cn = (c < 128) ? c : 127; epi_load(nxt, ring + (cn % RING_NS) * RING_SLOT, t, v0); }
                const LAS float* yb = ybuf + (cc & 1) * (16 * 68) + t * 68 + v0;
                const f32x4 y0 = *(const LAS f32x4*)(yb), y1 = *(const LAS f32x4*)(yb + 4);
                float s1 = (y0[0] + y0[1]) + (y0[2] + y0[3]) + (y1[0] + y1[1]) + (y1[2] + y1[3]);
                float s2 = y0[0] * y0[0] + y0[1] * y0[1] + y0[2] * y0[2] + y0[3] * y0[3] + y1[0] * y1[0] + y1[1] * y1[1] + y1[2] * y1[2] + y1[3] * y1[3];
                s1 = oct_allsum(s1); s2 = oct_allsum(s2);
                const float mean = s1 * (1.f / 64.f);
                const float var = fmaxf(s2 * (1.f / 64.f) - mean * mean, 0.f);
                const float rstd = rsq_(var + 64e-5f);
                const float vvf[8] = {bf2f(cur.v[0]), bf2f(cur.v[1]), bf2f(cur.v[2]), bf2f(cur.v[3]), bf2f(cur.v[4]), bf2f(cur.v[5]), bf2f(cur.v[6]), bf2f(cur.v[7])};
                const float gbf[8] = {bflo(cur.gb.x), bfhi(cur.gb.x), bflo(cur.gb.y), bfhi(cur.gb.y), bflo(cur.gb.z), bfhi(cur.gb.z), bflo(cur.gb.w), bfhi(cur.gb.w)};
                float o[8];
#pragma unroll
                for (int i = 0; i < 8; ++i) {
                    const float yv = (i < 4) ? y0[i & 3] : y1[i & 3];
                    const float gn = (i < 4) ? ga0[i & 3] : ga1[i & 3], bs = (i < 4) ? bi0[i & 3] : bi1[i & 3];
                    const float yn = (yv - mean) * rstd * gn + bs;
                    o[i] = (yn + cur.bon * vvf[i]) * gbf[i] * sigmoidf_(gbf[i]);
                }
                *(u32x4*)(Y + ((size_t)b * 2048 + cc * 16 + t) * 1024 + 512 + h * 64 + v0) = (u32x4){pack2(o[0], o[1]), pack2(o[2], o[3]), pack2(o[4], o[5]), pack2(o[6], o[7])};
                cur = nxt;
            }
            if (c < 128) __builtin_amdgcn_s_barrier();
        }
        return;
    }
    if (wave >= 4) { if (wave == 4) p3_loader<0>(p, ring, bh, lane); else p3_loader<1>(p, ring, bh, lane); return; }
    const int sl = wave;
    f32x4 acc0 = (f32x4){0.f, 0.f, 0.f, 0.f}, acc1 = acc0, acc2 = acc0, acc3 = acc0;
    ChunkOps cur, nxt;
    __builtin_amdgcn_s_barrier();
    lds_chunk_ops(cur, ring, sl, lane, fq);
#pragma unroll 2
    for (int c = 0; c < 128; ++c) {
        { const int cn = (c + 1 < 128) ? c + 1 : c; lds_chunk_ops(nxt, ring + (cn % RING_NS) * RING_SLOT, sl, lane, fq); }
        const bf16x8 sb0 = as_bf8((u32x4){pack2(acc0[0], acc0[1]), pack2(acc0[2], acc0[3]), pack2(acc1[0], acc1[1]), pack2(acc1[2], acc1[3])});
        const bf16x8 sb1 = as_bf8((u32x4){pack2(acc2[0], acc2[1]), pack2(acc2[2], acc2[3]), pack2(acc3[0], acc3[1]), pack2(acc3[2], acc3[3])});
        f32x4 U = (f32x4){bflo(cur.uh.x), bfhi(cur.uh.x), bflo(cur.uh.y), bfhi(cur.uh.y)};
        U = MFMA16(as_bf8(cur.af0), sb0, U); U = MFMA16(as_bf8(cur.af1), sb1, U);
        f32x4 Yv = (f32x4){bflo(cur.y0.x), bfhi(cur.y0.x), bflo(cur.y0.y), bfhi(cur.y0.y)};
        Yv = MFMA16(as_bf8(cur.rf0), sb0, Yv); Yv = MFMA16(as_bf8(cur.rf1), sb1, Yv);
        const unsigned u01 = pack2(U[0], U[1]), u23 = pack2(U[2], U[3]);
        Yv = MFMA16(as_bf8((u32x4){cur.arb.x, cur.arb.y, 0u, 0u}), as_bf8((u32x4){u01, u23, 0u, 0u}), Yv);
        const bf16x8 uvb = as_bf8((u32x4){u01, u23, cur.vf.x, cur.vf.y});
        acc0 = MFMA16(as_bf8(cur.bk0), uvb, acc0 * cur.g0); acc1 = MFMA16(as_bf8(cur.bk1), uvb, acc1 * cur.g1);
        acc2 = MFMA16(as_bf8(cur.bk2), uvb, acc2 * cur.g2); acc3 = MFMA16(as_bf8(cur.bk3), uvb, acc3 * cur.g3);
        LAS float* yb = ybuf + (c & 1) * (16 * 68) + (4 * fq) * 68 + sl * 16 + fr;
        yb[0] = Yv[0]; yb[68] = Yv[1]; yb[136] = Yv[2]; yb[204] = Yv[3];
        asm volatile("s_waitcnt lgkmcnt(0)" ::: "memory");
        __builtin_amdgcn_s_barrier();
        asm volatile("" ::: "memory");
        cur = nxt;
    }
}

__device__ void phase5(const Params& p) {
    const int tid = threadIdx.x, lane = tid & 63, wave = tid >> 6, blk = blockIdx.x;
#pragma unroll 1
    for (int r0 = 0; r0 < 8; r0 += 4) {
        f32x4 v[4][4]; float ss[4];
#pragma unroll
        for (int i = 0; i < 4; ++i) {
            const f32x4* xr = (const f32x4*)(p.out + (size_t)(blk * 64 + wave * 8 + r0 + i) * DM);
#pragma unroll
            for (int q = 0; q < 4; ++q) v[i][q] = xr[lane + 64 * q];
        }
#pragma unroll
        for (int i = 0; i < 4; ++i) {
            float s = 0.f;
#pragma unroll
            for (int q = 0; q < 4; ++q) s += v[i][q][0] * v[i][q][0] + v[i][q][1] * v[i][q][1] + v[i][q][2] * v[i][q][2] + v[i][q][3] * v[i][q][3];
            ss[i] = wave_sum(s);
        }
#pragma unroll
        for (int i = 0; i < 4; ++i) {
            f32x4* xr = (f32x4*)(p.out + (size_t)(blk * 64 + wave * 8 + r0 + i) * DM);
            const float inv = rsq_(ss[i] * (1.f / 1024.f) + 1e-6f);
#pragma unroll
            for (int q = 0; q < 4; ++q) { const f32x4 g = ((const f32x4*)p.final_gain)[lane + 64 * q]; xr[lane + 64 * q] = v[i][q] * inv * g; }
        }
    }
}

__global__ void __launch_bounds__(512, 2) hybrid_fwd(Params p) {
    __shared__ uint4 xb_words;
    if (threadIdx.x == 0) xb_words = make_uint4(0u, 0u, 0u, 0u);
    __syncthreads();
    XcdBarrier bar; bar.bar = (unsigned*)(p.ws + WS_CTL); bar.x = 0; bar.st = (volatile LAS unsigned*)&xb_words;
    const int lo = p.ph_lo, hi = p.ph_hi;
    if (hi - lo > 1) bar = xcd_barrier_post((unsigned*)(p.ws + WS_CTL), (volatile LAS unsigned*)&xb_words);
#define IN(k) (lo <= (k) && (k) < hi)
#define SEAM(k) do { if (IN(k) && IN((k) + 1)) xcd_barrier(bar); } while (0)
#define RUN(k, f) do { if (IN(k)) { if (PROBE_DUP == (k)) { for (int _r = 0; _r < p.dup_n; ++_r) { if (_r) __syncthreads(); f(p); } } else f(p); } } while (0)
    RUN(0, phase0);
    SEAM(0);
    RUN(1, phase1);
    SEAM(1);
    RUN(2, phase2);
    SEAM(2);
    RUN(3, phase3);
    SEAM(3);
    RUN(4, phase4);
}

extern "C" void kernel_launch(void* const* d_in, const int* in_sizes, int n_in, void* d_out, int out_size, void* d_ws, size_t ws_size, hipStream_t stream) {
    static int grid = 0;
    if (grid == 0) {
        if (n_in != 17 || out_size != NTOK * DM || ws_size < WS_END) { fprintf(stderr, "kernel_launch: unexpected problem (n_in %d out %d ws %zu need %zu)\n", n_in, out_size, ws_size, (size_t)WS_END); grid = -1; return; }
        if (hipFuncSetAttribute((const void*)hybrid_fwd, hipFuncAttributeMaxDynamicSharedMemorySize, LDS_BYTES) != hipSuccess) { fprintf(stderr, "kernel_launch: hipFuncSetAttribute failed\n"); grid = -1; return; }
        int per_cu = 0;
        if (hipOccupancyMaxActiveBlocksPerMultiprocessor(&per_cu, (const void*)hybrid_fwd, 512, LDS_BYTES) != hipSuccess || per_cu < 1) fprintf(stderr, "kernel_launch: occupancy query says %d blocks per CU\n", per_cu);
        (void)hipGetLastError();
        grid = 256;
    }
    if (grid < 0) return;
    (void)hipMemsetAsync((char*)d_ws + WS_CTL, 0, 16384, stream);
    Params p{};
    p.x = (const float*)d_in[0]; p.norm_gain = (const float*)d_in[1]; p.w_in = (const float*)d_in[2]; p.pool_w = (const float*)d_in[3];
    p.pool_scale = (const float*)d_in[4]; p.shift_mu = (const float*)d_in[5]; p.w0 = (const float*)d_in[6]; p.w_up = (const float*)d_in[7];
    p.a0 = (const float*)d_in[8]; p.a_up = (const float*)d_in[9]; p.k_k = (const float*)d_in[10]; p.k_a = (const float*)d_in[11];
    p.r_k = (const float*)d_in[12]; p.gn_gain = (const float*)d_in[13]; p.gn_bias = (const float*)d_in[14]; p.w_out = (const float*)d_in[15];
    p.final_gain = (const float*)d_in[16];
    p.out = (float*)d_out; p.ws = (unsigned char*)d_ws; p.dup_n = 2;
#if N_LAUNCHES == 1
    p.ph_lo = 0; p.ph_hi = NPH;
    hipLaunchKernelGGL(hybrid_fwd, dim3(grid), dim3(512), LDS_BYTES, stream, p);
#else
    for (int k = 0; k < NPH; ++k) { p.ph_lo = k; p.ph_hi = k + 1; hipLaunchKernelGGL(hybrid_fwd, dim3(grid), dim3(512), LDS_BYTES, stream, p); }
#endif
}
```

```cpp
#include <hip/hip_runtime.h>
#include <stdint.h>
#include <cstdio>

typedef unsigned short u16;
typedef short bf16x8 __attribute__((ext_vector_type(8)));
typedef float f32x4 __attribute__((ext_vector_type(4)));
typedef float f32x2 __attribute__((ext_vector_type(2)));
typedef unsigned u32x2 __attribute__((ext_vector_type(2)));
typedef unsigned u32x4 __attribute__((ext_vector_type(4)));

#ifndef PROBE_DUP
#define PROBE_DUP -1
#endif
#ifndef N_LAUNCHES
#define N_LAUNCHES 1
#endif

constexpr int NTOK = 16384, DM = 1024, SEQ = 2048, DIN = 3200, DINP = 3328;
constexpr int NPH = 5;
constexpr int LDS_BYTES = 18432 + 8 * 17408;

constexpr size_t WS_CTL = 0;
constexpr size_t WS_WINT = 16384;
constexpr size_t WS_WOUTT = WS_WINT + (size_t)DINP * 1024 * 2;
constexpr size_t WS_WUPT = WS_WOUTT + (size_t)1024 * 1024 * 2;
constexpr size_t WS_AUPT = WS_WUPT + 512 * 64 * 2;
constexpr size_t WS_POOLT = WS_AUPT + 512 * 64 * 2;
constexpr size_t WS_Z = WS_POOLT + 4 * 128 * 128 * 2;
constexpr size_t WS_REC = WS_Z + (size_t)NTOK * DIN * 2;
constexpr size_t WS_Y = WS_REC + (size_t)64 * 2048 * 896;
constexpr size_t WS_BONUS = WS_Y + (size_t)NTOK * 1024 * 2;
constexpr size_t WS_PART = WS_BONUS + (size_t)64 * 2048 * 4;
constexpr size_t WS_END = WS_PART + (size_t)64 * 4 * 256 * 4;
constexpr int CTL_CNT_WORD = 3584;
constexpr int NUNIT = 64 * 128;
constexpr size_t CH_AF = WS_REC;
constexpr size_t CH_RF = CH_AF + (size_t)NUNIT * 2048;
constexpr size_t CH_BKF = CH_RF + (size_t)NUNIT * 2048;
constexpr size_t CH_ARB = CH_BKF + (size_t)NUNIT * 4096;
constexpr size_t CH_G15 = CH_ARB + (size_t)NUNIT * 512;
constexpr size_t CH_END = CH_G15 + (size_t)NUNIT * 256;
constexpr size_t WS_VB = CH_END;
static_assert(WS_VB + (size_t)NTOK * 512 * 2 <= WS_Y, "chunk operands + v must fit in the record region");
constexpr size_t OUT_CHV = 0;
constexpr size_t OUT_GB = (size_t)NUNIT * 4 * 3 * 512;
static_assert(OUT_GB + (size_t)NTOK * 512 * 2 <= (size_t)NTOK * DM * 4, "d_out scratch");

struct Params {
    const float* x; const float* norm_gain; const float* w_in; const float* pool_w; const float* pool_scale;
    const float* shift_mu; const float* w0; const float* w_up; const float* a0; const float* a_up;
    const float* k_k; const float* k_a; const float* r_k; const float* gn_gain; const float* gn_bias;
    const float* w_out; const float* final_gain;
    float* out; unsigned char* ws;
    int ph_lo, ph_hi, dup_n, pad;
};

extern __shared__ __attribute__((aligned(16))) unsigned char dyn_smem[];

__device__ __forceinline__ float bf2f(u16 v) { return __uint_as_float(((unsigned)v) << 16); }
__device__ __forceinline__ float bflo(unsigned v) { return __uint_as_float(v << 16); }
__device__ __forceinline__ float bfhi(unsigned v) { return __uint_as_float(v & 0xffff0000u); }
typedef __bf16 bf16x2_t __attribute__((ext_vector_type(2)));
__device__ __forceinline__ unsigned pack2(float lo, float hi) { bf16x2_t v = {(__bf16)lo, (__bf16)hi}; return __builtin_bit_cast(unsigned, v); }
__device__ __forceinline__ u16 f2bf(float f) { return (u16)(pack2(f, 0.f) & 0xffffu); }
__device__ __forceinline__ float wave_sum(float v) {
#pragma unroll
    for (int m = 32; m >= 1; m >>= 1) v += __shfl_xor(v, m, 64);
    return v;
}
__device__ __forceinline__ float rcp_(float v) { return __builtin_amdgcn_rcpf(v); }
__device__ __forceinline__ float rsq_(float v) { return __builtin_amdgcn_rsqf(v); }
__device__ __forceinline__ float sigmoidf_(float v) { return rcp_(1.f + __expf(-v)); }
__device__ __forceinline__ float tanhf_(float v) { return 1.f - 2.f * rcp_(1.f + __expf(2.f * v)); }

#define XB_TMO      128
#define XB_XCNT(j)  (256  + 64 * (j))
#define XB_XSUB(j)  (1280 + 64 * (j))
#define XB_XGEN(j)  (2304 + 64 * (j))
#define XB_TOP      3328
#define XB_TOPGEN   3392
#define XCD_BAR_WORDS 3456
#define XB_SPIN_CAP (1u << 22)
#define LAS __attribute__((address_space(3)))

__device__ __forceinline__ unsigned xb_ld(unsigned* p)              { return __hip_atomic_load(p, __ATOMIC_RELAXED, __HIP_MEMORY_SCOPE_AGENT); }
__device__ __forceinline__ unsigned xb_add(unsigned* p, unsigned v) { return __hip_atomic_fetch_add(p, v, __ATOMIC_RELAXED, __HIP_MEMORY_SCOPE_AGENT); }
__device__ __forceinline__ unsigned xb_xcc_id() { return (unsigned)__builtin_amdgcn_s_getreg((3 << 11) | 20) & 0xFu; }
#define XB_SPIN(cond, bar) do { unsigned _sp = 0; while (cond) { __builtin_amdgcn_s_sleep(8); \
    if ((++_sp & 255u) == 0u) { if (xb_ld(&(bar)[XB_TMO])) break; if (_sp > XB_SPIN_CAP) { atomicAdd(&(bar)[XB_TMO], 1u); break; } } } } while (0)

struct XcdBarrier { unsigned* bar; unsigned x; volatile LAS unsigned* st; };

__device__ __forceinline__ XcdBarrier xcd_barrier_post(unsigned* bar, volatile LAS unsigned* st) {
    XcdBarrier b; b.bar = bar; b.x = xb_xcc_id(); b.st = st;
    if (threadIdx.x == 0) (void)xb_add(&bar[XB_XCNT(b.x)], 1u);
    return b;
}
__device__ __forceinline__ void xcd_barrier_complete(unsigned* bar, unsigned x, unsigned& nloc, unsigned& nx) {
    const unsigned G = gridDim.x * gridDim.y * gridDim.z;
    unsigned sum, cnt, mine, sp = 0u;
    for (;;) {
        sum = 0u; cnt = 0u; mine = 0u;
#pragma unroll
        for (unsigned j = 0; j < 16; ++j) { const unsigned c = xb_ld(&bar[XB_XCNT(j)]); sum += c; cnt += (c > 0u) ? 1u : 0u; mine = (j == x) ? c : mine; }
        if (sum == G) break;
        __builtin_amdgcn_s_sleep(1);
        if ((++sp & 255u) == 0u) { if (xb_ld(&bar[XB_TMO])) break; if (sp > XB_SPIN_CAP) { atomicAdd(&bar[XB_TMO], 1u); break; } }
    }
    nloc = mine > 0u ? mine : 1u; nx = cnt > 0u ? cnt : 1u;
}
__device__ __forceinline__ void xcd_barrier(const XcdBarrier& b) {
    asm volatile("s_waitcnt vmcnt(0)" ::: "memory");
    __syncthreads();
    if (threadIdx.x == 0) {
        unsigned* bar = b.bar;
        __builtin_amdgcn_s_waitcnt(0);
        unsigned nloc = b.st[0], nx = b.st[1];
        if (nloc == 0u) { xcd_barrier_complete(bar, b.x, nloc, nx); b.st[0] = nloc; b.st[1] = nx; }
        const unsigned old = xb_add(&bar[XB_XSUB(b.x)], 1u);
        const unsigned gen = old / nloc;
        if (old + 1u == (gen + 1u) * nloc) {
            __builtin_amdgcn_fence(__ATOMIC_RELEASE, "agent");
            asm volatile("s_waitcnt vmcnt(0)" ::: "memory");
            const unsigned og = xb_add(&bar[XB_TOP], 1u);
            const unsigned tg = og / nx;
            if (og + 1u == (tg + 1u) * nx) xb_add(&bar[XB_TOPGEN], 1u);
            else XB_SPIN(xb_ld(&bar[XB_TOPGEN]) == tg, bar);
            __builtin_amdgcn_fence(__ATOMIC_ACQUIRE, "agent");
            xb_add(&bar[XB_XGEN(b.x)], 1u);
            asm volatile("s_waitcnt vmcnt(0)" ::: "memory");
        } else {
            XB_SPIN(xb_ld(&bar[XB_XGEN(b.x)]) == gen, bar);
            __builtin_amdgcn_fence(__ATOMIC_ACQUIRE, "agent");
            asm volatile("s_waitcnt vmcnt(0)" ::: "memory");
        }
    }
    __syncthreads();
}

constexpr int BM = 256, BK = 64, HALF = 128, HTB = HALF * BK * 2, STAGE_BYTES = 8 * HTB, NXCD = 8, WGM = 8;
__device__ __forceinline__ int lds_byte(int r, int c) { const int st = (r >> 4) * 2 + (c >> 5), rr = r & 15, cc = c & 31, ob = rr * 64 + cc * 2; return st * 1024 + (ob ^ (((ob >> 9) & 1) << 5)); }
__device__ __forceinline__ void stage_rc(int b, int& R, int& C) { const int st = b / 1024, sb = b % 1024, swz = sb ^ (((sb >> 9) & 1) << 5); R = (st >> 1) * 16 + swz / 64; C = (st & 1) * 32 + (swz % 64) / 2; }
__device__ __forceinline__ int perm32(int rho) { const int n = rho >> 4, i = rho & 15; return 8 * (i >> 2) + 4 * n + (i & 3); }

struct Unit { int pm, pn; };
struct Gemm { const u16* A; const u16* Bt; int M, N, K, Nvalid; };
struct StaticOrder {
    int nM, nN, nwg, G, c;
    __device__ void init(int M, int N, int G_, int c_) { nM = M / BM; nN = N / BM; nwg = nM * nN; G = G_; c = c_; }
    __device__ bool next(int i, Unit& u) const {
        const long L = (long)i * G + c; if (L >= nwg) return false;
        int wgid = (int)L; { const int q = nwg / NXCD, r = nwg % NXCD, xcd = wgid % NXCD, off = wgid / NXCD; wgid = (xcd < r ? xcd * (q + 1) : r * (q + 1) + (xcd - r) * q) + off; }
        const int nig = WGM * nN, gid = wgid / nig, fm = gid * WGM, gsz = (nM - fm) < WGM ? (nM - fm) : WGM;
        u.pm = fm + ((wgid % nig) % gsz); u.pn = (wgid % nig) / gsz; return true;
    }
};
struct EpiZ {
    static constexpr bool PERM = true, AFTER_DRAIN = false;
    u16* Z;
    __device__ __forceinline__ void operator()(const f32x4 (&acc)[2][2][4][2], const Unit& u, int wr, int wc, int fr, int fq) const {
        const int row0 = u.pm * BM + wr * 64 + fr, col0 = u.pn * BM + wc * 32 + 8 * fq;
#pragma unroll
        for (int ai = 0; ai < 2; ++ai)
#pragma unroll
            for (int m = 0; m < 4; ++m) { u16* rowp = Z + (size_t)(row0 + ai * HALF + m * 16) * DIN;
#pragma unroll
                for (int bj = 0; bj < 2; ++bj) { const int col = col0 + bj * HALF; const f32x4 v0 = acc[ai][bj][m][0], v1 = acc[ai][bj][m][1];
                    if (col < DIN) *(u32x4*)(rowp + col) = (u32x4){pack2(v0[0], v0[1]), pack2(v0[2], v0[3]), pack2(v1[0], v1[1]), pack2(v1[2], v1[3])}; } }
    }
};
struct EpiRes {
    static constexpr bool PERM = false, AFTER_DRAIN = false;
    const float* x; float* out;
    __device__ __forceinline__ void operator()(const f32x4 (&acc)[2][2][4][2], const Unit& u, int wr, int wc, int fr, int fq) const {
        const int row0 = u.pm * BM + wr * 64 + fr, col0 = u.pn * BM + wc * 32 + 4 * fq;
#pragma unroll
        for (int ai = 0; ai < 2; ++ai)
#pragma unroll
            for (int m = 0; m < 4; ++m) { const size_t ro = (size_t)(row0 + ai * HALF + m * 16) * DM + col0;
#pragma unroll
                for (int bj = 0; bj < 2; ++bj)
#pragma unroll
                    for (int n = 0; n < 2; ++n) { const f32x4 xv = *(const f32x4*)(x + ro + bj * HALF + n * 16); *(f32x4*)(out + ro + bj * HALF + n * 16) = xv + acc[ai][bj][m][n]; } }
    }
};
struct EpiResNorm {
    static constexpr bool PERM = false, AFTER_DRAIN = true;
    const float* x; const float* gain; float* out; float* part; unsigned* cnt;
    __device__ __forceinline__ void fused(f32x4 (&acc)[2][2][4][2], const Unit& u, int wr, int wc, int fr, int fq, LAS unsigned char* lds) const {
        const int row0 = u.pm * BM + wr * 64 + fr, col0 = u.pn * BM + wc * 32 + 4 * fq;
        LAS float* red = (LAS float*)lds;
        LAS float* tot = red + 1024;
        float rs[2][4];
#pragma unroll
        for (int ai = 0; ai < 2; ++ai)
#pragma unroll
            for (int m = 0; m < 4; ++m) { const size_t ro = (size_t)(row0 + ai * HALF + m * 16) * DM + col0; float s = 0.f;
#pragma unroll
                for (int bj = 0; bj < 2; ++bj)
#pragma unroll
                    for (int n = 0; n < 2; ++n) { const f32x4 v = __builtin_nontemporal_load((const f32x4*)(x + ro + bj * HALF + n * 16)) + acc[ai][bj][m][n]; acc[ai][bj][m][n] = v; s += v[0] * v[0] + v[1] * v[1] + v[2] * v[2] + v[3] * v[3]; }
                s += __shfl_xor(s, 16, 64); s += __shfl_xor(s, 32, 64);
                rs[ai][m] = s; }
        if (fq == 0) {
#pragma unroll
            for (int ai = 0; ai < 2; ++ai)
#pragma unroll
                for (int m = 0; m < 4; ++m) red[((wr * 4 + wc) * 8 + ai * 4 + m) * 16 + fr] = rs[ai][m];
        }
        __syncthreads();
        if (threadIdx.x < 256) {
            const int rl = threadIdx.x, ai = rl >> 7, wr_ = (rl >> 6) & 1, m = (rl >> 4) & 3, fr_ = rl & 15;
            const int o = ((wr_ * 4) * 8 + ai * 4 + m) * 16 + fr_;
            const float s = red[o] + red[o + 128] + red[o + 256] + red[o + 384];
            __hip_atomic_store(part + ((size_t)u.pm * 4 + u.pn) * 256 + rl, s, __ATOMIC_RELAXED, __HIP_MEMORY_SCOPE_AGENT);
        }
        asm volatile("s_waitcnt vmcnt(0)" ::: "memory");
        __syncthreads();
        if (threadIdx.x == 0) {
            __builtin_amdgcn_fence(__ATOMIC_RELEASE, "agent");
            asm volatile("s_waitcnt vmcnt(0)" ::: "memory");
            __hip_atomic_fetch_add(cnt + u.pm, 1u, __ATOMIC_RELAXED, __HIP_MEMORY_SCOPE_AGENT);
            unsigned sp = 0;
            while (__hip_atomic_load(cnt + u.pm, __ATOMIC_RELAXED, __HIP_MEMORY_SCOPE_AGENT) < 4u) { __builtin_amdgcn_s_sleep(1); if (++sp > (1u << 24)) break; }
            __builtin_amdgcn_fence(__ATOMIC_ACQUIRE, "agent");
            asm volatile("s_waitcnt vmcnt(0)" ::: "memory");
        }
        __syncthreads();
        for (int e = threadIdx.x; e < 1024; e += 512) tot[e] = __hip_atomic_load(part + (size_t)u.pm * 1024 + e, __ATOMIC_RELAXED, __HIP_MEMORY_SCOPE_AGENT);
        __syncthreads();
#pragma unroll
        for (int ai = 0; ai < 2; ++ai)
#pragma unroll
            for (int m = 0; m < 4; ++m) { const int rl = ai * 128 + wr * 64 + m * 16 + fr;
                const float inv = rsq_((tot[rl] + tot[256 + rl] + tot[512 + rl] + tot[768 + rl]) * (1.f / 1024.f) + 1e-6f);
                const size_t ro = (size_t)(row0 + ai * HALF + m * 16) * DM + col0;
#pragma unroll
                for (int bj = 0; bj < 2; ++bj)
#pragma unroll
                    for (int n = 0; n < 2; ++n) { const f32x4 g = *(const f32x4*)(gain + col0 + bj * HALF + n * 16); __builtin_nontemporal_store(acc[ai][bj][m][n] * inv * g, (f32x4*)(out + ro + bj * HALF + n * 16)); } }
    }
};

template <class Epi, class Sched>
__device__ __forceinline__ void gemm_phase(LAS unsigned char* lds, const Gemm g, const Sched& S, const Epi& E) {
    const int tid = threadIdx.x, wid = __builtin_amdgcn_readfirstlane(tid >> 6), lane = tid & 63, wr = wid >> 2, wc = wid & 3, fr = lane & 15, fq = lane >> 4;
    const int K = g.K, nt = K / BK;
    unsigned voffA[2], voffB[2];
#pragma unroll
    for (int i = 0; i < 2; ++i) { int R, C; stage_rc(tid * 16 + i * 8192, R, C); const int Rb = Epi::PERM ? ((R & ~31) + perm32(R & 31)) : R;
        voffA[i] = (unsigned)(R * K + C) * 2u; voffB[i] = (unsigned)(Rb * K + C) * 2u; }
    const size_t kstep = (size_t)(BK * 2);
    const size_t hstep = (size_t)HALF * K * 2;
    const size_t tstep = 2 * hstep;
    const unsigned ldsw = (unsigned)wid * 1024u;
    const int aoff = lds_byte(wr * 64 + fr, fq * 8), boff = lds_byte(wc * 32 + fr, fq * 8);
#define PG8_SA(b, h) (((b) * 2 + (h)) * HTB)
#define PG8_SB(b, h) ((4 + (b) * 2 + (h)) * HTB)
#define PG8_STAGE(bufoff, gbase, voff) do { _Pragma("unroll") for (int _i = 0; _i < 2; ++_i) \
        __builtin_amdgcn_global_load_lds((const unsigned*)((const char*)(gbase) + (voff)[_i]), (LAS unsigned*)(lds + (bufoff) + ldsw + _i * 8192), 16, 0, 0); } while (0)
#define PG8_LDA(dst, b, h) do { _Pragma("unroll") for (int m = 0; m < 4; ++m) _Pragma("unroll") for (int k = 0; k < 2; ++k) dst[m][k] = *(const LAS bf16x8*)(lds + PG8_SA(b, h) + aoff + m * 2048 + k * 1024); } while (0)
#define PG8_LDB(dst, b, h) do { _Pragma("unroll") for (int n = 0; n < 2; ++n) _Pragma("unroll") for (int k = 0; k < 2; ++k) dst[n][k] = *(const LAS bf16x8*)(lds + PG8_SB(b, h) + boff + n * 2048 + k * 1024); } while (0)
#define PG8_MMA(ai, bj, At, Bt) do { __builtin_amdgcn_s_setprio(1); _Pragma("unroll") for (int m = 0; m < 4; ++m) _Pragma("unroll") for (int n = 0; n < 2; ++n) _Pragma("unroll") for (int k = 0; k < 2; ++k) \
        acc[ai][bj][m][n] = __builtin_amdgcn_mfma_f32_16x16x32_bf16(Bt[n][k], At[m][k], acc[ai][bj][m][n], 0, 0, 0); __builtin_amdgcn_s_setprio(0); } while (0)
#define PG8_WAIT_V(n) asm volatile("s_waitcnt vmcnt(" #n ")" ::: "memory")
#define PG8_WAIT_L(n) asm volatile("s_waitcnt lgkmcnt(" #n ")" ::: "memory")
#define PG8_BAR __builtin_amdgcn_s_barrier()
#define PG8_SCHED __builtin_amdgcn_sched_barrier(0)
    Unit cur, nxt; int ui = 0;
    if (!S.next(0, cur)) return;
    f32x4 acc[2][2][4][2];
#pragma unroll
    for (int a = 0; a < 2; ++a)
#pragma unroll
        for (int b = 0; b < 2; ++b)
#pragma unroll
            for (int m = 0; m < 4; ++m)
#pragma unroll
                for (int n = 0; n < 2; ++n) acc[a][b][m][n] = (f32x4){0.f, 0.f, 0.f, 0.f};
    bf16x8 At[4][2], B0[2][2], B1[2][2];
    const char* cA = (const char*)g.A + (size_t)cur.pm * tstep; const char* cB = (const char*)g.Bt + (size_t)cur.pn * tstep;
    PG8_STAGE(PG8_SB(0, 0), cB, voffB); PG8_STAGE(PG8_SA(0, 0), cA, voffA); PG8_STAGE(PG8_SB(0, 1), cB + hstep, voffB); PG8_STAGE(PG8_SA(0, 1), cA + hstep, voffA);
    if (wr == 1) PG8_BAR;
    PG8_WAIT_V(4); PG8_BAR;
    PG8_STAGE(PG8_SB(1, 0), cB + kstep, voffB); PG8_STAGE(PG8_SA(1, 0), cA + kstep, voffA); PG8_STAGE(PG8_SB(1, 1), cB + hstep + kstep, voffB);
    PG8_WAIT_V(6); PG8_BAR;
    for (;;) {
        const bool has_next = S.next(ui + 1, nxt);
        const char* nA = has_next ? (const char*)g.A + (size_t)nxt.pm * tstep : cA; const char* nB = has_next ? (const char*)g.Bt + (size_t)nxt.pn * tstep : cB;
        const bool rhalf = (cur.pn * BM + HALF) < g.Nvalid;
        for (int t = 0; t < nt; t += 2) {
            const bool last = (t == nt - 2);
            const char* a1 = cA + (size_t)(t + 1) * kstep;
            const char* a2 = last ? nA : cA + (size_t)(t + 2) * kstep; const char* b2 = last ? nB : cB + (size_t)(t + 2) * kstep;
            const char* a3 = a2 + kstep; const char* b3 = b2 + kstep;
            PG8_LDB(B0, 0, 0); PG8_SCHED; PG8_LDA(At, 0, 0); PG8_STAGE(PG8_SA(1, 1), a1 + hstep, voffA);
            PG8_WAIT_L(8); PG8_BAR; PG8_WAIT_L(0); PG8_MMA(0, 0, At, B0); PG8_BAR; PG8_SCHED;
            PG8_LDB(B1, 0, 1); PG8_STAGE(PG8_SB(0, 0), b2, voffB);
            PG8_BAR; PG8_WAIT_L(0); if (rhalf) PG8_MMA(0, 1, At, B1); PG8_BAR;
            PG8_LDA(At, 0, 1); PG8_STAGE(PG8_SA(0, 0), a2, voffA);
            PG8_BAR; PG8_WAIT_L(0); PG8_MMA(1, 0, At, B0); PG8_BAR; PG8_SCHED;
            PG8_STAGE(PG8_SB(0, 1), b2 + hstep, voffB);
            PG8_WAIT_V(6); PG8_BAR; if (rhalf) PG8_MMA(1, 1, At, B1); PG8_BAR;
            PG8_LDB(B0, 1, 0); PG8_SCHED; PG8_LDA(At, 1, 0); PG8_STAGE(PG8_SA(0, 1), a2 + hstep, voffA);
            PG8_WAIT_L(8); PG8_BAR; PG8_WAIT_L(0); PG8_MMA(0, 0, At, B0); PG8_BAR; PG8_SCHED;
            PG8_LDB(B1, 1, 1); PG8_STAGE(PG8_SB(1, 0), b3, voffB);
            PG8_BAR; PG8_WAIT_L(0); if (rhalf) PG8_MMA(0, 1, At, B1); PG8_BAR;
            PG8_LDA(At, 1, 1); PG8_STAGE(PG8_SA(1, 0), a3, voffA);
            PG8_BAR; PG8_WAIT_L(0); PG8_MMA(1, 0, At, B0); PG8_BAR; PG8_SCHED;
            PG8_STAGE(PG8_SB(1, 1), b3 + hstep, voffB);
            PG8_WAIT_V(6); PG8_BAR; if (rhalf) PG8_MMA(1, 1, At, B1); PG8_BAR;
        }
        if constexpr (!Epi::AFTER_DRAIN) E(acc, cur, wr, wc, fr, fq);
        if (!has_next) break;
#pragma unroll
        for (int a = 0; a < 2; ++a)
#pragma unroll
            for (int b = 0; b < 2; ++b)
#pragma unroll
                for (int m = 0; m < 4; ++m)
#pragma unroll
                    for (int n = 0; n < 2; ++n) acc[a][b][m][n] = (f32x4){0.f, 0.f, 0.f, 0.f};
        cur = nxt; cA = nA; cB = nB; ++ui;
    }
    PG8_WAIT_V(0);
    if (wr == 0) PG8_BAR;
    PG8_BAR;
    if constexpr (Epi::AFTER_DRAIN) E.fused(acc, cur, wr, wc, fr, fq, lds);
#undef PG8_SA
#undef PG8_SB
#undef PG8_STAGE
#undef PG8_LDA
#undef PG8_LDB
#undef PG8_MMA
#undef PG8_WAIT_V
#undef PG8_WAIT_L
#undef PG8_BAR
#undef PG8_SCHED
}

#define WSYNC() do { __builtin_amdgcn_wave_barrier(); asm volatile("s_waitcnt lgkmcnt(0)" ::: "memory"); __builtin_amdgcn_wave_barrier(); } while (0)
__device__ void phase0(const Params& p) {
    const int tid = threadIdx.x, lane = tid & 63, wave = tid >> 6, blk = blockIdx.x;
    u16* Hbf = (u16*)p.out;
#pragma unroll 1
    for (int r0 = 0; r0 < 8; r0 += 4) {
        f32x4 v[4][4]; float ss[4];
#pragma unroll
        for (int i = 0; i < 4; ++i) {
            const f32x4* xr = (const f32x4*)(p.x + (size_t)(blk * 64 + wave * 8 + r0 + i) * DM);
#pragma unroll
            for (int q = 0; q < 4; ++q) v[i][q] = __builtin_nontemporal_load(xr + lane + 64 * q);
        }
#pragma unroll
        for (int i = 0; i < 4; ++i) {
            float s = 0.f;
#pragma unroll
            for (int q = 0; q < 4; ++q) s += v[i][q][0] * v[i][q][0] + v[i][q][1] * v[i][q][1] + v[i][q][2] * v[i][q][2] + v[i][q][3] * v[i][q][3];
            ss[i] = wave_sum(s);
        }
#pragma unroll
        for (int i = 0; i < 4; ++i) {
            const int row = blk * 64 + wave * 8 + r0 + i;
            const float inv = rsq_(ss[i] * (1.f / 1024.f) + 1e-6f);
#pragma unroll
            for (int q = 0; q < 4; ++q) {
                const f32x4 g = ((const f32x4*)p.norm_gain)[lane + 64 * q];
                u32x2 o; o.x = pack2(v[i][q][0] * inv * g[0], v[i][q][1] * inv * g[1]); o.y = pack2(v[i][q][2] * inv * g[2], v[i][q][3] * inv * g[3]);
                *(u32x2*)(Hbf + (size_t)row * DM + (lane + 64 * q) * 4) = o;
            }
        }
    }
    u16* WinT = (u16*)(p.ws + WS_WINT); u16* WoutT = (u16*)(p.ws + WS_WOUTT);
    {
        float* tl = (float*)dyn_smem + wave * (64 * 65);
        const int t = blk + 256 * wave;
        if (t < 832 + 256) {
            const float* src; u16* dst; int kt, ntile, N;
            if (t < 832) { kt = t & 15; ntile = t >> 4; src = p.w_in; N = DIN; dst = WinT; }
            else { const int t2 = t - 832; kt = t2 & 15; ntile = t2 >> 4; src = p.w_out; N = 1024; dst = WoutT; }
            const int k0 = kt * 64, n0 = ntile * 64, n4 = (lane & 15) * 4;
            f32x4 v[16];
#pragma unroll
            for (int i = 0; i < 16; ++i) { const int kk = (lane >> 4) + 4 * i; v[i] = (n0 + n4 < N) ? *(const f32x4*)(src + (size_t)(k0 + kk) * N + n0 + n4) : (f32x4){0.f, 0.f, 0.f, 0.f}; }
#pragma unroll
            for (int i = 0; i < 16; ++i) { const int kk = (lane >> 4) + 4 * i; float* d = tl + kk * 65 + n4; d[0] = v[i][0]; d[1] = v[i][1]; d[2] = v[i][2]; d[3] = v[i][3]; }
            WSYNC();
            const int kp = lane & 31, nh = lane >> 5;
#pragma unroll 8
            for (int i = 0; i < 32; ++i) { const int nn = 2 * i + nh;
                *(unsigned*)(dst + (size_t)(n0 + nn) * 1024 + k0 + 2 * kp) = pack2(tl[(2 * kp) * 65 + nn], tl[(2 * kp + 1) * 65 + nn]); }
        }
    }
    u16* WupT = (u16*)(p.ws + WS_WUPT); u16* AupT = (u16*)(p.ws + WS_AUPT); u16* PoolT = (u16*)(p.ws + WS_POOLT);
    const int gt = blk * 512 + tid;
    if (gt < 32768) { const int c = gt >> 6, j = gt & 63; WupT[gt] = f2bf(p.w_up[j * 512 + c]); AupT[gt] = f2bf(p.a_up[j * 512 + c]); }
    if (gt < 65536) { const int g = gt >> 14, d = (gt >> 7) & 127, c = gt & 127; PoolT[gt] = f2bf(p.pool_w[(g * 128 + c) * 128 + d]); }
}

__device__ void phase1(const Params& p) {
    Gemm g; g.A = (const u16*)p.out; g.Bt = (const u16*)(p.ws + WS_WINT); g.M = NTOK; g.N = DINP; g.K = 1024; g.Nvalid = DIN;
    StaticOrder S; S.init(NTOK, DINP, 256, blockIdx.x);
    EpiZ E; E.Z = (u16*)(p.ws + WS_Z);
    gemm_phase((LAS unsigned char*)dyn_smem, g, S, E);
}
__device__ void phase4(const Params& p) {
    Gemm g; g.A = (const u16*)(p.ws + WS_Y); g.Bt = (const u16*)(p.ws + WS_WOUTT); g.M = NTOK; g.N = 1024; g.K = 1024; g.Nvalid = 1024;
    StaticOrder S; S.init(NTOK, 1024, 256, blockIdx.x);
    EpiResNorm E; E.x = p.x; E.gain = p.final_gain; E.out = p.out; E.part = (float*)(p.ws + WS_PART); E.cnt = (unsigned*)(p.ws + WS_CTL) + CTL_CNT_WORD;
    gemm_phase((LAS unsigned char*)dyn_smem, g, S, E);
}

template <int CTRL> __device__ __forceinline__ float dpp_add(float v) {
    const int t = __builtin_amdgcn_update_dpp(0, __float_as_int(v), CTRL, 0xf, 0xf, false);
    return v + __int_as_float(t);
}
__device__ __forceinline__ float row16_allsum(float v) {
    v = dpp_add<0x128>(v); v = dpp_add<0x124>(v); v = dpp_add<0x122>(v); v = dpp_add<0x121>(v);
    return v;
}
#define MFMA16(a, b, c) __builtin_amdgcn_mfma_f32_16x16x32_bf16((a), (b), (c), 0, 0, 0)
__device__ __forceinline__ bf16x8 as_bf8(u32x4 v) { return __builtin_bit_cast(bf16x8, v); }
template <int W> __device__ __forceinline__ void pooled_run(const u16* __restrict__ Z, u16* pooled, int t0, int s0, int cp, int hf) {
    const int c0 = 2 * cp, tb = hf * 32;
    unsigned raw[W - 1 + 32];
#pragma unroll
    for (int i = 0; i < W - 1 + 32; ++i) { const int tt = tb - (W - 1) + i; raw[i] = (s0 + tt >= 0) ? *(const unsigned*)(Z + (size_t)(t0 + tt) * DIN + c0) : 0u; }
    float sum0 = 0.f, sum1 = 0.f;
#pragma unroll
    for (int i = 0; i < W - 1; ++i) { sum0 += bflo(raw[i]); sum1 += bfhi(raw[i]); }
#pragma unroll
    for (int j = 0; j < 32; ++j) {
        const int tt = tb + j, s = s0 + tt;
        const float u0 = bflo(raw[W - 1 + j]), u1 = bfhi(raw[W - 1 + j]);
        sum0 += u0; sum1 += u1;
        const float rc = rcp_((float)((s + 1 < W) ? (s + 1) : W));
        *(unsigned*)(pooled + tt * 520 + c0) = pack2(sum0 * rc - u0, sum1 * rc - u1);
        sum0 -= bflo(raw[j]); sum1 -= bfhi(raw[j]);
    }
}
constexpr int RST = 912;
__device__ __forceinline__ void p2_zload(u32x4 (&zq)[7], const u16* __restrict__ Z, size_t T0, bool has_halo, int h, int lane) {
#pragma unroll
    for (int q = 0; q < 7; ++q) {
        const int pidx = lane + 64 * q, rr = pidx / 24, w = pidx - rr * 24, a = w >> 3, pc = w & 7;
        u32x4 v = (u32x4){0u, 0u, 0u, 0u};
        if (pidx < 17 * 24) {
            if (rr < 16) v = *(const u32x4*)(Z + (T0 + rr) * DIN + 1024 + a * 512 + h * 64 + pc * 8);
            else if (has_halo) v = *(const u32x4*)(Z + (T0 - 1) * DIN + 1024 + a * 512 + h * 64 + pc * 8);
        }
        zq[q] = v;
    }
}
constexpr int P2_WREG = 17408;
__device__ void phase2(const Params& p) {
    const int tid = threadIdx.x, lane = tid & 63, wave = tid >> 6, blk = blockIdx.x, fr = lane & 15, fq = lane >> 4;
    const int t0 = blk * 64, b = t0 >> 11, s0 = t0 & 2047;
    const u16* Z = (const u16*)(p.ws + WS_Z);
    u16* twb = (u16*)dyn_smem;
    u16* alb = twb + 64 * 72;
    u16* pooled = alb + 64 * 72;
    for (int e = tid; e < 64 * 128; e += 512) {
        const int tt = e >> 7, j = e & 127;
        const size_t zi = (size_t)(t0 + tt) * DIN + 2560 + j;
        const float cur = bf2f(Z[zi]);
        const float prev = (s0 + tt > 0) ? bf2f(Z[zi - DIN]) : 0.f;
        const float val = cur + p.shift_mu[1536 + j] * (prev - cur);
        if (j < 64) twb[tt * 72 + j] = f2bf(tanhf_(val)); else alb[tt * 72 + (j - 64)] = f2bf(val);
    }
    {
        const int cp = tid & 255, hf = tid >> 8;
        switch (wave & 3) {
            case 0: pooled_run<2>(Z, pooled, t0, s0, cp, hf); break;
            case 1: pooled_run<4>(Z, pooled, t0, s0, cp, hf); break;
            case 2: pooled_run<8>(Z, pooled, t0, s0, cp, hf); break;
            default: pooled_run<16>(Z, pooled, t0, s0, cp, hf); break;
        }
    }
    __syncthreads();
    {
        const int g = wave >> 1, dbase = (wave & 1) * 64, ch0 = g * 128 + dbase;
        const u16* PoolT = (const u16*)(p.ws + WS_POOLT); u16* Y = (u16*)(p.ws + WS_Y);
        unsigned char* gt = dyn_smem + 84992 + wave * 8704;
        u32x4 gq[8];
#pragma unroll
        for (int q = 0; q < 8; ++q) { const int idx = lane + 64 * q, row = idx >> 3, pc = idx & 7; gq[q] = *(const u32x4*)(Z + (size_t)(t0 + row) * DIN + 512 + ch0 + pc * 8); }
        f32x4 acc[4][4];
#pragma unroll
        for (int mt = 0; mt < 4; ++mt)
#pragma unroll
            for (int nt = 0; nt < 4; ++nt) acc[mt][nt] = (f32x4){0.f, 0.f, 0.f, 0.f};
#pragma unroll
        for (int ks = 0; ks < 4; ++ks) {
            bf16x8 Bf[4];
#pragma unroll
            for (int nt = 0; nt < 4; ++nt) Bf[nt] = *(const bf16x8*)(PoolT + (size_t)(ch0 + nt * 16 + fr) * 128 + ks * 32 + fq * 8);
#pragma unroll
            for (int mt = 0; mt < 4; ++mt) {
                const bf16x8 Af = *(const bf16x8*)(pooled + (mt * 16 + fr) * 520 + g * 128 + ks * 32 + fq * 8);
#pragma unroll
                for (int nt = 0; nt < 4; ++nt) acc[mt][nt] = MFMA16(Bf[nt], Af, acc[mt][nt]);
            }
        }
#pragma unroll
        for (int q = 0; q < 8; ++q) { const int idx = lane + 64 * q, row = idx >> 3, pc = idx & 7;
            *(u32x2*)(gt + row * 136 + pc * 16) = (u32x2){gq[q].x, gq[q].y}; *(u32x2*)(gt + row * 136 + pc * 16 + 8) = (u32x2){gq[q].z, gq[q].w}; }
        WSYNC();
#pragma unroll
        for (int mt = 0; mt < 4; ++mt) {
#pragma unroll
            for (int nt = 0; nt < 4; ++nt) {
                const int cl = nt * 16 + fq * 4;
                u32x2* slot = (u32x2*)(gt + (mt * 16 + fr) * 136 + cl * 2);
                const u32x2 ga = *slot;
                const f32x4 ps = *(const f32x4*)(p.pool_scale + ch0 + cl);
                const f32x4 gv = (f32x4){bflo(ga.x), bfhi(ga.x), bflo(ga.y), bfhi(ga.y)};
                f32x4 y;
#pragma unroll
                for (int jj = 0; jj < 4; ++jj) y[jj] = acc[mt][nt][jj] * ps[jj] * gv[jj] * sigmoidf_(gv[jj]);
                *slot = (u32x2){pack2(y[0], y[1]), pack2(y[2], y[3])};
            }
        }
        WSYNC();
#pragma unroll
        for (int q = 0; q < 8; ++q) { const int idx = lane + 64 * q, row = idx >> 3, pc = idx & 7;
            const u32x2 a = *(const u32x2*)(gt + row * 136 + pc * 16), b2 = *(const u32x2*)(gt + row * 136 + pc * 16 + 8);
            *(u32x4*)(Y + (size_t)(t0 + row) * 1024 + ch0 + pc * 8) = (u32x4){a.x, a.y, b2.x, b2.y}; }
    }
    __syncthreads();
    const int h = wave, bh = b * 8 + h;
    unsigned char* WL = dyn_smem + 18432 + wave * P2_WREG;
    unsigned char* recl = WL;
    u16* AR = (u16*)WL;
    u16* BK = AR + 32 * 72;
    u16* AtT = BK + 32 * 72;
    u16* BhT = AtT + 64 * 16;
    u16* KhT = BhT + 64 * 16;
    u16* VT = KhT + 64 * 16;
    float* Pab = (float*)WL;
    u16* Tm = (u16*)(Pab + 16 * 17);
    u16* AakT = Tm + 16 * 24;
    u16* M1m = AakT + 16 * 24;
    u16* Ark = M1m + 16 * 24;
    u16* Arb = Ark + 16 * 24;
    const u16* WupT = (const u16*)(p.ws + WS_WUPT); const u16* AupT = (const u16*)(p.ws + WS_AUPT);
    float* BON = (float*)(p.ws + WS_BONUS); u16* VB = (u16*)(p.ws + WS_VB);
    unsigned char* AFg = p.ws + CH_AF; unsigned char* RFg = p.ws + CH_RF; unsigned char* BKFg = p.ws + CH_BKF; unsigned char* ARBg = p.ws + CH_ARB;
    float* G15g = (float*)(p.ws + CH_G15); unsigned char* CHVg = (unsigned char*)p.out + OUT_CHV;
    const bf16x8 zero8 = (bf16x8){0, 0, 0, 0, 0, 0, 0, 0};
    const f32x4 zero4 = (f32x4){0.f, 0.f, 0.f, 0.f};
    bf16x8 BwF[2][4];
#pragma unroll
    for (int ks = 0; ks < 2; ++ks)
#pragma unroll
        for (int nt = 0; nt < 4; ++nt) BwF[ks][nt] = *(const bf16x8*)(WupT + (h * 64 + nt * 16 + fr) * 64 + ks * 32 + fq * 8);
#pragma unroll 1
    for (int mt = 0; mt < 4; ++mt) {
        const size_t u = (size_t)bh * 128 + (s0 >> 4) + mt;
        {
            u32x4 zq[7];
            p2_zload(zq, Z, (size_t)(t0 + mt * 16), (s0 + mt * 16) > 0, h, lane);
            f32x4 aw[4], aa[4];
#pragma unroll
            for (int nt = 0; nt < 4; ++nt) { aw[nt] = zero4; aa[nt] = zero4; }
#pragma unroll
            for (int ks = 0; ks < 2; ++ks) {
                const bf16x8 Aw = *(const bf16x8*)(twb + (mt * 16 + fr) * 72 + ks * 32 + fq * 8);
                const bf16x8 Aa = *(const bf16x8*)(alb + (mt * 16 + fr) * 72 + ks * 32 + fq * 8);
#pragma unroll
                for (int nt = 0; nt < 4; ++nt) {
                    const bf16x8 Ba = *(const bf16x8*)(AupT + (h * 64 + nt * 16 + fr) * 64 + ks * 32 + fq * 8);
                    aw[nt] = MFMA16(BwF[ks][nt], Aw, aw[nt]);
                    aa[nt] = MFMA16(Ba, Aa, aa[nt]);
                }
            }
#pragma unroll
            for (int q = 0; q < 7; ++q) {
                const int pidx = lane + 64 * q, rr = pidx / 24, w = pidx - rr * 24, a = w >> 3, pc = w & 7;
                if (pidx < 17 * 24) *(u32x4*)(recl + ((rr < 16) ? rr * RST + 256 : 16 * RST) + a * 128 + pc * 16) = zq[q];
            }
            WSYNC();
            const int tt = mt * 16 + fr, s = s0 + tt; const size_t T = (size_t)(t0 + tt);
            f32x4 Kr[4], Av[4];
            float n2 = 0.f, bon = 0.f;
            unsigned char* rec = recl + fr * RST;
            const unsigned char* prec = (fr > 0) ? (recl + (fr - 1) * RST) : (recl + 16 * RST - 256);
#pragma unroll
            for (int nt = 0; nt < 4; ++nt) {
                const int cb = h * 64 + nt * 16 + fq * 4, ci = nt * 16 + fq * 4;
                const u32x2 zr = *(const u32x2*)(rec + 256 + ci * 2), zk = *(const u32x2*)(rec + 384 + ci * 2), zv = *(const u32x2*)(rec + 512 + ci * 2);
                const u32x2 pr = *(const u32x2*)(prec + 256 + ci * 2), pk = *(const u32x2*)(prec + 384 + ci * 2), pv = *(const u32x2*)(prec + 512 + ci * 2);
                const f32x4 mur = *(const f32x4*)(p.shift_mu + cb), muk = *(const f32x4*)(p.shift_mu + 512 + cb), muv = *(const f32x4*)(p.shift_mu + 1024 + cb);
                const f32x4 w0v = *(const f32x4*)(p.w0 + cb), a0v = *(const f32x4*)(p.a0 + cb), kkv = *(const f32x4*)(p.k_k + cb), kav = *(const f32x4*)(p.k_a + cb), rkv = *(const f32x4*)(p.r_k + cb);
                const f32x4 cr = (f32x4){bflo(zr.x), bfhi(zr.x), bflo(zr.y), bfhi(zr.y)}, ck = (f32x4){bflo(zk.x), bfhi(zk.x), bflo(zk.y), bfhi(zk.y)}, cv = (f32x4){bflo(zv.x), bfhi(zv.x), bflo(zv.y), bfhi(zv.y)};
                const f32x4 qr = (f32x4){bflo(pr.x), bfhi(pr.x), bflo(pr.y), bfhi(pr.y)}, qk = (f32x4){bflo(pk.x), bfhi(pk.x), bflo(pk.y), bfhi(pk.y)}, qv = (f32x4){bflo(pv.x), bfhi(pv.x), bflo(pv.y), bfhi(pv.y)};
                f32x4 Rr, Kp, Vv, Dc;
#pragma unroll
                for (int jj = 0; jj < 4; ++jj) {
                    const float r = cr[jj] + mur[jj] * (qr[jj] - cr[jj]);
                    const float k = ck[jj] + muk[jj] * (qk[jj] - ck[jj]);
                    const float v = cv[jj] + muv[jj] * (qv[jj] - cv[jj]);
                    const float ww = aw[nt][jj] + w0v[jj];
                    const float a = sigmoidf_(aa[nt][jj] + a0v[jj]);
                    const float dec = __expf(-0.6065306597126334f * sigmoidf_(ww));
                    const float kr = k * kkv[jj];
                    n2 += kr * kr;
                    const float kp = k * (1.f + (a - 1.f) * kav[jj]);
                    bon += r * kp * rkv[jj];
                    Rr[jj] = r; Kp[jj] = kp; Vv[jj] = v; Kr[nt][jj] = kr; Av[nt][jj] = a; Dc[jj] = dec;
                }
                *(f32x4*)(rec + ci * 4) = Dc;
                *(u32x2*)(rec + 256 + ci * 2) = (u32x2){pack2(Rr[0], Rr[1]), pack2(Rr[2], Rr[3])};
                *(u32x2*)(rec + 384 + ci * 2) = (u32x2){pack2(Kp[0], Kp[1]), pack2(Kp[2], Kp[3])};
                const u32x2 vpk = (u32x2){pack2(Vv[0], Vv[1]), pack2(Vv[2], Vv[3])};
                *(u32x2*)(rec + 512 + ci * 2) = vpk;
            }
            n2 += __shfl_xor(n2, 16, 64); n2 += __shfl_xor(n2, 32, 64);
            bon += __shfl_xor(bon, 16, 64); bon += __shfl_xor(bon, 32, 64);
            const float inv = rsq_(fmaxf(n2, 1e-24f));
#pragma unroll
            for (int nt = 0; nt < 4; ++nt) {
                const int ci = nt * 16 + fq * 4;
                const f32x4 kk = Kr[nt] * inv;
                *(u32x2*)(rec + 640 + ci * 2) = (u32x2){pack2(kk[0], kk[1]), pack2(kk[2], kk[3])};
                const f32x4 nb = -(kk * Av[nt]);
                *(u32x2*)(rec + 768 + ci * 2) = (u32x2){pack2(nb[0], nb[1]), pack2(nb[2], nb[3])};
            }
            if (fq == 0) BON[(size_t)bh * 2048 + s] = bon;
        }
        WSYNC();
        {
            float w_[16], r_[16], kp_[16], kk_[16], nb_[16];
            {
                unsigned vv[16];
#pragma unroll
                for (int t = 0; t < 16; ++t) vv[t] = *(const u16*)(recl + t * RST + 512 + lane * 2);
                *(u32x4*)(VT + lane * 16) = (u32x4){vv[0] | (vv[1] << 16), vv[2] | (vv[3] << 16), vv[4] | (vv[5] << 16), vv[6] | (vv[7] << 16)};
                *(u32x4*)(VT + lane * 16 + 8) = (u32x4){vv[8] | (vv[9] << 16), vv[10] | (vv[11] << 16), vv[12] | (vv[13] << 16), vv[14] | (vv[15] << 16)};
            }
#pragma unroll
            for (int t = 0; t < 16; ++t) {
                const unsigned char* rt = recl + t * RST;
                w_[t] = *(const float*)(rt + lane * 4);
                r_[t] = bf2f(*(const u16*)(rt + 256 + lane * 2)); kp_[t] = bf2f(*(const u16*)(rt + 384 + lane * 2));
                kk_[t] = bf2f(*(const u16*)(rt + 640 + lane * 2)); nb_[t] = bf2f(*(const u16*)(rt + 768 + lane * 2));
            }
            WSYNC();
            float g = 1.f;
            float At[16], Bt[16], Kt[16];
#pragma unroll
            for (int t = 0; t < 16; ++t) {
                const float gp = g; g = g * w_[t]; const float ig = rcp_(g);
                const float a = kk_[t] * gp, rr = r_[t] * g, bb = nb_[t] * ig, kt = kp_[t] * ig;
                AR[t * 72 + lane] = f2bf(a); AR[(16 + t) * 72 + lane] = f2bf(rr); BK[t * 72 + lane] = f2bf(bb); BK[(16 + t) * 72 + lane] = f2bf(kt);
                At[t] = a; Bt[t] = bb; Kt[t] = kt;
            }
            u32x4 o0, o1;
            o0 = (u32x4){pack2(At[0], At[1]), pack2(At[2], At[3]), pack2(At[4], At[5]), pack2(At[6], At[7])};
            o1 = (u32x4){pack2(At[8], At[9]), pack2(At[10], At[11]), pack2(At[12], At[13]), pack2(At[14], At[15])};
            *(u32x4*)(AtT + lane * 16) = o0; *(u32x4*)(AtT + lane * 16 + 8) = o1;
            o0 = (u32x4){pack2(Bt[0] * g, Bt[1] * g), pack2(Bt[2] * g, Bt[3] * g), pack2(Bt[4] * g, Bt[5] * g), pack2(Bt[6] * g, Bt[7] * g)};
            o1 = (u32x4){pack2(Bt[8] * g, Bt[9] * g), pack2(Bt[10] * g, Bt[11] * g), pack2(Bt[12] * g, Bt[13] * g), pack2(Bt[14] * g, Bt[15] * g)};
            *(u32x4*)(BhT + lane * 16) = o0; *(u32x4*)(BhT + lane * 16 + 8) = o1;
            o0 = (u32x4){pack2(Kt[0] * g, Kt[1] * g), pack2(Kt[2] * g, Kt[3] * g), pack2(Kt[4] * g, Kt[5] * g), pack2(Kt[6] * g, Kt[7] * g)};
            o1 = (u32x4){pack2(Kt[8] * g, Kt[9] * g), pack2(Kt[10] * g, Kt[11] * g), pack2(Kt[12] * g, Kt[13] * g), pack2(Kt[14] * g, Kt[15] * g)};
            *(u32x4*)(KhT + lane * 16) = o0; *(u32x4*)(KhT + lane * 16 + 8) = o1;
            G15g[u * 64 + lane] = g;
        }
        WSYNC();
        {
            u32x2 rp[4];
#pragma unroll
            for (int ta = 0; ta < 4; ++ta) rp[ta] = *(const u32x2*)(AR + (16 + fr) * 72 + 16 * ta + 4 * fq);
            *(u32x4*)(RFg + (u * 64 + lane) * 32) = (u32x4){rp[0].x, rp[0].y, rp[1].x, rp[1].y};
            *(u32x4*)(RFg + (u * 64 + lane) * 32 + 16) = (u32x4){rp[2].x, rp[2].y, rp[3].x, rp[3].y};
#pragma unroll
            for (int ta = 0; ta < 4; ++ta) {
                const u32x2 b2 = *(const u32x2*)(BhT + (16 * ta + fr) * 16 + 4 * fq), k2 = *(const u32x2*)(KhT + (16 * ta + fr) * 16 + 4 * fq);
                *(u32x4*)(BKFg + ((u * 4 + ta) * 64 + lane) * 16) = (u32x4){b2.x, b2.y, k2.x, k2.y};
            }
#pragma unroll
            for (int sl = 0; sl < 4; ++sl) *(u32x2*)(CHVg + (((u * 4 + sl) * 3 + 2) * 64 + lane) * 8) = *(const u32x2*)(VT + (16 * sl + fr) * 16 + 4 * fq);
        }
        {
            f32x4 P00 = zero4, P01 = zero4, P10 = zero4, P11 = zero4;
#pragma unroll
            for (int s = 0; s < 2; ++s) {
                const bf16x8 a0 = *(const bf16x8*)(AR + fr * 72 + s * 32 + fq * 8), a1 = *(const bf16x8*)(AR + (16 + fr) * 72 + s * 32 + fq * 8);
                const bf16x8 b0 = *(const bf16x8*)(BK + fr * 72 + s * 32 + fq * 8), b1 = *(const bf16x8*)(BK + (16 + fr) * 72 + s * 32 + fq * 8);
                P00 = MFMA16(a0, b0, P00); P01 = MFMA16(a0, b1, P01); P10 = MFMA16(a1, b0, P10); P11 = MFMA16(a1, b1, P11);
            }
            WSYNC();
            float ak[4];
#pragma unroll
            for (int r = 0; r < 4; ++r) {
                const int i = 4 * fq + r, j = fr;
                Pab[i * 17 + j] = (j < i) ? P00[r] : 0.f;
                ak[r] = (j < i) ? P01[r] : 0.f;
                Arb[i * 24 + j] = f2bf((j <= i) ? P10[r] : 0.f);
                Ark[i * 24 + j] = f2bf((j <= i) ? P11[r] : 0.f);
            }
            *(u32x2*)(AakT + fr * 24 + 4 * fq) = (u32x2){pack2(ak[0], ak[1]), pack2(ak[2], ak[3])};
        }
        WSYNC();
        {
            float T[16];
#pragma unroll
            for (int i = 0; i < 16; ++i) T[i] = (i == fr) ? 1.f : 0.f;
#pragma unroll
            for (int j = 0; j < 15; ++j) {
#pragma unroll
                for (int i = j + 1; i < 16; ++i) T[i] += Pab[i * 17 + j] * T[j];
            }
#pragma unroll
            for (int i = 0; i < 16; ++i) Tm[i * 24 + fr] = f2bf(T[i]);
            *(u32x2*)(ARBg + (u * 64 + lane) * 8) = *(const u32x2*)(Arb + fr * 24 + 4 * fq);
        }
        WSYNC();
        const bf16x8 Tld = *(const bf16x8*)(Tm + fr * 24 + (fq & 1) * 8);
        const bf16x8 Tf = (fq < 2) ? Tld : zero8;
        {
            f32x4 D[4];
#pragma unroll
            for (int ta = 0; ta < 4; ++ta) {
                const bf16x8 ald = *(const bf16x8*)(AtT + (16 * ta + fr) * 16 + (fq & 1) * 8);
                D[ta] = MFMA16((fq < 2) ? ald : zero8, Tf, zero4);
            }
            *(u32x4*)(AFg + (u * 64 + lane) * 32) = (u32x4){pack2(D[0][0], D[0][1]), pack2(D[0][2], D[0][3]), pack2(D[1][0], D[1][1]), pack2(D[1][2], D[1][3])};
            *(u32x4*)(AFg + (u * 64 + lane) * 32 + 16) = (u32x4){pack2(D[2][0], D[2][1]), pack2(D[2][2], D[2][3]), pack2(D[3][0], D[3][1]), pack2(D[3][2], D[3][3])};
            const bf16x8 akld = *(const bf16x8*)(AakT + fr * 24 + (fq & 1) * 8);
            const f32x4 M1 = MFMA16(Tf, (fq < 2) ? akld : zero8, zero4);
#pragma unroll
            for (int r = 0; r < 4; ++r) M1m[(4 * fq + r) * 24 + fr] = f2bf(M1[r]);
        }
        WSYNC();
        {
            const bf16x8 m1ld = *(const bf16x8*)(M1m + fr * 24 + (fq & 1) * 8), rkld = *(const bf16x8*)(Ark + fr * 24 + (fq & 1) * 8);
            const bf16x8 M1f = (fq < 2) ? m1ld : zero8, Arkf = (fq < 2) ? rkld : zero8;
#pragma unroll
            for (int sl = 0; sl < 4; ++sl) {
                const bf16x8 vld = *(const bf16x8*)(VT + (16 * sl + fr) * 16 + (fq & 1) * 8);
                const bf16x8 Vb = (fq < 2) ? vld : zero8;
                const f32x4 Uh = MFMA16(M1f, Vb, zero4), Y0 = MFMA16(Arkf, Vb, zero4);
                *(u32x2*)(CHVg + (((u * 4 + sl) * 3 + 0) * 64 + lane) * 8) = (u32x2){pack2(Uh[0], Uh[1]), pack2(Uh[2], Uh[3])};
                *(u32x2*)(CHVg + (((u * 4 + sl) * 3 + 1) * 64 + lane) * 8) = (u32x2){pack2(Y0[0], Y0[1]), pack2(Y0[2], Y0[3])};
            }
        }
        WSYNC();
    }
}

struct ChunkOps { u32x4 af0, af1, rf0, rf1, bk0, bk1, bk2, bk3; u32x2 arb, uh, y0, vf; f32x4 g0, g1, g2, g3; };
constexpr int RING_SLOT = 17408, RING_NS = 7, RING_D = 6;
__device__ __forceinline__ void lds_chunk_ops(ChunkOps& o, const LAS unsigned char* s, int sl, int lane, int fq) {
    o.af0 = *(const LAS u32x4*)(s + lane * 32); o.af1 = *(const LAS u32x4*)(s + lane * 32 + 16);
    o.rf0 = *(const LAS u32x4*)(s + 2048 + lane * 32); o.rf1 = *(const LAS u32x4*)(s + 2048 + lane * 32 + 16);
    o.bk0 = *(const LAS u32x4*)(s + 4096 + (0 * 64 + lane) * 16); o.bk1 = *(const LAS u32x4*)(s + 4096 + (1 * 64 + lane) * 16);
    o.bk2 = *(const LAS u32x4*)(s + 4096 + (2 * 64 + lane) * 16); o.bk3 = *(const LAS u32x4*)(s + 4096 + (3 * 64 + lane) * 16);
    o.uh = *(const LAS u32x2*)(s + 8192 + ((sl * 3 + 0) * 64 + lane) * 8);
    o.y0 = *(const LAS u32x2*)(s + 8192 + ((sl * 3 + 1) * 64 + lane) * 8);
    o.vf = *(const LAS u32x2*)(s + 8192 + ((sl * 3 + 2) * 64 + lane) * 8);
    o.arb = *(const LAS u32x2*)(s + 16384 + lane * 8);
    o.g0 = *(const LAS f32x4*)(s + 16896 + 16 * fq); o.g1 = *(const LAS f32x4*)(s + 16896 + 64 + 16 * fq);
    o.g2 = *(const LAS f32x4*)(s + 16896 + 128 + 16 * fq); o.g3 = *(const LAS f32x4*)(s + 16896 + 192 + 16 * fq);
}
template <int LW> __device__ __forceinline__ void ring_issue(const Params& p, LAS unsigned char* ring, int bh, int c, int lane) {
    const size_t u = (size_t)bh * 128 + c;
    LAS unsigned char* slot = ring + (c % RING_NS) * RING_SLOT;
    const unsigned char* ws = p.ws; const unsigned char* od = (const unsigned char*)p.out;
#pragma unroll
    for (int j = 0; j < 8; ++j) {
        constexpr int Q0 = LW * 8; const int q = Q0 + j;
        const unsigned char* g;
        if (q < 2) g = ws + CH_AF + u * 2048 + q * 1024 + lane * 16;
        else if (q < 4) g = ws + CH_RF + u * 2048 + (q - 2) * 1024 + lane * 16;
        else if (q < 8) g = ws + CH_BKF + u * 4096 + (q - 4) * 1024 + lane * 16;
        else if (q < 14) g = od + OUT_CHV + u * 6144 + (q - 8) * 1024 + lane * 16;
        else { const int i = (q - 14) * 64 + lane; g = ws + WS_Z + (((size_t)(bh >> 3) * 2048 + c * 16 + (i >> 3)) * DIN + 2688 + (bh & 7) * 64) * 2 + (i & 7) * 16; }
        __builtin_amdgcn_global_load_lds((const unsigned*)g, (LAS unsigned*)(slot + q * 1024), 16, 0, 0);
    }
    if (LW == 0) {
        __builtin_amdgcn_global_load_lds((const unsigned*)(ws + CH_ARB + u * 512 + lane * 4), (LAS unsigned*)(slot + 16384), 4, 0, 0);
        __builtin_amdgcn_global_load_lds((const unsigned*)(ws + CH_ARB + u * 512 + 256 + lane * 4), (LAS unsigned*)(slot + 16384 + 256), 4, 0, 0);
    } else {
        __builtin_amdgcn_global_load_lds((const unsigned*)(ws + CH_G15 + u * 256 + lane * 4), (LAS unsigned*)(slot + 16896), 4, 0, 0);
        __builtin_amdgcn_global_load_lds((const unsigned*)(ws + WS_BONUS + ((size_t)bh * 2048 + c * 16) * 4 + (lane & 15) * 4), (LAS unsigned*)(slot + 17152), 4, 0, 0);
    }
}
template <int CTRL> __device__ __forceinline__ float dpp_add_q(float v) {
    const int t = __builtin_amdgcn_update_dpp(0, __float_as_int(v), CTRL, 0xf, 0xf, false);
    return v + __int_as_float(t);
}
__device__ __forceinline__ float oct_allsum(float v) {
    v = dpp_add_q<0xB1>(v); v = dpp_add_q<0x4E>(v); v = dpp_add_q<0x141>(v);
    return v;
}
struct EpiIn { u32x4 gb; float bon; u16 v[8]; };
__device__ __forceinline__ void epi_load(EpiIn& e, const LAS unsigned char* s, int t, int v0) {
    e.gb = *(const LAS u32x4*)(s + 14336 + t * 128 + v0 * 2);
    e.bon = *(const LAS float*)(s + 17152 + t * 4);
    const LAS unsigned char* vp = s + 8192 + (((v0 >> 4) * 3 + 2) * 64 + (t >> 2) * 16 + (v0 & 15)) * 8 + (t & 3) * 2;
#pragma unroll
    for (int i = 0; i < 8; ++i) e.v[i] = *(const LAS u16*)(vp + 8 * i);
}
template <int LW> __device__ __forceinline__ void p3_loader(const Params& p, LAS unsigned char* ring, int bh, int lane) {
#pragma unroll
    for (int c = 0; c < RING_D; ++c) ring_issue<LW>(p, ring, bh, c, lane);
    asm volatile("s_waitcnt vmcnt(40)" ::: "memory");
    __builtin_amdgcn_s_barrier();
#pragma unroll 1
    for (int c = 0; c < 128; ++c) {
        const int cn = (c + RING_D < 128) ? c + RING_D : 127;
        ring_issue<LW>(p, ring, bh, cn, lane);
        asm volatile("s_waitcnt vmcnt(40)" ::: "memory");
        __builtin_amdgcn_s_barrier();
    }
    asm volatile("s_waitcnt vmcnt(0)" ::: "memory");
}
__device__ void phase3(const Params& p) {
    const int tid = threadIdx.x, lane = tid & 63, wave = __builtin_amdgcn_readfirstlane(tid >> 6), fr = lane & 15, fq = lane >> 4;
    if ((blockIdx.x >> 3) & 3) return;
    const int bh = (blockIdx.x & 7) * 8 + (blockIdx.x >> 5);
    LAS unsigned char* ring = (LAS unsigned char*)dyn_smem;
    LAS float* ybuf = (LAS float*)(ring + RING_NS * RING_SLOT);
    if (wave >= 6) {
        const int e = (wave - 6) * 64 + lane, t = e >> 3, v0 = (e & 7) * 8, b = bh >> 3, h = bh & 7;
        f32x4 ga0 = *(const f32x4*)(p.gn_gain + h * 64 + v0), ga1 = *(const f32x4*)(p.gn_gain + h * 64 + v0 + 4);
        f32x4 bi0 = *(const f32x4*)(p.gn_bias + h * 64 + v0), bi1 = *(const f32x4*)(p.gn_bias + h * 64 + v0 + 4);
        u16* Y = (u16*)(p.ws + WS_Y);
        EpiIn cur, nxt;
        __builtin_amdgcn_s_barrier();
        epi_load(cur, ring, t, v0);
#pragma unroll 1
        for (int c = 0; c <= 128; ++c) {
            if (c >= 1) {
                const int cc = c - 1;
                { const int cn = (c < 128) ? c : 127; epi_load(nxt, ring + (cn % RING_NS) * RING_SLOT, t, v0); }
                const LAS float* yb = ybuf + (cc & 1) * (16 * 68) + t * 68 + v0;
                const f32x4 y0 = *(const LAS f32x4*)(yb), y1 = *(const LAS f32x4*)(yb + 4);
                float s1 = (y0[0] + y0[1]) + (y0[2] + y0[3]) + (y1[0] + y1[1]) + (y1[2] + y1[3]);
                float s2 = y0[0] * y0[0] + y0[1] * y0[1] + y0[2] * y0[2] + y0[3] * y0[3] + y1[0] * y1[0] + y1[1] * y1[1] + y1[2] * y1[2] + y1[3] * y1[3];
                s1 = oct_allsum(s1); s2 = oct_allsum(s2);
                const float mean = s1 * (1.f / 64.f);
                const float var = fmaxf(s2 * (1.f / 64.f) - mean * mean, 0.f);
                const float rstd = rsq_(var + 64e-5f);
                const float vvf[8] = {bf2f(cur.v[0]), bf2f(cur.v[1]), bf2f(cur.v[2]), bf2f(cur.v[3]), bf2f(cur.v[4]), bf2f(cur.v[5]), bf2f(cur.v[6]), bf2f(cur.v[7])};
                const float gbf[8] = {bflo(cur.gb.x), bfhi(cur.gb.x), bflo(cur.gb.y), bfhi(cur.gb.y), bflo(cur.gb.z), bfhi(cur.gb.z), bflo(cur.gb.w), bfhi(cur.gb.w)};
                float o[8];
#pragma unroll
                for (int i = 0; i < 8; ++i) {
                    const float yv = (i < 4) ? y0[i & 3] : y1[i & 3];
                    const float gn = (i < 4) ? ga0[i & 3] : ga1[i & 3], bs = (i < 4) ? bi0[i & 3] : bi1[i & 3];
                    const float yn = (yv - mean) * rstd * gn + bs;
                    o[i] = (yn + cur.bon * vvf[i]) * gbf[i] * sigmoidf_(gbf[i]);
                }
                *(u32x4*)(Y + ((size_t)b * 2048 + cc * 16 + t) * 1024 + 512 + h * 64 + v0) = (u32x4){pack2(o[0], o[1]), pack2(o[2], o[3]), pack2(o[4], o[5]), pack2(o[6], o[7])};
                cur = nxt;
            }
            if (c < 128) __builtin_amdgcn_s_barrier();
        }
        return;
    }
    if (wave >= 4) { if (wave == 4) p3_loader<0>(p, ring, bh, lane); else p3_loader<1>(p, ring, bh, lane); return; }
    const int sl = wave;
    f32x4 acc0 = (f32x4){0.f, 0.f, 0.f, 0.f}, acc1 = acc0, acc2 = acc0, acc3 = acc0;
    ChunkOps cur, nxt;
    __builtin_amdgcn_s_barrier();
    lds_chunk_ops(cur, ring, sl, lane, fq);
#pragma unroll 2
    for (int c = 0; c < 128; ++c) {
        { const int cn = (c + 1 < 128) ? c + 1 : c; lds_chunk_ops(nxt, ring + (cn % RING_NS) * RING_SLOT, sl, lane, fq); }
        const bf16x8 sb0 = as_bf8((u32x4){pack2(acc0[0], acc0[1]), pack2(acc0[2], acc0[3]), pack2(acc1[0], acc1[1]), pack2(acc1[2], acc1[3])});
        const bf16x8 sb1 = as_bf8((u32x4){pack2(acc2[0], acc2[1]), pack2(acc2[2], acc2[3]), pack2(acc3[0], acc3[1]), pack2(acc3[2], acc3[3])});
        f32x4 U = (f32x4){bflo(cur.uh.x), bfhi(cur.uh.x), bflo(cur.uh.y), bfhi(cur.uh.y)};
        U = MFMA16(as_bf8(cur.af0), sb0, U); U = MFMA16(as_bf8(cur.af1), sb1, U);
        f32x4 Yv = (f32x4){bflo(cur.y0.x), bfhi(cur.y0.x), bflo(cur.y0.y), bfhi(cur.y0.y)};
        Yv = MFMA16(as_bf8(cur.rf0), sb0, Yv); Yv = MFMA16(as_bf8(cur.rf1), sb1, Yv);
        const unsigned u01 = pack2(U[0], U[1]), u23 = pack2(U[2], U[3]);
        Yv = MFMA16(as_bf8((u32x4){cur.arb.x, cur.arb.y, 0u, 0u}), as_bf8((u32x4){u01, u23, 0u, 0u}), Yv);
        const bf16x8 uvb = as_bf8((u32x4){u01, u23, cur.vf.x, cur.vf.y});
        acc0 = MFMA16(as_bf8(cur.bk0), uvb, acc0 * cur.g0); acc1 = MFMA16(as_bf8(cur.bk1), uvb, acc1 * cur.g1);
        acc2 = MFMA16(as_bf8(cur.bk2), uvb, acc2 * cur.g2); acc3 = MFMA16(as_bf8(cur.bk3), uvb, acc3 * cur.g3);
        LAS float* yb = ybuf + (c & 1) * (16 * 68) + (4 * fq) * 68 + sl * 16 + fr;
        yb[0] = Yv[0]; yb[68] = Yv[1]; yb[136] = Yv[2]; yb[204] = Yv[3];
        asm volatile("s_waitcnt lgkmcnt(0)" ::: "memory");
        __builtin_amdgcn_s_barrier();
        asm volatile("" ::: "memory");
        cur = nxt;
    }
}

__device__ void phase5(const Params& p) {
    const int tid = threadIdx.x, lane = tid & 63, wave = tid >> 6, blk = blockIdx.x;
#pragma unroll 1
    for (int r0 = 0; r0 < 8; r0 += 4) {
        f32x4 v[4][4]; float ss[4];
#pragma unroll
        for (int i = 0; i < 4; ++i) {
            const f32x4* xr = (const f32x4*)(p.out + (size_t)(blk * 64 + wave * 8 + r0 + i) * DM);
#pragma unroll
            for (int q = 0; q < 4; ++q) v[i][q] = xr[lane + 64 * q];
        }
#pragma unroll
        for (int i = 0; i < 4; ++i) {
            float s = 0.f;
#pragma unroll
            for (int q = 0; q < 4; ++q) s += v[i][q][0] * v[i][q][0] + v[i][q][1] * v[i][q][1] + v[i][q][2] * v[i][q][2] + v[i][q][3] * v[i][q][3];
            ss[i] = wave_sum(s);
        }
#pragma unroll
        for (int i = 0; i < 4; ++i) {
            f32x4* xr = (f32x4*)(p.out + (size_t)(blk * 64 + wave * 8 + r0 + i) * DM);
            const float inv = rsq_(ss[i] * (1.f / 1024.f) + 1e-6f);
#pragma unroll
            for (int q = 0; q < 4; ++q) { const f32x4 g = ((const f32x4*)p.final_gain)[lane + 64 * q]; xr[lane + 64 * q] = v[i][q] * inv * g; }
        }
    }
}

__global__ void __launch_bounds__(512, 2) hybrid_fwd(Params p) {
    __shared__ uint4 xb_words;
    if (threadIdx.x == 0) xb_words = make_uint4(0u, 0u, 0u, 0u);
    __syncthreads();
    XcdBarrier bar; bar.bar = (unsigned*)(p.ws + WS_CTL); bar.x = 0; bar.st = (volatile LAS unsigned*)&xb_words;
    const int lo = p.ph_lo, hi = p.ph_hi;
    if (hi - lo > 1) bar = xcd_barrier_post((unsigned*)(p.ws + WS_CTL), (volatile LAS unsigned*)&xb_words);
#define IN(k) (lo <= (k) && (k) < hi)
#define SEAM(k) do { if (IN(k) && IN((k) + 1)) xcd_barrier(bar); } while (0)
#define RUN(k, f) do { if (IN(k)) { if (PROBE_DUP == (k)) { for (int _r = 0; _r < p.dup_n; ++_r) { if (_r) __syncthreads(); f(p); } } else f(p); } } while (0)
    RUN(0, phase0);
    SEAM(0);
    RUN(1, phase1);
    SEAM(1);
    RUN(2, phase2);
    SEAM(2);
    RUN(3, phase3);
    SEAM(3);
    RUN(4, phase4);
}

extern "C" void kernel_launch(void* const* d_in, const int* in_sizes, int n_in, void* d_out, int out_size, void* d_ws, size_t ws_size, hipStream_t stream) {
    static int grid = 0;
    if (grid == 0) {
        if (n_in != 17 || out_size != NTOK * DM || ws_size < WS_END) { fprintf(stderr, "kernel_launch: unexpected problem (n_in %d out %d ws %zu need %zu)\n", n_in, out_size, ws_size, (size_t)WS_END); grid = -1; return; }
        if (hipFuncSetAttribute((const void*)hybrid_fwd, hipFuncAttributeMaxDynamicSharedMemorySize, LDS_BYTES) != hipSuccess) { fprintf(stderr, "kernel_launch: hipFuncSetAttribute failed\n"); grid = -1; return; }
        int per_cu = 0;
        if (hipOccupancyMaxActiveBlocksPerMultiprocessor(&per_cu, (const void*)hybrid_fwd, 512, LDS_BYTES) != hipSuccess || per_cu < 1) fprintf(stderr, "kernel_launch: occupancy query says %d blocks per CU\n", per_cu);
        (void)hipGetLastError();
        grid = 256;
    }
    if (grid < 0) return;
    (void)hipMemsetAsync((char*)d_ws + WS_CTL, 0, 16384, stream);
    Params p{};
    p.x = (const float*)d_in[0]; p.norm_gain = (const float*)d_in[1]; p.w_in = (const float*)d_in[2]; p.pool_w = (const float*)d_in[3];
    p.pool_scale = (const float*)d_in[4]; p.shift_mu = (const float*)d_in[5]; p.w0 = (const float*)d_in[6]; p.w_up = (const float*)d_in[7];
    p.a0 = (const float*)d_in[8]; p.a_up = (const float*)d_in[9]; p.k_k = (const float*)d_in[10]; p.k_a = (const float*)d_in[11];
    p.r_k = (const float*)d_in[12]; p.gn_gain = (const float*)d_in[13]; p.gn_bias = (const float*)d_in[14]; p.w_out = (const float*)d_in[15];
    p.final_gain = (const float*)d_in[16];
    p.out = (float*)d_out; p.ws = (unsigned char*)d_ws; p.dup_n = 2;
#if N_LAUNCHES == 1
    p.ph_lo = 0; p.ph_hi = NPH;
    hipLaunchKernelGGL(hybrid_fwd, dim3(grid), dim3(512), LDS_BYTES, stream, p);
#else
    for (int k = 0; k < NPH; ++k) { p.ph_lo = k; p.ph_hi = k + 1; hipLaunchKernelGGL(hybrid_fwd, dim3(grid), dim3(512), LDS_BYTES, stream, p); }
#endif
}
```
